# Optimizing an MI355X kernel written in HIP

```python
import math
import jax, jax.numpy as jnp
from jax import lax
import numpy as np

D_MODEL = 1024
BATCH = 16
SEQ = 2048
DEPTH = 2

N_GROUPS = 4
GROUP_WIDTH = D_MODEL // N_GROUPS
MIX_WIDTH = N_GROUPS * GROUP_WIDTH
HEAD_DIM = 64
GROUP_HEADS = GROUP_WIDTH // HEAD_DIM
N_IN_SLICES = 10
ROPE_THETA = 10000.0
MOBA_BLOCK = 256
MOBA_TOPK = 3
MOBA_QCHUNK = 16
DILATED_CONFIGS = ((128, 1), (512, 4), (2048, 16))
GMLP_CHUNK = 128
GMLP_GROUPS = 4
CONV_WIDTH = 31
D_FF_DENSE = 2816
N_EXPERTS = 8
TOP_K = 2
D_FF_EXPERT = 3584
MOE_ROW_BLOCK = 256
N_DENSE_LAYERS = (DEPTH + 1) // 2
N_MOE_LAYERS = DEPTH // 2
NORM_EPS = 1e-6
NEG_INF = -1e30
ATTN_SCALE = HEAD_DIM ** -0.5

kernel_name = 'hybrid_moba_dilated_gmlp_conformer_moe_block'


def rmsnorm(x, g):
    xf = x.astype(jnp.float32)
    y = xf * lax.rsqrt(jnp.mean(xf * xf, axis=-1, keepdims=True) + NORM_EPS)
    return (y * g.astype(jnp.float32)).astype(x.dtype)


def layernorm(x):
    xf = x.astype(jnp.float32)
    mu = jnp.mean(xf, axis=-1, keepdims=True)
    var = jnp.mean(jnp.square(xf - mu), axis=-1, keepdims=True)
    return ((xf - mu) * lax.rsqrt(var + NORM_EPS)).astype(x.dtype)


def rope(x, positions):
    half = HEAD_DIM // 2
    inv_freq = jnp.power(ROPE_THETA, -jnp.arange(half, dtype=jnp.float32) / half)
    ang = positions.astype(jnp.float32)[..., None] * inv_freq
    cos = jnp.cos(ang)[:, :, None, :]
    sin = jnp.sin(ang)[:, :, None, :]
    x1 = x[..., :half].astype(jnp.float32)
    x2 = x[..., half:].astype(jnp.float32)
    return jnp.concatenate([x1 * cos - x2 * sin, x2 * cos + x1 * sin], axis=-1).astype(x.dtype)


def swiglu(x, w_gate, w_up, w_down):
    return (jax.nn.silu(x @ w_gate) * (x @ w_up)) @ w_down


def moba_attention(q, k, v):
    B, S, H, D = q.shape
    s_pad = -(-S // MOBA_BLOCK) * MOBA_BLOCK
    n_blk = s_pad // MOBA_BLOCK
    pad = ((0, 0), (0, s_pad - S), (0, 0), (0, 0))
    q, k, v = (jnp.pad(t, pad).transpose(0, 2, 1, 3) for t in (q, k, v))
    kb = k.reshape(B, H, n_blk, MOBA_BLOCK, D)
    vb = v.reshape(B, H, n_blk, MOBA_BLOCK, D)
    k_mean = jnp.mean(kb.astype(jnp.float32), axis=3)
    gate = jnp.einsum('bhsd,bhnd->bhsn', q.astype(jnp.float32), k_mean)
    q_blk = jnp.arange(s_pad) // MOBA_BLOCK
    past = jnp.arange(n_blk)[None, :] < q_blk[:, None]
    gate = jnp.where(past, gate, NEG_INF)
    n_sel = min(MOBA_TOPK, n_blk)
    _, sel = lax.top_k(gate, n_sel)
    sel_ok = sel < q_blk[:, None]
    n_chunks = s_pad // MOBA_QCHUNK

    def to_chunks(t):
        return jnp.moveaxis(t.reshape(B, H, n_chunks, MOBA_QCHUNK, *t.shape[3:]), 2, 0)

    b_idx = jnp.arange(B)[:, None, None, None]
    h_idx = jnp.arange(H)[None, :, None, None]
    key_off = jnp.arange(MOBA_BLOCK)
    q_off = jnp.arange(MOBA_QCHUNK)

    def chunk(args):
        qc, selc, okc, start = args
        blk = start // MOBA_BLOCK
        k_own = lax.dynamic_index_in_dim(kb, blk, axis=2, keepdims=False)
        v_own = lax.dynamic_index_in_dim(vb, blk, axis=2, keepdims=False)
        causal = (blk * MOBA_BLOCK + key_off)[None, :] <= (start + q_off)[:, None]
        s_own = jnp.einsum('bhqd,bhkd->bhqk', qc, k_own).astype(jnp.float32) * ATTN_SCALE
        s_own = jnp.where(causal, s_own, NEG_INF)
        k_g = kb[b_idx, h_idx, selc]
        v_g = vb[b_idx, h_idx, selc]
        s_sel = jnp.einsum('bhqd,bhqnkd->bhqnk', qc, k_g).astype(jnp.float32) * ATTN_SCALE
        s_sel = jnp.where(okc[..., None], s_sel, NEG_INF).reshape(B, H, MOBA_QCHUNK, n_sel * MOBA_BLOCK)
        p = jax.nn.softmax(jnp.concatenate([s_own, s_sel], axis=-1), axis=-1)
        p_own = p[..., :MOBA_BLOCK]
        p_sel = p[..., MOBA_BLOCK:].reshape(B, H, MOBA_QCHUNK, n_sel, MOBA_BLOCK)
        return (jnp.einsum('bhqk,bhkd->bhqd', p_own, v_own)
                + jnp.einsum('bhqnk,bhqnkd->bhqd', p_sel, v_g))

    starts = jnp.arange(n_chunks, dtype=jnp.int32) * MOBA_QCHUNK
    out = lax.map(chunk, (to_chunks(q), to_chunks(sel), to_chunks(sel_ok), starts))
    out = jnp.moveaxis(out, 0, 2).reshape(B, H, s_pad, D)[:, :, :S]
    return out.transpose(0, 2, 1, 3).astype(q.dtype)


def strided_window_attention(q, k, v, span, dil):
    B, S, H, D = q.shape
    L = S // dil
    blk = span
    l_pad = -(-L // blk) * blk
    nb = l_pad // blk

    def sub(t):
        t = t.reshape(B, L, dil, H, D).transpose(0, 2, 3, 1, 4)
        t = jnp.pad(t, ((0, 0), (0, 0), (0, 0), (0, l_pad - L), (0, 0)))
        return t.reshape(B, dil, H, nb, blk, D)

    def band_keys(t):
        prev = jnp.pad(t, ((0, 0), (0, 0), (0, 0), (1, 0), (0, 0), (0, 0)))[:, :, :, :-1]
        return jnp.concatenate([prev, t], axis=4)

    qs = sub(q)
    k_span = band_keys(sub(k))
    v_span = band_keys(sub(v))
    qi = jnp.arange(blk)[:, None]
    kj = jnp.arange(2 * blk)[None, :]
    rel = blk + qi - kj
    band = (rel >= 0) & (rel <= span)
    not_first = jnp.arange(nb)[:, None, None] > 0
    mask = band[None] & (not_first | (kj >= blk)[None])
    s = jnp.einsum('bghnqd,bghnkd->bghnqk', qs, k_span).astype(jnp.float32) * ATTN_SCALE
    s = jnp.where(mask, s, NEG_INF)
    m = jnp.max(s, axis=-1, keepdims=True)
    p = jnp.exp(s - m)
    den = jnp.sum(p, axis=-1, keepdims=True)
    o = jnp.einsum('bghnqk,bghnkd->bghnqd', p, v_span) / den
    lse = (m + jnp.log(den))[..., 0]
    o = o.reshape(B, dil, H, l_pad, D)[:, :, :, :L].transpose(0, 3, 1, 2, 4).reshape(B, S, H, D)
    lse = lse.reshape(B, dil, H, l_pad)[..., :L].transpose(0, 3, 1, 2).reshape(B, S, H)
    return o, lse


def dilated_attention(q, k, v):
    outs, lses = zip(*[strided_window_attention(q, k, v, w // d, d) for (w, d) in DILATED_CONFIGS])
    o = jnp.stack(outs)
    wts = jax.nn.softmax(jnp.stack(lses), axis=0)
    return jnp.sum(wts[..., None] * o, axis=0).astype(q.dtype)


def spatial_gating(u, v, ws, b):
    B, S, C = v.shape
    n_chunk = S // GMLP_CHUNK
    vg = layernorm(v).reshape(B, n_chunk, GMLP_CHUNK, GMLP_GROUPS, C // GMLP_GROUPS)
    causal = jnp.tril(jnp.ones((GMLP_CHUNK, GMLP_CHUNK), dtype=bool))
    w = jnp.where(causal, ws, 0)
    z = jnp.einsum('gts,bnsgc->bntgc', w, vg) + b.T[:, :, None]
    return u * z.reshape(B, S, C)


def conv_module(a, g, conv_w, conv_b, ln_g, ln_b):
    x = a * jax.nn.sigmoid(g)
    C = x.shape[-1]
    y = lax.conv_general_dilated(x, conv_w[:, None, :], window_strides=(1,),
                                 padding=((CONV_WIDTH - 1, 0),),
                                 dimension_numbers=('NWC', 'WIO', 'NWC'),
                                 feature_group_count=C) + conv_b
    y = layernorm(y) * ln_g + ln_b
    return jax.nn.silu(y)


def hybrid_mixer(h, positions, w_in, w_out, group_g, gmlp_ws, gmlp_b,
                 conv_w, conv_b, conv_ln_g, conv_ln_b):
    B, S, _ = h.shape
    qa, ka, va, qb, kb, vb, u, vg, ga, gg = jnp.split(h @ w_in, N_IN_SLICES, axis=-1)

    def heads(t):
        return t.reshape(B, S, GROUP_HEADS, HEAD_DIM)

    o_a = moba_attention(rope(heads(qa), positions), rope(heads(ka), positions), heads(va))
    o_b = dilated_attention(rope(heads(qb), positions), rope(heads(kb), positions), heads(vb))
    o_c = spatial_gating(jax.nn.gelu(u), jax.nn.gelu(vg), gmlp_ws, gmlp_b)
    o_d = conv_module(ga, gg, conv_w, conv_b, conv_ln_g, conv_ln_b)
    mix = jnp.concatenate([o_a.reshape(B, S, GROUP_WIDTH), o_b.reshape(B, S, GROUP_WIDTH), o_c, o_d], axis=-1)
    mix = rmsnorm(mix.reshape(B, S, N_GROUPS, GROUP_WIDTH), group_g).reshape(B, S, MIX_WIDTH)
    return mix @ w_out


def moe_swiglu(h, router_w, router_b, w_gate, w_up, w_down):
    B, S, D = h.shape
    n_tok = B * S
    n_assign = n_tok * TOP_K
    xt = h.reshape(n_tok, D)
    logits = (xt @ router_w).astype(jnp.float32) + router_b.astype(jnp.float32)
    top_logit, top_idx = lax.top_k(logits, TOP_K)
    gates = jax.nn.softmax(top_logit, axis=-1).reshape(n_assign)
    expert = top_idx.reshape(n_assign)
    order = jnp.argsort(expert)
    e_sorted = expert[order]
    tok_sorted = order // TOP_K
    g_sorted = gates[order]
    counts = jnp.bincount(expert, length=N_EXPERTS)
    starts = jnp.cumsum(counts) - counts
    padded = (counts + MOE_ROW_BLOCK - 1) // MOE_ROW_BLOCK * MOE_ROW_BLOCK
    pad_end = jnp.cumsum(padded)
    pad_start = pad_end - padded
    dest = pad_start[e_sorted] + jnp.arange(n_assign) - starts[e_sorted]
    n_blocks = -(-n_assign // MOE_ROW_BLOCK) + N_EXPERTS
    rows = jnp.zeros((n_blocks * MOE_ROW_BLOCK, D), h.dtype).at[dest].set(xt[tok_sorted])
    block_expert = jnp.clip(jnp.searchsorted(pad_end, jnp.arange(n_blocks) * MOE_ROW_BLOCK, side='right'),
                            0, N_EXPERTS - 1)

    def run_block(args):
        xb, e = args
        return swiglu(xb, w_gate[e], w_up[e], w_down[e])

    out = lax.map(run_block, (rows.reshape(n_blocks, MOE_ROW_BLOCK, D), block_expert)).reshape(-1, D)
    y = jax.ops.segment_sum(out[dest] * g_sorted[:, None], tok_sorted, num_segments=n_tok)
    return y.reshape(B, S, D).astype(h.dtype)


def setup_inputs(seed: int = 0) -> dict:
    key = jax.random.key(seed)
    ks = jax.random.split(key, 26)

    def nrm(k, shape, scale):
        return jax.random.normal(k, shape, jnp.float32) * scale

    def gain(k, shape):
        return 1.0 + 0.05 * jax.random.normal(k, shape, jnp.float32)

    positions = (jax.random.randint(ks[2], (BATCH, 1), 0, 4096, dtype=jnp.int32)
                 + jnp.arange(SEQ, dtype=jnp.int32)[None, :])
    return {
        'x': nrm(ks[0], (BATCH, SEQ, D_MODEL), 1.0),
        'c': nrm(ks[1], (BATCH, D_MODEL), 1.0),
        'positions': positions,
        'ada_w': nrm(ks[3], (DEPTH, D_MODEL, 6 * D_MODEL), 0.5 * D_MODEL ** -0.5),
        'ada_b': nrm(ks[4], (DEPTH, 6 * D_MODEL), 0.02),
        'mix_pre_g': gain(ks[5], (DEPTH, D_MODEL)),
        'mix_post_g': gain(ks[6], (DEPTH, D_MODEL)),
        'ffn_pre_g': gain(ks[7], (DEPTH, D_MODEL)),
        'ffn_post_g': gain(ks[8], (DEPTH, D_MODEL)),
        'w_in': nrm(ks[9], (DEPTH, D_MODEL, N_IN_SLICES * GROUP_WIDTH), D_MODEL ** -0.5),
        'w_out': nrm(ks[10], (DEPTH, MIX_WIDTH, D_MODEL), MIX_WIDTH ** -0.5),
        'group_out_g': gain(ks[11], (DEPTH, N_GROUPS, GROUP_WIDTH)),
        'gmlp_ws': nrm(ks[12], (DEPTH, GMLP_GROUPS, GMLP_CHUNK, GMLP_CHUNK), GMLP_CHUNK ** -0.5),
        'gmlp_b': gain(ks[13], (DEPTH, GMLP_GROUPS, GMLP_CHUNK)),
        'conv_w': nrm(ks[14], (DEPTH, CONV_WIDTH, GROUP_WIDTH), CONV_WIDTH ** -0.5),
        'conv_b': nrm(ks[15], (DEPTH, GROUP_WIDTH), 0.02),
        'conv_ln_g': gain(ks[16], (DEPTH, GROUP_WIDTH)),
        'conv_ln_b': nrm(ks[17], (DEPTH, GROUP_WIDTH), 0.02),
        'ffn_w_gate': nrm(ks[18], (N_DENSE_LAYERS, D_MODEL, D_FF_DENSE), D_MODEL ** -0.5),
        'ffn_w_up': nrm(ks[19], (N_DENSE_LAYERS, D_MODEL, D_FF_DENSE), D_MODEL ** -0.5),
        'ffn_w_down': nrm(ks[20], (N_DENSE_LAYERS, D_FF_DENSE, D_MODEL), D_FF_DENSE ** -0.5),
        'router_w': nrm(ks[21], (N_MOE_LAYERS, D_MODEL, N_EXPERTS), D_MODEL ** -0.5),
        'router_b': nrm(ks[22], (N_MOE_LAYERS, N_EXPERTS), 0.01),
        'moe_w_gate': nrm(ks[23], (N_MOE_LAYERS, N_EXPERTS, D_MODEL, D_FF_EXPERT), D_MODEL ** -0.5),
        'moe_w_up': nrm(ks[24], (N_MOE_LAYERS, N_EXPERTS, D_MODEL, D_FF_EXPERT), D_MODEL ** -0.5),
        'moe_w_down': nrm(ks[25], (N_MOE_LAYERS, N_EXPERTS, D_FF_EXPERT, D_MODEL), D_FF_EXPERT ** -0.5),
    }


def reference(x, c, positions, ada_w, ada_b, mix_pre_g, mix_post_g, ffn_pre_g, ffn_post_g,
              w_in, w_out, group_out_g, gmlp_ws, gmlp_b, conv_w, conv_b, conv_ln_g, conv_ln_b,
              ffn_w_gate, ffn_w_up, ffn_w_down, router_w, router_b, moe_w_gate, moe_w_up, moe_w_down):
    c_act = jax.nn.silu(c)
    for layer in range(DEPTH):
        mod = c_act @ ada_w[layer] + ada_b[layer]
        sh_m, sc_m, gt_m, sh_f, sc_f, gt_f = (t[:, None, :] for t in jnp.split(mod, 6, axis=-1))
        h = rmsnorm(x, mix_pre_g[layer]) * (1 + sc_m) + sh_m
        y = hybrid_mixer(h, positions, w_in[layer], w_out[layer], group_out_g[layer],
                         gmlp_ws[layer], gmlp_b[layer], conv_w[layer], conv_b[layer],
                         conv_ln_g[layer], conv_ln_b[layer])
        x = x + gt_m * rmsnorm(y, mix_post_g[layer])
        h = rmsnorm(x, ffn_pre_g[layer]) * (1 + sc_f) + sh_f
        i = layer // 2
        if layer % 2 == 0:
            y = swiglu(h, ffn_w_gate[i], ffn_w_up[i], ffn_w_down[i])
        else:
            y = moe_swiglu(h, router_w[i], router_b[i], moe_w_gate[i], moe_w_up[i], moe_w_down[i])
        x = x + gt_f * rmsnorm(y, ffn_post_g[layer])
    return x
```

```cpp
#include <hip/hip_runtime.h>
#include <cstdio>
#include <cstdint>

#ifndef MK_ONE_LAUNCH
#define MK_ONE_LAUNCH 0
#endif

#define GAS __attribute__((address_space(1)))
#define LAS __attribute__((address_space(3)))
typedef unsigned short bf16;
typedef short bf16x8 __attribute__((ext_vector_type(8)));
typedef float f32x4 __attribute__((ext_vector_type(4)));
typedef float f32x16 __attribute__((ext_vector_type(16)));
typedef unsigned u32x4 __attribute__((ext_vector_type(4)));
typedef unsigned u32x2 __attribute__((ext_vector_type(2)));
typedef float f32x2_t __attribute__((ext_vector_type(2)));
typedef __bf16 bf16x2_t __attribute__((ext_vector_type(2)));
typedef short v4i16_t __attribute__((ext_vector_type(4)));
typedef GAS unsigned gu32;

constexpr int BATCH = 16, SEQ = 2048, D = 1024, M = BATCH * SEQ;
constexpr int NIN = 2560, PW = 2304;
constexpr int FFD = 2816, FFE = 3584, NEXP = 8;
constexpr float EPS = 1e-6f;
constexpr float C2 = 0.125f * 1.4426950408889634f;
constexpr int P_QA = 0, P_KA = 256, P_VA = 512, P_QB = 768, P_KB = 1024, P_VB = 1280, P_GU = 1536, P_GV = 1792, P_GLU = 2048;
constexpr int MOE_TILES_MAX = 264, CHUNK_TILES = 64, NCHUNK = 5;

__device__ __forceinline__ unsigned cvtpk(float lo, float hi) { f32x2_t v = {lo, hi}; bf16x2_t b = __builtin_convertvector(v, bf16x2_t); return __builtin_bit_cast(unsigned, b); }
__device__ __forceinline__ float bf2f(unsigned short b) { return __uint_as_float((unsigned)b << 16); }
__device__ __forceinline__ float bflo(unsigned w) { return __uint_as_float(w << 16); }
__device__ __forceinline__ float bfhi(unsigned w) { return __uint_as_float(w & 0xffff0000u); }
__device__ __forceinline__ float fast_exp2(float x) { return __builtin_amdgcn_exp2f(x); }
__device__ __forceinline__ float fast_rcp(float x) { return __builtin_amdgcn_rcpf(x); }
__device__ __forceinline__ float sigmoidf_(float x) { return fast_rcp(1.0f + fast_exp2(-1.4426950408889634f * x)); }
__device__ __forceinline__ float siluf_(float x) { return x * sigmoidf_(x); }
__device__ __forceinline__ float gelu_tanh(float x) { const float u = x + 0.044715f * x * x * x; return x * fast_rcp(1.0f + fast_exp2(-2.3022081982f * u)); }
__device__ __forceinline__ float wave_sum(float v) {
#pragma unroll
    for (int o = 1; o < 64; o <<= 1) v += __shfl_xor(v, o);
    return v;
}

namespace pg8 {
constexpr int BM = 256, BK = 64, HALF = 128, HTB = HALF * BK * 2, STAGE_BYTES = 8 * HTB, NXCD = 8, WGM = 8;
__host__ __device__ __forceinline__ int lds_byte(int r, int c) { const int st = (r >> 4) * 2 + (c >> 5), rr = r & 15, cc = c & 31, ob = rr * 64 + cc * 2; return st * 1024 + (ob ^ (((ob >> 9) & 1) << 5)); }
__host__ __device__ __forceinline__ void stage_rc(int b, int& R, int& C) { const int st = b / 1024, sb = b % 1024, swz = sb ^ (((sb >> 9) & 1) << 5); R = (st >> 1) * 16 + swz / 64; C = (st & 1) * 32 + (swz % 64) / 2; }
__host__ __device__ __forceinline__ int perm32(int rho) { const int n = rho >> 4, i = rho & 15; return 8 * (i >> 2) + 4 * n + (i & 3); }

struct Unit { int pm, pn; };
struct StaticOrder {
    int nM, nN, nwg, G, c;
    __device__ void init(int nM_, int nN_, int G_, int c_) { nM = nM_; nN = nN_; nwg = nM * nN; G = G_; c = c_; }
    __device__ bool next(int i, Unit& u) const {
        const long L = (long)i * G + c; if (L >= nwg) return false;
        int wgid = (int)L; { const int q = nwg / NXCD, r = nwg % NXCD, xcd = wgid % NXCD, off = wgid / NXCD; wgid = (xcd < r ? xcd * (q + 1) : r * (q + 1) + (xcd - r) * q) + off; }
        const int nig = WGM * nN, gid = wgid / nig, fm = gid * WGM, gsz = (nM - fm) < WGM ? (nM - fm) : WGM;
        u.pm = fm + ((wgid % nig) % gsz); u.pn = (wgid % nig) / gsz; return true;
    }
};
struct SchedPlain : StaticOrder {
    static constexpr bool GATHER = false;
    const char* Bt; size_t tstep;
    __device__ __forceinline__ int arow(const Unit& u, int rr) const { return u.pm * BM + rr; }
    __device__ __forceinline__ const char* bptr(const Unit& u) const { return Bt + (size_t)u.pn * tstep; }
};
template <bool GATHER_> struct SchedMoe : StaticOrder {
    static constexpr bool GATHER = GATHER_;
    const char* Bt; size_t tstep, estride; int tile0; const int* s2t; int ts[7];
    __device__ __forceinline__ int expert(int pmg) const { int e = 0;
#pragma unroll
        for (int k = 0; k < 7; ++k) e += (pmg >= ts[k]) ? 1 : 0;
        return e; }
    __device__ __forceinline__ int arow(const Unit& u, int rr) const { return GATHER ? s2t[(tile0 + u.pm) * BM + rr] : u.pm * BM + rr; }
    __device__ __forceinline__ const char* bptr(const Unit& u) const { return Bt + (size_t)expert(tile0 + u.pm) * estride + (size_t)u.pn * tstep; }
};

template <class Epi, class Sched>
__device__ __forceinline__ void gemm_phase(LAS unsigned char* lds, const char* Abase, const int K, const Sched& S, const Epi& E) {
    int tid = threadIdx.x; asm volatile("" : "+v"(tid)); const int wid = __builtin_amdgcn_readfirstlane(tid >> 6), lane = tid & 63, wr = wid >> 2, wc = wid & 3, fr = lane & 15, fq = lane >> 4;
    const int nt = K / BK;
    int R0, C0; stage_rc(tid * 16, R0, C0);
    const unsigned voffA = (unsigned)(R0 * K + C0) * 2u, voffB = (unsigned)(((R0 & ~31) + perm32(R0 & 31)) * K + C0) * 2u;
    const size_t kstep = (size_t)(BK * 2);
    const size_t hstep = (size_t)HALF * K * 2;
    const unsigned rowb = (unsigned)K * 2u, colb = (unsigned)C0 * 2u;
    const size_t q64 = (size_t)64 * K * 2;
    const unsigned ldsw = (unsigned)wid * 1024u;
    const int aoff = lds_byte(wr * 64 + fr, fq * 8), boff = lds_byte(wc * 32 + fr, fq * 8);
#define PG8_SA(b, h) (((b) * 2 + (h)) * HTB)
#define PG8_SB(b, h) ((4 + (b) * 2 + (h)) * HTB)
#define PG8_GLDS(gp, bufoff, i) __builtin_amdgcn_global_load_lds((const unsigned*)(gp), (LAS unsigned*)(lds + (bufoff) + ldsw + (i) * 8192), 16, 0, 0)
#define PG8_STAGE_B(bufoff, gbase) do { PG8_GLDS((const char*)(gbase) + voffB, bufoff, 0); PG8_GLDS((const char*)(gbase) + q64 + voffB, bufoff, 1); } while (0)
#define PG8_STAGE_A(bufoff, h, kb, NX) do { \
        if constexpr (Sched::GATHER) { const unsigned _o0 = (NX) ? ((h) ? na2 : na0) : ((h) ? va2 : va0), _o1 = (NX) ? ((h) ? na3 : na1) : ((h) ? va3 : va1); \
            PG8_GLDS(Abase + (kb) + _o0, bufoff, 0); PG8_GLDS(Abase + (kb) + _o1, bufoff, 1); } \
        else { const char* _b = ((NX) ? nA : cA) + (size_t)(h) * hstep + (kb); PG8_GLDS(_b + voffA, bufoff, 0); PG8_GLDS(_b + q64 + voffA, bufoff, 1); } } while (0)
#define PG8_LDA(dst, b, h) do { _Pragma("unroll") for (int m = 0; m < 4; ++m) _Pragma("unroll") for (int k = 0; k < 2; ++k) dst[m][k] = *(const LAS bf16x8*)(lds + PG8_SA(b, h) + aoff + m * 2048 + k * 1024); } while (0)
#define PG8_LDB(dst, b, h) do { _Pragma("unroll") for (int n = 0; n < 2; ++n) _Pragma("unroll") for (int k = 0; k < 2; ++k) dst[n][k] = *(const LAS bf16x8*)(lds + PG8_SB(b, h) + boff + n * 2048 + k * 1024); } while (0)
#define PG8_MMA(ai, bj, At, Bt) do { __builtin_amdgcn_s_setprio(1); _Pragma("unroll") for (int m = 0; m < 4; ++m) _Pragma("unroll") for (int n = 0; n < 2; ++n) _Pragma("unroll") for (int k = 0; k < 2; ++k) \
        acc[ai][bj][m][n] = __builtin_amdgcn_mfma_f32_16x16x32_bf16(Bt[n][k], At[m][k], acc[ai][bj][m][n], 0, 0, 0); __builtin_amdgcn_s_setprio(0); } while (0)
#define PG8_WAIT_V(n) asm volatile("s_waitcnt vmcnt(" #n ")" ::: "memory")
#define PG8_WAIT_L(n) asm volatile("s_waitcnt lgkmcnt(" #n ")" ::: "memory")
#define PG8_BAR __builtin_amdgcn_s_barrier()
#define PG8_SCHED __builtin_amdgcn_sched_barrier(0)
    Unit cur, nxt; int ui = 0;
    if (!S.next(0, cur)) return;
    f32x4 acc[2][2][4][2];
#pragma unroll
    for (int a = 0; a < 2; ++a)
#pragma unroll
        for (int b = 0; b < 2; ++b)
#pragma unroll
            for (int m = 0; m < 4; ++m)
#pragma unroll
                for (int n = 0; n < 2; ++n) acc[a][b][m][n] = (f32x4){0.f, 0.f, 0.f, 0.f};
    bf16x8 At[4][2], B0[2][2], B1[2][2];
    unsigned va0 = 0, va1 = 0, va2 = 0, va3 = 0, na0 = 0, na1 = 0, na2 = 0, na3 = 0;
    const char* cA = Abase; const char* nA = Abase;
    if constexpr (Sched::GATHER) { va0 = (unsigned)S.arow(cur, R0) * rowb + colb; va1 = (unsigned)S.arow(cur, R0 + 64) * rowb + colb;
                                   va2 = (unsigned)S.arow(cur, R0 + 128) * rowb + colb; va3 = (unsigned)S.arow(cur, R0 + 192) * rowb + colb; }
    else cA = Abase + (size_t)S.arow(cur, 0) * rowb;
    const char* cB = S.bptr(cur);
    PG8_STAGE_B(PG8_SB(0, 0), cB); PG8_STAGE_B(PG8_SB(0, 1), cB + hstep); PG8_STAGE_A(PG8_SA(0, 0), 0, 0, false); PG8_STAGE_A(PG8_SA(0, 1), 1, 0, false);
    if (wr == 1) PG8_BAR;
    PG8_WAIT_V(2); PG8_BAR;
    PG8_STAGE_B(PG8_SB(1, 0), cB + kstep); PG8_STAGE_A(PG8_SA(1, 0), 0, kstep, false); PG8_STAGE_B(PG8_SB(1, 1), cB + hstep + kstep);
    PG8_WAIT_V(6); PG8_BAR;
    for (;;) {
        const bool has_next = S.next(ui + 1, nxt);
        const char* nB = has_next ? S.bptr(nxt) : cB;
        if constexpr (Sched::GATHER) {
            na0 = va0; na1 = va1; na2 = va2; na3 = va3;
            if (has_next) { na0 = (unsigned)S.arow(nxt, R0) * rowb + colb; na1 = (unsigned)S.arow(nxt, R0 + 64) * rowb + colb;
                            na2 = (unsigned)S.arow(nxt, R0 + 128) * rowb + colb; na3 = (unsigned)S.arow(nxt, R0 + 192) * rowb + colb; }
        } else nA = has_next ? Abase + (size_t)S.arow(nxt, 0) * rowb : cA;
        for (int t = 0; t < nt; t += 2) {
            const bool last = (t == nt - 2);
            const size_t k1 = (size_t)(t + 1) * kstep, k2 = last ? 0 : (size_t)(t + 2) * kstep, k3 = k2 + kstep;
            const char* b2 = last ? nB : cB + (size_t)(t + 2) * kstep; const char* b3 = b2 + kstep;
            PG8_LDB(B0, 0, 0); PG8_LDB(B1, 0, 1); PG8_SCHED; PG8_LDA(At, 0, 0); PG8_STAGE_A(PG8_SA(1, 1), 1, k1, false);
            PG8_WAIT_V(8); PG8_WAIT_L(0); PG8_BAR; PG8_MMA(0, 0, At, B0); PG8_MMA(0, 1, At, B1); PG8_BAR; PG8_SCHED;
            PG8_LDA(At, 0, 1); PG8_STAGE_B(PG8_SB(0, 0), b2); PG8_STAGE_B(PG8_SB(0, 1), b2 + hstep); PG8_STAGE_A(PG8_SA(0, 0), 0, k2, last);
            PG8_WAIT_V(8); PG8_WAIT_L(0); PG8_BAR; PG8_MMA(1, 0, At, B0); PG8_MMA(1, 1, At, B1); PG8_BAR; PG8_SCHED;
            PG8_LDB(B0, 1, 0); PG8_LDB(B1, 1, 1); PG8_SCHED; PG8_LDA(At, 1, 0); PG8_STAGE_A(PG8_SA(0, 1), 1, k2, last);
            PG8_WAIT_V(8); PG8_WAIT_L(0); PG8_BAR; PG8_MMA(0, 0, At, B0); PG8_MMA(0, 1, At, B1); PG8_BAR; PG8_SCHED;
            PG8_LDA(At, 1, 1); PG8_STAGE_B(PG8_SB(1, 0), b3); PG8_STAGE_B(PG8_SB(1, 1), b3 + hstep); PG8_STAGE_A(PG8_SA(1, 0), 0, k3, last);
            PG8_WAIT_V(8); PG8_WAIT_L(0); PG8_BAR; PG8_MMA(1, 0, At, B0); PG8_MMA(1, 1, At, B1); PG8_BAR; PG8_SCHED;
        }
        if (wr == 0) PG8_BAR;
        E(acc, cur, wr, wc, fr, fq);
        if (!has_next) break;
#pragma unroll
        for (int a = 0; a < 2; ++a)
#pragma unroll
            for (int b = 0; b < 2; ++b)
#pragma unroll
                for (int m = 0; m < 4; ++m)
#pragma unroll
                    for (int n = 0; n < 2; ++n) acc[a][b][m][n] = (f32x4){0.f, 0.f, 0.f, 0.f};
        cur = nxt; cB = nB; cA = nA; va0 = na0; va1 = na1; va2 = na2; va3 = na3; ++ui;
        if (wr == 1) PG8_BAR;
    }
    PG8_WAIT_V(0);
    PG8_BAR;
#undef PG8_SA
#undef PG8_SB
#undef PG8_GLDS
#undef PG8_STAGE_A
#undef PG8_STAGE_B
#undef PG8_LDA
#undef PG8_LDB
#undef PG8_MMA
#undef PG8_WAIT_V
#undef PG8_WAIT_L
#undef PG8_BAR
#undef PG8_SCHED
}
}

struct EpiPlain {
    bf16* O; int ldc; int rowoff;
    __device__ __forceinline__ void operator()(const f32x4 (&acc)[2][2][4][2], const pg8::Unit& u, int wr, int wc, int fr, int fq) const {
        const int row0 = rowoff + u.pm * 256 + wr * 64 + fr, col0 = u.pn * 256 + wc * 32 + 8 * fq;
#pragma unroll
        for (int ai = 0; ai < 2; ++ai)
#pragma unroll
            for (int m = 0; m < 4; ++m) { bf16* rowp = O + (size_t)(row0 + ai * 128 + m * 16) * ldc + col0;
#pragma unroll
                for (int bj = 0; bj < 2; ++bj) { const f32x4 v0 = acc[ai][bj][m][0], v1 = acc[ai][bj][m][1];
                    u32x4 w; w.x = cvtpk(v0[0], v0[1]); w.y = cvtpk(v0[2], v0[3]); w.z = cvtpk(v1[0], v1[1]); w.w = cvtpk(v1[2], v1[3]);
                    *(u32x4*)(rowp + bj * 128) = w; } }
    }
};
struct EpiSwiGLU {
    bf16* O; int ldc;
    __device__ __forceinline__ void operator()(const f32x4 (&acc)[2][2][4][2], const pg8::Unit& u, int wr, int wc, int fr, int fq) const {
        const int row0 = u.pm * 256 + wr * 64 + fr, col0 = u.pn * 128 + wc * 32 + 8 * fq;
#pragma unroll
        for (int ai = 0; ai < 2; ++ai)
#pragma unroll
            for (int m = 0; m < 4; ++m) { bf16* rowp = O + (size_t)(row0 + ai * 128 + m * 16) * ldc + col0;
                float o[8];
#pragma unroll
                for (int n = 0; n < 2; ++n)
#pragma unroll
                    for (int e = 0; e < 4; ++e) o[4 * n + e] = siluf_(acc[ai][0][m][n][e]) * acc[ai][1][m][n][e];
                u32x4 w; w.x = cvtpk(o[0], o[1]); w.y = cvtpk(o[2], o[3]); w.z = cvtpk(o[4], o[5]); w.w = cvtpk(o[6], o[7]);
                *(u32x4*)rowp = w; }
    }
};
struct EpiInProj {
    bf16* P; const int* pos; float* kmsum;
    __device__ __forceinline__ void operator()(const f32x4 (&acc)[2][2][4][2], const pg8::Unit& u, int wr, int wc, int fr, int fq) const {
        const int pn = u.pn, row0 = u.pm * 256 + wr * 64 + fr;
        if (pn == 0 || pn == 1 || pn == 3 || pn == 4) {
            const int g = wc & 1, i0 = 16 * g + 4 * fq;
            float invf[4];
#pragma unroll
            for (int e = 0; e < 4; ++e) invf[e] = fast_exp2(-(float)(i0 + e) * 0.4152410118609203f);
            const float sc = (pn == 0 || pn == 3) ? C2 : 1.0f;
            float ks[2][2][4];
#pragma unroll
            for (int a = 0; a < 2; ++a)
#pragma unroll
                for (int b = 0; b < 2; ++b)
#pragma unroll
                    for (int e = 0; e < 4; ++e) ks[a][b][e] = 0.f;
#pragma unroll
            for (int ai = 0; ai < 2; ++ai)
#pragma unroll
                for (int m = 0; m < 4; ++m) { const int row = row0 + ai * 128 + m * 16; const float p = (float)pos[row];
                    float cs[4], sn[4];
#pragma unroll
                    for (int e = 0; e < 4; ++e) { const float ang = p * invf[e]; const float k = rintf(ang * 0.15915494309189535f);
                        float r = fmaf(-k, 6.2831854820251465f, ang); r = fmaf(-k, -1.7484556000744883e-07f, r); const float rev = r * 0.15915494309189535f;
                        cs[e] = __builtin_amdgcn_cosf(rev); sn[e] = __builtin_amdgcn_sinf(rev); }
                    bf16* rowp = P + (size_t)row * PW + 256 * pn;
#pragma unroll
                    for (int bj = 0; bj < 2; ++bj) { const int hh = 2 * bj + (wc >> 1); const f32x4 v0 = acc[ai][bj][m][0], v1 = acc[ai][bj][m][1];
                        float o0[4], o1[4];
#pragma unroll
                        for (int e = 0; e < 4; ++e) { o0[e] = (v0[e] * cs[e] - v1[e] * sn[e]) * sc; o1[e] = (v1[e] * cs[e] + v0[e] * sn[e]) * sc; ks[bj][0][e] += o0[e]; ks[bj][1][e] += o1[e]; }
                        bf16* dst = rowp + 64 * hh + i0;
                        u32x2 w0, w1; w0.x = cvtpk(o0[0], o0[1]); w0.y = cvtpk(o0[2], o0[3]); w1.x = cvtpk(o1[0], o1[1]); w1.y = cvtpk(o1[2], o1[3]);
                        *(u32x2*)dst = w0; *(u32x2*)(dst + 32) = w1; } }
            if (pn == 1) {
#pragma unroll
                for (int bj = 0; bj < 2; ++bj)
#pragma unroll
                    for (int n = 0; n < 2; ++n)
#pragma unroll
                        for (int e = 0; e < 4; ++e) { float v = ks[bj][n][e]; v += __shfl_xor(v, 1); v += __shfl_xor(v, 2); v += __shfl_xor(v, 4); v += __shfl_xor(v, 8);
                            if (fr == 0) atomicAdd(kmsum + (size_t)(u.pm * 4 + 2 * bj + (wc >> 1)) * 64 + 32 * n + i0 + e, v); }
            }
        } else if (pn >= 8) {
            const int col0 = P_GLU + 128 * (pn - 8) + wc * 32 + 8 * fq;
#pragma unroll
            for (int ai = 0; ai < 2; ++ai)
#pragma unroll
                for (int m = 0; m < 4; ++m) { bf16* rowp = P + (size_t)(row0 + ai * 128 + m * 16) * PW + col0;
                    float o[8];
#pragma unroll
                    for (int n = 0; n < 2; ++n)
#pragma unroll
                        for (int e = 0; e < 4; ++e) o[4 * n + e] = acc[ai][0][m][n][e] * sigmoidf_(acc[ai][1][m][n][e]);
                    u32x4 w; w.x = cvtpk(o[0], o[1]); w.y = cvtpk(o[2], o[3]); w.z = cvtpk(o[4], o[5]); w.w = cvtpk(o[6], o[7]);
                    *(u32x4*)rowp = w; }
        } else {
            const bool act = (pn >= 6);
            const int col0 = 256 * pn + wc * 32 + 8 * fq;
#pragma unroll
            for (int ai = 0; ai < 2; ++ai)
#pragma unroll
                for (int m = 0; m < 4; ++m) { bf16* rowp = P + (size_t)(row0 + ai * 128 + m * 16) * PW + col0;
#pragma unroll
                    for (int bj = 0; bj < 2; ++bj) { float o[8];
#pragma unroll
                        for (int n = 0; n < 2; ++n)
#pragma unroll
                            for (int e = 0; e < 4; ++e) { const float v = acc[ai][bj][m][n][e]; o[4 * n + e] = act ? gelu_tanh(v) : v; }
                        u32x4 w; w.x = cvtpk(o[0], o[1]); w.y = cvtpk(o[2], o[3]); w.z = cvtpk(o[4], o[5]); w.w = cvtpk(o[6], o[7]);
                        *(u32x4*)(rowp + bj * 128) = w; } }
        }
    }
};

#define MFMA32(a, b, c) __builtin_amdgcn_mfma_f32_32x32x16_bf16((a), (b), (c), 0, 0, 0)
__device__ __forceinline__ int crow(int i, int h) { return (i & 3) + 8 * (i >> 2) + 4 * h; }
__device__ __forceinline__ v4i16_t vtr(const LAS char* p) { return __builtin_amdgcn_ds_read_tr16_b64_v4i16((LAS v4i16_t*)p); }

__device__ __forceinline__ void attn_tile(f32x16& o0, f32x16& o1, float& m, float& l, const bf16x8 (&qf)[4], const bf16* kp, const bf16* vp, size_t v8,
                                          LAS char* vt, int lane, unsigned vmask) {
    const int h = lane >> 5;
    bf16x8 kf[4];
#pragma unroll
    for (int s = 0; s < 4; ++s) kf[s] = *(const bf16x8*)(kp + 16 * s);
    u32x4 vv[4];
#pragma unroll
    for (int w = 0; w < 4; ++w) vv[w] = *(const u32x4*)(vp + (size_t)w * v8);
    f32x16 p;
#pragma unroll
    for (int i = 0; i < 16; ++i) p[i] = 0.f;
#pragma unroll
    for (int s = 0; s < 4; ++s) p = MFMA32(kf[s], qf[s], p);
    { const int piece = lane & 7, key0 = lane >> 3;
#pragma unroll
      for (int w = 0; w < 4; ++w) *(LAS u32x4*)(vt + (2 * w + (piece >> 2)) * 512 + key0 * 64 + (piece & 3) * 16) = vv[w]; }
    float tm = -INFINITY;
#pragma unroll
    for (int i = 0; i < 16; ++i) { p[i] = ((vmask >> i) & 1u) ? p[i] : -INFINITY; tm = fmaxf(tm, p[i]); }
    tm = fmaxf(tm, __shfl_xor(tm, 32));
    const float mn = fmaxf(m, tm), alpha = fast_exp2(m - mn); m = mn;
    float rs = 0.f;
#pragma unroll
    for (int i = 0; i < 16; ++i) { p[i] = fast_exp2(p[i] - mn); rs += p[i]; }
    l = l * alpha + rs;
#pragma unroll
    for (int i = 0; i < 16; ++i) { o0[i] *= alpha; o1[i] *= alpha; }
    u32x4 w0, w1;
    w0.x = cvtpk(p[0], p[1]); w0.y = cvtpk(p[2], p[3]); w0.z = cvtpk(p[4], p[5]); w0.w = cvtpk(p[6], p[7]);
    w1.x = cvtpk(p[8], p[9]); w1.y = cvtpk(p[10], p[11]); w1.z = cvtpk(p[12], p[13]); w1.w = cvtpk(p[14], p[15]);
    const bf16x8 pf0 = __builtin_bit_cast(bf16x8, w0), pf1 = __builtin_bit_cast(bf16x8, w1);
    const LAS char* vb = vt + (4 * h + ((lane & 15) >> 2)) * 64 + ((lane >> 4) & 1) * 32 + (lane & 3) * 8;
#pragma unroll
    for (int s2 = 0; s2 < 2; ++s2) {
        const v4i16_t a0 = vtr(vb + (4 * s2 + 0) * 512), a1 = vtr(vb + (4 * s2 + 2) * 512);
        const v4i16_t b0 = vtr(vb + (4 * s2 + 1) * 512), b1 = vtr(vb + (4 * s2 + 3) * 512);
        const bf16x8 vf0 = (bf16x8){a0[0], a0[1], a0[2], a0[3], a1[0], a1[1], a1[2], a1[3]};
        const bf16x8 vf1 = (bf16x8){b0[0], b0[1], b0[2], b0[3], b1[0], b1[1], b1[2], b1[3]};
        o0 = MFMA32(vf0, s2 ? pf1 : pf0, o0);
        o1 = MFMA32(vf1, s2 ? pf1 : pf0, o1);
    }
}
__device__ __forceinline__ void attn_store(const f32x16& o0, const f32x16& o1, float inv, bf16* dst, int h) {
#pragma unroll
    for (int g = 0; g < 4; ++g) {
        u32x2 a, b; a.x = cvtpk(o0[4 * g] * inv, o0[4 * g + 1] * inv); a.y = cvtpk(o0[4 * g + 2] * inv, o0[4 * g + 3] * inv);
        b.x = cvtpk(o1[4 * g] * inv, o1[4 * g + 1] * inv); b.y = cvtpk(o1[4 * g + 2] * inv, o1[4 * g + 3] * inv);
        *(u32x2*)(dst + 8 * g + 4 * h) = a; *(u32x2*)(dst + 32 + 8 * g + 4 * h) = b; }
}
__device__ __forceinline__ void moba_item(const bf16* P, const float* kmsum, bf16* OA, int b, int hh, int qt, LAS char* vt, int lane) {
    const int r = lane & 31, h = lane >> 5, j = qt >> 3;
    const bf16* Pb = P + (size_t)b * SEQ * PW;
    const bf16* qp = Pb + (size_t)(32 * qt + r) * PW + P_QA + 64 * hh + 8 * h;
    bf16x8 qf[4];
#pragma unroll
    for (int s = 0; s < 4; ++s) qf[s] = *(const bf16x8*)(qp + 16 * s);
    unsigned sel = (1u << j) - 1u;
    if (j > 3) {
        f32x16 g;
#pragma unroll
        for (int i = 0; i < 16; ++i) g[i] = 0.f;
        const float* kmr = kmsum + (size_t)((b * 8 + (r & 7)) * 4 + hh) * 64 + 8 * h;
#pragma unroll
        for (int s = 0; s < 4; ++s) {
            f32x4 a = (f32x4){0.f, 0.f, 0.f, 0.f}, c = a;
            if (r < j) { a = *(const f32x4*)(kmr + 16 * s); c = *(const f32x4*)(kmr + 16 * s + 4); }
            float v[8] = {a[0], a[1], a[2], a[3], c[0], c[1], c[2], c[3]}; unsigned hi[4], lo[4];
#pragma unroll
            for (int e = 0; e < 4; ++e) { hi[e] = cvtpk(v[2 * e], v[2 * e + 1]); lo[e] = cvtpk(v[2 * e] - bflo(hi[e]), v[2 * e + 1] - bfhi(hi[e])); }
            const bf16x8 khi = __builtin_bit_cast(bf16x8, ((u32x4){hi[0], hi[1], hi[2], hi[3]})), klo = __builtin_bit_cast(bf16x8, ((u32x4){lo[0], lo[1], lo[2], lo[3]}));
            g = MFMA32(khi, qf[s], g); g = MFMA32(klo, qf[s], g);
        }
        float gate[8];
#pragma unroll
        for (int i = 0; i < 4; ++i) { const float o = __shfl_xor(g[i], 32); gate[i] = h ? o : g[i]; gate[4 + i] = h ? g[i] : o; }
        sel = 0u;
#pragma unroll
        for (int k = 0; k < 3; ++k) { float best = -INFINITY; int bi = 0;
#pragma unroll
            for (int n = 0; n < 8; ++n) { const bool c = (n < j) && !((sel >> n) & 1u) && (gate[n] > best); best = c ? gate[n] : best; bi = c ? n : bi; }
            sel |= 1u << bi; }
    }
    f32x16 o0, o1;
#pragma unroll
    for (int i = 0; i < 16; ++i) { o0[i] = 0.f; o1[i] = 0.f; }
    float m = -1e30f, l = 0.f;
    for (int kt = 0; kt <= qt; ++kt) {
        const int n = kt >> 3; unsigned vmask = 0xffffu;
        if (n < j) { const bool on = (sel >> n) & 1u; if (!__any(on)) continue; vmask = on ? 0xffffu : 0u; }
        else if (kt == qt) { vmask = 0u;
#pragma unroll
            for (int i = 0; i < 16; ++i) vmask |= (crow(i, h) <= r) ? (1u << i) : 0u; }
        const bf16* kp = Pb + (size_t)(32 * kt + r) * PW + P_KA + 64 * hh + 8 * h;
        const bf16* vp = Pb + (size_t)(32 * kt + (lane >> 3)) * PW + P_VA + 64 * hh + 8 * (lane & 7);
        attn_tile(o0, o1, m, l, qf, kp, vp, (size_t)8 * PW, vt, lane, vmask);
    }
    l += __shfl_xor(l, 32);
    attn_store(o0, o1, fast_rcp(l), OA + (size_t)(b * SEQ + 32 * qt + r) * 256 + 64 * hh, h);
}
__device__ __forceinline__ void dil_item(const bf16* P, bf16* DO, float* LS, int cfg, int b, int hh, int idx, LAS char* vt, int lane) {
    const int r = lane & 31, h = lane >> 5, sh = 2 * cfg, dil = 1 << sh, tsh = 6 - sh;
    const int res = idx >> tsh, qt = idx & ((1 << tsh) - 1);
    const bf16* Pb = P + ((size_t)b * SEQ + res) * PW;
    const size_t rs = (size_t)dil * PW;
    const bf16* qp = Pb + (size_t)(32 * qt + r) * rs + P_QB + 64 * hh + 8 * h;
    bf16x8 qf[4];
#pragma unroll
    for (int s = 0; s < 4; ++s) qf[s] = *(const bf16x8*)(qp + 16 * s);
    f32x16 o0, o1;
#pragma unroll
    for (int i = 0; i < 16; ++i) { o0[i] = 0.f; o1[i] = 0.f; }
    float m = -1e30f, l = 0.f;
    for (int kt = (qt > 4 ? qt - 4 : 0); kt <= qt; ++kt) {
        unsigned vmask = 0u;
#pragma unroll
        for (int i = 0; i < 16; ++i) { const int dl = 32 * (qt - kt) + r - crow(i, h); vmask |= (dl >= 0 && dl <= 128) ? (1u << i) : 0u; }
        const bf16* kp = Pb + (size_t)(32 * kt + r) * rs + P_KB + 64 * hh + 8 * h;
        const bf16* vp = Pb + (size_t)(32 * kt + (lane >> 3)) * rs + P_VB + 64 * hh + 8 * (lane & 7);
        attn_tile(o0, o1, m, l, qf, kp, vp, 8 * rs, vt, lane, vmask);
    }
    l += __shfl_xor(l, 32);
    const size_t row = (size_t)b * SEQ + (size_t)(32 * qt + r) * dil + res;
    attn_store(o0, o1, fast_rcp(l), DO + row * 256 + 64 * hh, h);
    if (h == 0) LS[row * 4 + hh] = m + __builtin_amdgcn_logf(l);
}

constexpr size_t MiB = 1u << 20;
constexpr size_t WS_CTL = 0, CTL_ZERO_BYTES = 1 * MiB;
constexpr size_t WS_MOD = 1 * MiB;
constexpr size_t WS_RTE = 2 * MiB, WS_RTP = WS_RTE + 256 * 1024, WS_RTG = WS_RTP + 256 * 1024, WS_S2T = WS_RTG + 256 * 1024;
constexpr size_t WS_WIN = 4 * MiB, WS_WOUT = 14 * MiB, WS_WFGU = 18 * MiB, WS_WFD = 29 * MiB, WS_WMGU = 35 * MiB, WS_WMD = 147 * MiB;
constexpr size_t WS_HB = 203 * MiB;
constexpr size_t WS_R = 267 * MiB;
constexpr size_t WS_P = WS_R, WS_DIL = WS_R + 144 * MiB, WS_LSE = WS_R + 192 * MiB, WS_OA = WS_R + 194 * MiB, WS_OC = WS_R + 210 * MiB, WS_OD = WS_R + 226 * MiB;
constexpr size_t WS_Y = WS_R;
constexpr size_t WS_FH = WS_R;
constexpr size_t WS_HID = WS_R, WS_YS = WS_R + 112 * MiB;
constexpr size_t WS_END = WS_R + 244 * MiB;
constexpr int CW_BAR = 4096;
constexpr int CW_CNT = 8192;
constexpr int CW_KM = 16384;
static_assert((CW_KM + 2 * 32768 * 1) * 4 <= (int)CTL_ZERO_BYTES + 0 || true, "");
static_assert((size_t)(CW_KM + 2 * 32768) * 4 <= CTL_ZERO_BYTES, "CTL region");

constexpr int RING_BYTES = 131072, LDSX_OFF = RING_BYTES, LDS_BYTES = 147456;

#define XB_TMO      128
#define XB_XCNT(j)  (256  + 64 * (j))
#define XB_XSUB(j)  (1280 + 64 * (j))
#define XB_XGEN(j)  (2304 + 64 * (j))
#define XB_TOP      3328
#define XB_TOPGEN   3392
#define XCD_BAR_WORDS 3456
#define XB_SPIN_CAP (1u << 18)
__device__ __forceinline__ unsigned xb_ld(unsigned* p)              { return __hip_atomic_load(p, __ATOMIC_RELAXED, __HIP_MEMORY_SCOPE_AGENT); }
__device__ __forceinline__ unsigned xb_add(unsigned* p, unsigned v) { return __hip_atomic_fetch_add(p, v, __ATOMIC_RELAXED, __HIP_MEMORY_SCOPE_AGENT); }
__device__ __forceinline__ unsigned xb_xcc_id() { return (unsigned)__builtin_amdgcn_s_getreg((3 << 11) | 20) & 0xFu; }
#define XB_SPIN(cond, bar) do { unsigned _sp = 0; while (cond) { __builtin_amdgcn_s_sleep(1); \
    if ((++_sp & 255u) == 0u) { if (xb_ld(&(bar)[XB_TMO])) break; if (_sp > XB_SPIN_CAP) { atomicAdd(&(bar)[XB_TMO], 1u); break; } } } } while (0)
struct XcdBarrier { unsigned* bar; unsigned x; volatile LAS unsigned* st; };
__device__ __forceinline__ XcdBarrier xcd_barrier_post(unsigned* bar, volatile LAS unsigned* st) {
    XcdBarrier b; b.bar = bar; b.x = xb_xcc_id(); b.st = st;
    if (threadIdx.x == 0) (void)xb_add(&bar[XB_XCNT(b.x)], 1u);
    return b;
}
__device__ __forceinline__ void xcd_barrier_complete(unsigned* bar, unsigned x, unsigned& nloc, unsigned& nx) {
    const unsigned G = gridDim.x * gridDim.y * gridDim.z;
    unsigned sum, cnt, mine, sp = 0u;
    for (;;) {
        sum = 0u; cnt = 0u; mine = 0u;
#pragma unroll
        for (unsigned j = 0; j < 16; ++j) { const unsigned c = xb_ld(&bar[XB_XCNT(j)]); sum += c; cnt += (c > 0u) ? 1u : 0u; mine = (j == x) ? c : mine; }
        if (sum == G) break;
        __builtin_amdgcn_s_sleep(1);
        if ((++sp & 255u) == 0u) { if (xb_ld(&bar[XB_TMO])) break; if (sp > XB_SPIN_CAP) { atomicAdd(&bar[XB_TMO], 1u); break; } }
    }
    nloc = mine > 0u ? mine : 1u; nx = cnt > 0u ? cnt : 1u;
}
__device__ __forceinline__ void xcd_barrier(const XcdBarrier& b) {
    asm volatile("s_waitcnt vmcnt(0)" ::: "memory");
    __syncthreads();
    if (threadIdx.x == 0) {
        unsigned* bar = b.bar;
        __builtin_amdgcn_s_waitcnt(0);
        unsigned nloc = b.st[0], nx = b.st[1];
        if (nloc == 0u) { xcd_barrier_complete(bar, b.x, nloc, nx); b.st[0] = nloc; b.st[1] = nx; }
        const unsigned old = xb_add(&bar[XB_XSUB(b.x)], 1u);
        const unsigned gen = old / nloc;
        if (old + 1u == (gen + 1u) * nloc) {
            __builtin_amdgcn_fence(__ATOMIC_RELEASE, "agent");
            asm volatile("s_waitcnt vmcnt(0)" ::: "memory");
            const unsigned og = xb_add(&bar[XB_TOP], 1u);
            const unsigned tg = og / nx;
            if (og + 1u == (tg + 1u) * nx) xb_add(&bar[XB_TOPGEN], 1u);
            else XB_SPIN(xb_ld(&bar[XB_TOPGEN]) == tg, bar);
            __builtin_amdgcn_fence(__ATOMIC_ACQUIRE, "agent");
            xb_add(&bar[XB_XGEN(b.x)], 1u);
            asm volatile("s_waitcnt vmcnt(0)" ::: "memory");
        } else {
            XB_SPIN(xb_ld(&bar[XB_XGEN(b.x)]) == gen, bar);
            __builtin_amdgcn_fence(__ATOMIC_ACQUIRE, "agent");
            asm volatile("s_waitcnt vmcnt(0)" ::: "memory");
        }
    }
    __syncthreads();
}

struct Args { const void* in[26]; float* out; unsigned char* ws; int ph_lo, ph_hi; };
struct Frame {
    LAS unsigned char* lds;
    unsigned char* ws; unsigned* ctl; float* out;
    int tid, lane, wave, vcu, G;
};
typedef const __attribute__((address_space(4))) Args* ArgsP;
__device__ __forceinline__ ArgsP args_ptr() { auto p = __builtin_amdgcn_kernarg_segment_ptr(); asm volatile("" : "+s"(p)); return (ArgsP)p; }
__device__ __forceinline__ int otid() { int t = threadIdx.x; asm volatile("" : "+v"(t)); return t; }
#define REFRESH(F) do { (F).tid = otid(); (F).lane = (F).tid & 63; (F).wave = __builtin_amdgcn_readfirstlane((F).tid >> 6); } while (0)
#define INP(A, k) ((const float*)(A)->in[k])
enum { I_X = 0, I_C, I_POS, I_ADAW, I_ADAB, I_MIXPRE, I_MIXPOST, I_FFNPRE, I_FFNPOST, I_WIN, I_WOUT, I_GROUPG, I_GMLPW, I_GMLPB, I_CONVW, I_CONVB, I_CONVLNG, I_CONVLNB,
       I_FFNWG, I_FFNWU, I_FFNWD, I_ROUTW, I_ROUTB, I_MOEWG, I_MOEWU, I_MOEWD };
#define LDS_WAIT() asm volatile("s_waitcnt lgkmcnt(0)" ::: "memory")

__device__ __forceinline__ void ld_f32_row(float (&v)[16], const float* p, int lane) {
#pragma unroll
    for (int j = 0; j < 4; ++j) { const f32x4 t = ((const f32x4*)p)[lane + 64 * j]; v[4 * j] = t[0]; v[4 * j + 1] = t[1]; v[4 * j + 2] = t[2]; v[4 * j + 3] = t[3]; }
}
__device__ __forceinline__ void ld_bf16_row(float (&v)[16], const bf16* p, int lane) {
#pragma unroll
    for (int j = 0; j < 4; ++j) { const u32x2 t = ((const u32x2*)p)[lane + 64 * j]; v[4 * j] = bflo(t.x); v[4 * j + 1] = bfhi(t.x); v[4 * j + 2] = bflo(t.y); v[4 * j + 3] = bfhi(t.y); }
}
__device__ __forceinline__ void st_f32_row(const float (&v)[16], float* p, int lane) {
#pragma unroll
    for (int j = 0; j < 4; ++j) ((f32x4*)p)[lane + 64 * j] = (f32x4){v[4 * j], v[4 * j + 1], v[4 * j + 2], v[4 * j + 3]};
}
__device__ __forceinline__ void st_bf16_row(const float (&v)[16], bf16* p, int lane) {
#pragma unroll
    for (int j = 0; j < 4; ++j) { u32x2 t; t.x = cvtpk(v[4 * j], v[4 * j + 1]); t.y = cvtpk(v[4 * j + 2], v[4 * j + 3]); ((u32x2*)p)[lane + 64 * j] = t; }
}
__device__ __forceinline__ float row_rstd(const float (&v)[16]) {
    float s = 0.f;
#pragma unroll
    for (int i = 0; i < 16; ++i) s += v[i] * v[i];
    return __builtin_amdgcn_rsqf(wave_sum(s) * (1.0f / D) + EPS);
}
__device__ __forceinline__ const float* mod_ptr(const Frame& F, int layer, int b, int part) { return (const float*)(F.ws + WS_MOD) + ((size_t)(layer * 16 + b) * 6 + part) * 1024; }

__device__ __forceinline__ int dst_row(int type, int n) {
    if (type == 0) return n;
    if (type == 1) return 256 * (n >> 7) + (n & 127);
    if (type == 2) return 256 * (n >> 7) + 128 + (n & 127);
    const int sl = n >> 8, cc = n & 255;
    if (sl == 0 || sl == 1 || sl == 3 || sl == 4) { const int hh = cc >> 6, d = cc & 63; return 256 * sl + 64 * hh + 32 * ((d >> 4) & 1) + 8 * ((d >> 2) & 3) + 4 * (d >> 5) + (d & 3); }
    if (sl < 8) return n;
    return 256 * (8 + ((cc >> 7) & 1)) + (sl == 9 ? 128 : 0) + (cc & 127);
}
__device__ __forceinline__ void transpose_item(const float* W, int K, int N, bf16* WT, int type, LAS float* scr, int item, int lane) {
    const int nblk = N / 32, kb = item / nblk, nb = item % nblk, k0 = 64 * kb, n0 = 32 * nb;
#pragma unroll 8
    for (int i = 0; i < 32; ++i) { const int kk = 2 * i + (lane >> 5); scr[kk * 33 + (lane & 31)] = W[(size_t)(k0 + kk) * N + n0 + (lane & 31)]; }
    LDS_WAIT(); asm volatile("" ::: "memory");
    const int c = lane & 7;
#pragma unroll
    for (int j = 0; j < 4; ++j) { const int n = (lane >> 3) + 8 * j; const LAS float* s = scr + (8 * c) * 33 + n;
        u32x4 o; o.x = cvtpk(s[0 * 33], s[1 * 33]); o.y = cvtpk(s[2 * 33], s[3 * 33]); o.z = cvtpk(s[4 * 33], s[5 * 33]); o.w = cvtpk(s[6 * 33], s[7 * 33]);
        *(u32x4*)(WT + (size_t)dst_row(type, n0 + n) * K + k0 + 8 * c) = o; }
    LDS_WAIT(); asm volatile("" ::: "memory");
}
__device__ __forceinline__ void ada_item(Frame& F, ArgsP A, int a, LAS float* scr) {
    const int layer = a / 96, n = 64 * (a % 96) + F.lane; const float* cin = INP(A, I_C); const float* ada_w = INP(A, I_ADAW);
    float acc[16];
#pragma unroll
    for (int b = 0; b < 16; ++b) acc[b] = 0.f;
    for (int kc = 0; kc < 4; ++kc) {
        for (int i = 0; i < 64; ++i) { const int idx = F.lane + 64 * i, b = idx >> 8, kk = idx & 255; scr[idx] = siluf_(cin[b * 1024 + kc * 256 + kk]); }
        LDS_WAIT(); asm volatile("" ::: "memory");
        const float* wp = ada_w + ((size_t)layer * 1024 + kc * 256) * 6144 + n;
#pragma unroll 4
        for (int kk = 0; kk < 256; ++kk) { const float w = wp[(size_t)kk * 6144];
#pragma unroll
            for (int b = 0; b < 16; ++b) acc[b] += scr[b * 256 + kk] * w; }
        LDS_WAIT(); asm volatile("" ::: "memory");
    }
    float* mod = (float*)(F.ws + WS_MOD);
    const float bias = INP(A, I_ADAB)[layer * 6144 + n];
#pragma unroll
    for (int b = 0; b < 16; ++b) mod[(size_t)(layer * 16 + b) * 6144 + n] = acc[b] + bias;
}
__device__ __forceinline__ void phase_prologue(Frame& F) {
    REFRESH(F);
    LAS float* scr = (LAS float*)(F.lds + F.wave * 16384);
    const int gw = F.vcu * 8 + F.wave, NGW = F.G * 8; ArgsP A = args_ptr();
    for (int a = gw; a < 192; a += NGW) ada_item(F, A, a, scr);
    constexpr int I_IN = 16 * 80, I_OUT = 16 * 32, I_FG = 16 * 88, I_FD = 44 * 32, I_MG = 16 * 112, I_MD = 56 * 32;
    constexpr int NITEMS = 2 * I_IN + 2 * I_OUT + 2 * I_FG + I_FD + 16 * I_MG + 8 * I_MD;
    bf16* WIN = (bf16*)(F.ws + WS_WIN); bf16* WOUT = (bf16*)(F.ws + WS_WOUT); bf16* WFGU = (bf16*)(F.ws + WS_WFGU); bf16* WFD = (bf16*)(F.ws + WS_WFD);
    bf16* WMGU = (bf16*)(F.ws + WS_WMGU); bf16* WMD = (bf16*)(F.ws + WS_WMD);
    for (int it = NITEMS - 1 - gw; it >= 0; it -= NGW) {
        int r = it;
        if (r < 2 * I_IN) { const int L = r / I_IN; transpose_item(INP(A, I_WIN) + (size_t)L * 1024 * NIN, 1024, NIN, WIN + (size_t)L * NIN * 1024, 3, scr, r % I_IN, F.lane); continue; } r -= 2 * I_IN;
        if (r < 2 * I_OUT) { const int L = r / I_OUT; transpose_item(INP(A, I_WOUT) + (size_t)L * 1024 * 1024, 1024, 1024, WOUT + (size_t)L * 1024 * 1024, 0, scr, r % I_OUT, F.lane); continue; } r -= 2 * I_OUT;
        if (r < I_FG) { transpose_item(INP(A, I_FFNWG), 1024, FFD, WFGU, 1, scr, r, F.lane); continue; } r -= I_FG;
        if (r < I_FG) { transpose_item(INP(A, I_FFNWU), 1024, FFD, WFGU, 2, scr, r, F.lane); continue; } r -= I_FG;
        if (r < I_FD) { transpose_item(INP(A, I_FFNWD), FFD, 1024, WFD, 0, scr, r, F.lane); continue; } r -= I_FD;
        if (r < 8 * I_MG) { const int e = r / I_MG; transpose_item(INP(A, I_MOEWG) + (size_t)e * 1024 * FFE, 1024, FFE, WMGU + (size_t)e * 2 * FFE * 1024, 1, scr, r % I_MG, F.lane); continue; } r -= 8 * I_MG;
        if (r < 8 * I_MG) { const int e = r / I_MG; transpose_item(INP(A, I_MOEWU) + (size_t)e * 1024 * FFE, 1024, FFE, WMGU + (size_t)e * 2 * FFE * 1024, 2, scr, r % I_MG, F.lane); continue; } r -= 8 * I_MG;
        { const int e = r / I_MD; transpose_item(INP(A, I_MOEWD) + (size_t)e * FFE * 1024, FFE, 1024, WMD + (size_t)e * 1024 * FFE, 0, scr, r % I_MD, F.lane); }
    }
}

__device__ __forceinline__ void norm_mod_store(const float (&x)[16], const float* g, const float* sc, const float* sh, bf16* dst, int lane, float (&h)[16]) {
    const float r = row_rstd(x);
    float gv[16], scv[16], shv[16]; ld_f32_row(gv, g, lane); ld_f32_row(scv, sc, lane); ld_f32_row(shv, sh, lane);
#pragma unroll
    for (int i = 0; i < 16; ++i) h[i] = x[i] * r * gv[i] * (1.0f + scv[i]) + shv[i];
    st_bf16_row(h, dst, lane);
}
__device__ __forceinline__ void phase_prenorm0(Frame& F) {
    REFRESH(F);
    const int rpw = M / (F.G * 8); bf16* HB = (bf16*)(F.ws + WS_HB); ArgsP A = args_ptr(); const float* x_in = INP(A, I_X); const float* mix_pre_g = INP(A, I_MIXPRE);
    for (int k = 0; k < rpw; ++k) { const int m = (F.vcu * 8 + F.wave) * rpw + k, b = m >> 11;
        float x[16], h[16]; ld_f32_row(x, x_in + (size_t)m * D, F.lane);
        norm_mod_store(x, mix_pre_g, mod_ptr(F, 0, b, 1), mod_ptr(F, 0, b, 0), HB + (size_t)m * D, F.lane, h); }
}
__device__ __forceinline__ void phase_postmix(Frame& F, int layer, bool moe) {
    REFRESH(F);
    const int rpw = M / (F.G * 8); bf16* HB = (bf16*)(F.ws + WS_HB); const bf16* Y = (const bf16*)(F.ws + WS_Y);
    ArgsP A = args_ptr(); const float* xsrc = layer == 0 ? INP(A, I_X) : F.out;
    const float* mix_post_g = INP(A, I_MIXPOST); const float* ffn_pre_g = INP(A, I_FFNPRE); const float* router_w = INP(A, I_ROUTW); const float* router_b = INP(A, I_ROUTB);
    LAS int* lcnt = (LAS int*)(F.lds + LDSX_OFF + 256);
    LAS int* lbase = lcnt + 8; LAS int* rinfo = lcnt + 16;
    if (moe) { if (F.tid < 16) lcnt[F.tid] = 0; __syncthreads(); }
    for (int k = 0; k < rpw; ++k) { const int rl = F.wave * rpw + k, m = F.vcu * 8 * rpw + rl, b = m >> 11;
        float x[16], y[16], g[16], gt[16], h[16];
        ld_f32_row(x, xsrc + (size_t)m * D, F.lane); ld_bf16_row(y, Y + (size_t)m * D, F.lane);
        const float ry = row_rstd(y);
        ld_f32_row(g, mix_post_g + layer * D, F.lane); ld_f32_row(gt, mod_ptr(F, layer, b, 2), F.lane);
#pragma unroll
        for (int i = 0; i < 16; ++i) x[i] += gt[i] * (y[i] * ry * g[i]);
        st_f32_row(x, F.out + (size_t)m * D, F.lane);
        norm_mod_store(x, ffn_pre_g + layer * D, mod_ptr(F, layer, b, 4), mod_ptr(F, layer, b, 3), HB + (size_t)m * D, F.lane, h);
        if (moe) {
            float lg[8];
#pragma unroll
            for (int e = 0; e < 8; ++e) lg[e] = 0.f;
#pragma unroll
            for (int j = 0; j < 4; ++j)
#pragma unroll
                for (int e4 = 0; e4 < 4; ++e4) { const float* rw = router_w + (size_t)(256 * j + 4 * F.lane + e4) * 8; const f32x4 w0 = *(const f32x4*)rw, w1 = *(const f32x4*)(rw + 4); const float hv = h[4 * j + e4];
                    lg[0] += hv * w0[0]; lg[1] += hv * w0[1]; lg[2] += hv * w0[2]; lg[3] += hv * w0[3]; lg[4] += hv * w1[0]; lg[5] += hv * w1[1]; lg[6] += hv * w1[2]; lg[7] += hv * w1[3]; }
#pragma unroll
            for (int e = 0; e < 8; ++e) lg[e] = wave_sum(lg[e]) + router_b[e];
            int e0 = 0; float l0 = lg[0];
#pragma unroll
            for (int e = 1; e < 8; ++e) if (lg[e] > l0) { l0 = lg[e]; e0 = e; }
            int e1 = -1; float l1 = -INFINITY;
#pragma unroll
            for (int e = 0; e < 8; ++e) if (e != e0 && lg[e] > l1) { l1 = lg[e]; e1 = e; }
            if (F.lane == 0) {
                const float g0 = fast_rcp(1.0f + __expf(l1 - l0));
                const int p0 = atomicAdd((int*)(lcnt + e0), 1), p1 = atomicAdd((int*)(lcnt + e1), 1);
                rinfo[rl * 4 + 0] = e0; rinfo[rl * 4 + 1] = e1; rinfo[rl * 4 + 2] = p0; rinfo[rl * 4 + 3] = p1;
                float* RTG = (float*)(F.ws + WS_RTG); RTG[2 * m] = g0; RTG[2 * m + 1] = 1.0f - g0;
            }
        }
    }
    if (moe) {
        __syncthreads();
        if (F.tid < 8) lbase[F.tid] = (int)__hip_atomic_fetch_add(F.ctl + CW_CNT + F.tid, (unsigned)lcnt[F.tid], __ATOMIC_RELAXED, __HIP_MEMORY_SCOPE_AGENT);
        __syncthreads();
        const int nrows = 8 * rpw;
        int* RTE = (int*)(F.ws + WS_RTE); int* RTP = (int*)(F.ws + WS_RTP);
        for (int rl = F.tid; rl < nrows; rl += 512) { const int m = F.vcu * nrows + rl; const int e0 = rinfo[rl * 4], e1 = rinfo[rl * 4 + 1];
            RTE[2 * m] = e0; RTE[2 * m + 1] = e1; RTP[2 * m] = lbase[e0] + rinfo[rl * 4 + 2]; RTP[2 * m + 1] = lbase[e1] + rinfo[rl * 4 + 3]; }
    }
}
__device__ __forceinline__ void moe_tiles(const Frame& F, int (&ts)[9], int (&cnt)[8]) {
    int acc = 0;
#pragma unroll
    for (int e = 0; e < 8; ++e) { cnt[e] = (int)__hip_atomic_load(F.ctl + CW_CNT + e, __ATOMIC_RELAXED, __HIP_MEMORY_SCOPE_AGENT); ts[e] = acc; acc += (cnt[e] + 255) >> 8; }
    ts[8] = acc;
}
__device__ __forceinline__ void phase_moe_index(Frame& F) {
    REFRESH(F);
    int ts[9], cnt[8]; moe_tiles(F, ts, cnt);
    int* S2T = (int*)(F.ws + WS_S2T); const int* RTE = (const int*)(F.ws + WS_RTE); const int* RTP = (const int*)(F.ws + WS_RTP);
    const int gt = F.vcu * 512 + F.tid, NT = F.G * 512;
    for (int s = gt; s < ts[8] * 256; s += NT) { const int tile = s >> 8; int e = 0;
#pragma unroll
        for (int k = 1; k < 8; ++k) e += (tile >= ts[k]) ? 1 : 0;
        int c = 0, t0 = 0;
#pragma unroll
        for (int k = 0; k < 8; ++k) { c = (k == e) ? cnt[k] : c; t0 = (k == e) ? ts[k] : t0; }
        if (s - 256 * t0 >= c) S2T[s] = 0; }
    for (int a = gt; a < 2 * M; a += NT) { const int e = RTE[a]; int t0 = 0;
#pragma unroll
        for (int k = 0; k < 8; ++k) t0 = (k == e) ? ts[k] : t0;
        S2T[256 * t0 + RTP[a]] = a >> 1; }
}
__device__ __forceinline__ void phase_postffn(Frame& F, int layer, bool moe) {
    REFRESH(F);
    const int rpw = M / (F.G * 8); bf16* HB = (bf16*)(F.ws + WS_HB);
    int ts[9], cnt[8]; if (moe) moe_tiles(F, ts, cnt);
    ArgsP A = args_ptr(); const float* ffn_post_g = INP(A, I_FFNPOST); const float* mix_pre_g = INP(A, I_MIXPRE);
    for (int k = 0; k < rpw; ++k) { const int m = (F.vcu * 8 + F.wave) * rpw + k, b = m >> 11;
        float x[16], y[16], g[16], gt[16], h[16];
        ld_f32_row(x, F.out + (size_t)m * D, F.lane);
        if (moe) {
            const int* RTE = (const int*)(F.ws + WS_RTE); const int* RTP = (const int*)(F.ws + WS_RTP); const float* RTG = (const float*)(F.ws + WS_RTG); const bf16* YS = (const bf16*)(F.ws + WS_YS);
            const int e0 = RTE[2 * m], e1 = RTE[2 * m + 1]; int t0 = 0, t1 = 0;
#pragma unroll
            for (int q = 0; q < 8; ++q) { t0 = (q == e0) ? ts[q] : t0; t1 = (q == e1) ? ts[q] : t1; }
            const size_t s0 = (size_t)256 * t0 + RTP[2 * m], s1 = (size_t)256 * t1 + RTP[2 * m + 1];
            const float g0 = RTG[2 * m], g1 = RTG[2 * m + 1];
            float ya[16], yb[16]; ld_bf16_row(ya, YS + s0 * D, F.lane); ld_bf16_row(yb, YS + s1 * D, F.lane);
#pragma unroll
            for (int i = 0; i < 16; ++i) y[i] = g0 * ya[i] + g1 * yb[i];
        } else ld_bf16_row(y, HB + (size_t)m * D, F.lane);
        const float ry = row_rstd(y);
        ld_f32_row(g, ffn_post_g + layer * D, F.lane); ld_f32_row(gt, mod_ptr(F, layer, b, 5), F.lane);
#pragma unroll
        for (int i = 0; i < 16; ++i) x[i] += gt[i] * (y[i] * ry * g[i]);
        st_f32_row(x, F.out + (size_t)m * D, F.lane);
        if (layer == 0) norm_mod_store(x, mix_pre_g + D, mod_ptr(F, 1, b, 1), mod_ptr(F, 1, b, 0), HB + (size_t)m * D, F.lane, h);
    }
}
__device__ __forceinline__ void phase_mixnorm(Frame& F, int layer) {
    REFRESH(F);
    const int rpw = M / (F.G * 8); bf16* MIXN = (bf16*)(F.ws + WS_HB);
    const bf16* OA = (const bf16*)(F.ws + WS_OA); const bf16* OC = (const bf16*)(F.ws + WS_OC); const bf16* OD = (const bf16*)(F.ws + WS_OD);
    const bf16* DIL = (const bf16*)(F.ws + WS_DIL); const float* LSE = (const float*)(F.ws + WS_LSE);
    const int lane = F.lane, hh = lane >> 4; ArgsP A = args_ptr(); const float* group_g = INP(A, I_GROUPG);
    for (int k = 0; k < rpw; ++k) { const size_t m = (size_t)(F.vcu * 8 + F.wave) * rpw + k;
        float v[4][4];
        { const u32x2 t = ((const u32x2*)(OA + m * 256))[lane]; v[0][0] = bflo(t.x); v[0][1] = bfhi(t.x); v[0][2] = bflo(t.y); v[0][3] = bfhi(t.y); }
        { const float l0 = LSE[m * 4 + hh], l1 = LSE[((size_t)M + m) * 4 + hh], l2 = LSE[((size_t)2 * M + m) * 4 + hh];
          const float mx = fmaxf(l0, fmaxf(l1, l2)); float w0 = fast_exp2(l0 - mx), w1 = fast_exp2(l1 - mx), w2 = fast_exp2(l2 - mx); const float inv = fast_rcp(w0 + w1 + w2); w0 *= inv; w1 *= inv; w2 *= inv;
          const u32x2 a = ((const u32x2*)(DIL + m * 256))[lane], bq = ((const u32x2*)(DIL + ((size_t)M + m) * 256))[lane], cq = ((const u32x2*)(DIL + ((size_t)2 * M + m) * 256))[lane];
          v[1][0] = w0 * bflo(a.x) + w1 * bflo(bq.x) + w2 * bflo(cq.x); v[1][1] = w0 * bfhi(a.x) + w1 * bfhi(bq.x) + w2 * bfhi(cq.x);
          v[1][2] = w0 * bflo(a.y) + w1 * bflo(bq.y) + w2 * bflo(cq.y); v[1][3] = w0 * bfhi(a.y) + w1 * bfhi(bq.y) + w2 * bfhi(cq.y); }
        { const u32x2 t = ((const u32x2*)(OC + m * 256))[lane]; v[2][0] = bflo(t.x); v[2][1] = bfhi(t.x); v[2][2] = bflo(t.y); v[2][3] = bfhi(t.y); }
        { const u32x2 t = ((const u32x2*)(OD + m * 256))[lane]; v[3][0] = bflo(t.x); v[3][1] = bfhi(t.x); v[3][2] = bflo(t.y); v[3][3] = bfhi(t.y); }
#pragma unroll
        for (int g = 0; g < 4; ++g) {
            const float ss = wave_sum(v[g][0] * v[g][0] + v[g][1] * v[g][1] + v[g][2] * v[g][2] + v[g][3] * v[g][3]);
            const float r = __builtin_amdgcn_rsqf(ss * (1.0f / 256.0f) + EPS);
            const f32x4 gg = *(const f32x4*)(group_g + (size_t)(layer * 4 + g) * 256 + 4 * lane);
            u32x2 t; t.x = cvtpk(v[g][0] * r * gg[0], v[g][1] * r * gg[1]); t.y = cvtpk(v[g][2] * r * gg[2], v[g][3] * r * gg[3]);
            ((u32x2*)(MIXN + m * D + 256 * g))[lane] = t; }
    }
}

__device__ __forceinline__ void gmlp_unit(Frame& F, int layer, int b, int ch) {
    const bf16* P = (const bf16*)(F.ws + WS_P); bf16* OC = (bf16*)(F.ws + WS_OC);
    const size_t R0 = (size_t)b * SEQ + 128 * ch;
    LAS bf16* VT = (LAS bf16*)F.lds;
    const int lane = F.lane, w = F.wave;
    for (int k = 0; k < 16; ++k) { const int s = 16 * w + k;
        const u32x2 t = ((const u32x2*)(P + (R0 + s) * PW + P_GV))[lane];
        float v0 = bflo(t.x), v1 = bfhi(t.x), v2 = bflo(t.y), v3 = bfhi(t.y);
        const float mean = wave_sum((v0 + v1) + (v2 + v3)) * (1.0f / 256.0f);
        v0 -= mean; v1 -= mean; v2 -= mean; v3 -= mean;
        const float rstd = __builtin_amdgcn_rsqf(wave_sum((v0 * v0 + v1 * v1) + (v2 * v2 + v3 * v3)) * (1.0f / 256.0f) + EPS);
        const unsigned p0 = cvtpk(v0 * rstd, v1 * rstd), p1 = cvtpk(v2 * rstd, v3 * rstd);
        VT[(4 * lane + 0) * 136 + s] = (bf16)(p0 & 0xffffu); VT[(4 * lane + 1) * 136 + s] = (bf16)(p0 >> 16);
        VT[(4 * lane + 2) * 136 + s] = (bf16)(p1 & 0xffffu); VT[(4 * lane + 3) * 136 + s] = (bf16)(p1 >> 16); }
    __syncthreads();
    const int g = w >> 1, cb = 64 * g + 32 * (w & 1), r = lane & 31, h = lane >> 5;
    ArgsP A = args_ptr();
    const float* W = INP(A, I_GMLPW) + (size_t)(layer * 4 + g) * 128 * 128;
    const float* bias = INP(A, I_GMLPB) + (size_t)(layer * 4 + g) * 128;
    for (int tt = 0; tt < 4; ++tt) {
        f32x16 acc;
#pragma unroll
        for (int i = 0; i < 16; ++i) acc[i] = 0.f;
        const int t = 32 * tt + r;
        for (int ks = 0; ks < 2 * (tt + 1); ++ks) {
            const int s0 = 16 * ks + 8 * h;
            const f32x4 a = *(const f32x4*)(W + (size_t)t * 128 + s0), c = *(const f32x4*)(W + (size_t)t * 128 + s0 + 4);
            float v[8] = {a[0], a[1], a[2], a[3], c[0], c[1], c[2], c[3]};
#pragma unroll
            for (int e = 0; e < 8; ++e) v[e] = (s0 + e <= t) ? v[e] : 0.f;
            u32x4 aw; aw.x = cvtpk(v[0], v[1]); aw.y = cvtpk(v[2], v[3]); aw.z = cvtpk(v[4], v[5]); aw.w = cvtpk(v[6], v[7]);
            const bf16x8 bfrag = *(const LAS bf16x8*)(VT + (cb + r) * 136 + s0);
            acc = MFMA32(__builtin_bit_cast(bf16x8, aw), bfrag, acc);
        }
#pragma unroll
        for (int i = 0; i < 16; ++i) { const int to = 32 * tt + crow(i, h); const float z = acc[i] + bias[to];
            const float u = bf2f(P[(R0 + to) * PW + P_GU + cb + r]);
            OC[(R0 + to) * 256 + cb + r] = (bf16)(cvtpk(u * z, 0.f) & 0xffffu); }
    }
    __syncthreads();
}
__device__ __forceinline__ void conv_unit(Frame& F, int layer, int b, int ch) {
    const bf16* P = (const bf16*)(F.ws + WS_P); bf16* OD = (bf16*)(F.ws + WS_OD);
    const int t0 = 64 * ch; const size_t Rb = (size_t)b * SEQ;
    LAS bf16* XT = (LAS bf16*)F.lds;
    LAS float* YT = (LAS float*)(F.lds + 48128);
    for (int id = F.tid; id < 94 * 32; id += 512) { const int row = id >> 5, piece = id & 31, t = t0 - 30 + row;
        u32x4 v = (u32x4){0u, 0u, 0u, 0u};
        if (t >= 0) v = *(const u32x4*)(P + (Rb + t) * PW + P_GLU + 8 * piece);
        *(LAS u32x4*)(XT + row * 256 + 8 * piece) = v; }
    __syncthreads();
    ArgsP A = args_ptr();
    { const int c = F.tid & 255, half = F.tid >> 8; const float* conv_w = INP(A, I_CONVW);
      float wk[31];
#pragma unroll
      for (int k = 0; k < 31; ++k) wk[k] = conv_w[(size_t)(layer * 31 + k) * 256 + c];
      const float cb = INP(A, I_CONVB)[layer * 256 + c];
      float xs[62];
#pragma unroll
      for (int i = 0; i < 62; ++i) xs[i] = bf2f(XT[(32 * half + i) * 256 + c]);
#pragma unroll
      for (int j = 0; j < 32; ++j) { float y = cb;
#pragma unroll
          for (int k = 0; k < 31; ++k) y += wk[k] * xs[j + k];
          YT[(32 * half + j) * 260 + c] = y; } }
    __syncthreads();
    { const int lane = F.lane;
      const f32x4 lg = *(const f32x4*)(INP(A, I_CONVLNG) + layer * 256 + 4 * lane), lb = *(const f32x4*)(INP(A, I_CONVLNB) + layer * 256 + 4 * lane);
      for (int k = 0; k < 8; ++k) { const int t = 8 * F.wave + k;
          f32x4 y = *(const LAS f32x4*)(YT + t * 260 + 4 * lane);
          const float mean = wave_sum((y[0] + y[1]) + (y[2] + y[3])) * (1.0f / 256.0f);
          y = y - mean;
          const float rstd = __builtin_amdgcn_rsqf(wave_sum((y[0] * y[0] + y[1] * y[1]) + (y[2] * y[2] + y[3] * y[3])) * (1.0f / 256.0f) + EPS);
          float o[4];
#pragma unroll
          for (int e = 0; e < 4; ++e) o[e] = siluf_(y[e] * rstd * lg[e] + lb[e]);
          u32x2 w; w.x = cvtpk(o[0], o[1]); w.y = cvtpk(o[2], o[3]);
          ((u32x2*)(OD + (Rb + t0 + t) * 256))[lane] = w; } }
    __syncthreads();
}
__device__ __forceinline__ void phase_mixers(Frame& F, int layer) {
    REFRESH(F);
    for (int u = F.vcu; u < 256; u += F.G) gmlp_unit(F, layer, u >> 4, u & 15);
    for (int u = F.vcu; u < 512; u += F.G) conv_unit(F, layer, u >> 5, u & 31);
    const bf16* P = (const bf16*)(F.ws + WS_P);
    const float* kms = (const float*)(F.ctl + CW_KM) + (size_t)layer * 32768;
    LAS char* vt = (LAS char*)(F.lds + F.wave * 4096);
    const int gw = F.vcu * 8 + F.wave, NGW = F.G * 8;
    for (int p = gw; p < 2048; p += NGW) { const int bh = p >> 5, q0 = p & 31;
        moba_item(P, kms, (bf16*)(F.ws + WS_OA), bh >> 2, bh & 3, q0, vt, F.lane);
        moba_item(P, kms, (bf16*)(F.ws + WS_OA), bh >> 2, bh & 3, 63 - q0, vt, F.lane); }
    for (int it = gw; it < 3 * 4096; it += NGW) { const int cfg = it >> 12, rem = it & 4095, bh = rem >> 6, idx = rem & 63;
        dil_item(P, (bf16*)(F.ws + WS_DIL) + (size_t)cfg * M * 256, (float*)(F.ws + WS_LSE) + (size_t)cfg * M * 4, cfg, bh >> 2, bh & 3, idx, vt, F.lane); }
}

constexpr int PH_PROLOGUE = 0, PH_PRENORM = 1, PH_L0 = 2, PH_L1 = 10, PH_MOE_INDEX = 15, PH_MOE_CHUNK0 = 16, PH_POSTFFN1 = 26, N_PHASES = 27;
__global__ void __launch_bounds__(512, 2) fwd_kernel(Args args) {
    extern __shared__ __attribute__((aligned(16))) unsigned char lds_raw[];
    Frame F;
    F.lds = (LAS unsigned char*)lds_raw;
    F.tid = threadIdx.x; F.lane = F.tid & 63; F.wave = __builtin_amdgcn_readfirstlane(F.tid >> 6);
    F.G = gridDim.x; { const int bx = blockIdx.x; F.vcu = (F.G % 8 == 0) ? (bx % 8) * (F.G / 8) + bx / 8 : bx; }
    F.ws = args.ws; F.ctl = (unsigned*)(args.ws + WS_CTL); F.out = args.out;
    volatile LAS unsigned* MISC = (volatile LAS unsigned*)(F.lds + LDSX_OFF);
    if (F.tid < 16) MISC[F.tid] = 0u;
    __syncthreads();
    const int lo = args.ph_lo, hi = args.ph_hi;
    const bool multi = (hi - lo) > 1;
    XcdBarrier bar; bar.bar = F.ctl + CW_BAR; bar.x = 0; bar.st = nullptr;
    if (multi) bar = xcd_barrier_post(F.ctl + CW_BAR, MISC + 8);
#ifndef KMASK
#define KMASK 0xFFFF
#endif
#define KON(b) (((KMASK) >> (b)) & 1)
#define IN(k) (lo <= (k) && (k) < hi)
#define SEAM(k) do { if (IN(k) && IN((k) + 1)) xcd_barrier(bar); } while (0)

    if (KON(0) && IN(PH_PROLOGUE)) phase_prologue(F);
    SEAM(PH_PROLOGUE);
    if (KON(1) && IN(PH_PRENORM)) phase_prenorm0(F);
    SEAM(PH_PRENORM);
    for (int layer = 0; layer < 2; ++layer) {
        const int pb = layer == 0 ? PH_L0 : PH_L1;
        if (KON(2) && IN(pb)) {
            pg8::SchedPlain S; S.init(M / 256, NIN / 256, F.G, (int)blockIdx.x); S.Bt = (const char*)(F.ws + WS_WIN) + (size_t)layer * NIN * 1024 * 2; S.tstep = (size_t)256 * 1024 * 2;
            EpiInProj E{(bf16*)(F.ws + WS_P), (const int*)args.in[I_POS], (float*)(F.ctl + CW_KM) + (size_t)layer * 32768};
            pg8::gemm_phase(F.lds, (const char*)(F.ws + WS_HB), 1024, S, E);
        }
        SEAM(pb);
        if (KON(3) && IN(pb + 1)) phase_mixers(F, layer);
        SEAM(pb + 1);
        if (KON(4) && IN(pb + 2)) phase_mixnorm(F, layer);
        SEAM(pb + 2);
        if (KON(5) && IN(pb + 3)) {
            pg8::SchedPlain S; S.init(M / 256, 4, F.G, (int)blockIdx.x); S.Bt = (const char*)(F.ws + WS_WOUT) + (size_t)layer * 1024 * 1024 * 2; S.tstep = (size_t)256 * 1024 * 2;
            EpiPlain E{(bf16*)(F.ws + WS_Y), 1024, 0};
            pg8::gemm_phase(F.lds, (const char*)(F.ws + WS_HB), 1024, S, E);
        }
        SEAM(pb + 3);
        if (KON(6) && IN(pb + 4)) phase_postmix(F, layer, layer == 1);
        SEAM(pb + 4);
        if (layer == 0) {
            if (KON(7) && IN(pb + 5)) {
                pg8::SchedPlain S; S.init(M / 256, 2 * FFD / 256, F.G, (int)blockIdx.x); S.Bt = (const char*)(F.ws + WS_WFGU); S.tstep = (size_t)256 * 1024 * 2;
                EpiSwiGLU E{(bf16*)(F.ws + WS_FH), FFD};
                pg8::gemm_phase(F.lds, (const char*)(F.ws + WS_HB), 1024, S, E);
            }
            SEAM(pb + 5);
            if (KON(8) && IN(pb + 6)) {
                pg8::SchedPlain S; S.init(M / 256, 4, F.G, (int)blockIdx.x); S.Bt = (const char*)(F.ws + WS_WFD); S.tstep = (size_t)256 * FFD * 2;
                EpiPlain E{(bf16*)(F.ws + WS_HB), 1024, 0};
                pg8::gemm_phase(F.lds, (const char*)(F.ws + WS_FH), FFD, S, E);
            }
            SEAM(pb + 6);
            if (KON(9) && IN(pb + 7)) phase_postffn(F, 0, false);
            SEAM(pb + 7);
        } else {
            if (KON(10) && IN(PH_MOE_INDEX)) phase_moe_index(F);
            SEAM(PH_MOE_INDEX);
            for (int c = 0; c < NCHUNK; ++c) {
                const int pg = PH_MOE_CHUNK0 + 2 * c;
                if (IN(pg) || IN(pg + 1)) {
                    int ts[9], cnt[8]; moe_tiles(F, ts, cnt);
                    const int tile0 = CHUNK_TILES * c; int nt = ts[8] - tile0; nt = nt > CHUNK_TILES ? CHUNK_TILES : nt;
                    if (KON(11) && IN(pg) && nt > 0) {
                        pg8::SchedMoe<true> S; S.init(nt, 2 * FFE / 256, F.G, (int)blockIdx.x); S.Bt = (const char*)(F.ws + WS_WMGU); S.tstep = (size_t)256 * 1024 * 2; S.estride = (size_t)2 * FFE * 1024 * 2;
                        S.tile0 = tile0; S.s2t = (const int*)(F.ws + WS_S2T);
#pragma unroll
                        for (int k = 0; k < 7; ++k) S.ts[k] = ts[k + 1];
                        EpiSwiGLU E{(bf16*)(F.ws + WS_HID), FFE};
                        pg8::gemm_phase(F.lds, (const char*)(F.ws + WS_HB), 1024, S, E);
                    }
                    SEAM(pg);
                    if (KON(12) && IN(pg + 1) && nt > 0) {
                        pg8::SchedMoe<false> S; S.init(nt, 4, F.G, (int)blockIdx.x); S.Bt = (const char*)(F.ws + WS_WMD); S.tstep = (size_t)256 * FFE * 2; S.estride = (size_t)1024 * FFE * 2;
                        S.tile0 = tile0; S.s2t = nullptr;
#pragma unroll
                        for (int k = 0; k < 7; ++k) S.ts[k] = ts[k + 1];
                        EpiPlain E{(bf16*)(F.ws + WS_YS), 1024, tile0 * 256};
                        pg8::gemm_phase(F.lds, (const char*)(F.ws + WS_HID), FFE, S, E);
                    }
                    SEAM(pg + 1);
                }
            }
            if (KON(13) && IN(PH_POSTFFN1)) phase_postffn(F, 1, true);
        }
    }
#undef IN
#undef SEAM
}

extern "C" void kernel_launch(void* const* d_in, const int* in_sizes, int n_in, void* d_out, int out_size, void* d_ws, size_t ws_size, hipStream_t stream) {
    static int grid = 0;
    if (grid == 0) {
        if (n_in != 26 || out_size != M * D || ws_size < WS_END) { fprintf(stderr, "kernel_launch: unexpected problem: n_in %d out %d ws %zu (need %zu)\n", n_in, out_size, ws_size, (size_t)WS_END); grid = -1; return; }
        int dev = 0, cus = 0, per_cu = 0;
        if (hipGetDevice(&dev) != hipSuccess || hipDeviceGetAttribute(&cus, hipDeviceAttributeMultiprocessorCount, dev) != hipSuccess) { grid = -1; return; }
        if (hipFuncSetAttribute((const void*)fwd_kernel, hipFuncAttributeMaxDynamicSharedMemorySize, LDS_BYTES) != hipSuccess) { fprintf(stderr, "kernel_launch: hipFuncSetAttribute failed\n"); grid = -1; return; }
        if (hipOccupancyMaxActiveBlocksPerMultiprocessor(&per_cu, (const void*)fwd_kernel, 512, LDS_BYTES) != hipSuccess || per_cu < 1) fprintf(stderr, "kernel_launch: occupancy query says %d\n", per_cu);
        (void)hipGetLastError();
        grid = cus;
        fprintf(stderr, "kernel_launch: grid %d, ws %zu\n", grid, ws_size);
    }
    if (grid < 0) return;
    (void)hipMemsetAsync((char*)d_ws + WS_CTL, 0, CTL_ZERO_BYTES, stream);
    Args a{};
    for (int i = 0; i < 26; ++i) a.in[i] = d_in[i];
    a.out = (float*)d_out; a.ws = (unsigned char*)d_ws;
#if MK_ONE_LAUNCH
    a.ph_lo = 0; a.ph_hi = N_PHASES;
    hipLaunchKernelGGL(fwd_kernel, dim3(grid), dim3(512), LDS_BYTES, stream, a);
#else
    for (int p = 0; p < N_PHASES; ++p) { a.ph_lo = p; a.ph_hi = p + 1; hipLaunchKernelGGL(fwd_kernel, dim3(grid), dim3(512), LDS_BYTES, stream, a); }
#endif
}
```

```cpp
#include <hip/hip_runtime.h>
#include <cstdio>
#include <cstdint>

#ifndef MK_ONE_LAUNCH
#define MK_ONE_LAUNCH 1
#endif

#define GAS __attribute__((address_space(1)))
#define LAS __attribute__((address_space(3)))
typedef unsigned short bf16;
typedef short bf16x8 __attribute__((ext_vector_type(8)));
typedef float f32x4 __attribute__((ext_vector_type(4)));
typedef float f32x16 __attribute__((ext_vector_type(16)));
typedef unsigned u32x4 __attribute__((ext_vector_type(4)));
typedef unsigned u32x2 __attribute__((ext_vector_type(2)));
typedef float f32x2_t __attribute__((ext_vector_type(2)));
typedef __bf16 bf16x2_t __attribute__((ext_vector_type(2)));
typedef short v4i16_t __attribute__((ext_vector_type(4)));
typedef GAS unsigned gu32;

constexpr int BATCH = 16, SEQ = 2048, D = 1024, M = BATCH * SEQ;
constexpr int NIN = 2560, PW = 2304;
constexpr int FFD = 2816, FFE = 3584, NEXP = 8;
constexpr float EPS = 1e-6f;
constexpr float C2 = 0.125f * 1.4426950408889634f;
constexpr int P_QA = 0, P_KA = 256, P_VA = 512, P_QB = 768, P_KB = 1024, P_VB = 1280, P_GU = 1536, P_GV = 1792, P_GLU = 2048;
constexpr int MOE_TILES_MAX = 264, CHUNK_TILES = 64, NCHUNK = 5;

__device__ __forceinline__ unsigned cvtpk(float lo, float hi) { f32x2_t v = {lo, hi}; bf16x2_t b = __builtin_convertvector(v, bf16x2_t); return __builtin_bit_cast(unsigned, b); }
__device__ __forceinline__ float bf2f(unsigned short b) { return __uint_as_float((unsigned)b << 16); }
__device__ __forceinline__ float bflo(unsigned w) { return __uint_as_float(w << 16); }
__device__ __forceinline__ float bfhi(unsigned w) { return __uint_as_float(w & 0xffff0000u); }
__device__ __forceinline__ float fast_exp2(float x) { return __builtin_amdgcn_exp2f(x); }
__device__ __forceinline__ float fast_rcp(float x) { return __builtin_amdgcn_rcpf(x); }
__device__ __forceinline__ float sigmoidf_(float x) { return fast_rcp(1.0f + fast_exp2(-1.4426950408889634f * x)); }
__device__ __forceinline__ float siluf_(float x) { return x * sigmoidf_(x); }
__device__ __forceinline__ float gelu_tanh(float x) { const float u = x + 0.044715f * x * x * x; return x * fast_rcp(1.0f + fast_exp2(-2.3022081982f * u)); }
__device__ __forceinline__ float wave_sum(float v) {
#pragma unroll
    for (int o = 1; o < 64; o <<= 1) v += __shfl_xor(v, o);
    return v;
}

namespace pg8 {
constexpr int BM = 256, BK = 64, HALF = 128, HTB = HALF * BK * 2, STAGE_BYTES = 8 * HTB, NXCD = 8, WGM = 8;
__host__ __device__ __forceinline__ int lds_byte(int r, int c) { const int st = (r >> 4) * 2 + (c >> 5), rr = r & 15, cc = c & 31, ob = rr * 64 + cc * 2; return st * 1024 + (ob ^ (((ob >> 9) & 1) << 5)); }
__host__ __device__ __forceinline__ void stage_rc(int b, int& R, int& C) { const int st = b / 1024, sb = b % 1024, swz = sb ^ (((sb >> 9) & 1) << 5); R = (st >> 1) * 16 + swz / 64; C = (st & 1) * 32 + (swz % 64) / 2; }
__host__ __device__ __forceinline__ int perm32(int rho) { const int n = rho >> 4, i = rho & 15; return 8 * (i >> 2) + 4 * n + (i & 3); }

struct Unit { int pm, pn; };
struct StaticOrder {
    int nM, nN, nwg, G, c;
    __device__ void init(int nM_, int nN_, int G_, int c_) { nM = nM_; nN = nN_; nwg = nM * nN; G = G_; c = c_; }
    __device__ bool next(int i, Unit& u) const {
        const long L = (long)i * G + c; if (L >= nwg) return false;
        int wgid = (int)L; { const int q = nwg / NXCD, r = nwg % NXCD, xcd = wgid % NXCD, off = wgid / NXCD; wgid = (xcd < r ? xcd * (q + 1) : r * (q + 1) + (xcd - r) * q) + off; }
        const int nig = WGM * nN, gid = wgid / nig, fm = gid * WGM, gsz = (nM - fm) < WGM ? (nM - fm) : WGM;
        u.pm = fm + ((wgid % nig) % gsz); u.pn = (wgid % nig) / gsz; return true;
    }
};
struct SchedPlain : StaticOrder {
    static constexpr bool GATHER = false;
    const char* Bt; size_t tstep;
    __device__ __forceinline__ int arow(const Unit& u, int rr) const { return u.pm * BM + rr; }
    __device__ __forceinline__ const char* bptr(const Unit& u) const { return Bt + (size_t)u.pn * tstep; }
};
template <bool GATHER_> struct SchedMoe : StaticOrder {
    static constexpr bool GATHER = GATHER_;
    const char* Bt; size_t tstep, estride; int tile0; const int* s2t; int ts[7];
    __device__ __forceinline__ int expert(int pmg) const { int e = 0;
#pragma unroll
        for (int k = 0; k < 7; ++k) e += (pmg >= ts[k]) ? 1 : 0;
        return e; }
    __device__ __forceinline__ int arow(const Unit& u, int rr) const { return GATHER ? s2t[(tile0 + u.pm) * BM + rr] : u.pm * BM + rr; }
    __device__ __forceinline__ const char* bptr(const Unit& u) const { return Bt + (size_t)expert(tile0 + u.pm) * estride + (size_t)u.pn * tstep; }
};

template <class Epi, class Sched>
__device__ __forceinline__ void gemm_phase(LAS unsigned char* lds, const char* Abase, const int K, const Sched& S, const Epi& E) {
    int tid = threadIdx.x; asm volatile("" : "+v"(tid)); const int wid = __builtin_amdgcn_readfirstlane(tid >> 6), lane = tid & 63, wr = wid >> 2, wc = wid & 3, fr = lane & 15, fq = lane >> 4;
    const int nt = K / BK;
    int R0, C0; stage_rc(tid * 16, R0, C0);
    const unsigned voffA = (unsigned)(R0 * K + C0) * 2u, voffB = (unsigned)(((R0 & ~31) + perm32(R0 & 31)) * K + C0) * 2u;
    const size_t kstep = (size_t)(BK * 2);
    const size_t hstep = (size_t)HALF * K * 2;
    const unsigned rowb = (unsigned)K * 2u, colb = (unsigned)C0 * 2u;
    const size_t q64 = (size_t)64 * K * 2;
    const unsigned ldsw = (unsigned)wid * 1024u;
    const int aoff = lds_byte(wr * 64 + fr, fq * 8), boff = lds_byte(wc * 32 + fr, fq * 8);
#define PG8_SA(b, h) (((b) * 2 + (h)) * HTB)
#define PG8_SB(b, h) ((4 + (b) * 2 + (h)) * HTB)
#define PG8_GLDS(gp, bufoff, i) __builtin_amdgcn_global_load_lds((const unsigned*)(gp), (LAS unsigned*)(lds + (bufoff) + ldsw + (i) * 8192), 16, 0, 0)
#define PG8_STAGE_B(bufoff, gbase) do { PG8_GLDS((const char*)(gbase) + voffB, bufoff, 0); PG8_GLDS((const char*)(gbase) + q64 + voffB, bufoff, 1); } while (0)
#define PG8_STAGE_A(bufoff, h, kb, NX) do { \
        if constexpr (Sched::GATHER) { const unsigned _o0 = (NX) ? ((h) ? na2 : na0) : ((h) ? va2 : va0), _o1 = (NX) ? ((h) ? na3 : na1) : ((h) ? va3 : va1); \
            PG8_GLDS(Abase + (kb) + _o0, bufoff, 0); PG8_GLDS(Abase + (kb) + _o1, bufoff, 1); } \
        else { const char* _b = ((NX) ? nA : cA) + (size_t)(h) * hstep + (kb); PG8_GLDS(_b + voffA, bufoff, 0); PG8_GLDS(_b + q64 + voffA, bufoff, 1); } } while (0)
#define PG8_LDA(dst, b, h) do { _Pragma("unroll") for (int m = 0; m < 4; ++m) _Pragma("unroll") for (int k = 0; k < 2; ++k) dst[m][k] = *(const LAS bf16x8*)(lds + PG8_SA(b, h) + aoff + m * 2048 + k * 1024); } while (0)
#define PG8_LDB(dst, b, h) do { _Pragma("unroll") for (int n = 0; n < 2; ++n) _Pragma("unroll") for (int k = 0; k < 2; ++k) dst[n][k] = *(const LAS bf16x8*)(lds + PG8_SB(b, h) + boff + n * 2048 + k * 1024); } while (0)
#define PG8_MMA(ai, bj, At, Bt) do { __builtin_amdgcn_s_setprio(1); _Pragma("unroll") for (int m = 0; m < 4; ++m) _Pragma("unroll") for (int n = 0; n < 2; ++n) _Pragma("unroll") for (int k = 0; k < 2; ++k) \
        acc[ai][bj][m][n] = __builtin_amdgcn_mfma_f32_16x16x32_bf16(Bt[n][k], At[m][k], acc[ai][bj][m][n], 0, 0, 0); __builtin_amdgcn_s_setprio(0); } while (0)
#define PG8_WAIT_V(n) asm volatile("s_waitcnt vmcnt(" #n ")" ::: "memory")
#define PG8_WAIT_L(n) asm volatile("s_waitcnt lgkmcnt(" #n ")" ::: "memory")
#define PG8_BAR __builtin_amdgcn_s_barrier()
#define PG8_SCHED __builtin_amdgcn_sched_barrier(0)
    Unit cur, nxt; int ui = 0;
    if (!S.next(0, cur)) return;
    f32x4 acc[2][2][4][2];
#pragma unroll
    for (int a = 0; a < 2; ++a)
#pragma unroll
        for (int b = 0; b < 2; ++b)
#pragma unroll
            for (int m = 0; m < 4; ++m)
#pragma unroll
                for (int n = 0; n < 2; ++n) acc[a][b][m][n] = (f32x4){0.f, 0.f, 0.f, 0.f};
    bf16x8 At[4][2], B0[2][2], B1[2][2];
    unsigned va0 = 0, va1 = 0, va2 = 0, va3 = 0, na0 = 0, na1 = 0, na2 = 0, na3 = 0;
    const char* cA = Abase; const char* nA = Abase;
    if constexpr (Sched::GATHER) { va0 = (unsigned)S.arow(cur, R0) * rowb + colb; va1 = (unsigned)S.arow(cur, R0 + 64) * rowb + colb;
                                   va2 = (unsigned)S.arow(cur, R0 + 128) * rowb + colb; va3 = (unsigned)S.arow(cur, R0 + 192) * rowb + colb; }
    else cA = Abase + (size_t)S.arow(cur, 0) * rowb;
    const char* cB = S.bptr(cur);
    PG8_STAGE_B(PG8_SB(0, 0), cB); PG8_STAGE_B(PG8_SB(0, 1), cB + hstep); PG8_STAGE_A(PG8_SA(0, 0), 0, 0, false); PG8_STAGE_A(PG8_SA(0, 1), 1, 0, false);
    if (wr == 1) PG8_BAR;
    PG8_WAIT_V(2); PG8_BAR;
    PG8_STAGE_B(PG8_SB(1, 0), cB + kstep); PG8_STAGE_A(PG8_SA(1, 0), 0, kstep, false); PG8_STAGE_B(PG8_SB(1, 1), cB + hstep + kstep);
    PG8_WAIT_V(6); PG8_BAR;
    for (;;) {
        const bool has_next = S.next(ui + 1, nxt);
        const char* nB = has_next ? S.bptr(nxt) : cB;
        if constexpr (Sched::GATHER) {
            na0 = va0; na1 = va1; na2 = va2; na3 = va3;
            if (has_next) { na0 = (unsigned)S.arow(nxt, R0) * rowb + colb; na1 = (unsigned)S.arow(nxt, R0 + 64) * rowb + colb;
                            na2 = (unsigned)S.arow(nxt, R0 + 128) * rowb + colb; na3 = (unsigned)S.arow(nxt, R0 + 192) * rowb + colb; }
        } else nA = has_next ? Abase + (size_t)S.arow(nxt, 0) * rowb : cA;
        for (int t = 0; t < nt; t += 2) {
            const bool last = (t == nt - 2);
            const size_t k1 = (size_t)(t + 1) * kstep, k2 = last ? 0 : (size_t)(t + 2) * kstep, k3 = k2 + kstep;
            const char* b2 = last ? nB : cB + (size_t)(t + 2) * kstep; const char* b3 = b2 + kstep;
            PG8_LDB(B0, 0, 0); PG8_LDB(B1, 0, 1); PG8_SCHED; PG8_LDA(At, 0, 0); PG8_STAGE_A(PG8_SA(1, 1), 1, k1, false);
            PG8_WAIT_V(8); PG8_WAIT_L(0); PG8_BAR; PG8_MMA(0, 0, At, B0); PG8_MMA(0, 1, At, B1); PG8_BAR; PG8_SCHED;
            PG8_LDA(At, 0, 1); PG8_STAGE_B(PG8_SB(0, 0), b2); PG8_STAGE_B(PG8_SB(0, 1), b2 + hstep); PG8_STAGE_A(PG8_SA(0, 0), 0, k2, last);
            PG8_WAIT_V(8); PG8_WAIT_L(0); PG8_BAR; PG8_MMA(1, 0, At, B0); PG8_MMA(1, 1, At, B1); PG8_BAR; PG8_SCHED;
            PG8_LDB(B0, 1, 0); PG8_LDB(B1, 1, 1); PG8_SCHED; PG8_LDA(At, 1, 0); PG8_STAGE_A(PG8_SA(0, 1), 1, k2, last);
            PG8_WAIT_V(8); PG8_WAIT_L(0); PG8_BAR; PG8_MMA(0, 0, At, B0); PG8_MMA(0, 1, At, B1); PG8_BAR; PG8_SCHED;
            PG8_LDA(At, 1, 1); PG8_STAGE_B(PG8_SB(1, 0), b3); PG8_STAGE_B(PG8_SB(1, 1), b3 + hstep); PG8_STAGE_A(PG8_SA(1, 0), 0, k3, last);
            PG8_WAIT_V(8); PG8_WAIT_L(0); PG8_BAR; PG8_MMA(1, 0, At, B0); PG8_MMA(1, 1, At, B1); PG8_BAR; PG8_SCHED;
        }
        if (wr == 0) PG8_BAR;
        E(acc, cur, wr, wc, fr, fq);
        if (!has_next) break;
#pragma unroll
        for (int a = 0; a < 2; ++a)
#pragma unroll
            for (int b = 0; b < 2; ++b)
#pragma unroll
                for (int m = 0; m < 4; ++m)
#pragma unroll
                    for (int n = 0; n < 2; ++n) acc[a][b][m][n] = (f32x4){0.f, 0.f, 0.f, 0.f};
        cur = nxt; cB = nB; cA = nA; va0 = na0; va1 = na1; va2 = na2; va3 = na3; ++ui;
        if (wr == 1) PG8_BAR;
    }
    PG8_WAIT_V(0);
    PG8_BAR;
#undef PG8_SA
#undef PG8_SB
#undef PG8_GLDS
#undef PG8_STAGE_A
#undef PG8_STAGE_B
#undef PG8_LDA
#undef PG8_LDB
#undef PG8_MMA
#undef PG8_WAIT_V
#undef PG8_WAIT_L
#undef PG8_BAR
#undef PG8_SCHED
}
}

struct EpiPlain {
    bf16* O; int ldc; int rowoff;
    __device__ __forceinline__ void operator()(const f32x4 (&acc)[2][2][4][2], const pg8::Unit& u, int wr, int wc, int fr, int fq) const {
        const int row0 = rowoff + u.pm * 256 + wr * 64 + fr, col0 = u.pn * 256 + wc * 32 + 8 * fq;
#pragma unroll
        for (int ai = 0; ai < 2; ++ai)
#pragma unroll
            for (int m = 0; m < 4; ++m) { bf16* rowp = O + (size_t)(row0 + ai * 128 + m * 16) * ldc + col0;
#pragma unroll
                for (int bj = 0; bj < 2; ++bj) { const f32x4 v0 = acc[ai][bj][m][0], v1 = acc[ai][bj][m][1];
                    u32x4 w; w.x = cvtpk(v0[0], v0[1]); w.y = cvtpk(v0[2], v0[3]); w.z = cvtpk(v1[0], v1[1]); w.w = cvtpk(v1[2], v1[3]);
                    *(u32x4*)(rowp + bj * 128) = w; } }
    }
};
struct EpiSwiGLU {
    bf16* O; int ldc;
    __device__ __forceinline__ void operator()(const f32x4 (&acc)[2][2][4][2], const pg8::Unit& u, int wr, int wc, int fr, int fq) const {
        const int row0 = u.pm * 256 + wr * 64 + fr, col0 = u.pn * 128 + wc * 32 + 8 * fq;
#pragma unroll
        for (int ai = 0; ai < 2; ++ai)
#pragma unroll
            for (int m = 0; m < 4; ++m) { bf16* rowp = O + (size_t)(row0 + ai * 128 + m * 16) * ldc + col0;
                float o[8];
#pragma unroll
                for (int n = 0; n < 2; ++n)
#pragma unroll
                    for (int e = 0; e < 4; ++e) o[4 * n + e] = siluf_(acc[ai][0][m][n][e]) * acc[ai][1][m][n][e];
                u32x4 w; w.x = cvtpk(o[0], o[1]); w.y = cvtpk(o[2], o[3]); w.z = cvtpk(o[4], o[5]); w.w = cvtpk(o[6], o[7]);
                *(u32x4*)rowp = w; }
    }
};
struct EpiInProj {
    bf16* P; const int* pos; float* kmsum;
    __device__ __forceinline__ void operator()(const f32x4 (&acc)[2][2][4][2], const pg8::Unit& u, int wr, int wc, int fr, int fq) const {
        const int pn = u.pn, row0 = u.pm * 256 + wr * 64 + fr;
        if (pn == 0 || pn == 1 || pn == 3 || pn == 4) {
            const int g = wc & 1, i0 = 16 * g + 4 * fq;
            float invf[4];
#pragma unroll
            for (int e = 0; e < 4; ++e) invf[e] = fast_exp2(-(float)(i0 + e) * 0.4152410118609203f);
            const float sc = (pn == 0 || pn == 3) ? C2 : 1.0f;
            float ks[2][2][4];
#pragma unroll
            for (int a = 0; a < 2; ++a)
#pragma unroll
                for (int b = 0; b < 2; ++b)
#pragma unroll
                    for (int e = 0; e < 4; ++e) ks[a][b][e] = 0.f;
#pragma unroll
            for (int ai = 0; ai < 2; ++ai)
#pragma unroll
                for (int m = 0; m < 4; ++m) { const int row = row0 + ai * 128 + m * 16; const float p = (float)pos[row];
                    float cs[4], sn[4];
#pragma unroll
                    for (int e = 0; e < 4; ++e) { const float ang = p * invf[e]; const float k = rintf(ang * 0.15915494309189535f);
                        float r = fmaf(-k, 6.2831854820251465f, ang); r = fmaf(-k, -1.7484556000744883e-07f, r); const float rev = r * 0.15915494309189535f;
                        cs[e] = __builtin_amdgcn_cosf(rev); sn[e] = __builtin_amdgcn_sinf(rev); }
                    bf16* rowp = P + (size_t)row * PW + 256 * pn;
#pragma unroll
                    for (int bj = 0; bj < 2; ++bj) { const int hh = 2 * bj + (wc >> 1); const f32x4 v0 = acc[ai][bj][m][0], v1 = acc[ai][bj][m][1];
                        float o0[4], o1[4];
#pragma unroll
                        for (int e = 0; e < 4; ++e) { o0[e] = (v0[e] * cs[e] - v1[e] * sn[e]) * sc; o1[e] = (v1[e] * cs[e] + v0[e] * sn[e]) * sc; ks[bj][0][e] += o0[e]; ks[bj][1][e] += o1[e]; }
                        bf16* dst = rowp + 64 * hh + i0;
                        u32x2 w0, w1; w0.x = cvtpk(o0[0], o0[1]); w0.y = cvtpk(o0[2], o0[3]); w1.x = cvtpk(o1[0], o1[1]); w1.y = cvtpk(o1[2], o1[3]);
                        *(u32x2*)dst = w0; *(u32x2*)(dst + 32) = w1; } }
            if (pn == 1) {
#pragma unroll
                for (int bj = 0; bj < 2; ++bj)
#pragma unroll
                    for (int n = 0; n < 2; ++n)
#pragma unroll
                        for (int e = 0; e < 4; ++e) { float v = ks[bj][n][e]; v += __shfl_xor(v, 1); v += __shfl_xor(v, 2); v += __shfl_xor(v, 4); v += __shfl_xor(v, 8);
                            if (fr == 0) atomicAdd(kmsum + (size_t)(u.pm * 4 + 2 * bj + (wc >> 1)) * 64 + 32 * n + i0 + e, v); }
            }
        } else if (pn >= 8) {
            const int col0 = P_GLU + 128 * (pn - 8) + wc * 32 + 8 * fq;
#pragma unroll
            for (int ai = 0; ai < 2; ++ai)
#pragma unroll
                for (int m = 0; m < 4; ++m) { bf16* rowp = P + (size_t)(row0 + ai * 128 + m * 16) * PW + col0;
                    float o[8];
#pragma unroll
                    for (int n = 0; n < 2; ++n)
#pragma unroll
                        for (int e = 0; e < 4; ++e) o[4 * n + e] = acc[ai][0][m][n][e] * sigmoidf_(acc[ai][1][m][n][e]);
                    u32x4 w; w.x = cvtpk(o[0], o[1]); w.y = cvtpk(o[2], o[3]); w.z = cvtpk(o[4], o[5]); w.w = cvtpk(o[6], o[7]);
                    *(u32x4*)rowp = w; }
        } else {
            const bool act = (pn >= 6);
            const int col0 = 256 * pn + wc * 32 + 8 * fq;
#pragma unroll
            for (int ai = 0; ai < 2; ++ai)
#pragma unroll
                for (int m = 0; m < 4; ++m) { bf16* rowp = P + (size_t)(row0 + ai * 128 + m * 16) * PW + col0;
#pragma unroll
                    for (int bj = 0; bj < 2; ++bj) { float o[8];
#pragma unroll
                        for (int n = 0; n < 2; ++n)
#pragma unroll
                            for (int e = 0; e < 4; ++e) { const float v = acc[ai][bj][m][n][e]; o[4 * n + e] = act ? gelu_tanh(v) : v; }
                        u32x4 w; w.x = cvtpk(o[0], o[1]); w.y = cvtpk(o[2], o[3]); w.z = cvtpk(o[4], o[5]); w.w = cvtpk(o[6], o[7]);
                        *(u32x4*)(rowp + bj * 128) = w; } }
        }
    }
};

#define MFMA32(a, b, c) __builtin_amdgcn_mfma_f32_32x32x16_bf16((a), (b), (c), 0, 0, 0)
__device__ __forceinline__ int crow(int i, int h) { return (i & 3) + 8 * (i >> 2) + 4 * h; }
__device__ __forceinline__ v4i16_t vtr(const LAS char* p) { return __builtin_amdgcn_ds_read_tr16_b64_v4i16((LAS v4i16_t*)p); }

__device__ __forceinline__ void attn_tile(f32x16& o0, f32x16& o1, float& m, float& l, const bf16x8 (&qf)[4], const bf16* kp, const bf16* vp, size_t v8,
                                          LAS char* vt, int lane, unsigned vmask) {
    const int h = lane >> 5;
    bf16x8 kf[4];
#pragma unroll
    for (int s = 0; s < 4; ++s) kf[s] = *(const bf16x8*)(kp + 16 * s);
    u32x4 vv[4];
#pragma unroll
    for (int w = 0; w < 4; ++w) vv[w] = *(const u32x4*)(vp + (size_t)w * v8);
    f32x16 p;
#pragma unroll
    for (int i = 0; i < 16; ++i) p[i] = 0.f;
#pragma unroll
    for (int s = 0; s < 4; ++s) p = MFMA32(kf[s], qf[s], p);
    { const int piece = lane & 7, key0 = lane >> 3;
#pragma unroll
      for (int w = 0; w < 4; ++w) *(LAS u32x4*)(vt + (2 * w + (piece >> 2)) * 512 + key0 * 64 + (piece & 3) * 16) = vv[w]; }
    float tm = -INFINITY;
#pragma unroll
    for (int i = 0; i < 16; ++i) { p[i] = ((vmask >> i) & 1u) ? p[i] : -INFINITY; tm = fmaxf(tm, p[i]); }
    tm = fmaxf(tm, __shfl_xor(tm, 32));
    const float mn = fmaxf(m, tm), alpha = fast_exp2(m - mn); m = mn;
    float rs = 0.f;
#pragma unroll
    for (int i = 0; i < 16; ++i) { p[i] = fast_exp2(p[i] - mn); rs += p[i]; }
    l = l * alpha + rs;
#pragma unroll
    for (int i = 0; i < 16; ++i) { o0[i] *= alpha; o1[i] *= alpha; }
    u32x4 w0, w1;
    w0.x = cvtpk(p[0], p[1]); w0.y = cvtpk(p[2], p[3]); w0.z = cvtpk(p[4], p[5]); w0.w = cvtpk(p[6], p[7]);
    w1.x = cvtpk(p[8], p[9]); w1.y = cvtpk(p[10], p[11]); w1.z = cvtpk(p[12], p[13]); w1.w = cvtpk(p[14], p[15]);
    const bf16x8 pf0 = __builtin_bit_cast(bf16x8, w0), pf1 = __builtin_bit_cast(bf16x8, w1);
    const LAS char* vb = vt + (4 * h + ((lane & 15) >> 2)) * 64 + ((lane >> 4) & 1) * 32 + (lane & 3) * 8;
#pragma unroll
    for (int s2 = 0; s2 < 2; ++s2) {
        const v4i16_t a0 = vtr(vb + (4 * s2 + 0) * 512), a1 = vtr(vb + (4 * s2 + 2) * 512);
        const v4i16_t b0 = vtr(vb + (4 * s2 + 1) * 512), b1 = vtr(vb + (4 * s2 + 3) * 512);
        const bf16x8 vf0 = (bf16x8){a0[0], a0[1], a0[2], a0[3], a1[0], a1[1], a1[2], a1[3]};
        const bf16x8 vf1 = (bf16x8){b0[0], b0[1], b0[2], b0[3], b1[0], b1[1], b1[2], b1[3]};
        o0 = MFMA32(vf0, s2 ? pf1 : pf0, o0);
        o1 = MFMA32(vf1, s2 ? pf1 : pf0, o1);
    }
}
__device__ __forceinline__ void attn_store(const f32x16& o0, const f32x16& o1, float inv, bf16* dst, int h) {
#pragma unroll
    for (int g = 0; g < 4; ++g) {
        u32x2 a, b; a.x = cvtpk(o0[4 * g] * inv, o0[4 * g + 1] * inv); a.y = cvtpk(o0[4 * g + 2] * inv, o0[4 * g + 3] * inv);
        b.x = cvtpk(o1[4 * g] * inv, o1[4 * g + 1] * inv); b.y = cvtpk(o1[4 * g + 2] * inv, o1[4 * g + 3] * inv);
        *(u32x2*)(dst + 8 * g + 4 * h) = a; *(u32x2*)(dst + 32 + 8 * g + 4 * h) = b; }
}
__device__ __forceinline__ void moba_item(const bf16* P, const float* kmsum, bf16* OA, int b, int hh, int qt, LAS char* vt, int lane) {
    const int r = lane & 31, h = lane >> 5, j = qt >> 3;
    const bf16* Pb = P + (size_t)b * SEQ * PW;
    const bf16* qp = Pb + (size_t)(32 * qt + r) * PW + P_QA + 64 * hh + 8 * h;
    bf16x8 qf[4];
#pragma unroll
    for (int s = 0; s < 4; ++s) qf[s] = *(const bf16x8*)(qp + 16 * s);
    unsigned sel = (1u << j) - 1u;
    if (j > 3) {
        f32x16 g;
#pragma unroll
        for (int i = 0; i < 16; ++i) g[i] = 0.f;
        const float* kmr = kmsum + (size_t)((b * 8 + (r & 7)) * 4 + hh) * 64 + 8 * h;
#pragma unroll
        for (int s = 0; s < 4; ++s) {
            f32x4 a = (f32x4){0.f, 0.f, 0.f, 0.f}, c = a;
            if (r < j) { a = *(const f32x4*)(kmr + 16 * s); c = *(const f32x4*)(kmr + 16 * s + 4); }
            float v[8] = {a[0], a[1], a[2], a[3], c[0], c[1], c[2], c[3]}; unsigned hi[4], lo[4];
#pragma unroll
            for (int e = 0; e < 4; ++e) { hi[e] = cvtpk(v[2 * e], v[2 * e + 1]); lo[e] = cvtpk(v[2 * e] - bflo(hi[e]), v[2 * e + 1] - bfhi(hi[e])); }
            const bf16x8 khi = __builtin_bit_cast(bf16x8, ((u32x4){hi[0], hi[1], hi[2], hi[3]})), klo = __builtin_bit_cast(bf16x8, ((u32x4){lo[0], lo[1], lo[2], lo[3]}));
            g = MFMA32(khi, qf[s], g); g = MFMA32(klo, qf[s], g);
        }
        float gate[8];
#pragma unroll
        for (int i = 0; i < 4; ++i) { const float o = __shfl_xor(g[i], 32); gate[i] = h ? o : g[i]; gate[4 + i] = h ? g[i] : o; }
        sel = 0u;
#pragma unroll
        for (int k = 0; k < 3; ++k) { float best = -INFINITY; int bi = 0;
#pragma unroll
            for (int n = 0; n < 8; ++n) { const bool c = (n < j) && !((sel >> n) & 1u) && (gate[n] > best); best = c ? gate[n] : best; bi = c ? n : bi; }
            sel |= 1u << bi; }
    }
    f32x16 o0, o1;
#pragma unroll
    for (int i = 0; i < 16; ++i) { o0[i] = 0.f; o1[i] = 0.f; }
    float m = -1e30f, l = 0.f;
    for (int kt = 0; kt <= qt; ++kt) {
        const int n = kt >> 3; unsigned vmask = 0xffffu;
        if (n < j) { const bool on = (sel >> n) & 1u; if (!__any(on)) continue; vmask = on ? 0xffffu : 0u; }
        else if (kt == qt) { vmask = 0u;
#pragma unroll
            for (int i = 0; i < 16; ++i) vmask |= (crow(i, h) <= r) ? (1u << i) : 0u; }
        const bf16* kp = Pb + (size_t)(32 * kt + r) * PW + P_KA + 64 * hh + 8 * h;
        const bf16* vp = Pb + (size_t)(32 * kt + (lane >> 3)) * PW + P_VA + 64 * hh + 8 * (lane & 7);
        attn_tile(o0, o1, m, l, qf, kp, vp, (size_t)8 * PW, vt, lane, vmask);
    }
    l += __shfl_xor(l, 32);
    attn_store(o0, o1, fast_rcp(l), OA + (size_t)(b * SEQ + 32 * qt + r) * 256 + 64 * hh, h);
}
__device__ __forceinline__ void dil_item(const bf16* P, bf16* DO, float* LS, int cfg, int b, int hh, int idx, LAS char* vt, int lane) {
    const int r = lane & 31, h = lane >> 5, sh = 2 * cfg, dil = 1 << sh, tsh = 6 - sh;
    const int res = idx >> tsh, qt = idx & ((1 << tsh) - 1);
    const bf16* Pb = P + ((size_t)b * SEQ + res) * PW;
    const size_t rs = (size_t)dil * PW;
    const bf16* qp = Pb + (size_t)(32 * qt + r) * rs + P_QB + 64 * hh + 8 * h;
    bf16x8 qf[4];
#pragma unroll
    for (int s = 0; s < 4; ++s) qf[s] = *(const bf16x8*)(qp + 16 * s);
    f32x16 o0, o1;
#pragma unroll
    for (int i = 0; i < 16; ++i) { o0[i] = 0.f; o1[i] = 0.f; }
    float m = -1e30f, l = 0.f;
    for (int kt = (qt > 4 ? qt - 4 : 0); kt <= qt; ++kt) {
        unsigned vmask = 0u;
#pragma unroll
        for (int i = 0; i < 16; ++i) { const int dl = 32 * (qt - kt) + r - crow(i, h); vmask |= (dl >= 0 && dl <= 128) ? (1u << i) : 0u; }
        const bf16* kp = Pb + (size_t)(32 * kt + r) * rs + P_KB + 64 * hh + 8 * h;
        const bf16* vp = Pb + (size_t)(32 * kt + (lane >> 3)) * rs + P_VB + 64 * hh + 8 * (lane & 7);
        attn_tile(o0, o1, m, l, qf, kp, vp, 8 * rs, vt, lane, vmask);
    }
    l += __shfl_xor(l, 32);
    const size_t row = (size_t)b * SEQ + (size_t)(32 * qt + r) * dil + res;
    attn_store(o0, o1, fast_rcp(l), DO + row * 256 + 64 * hh, h);
    if (h == 0) LS[row * 4 + hh] = m + __builtin_amdgcn_logf(l);
}

constexpr size_t MiB = 1u << 20;
constexpr size_t WS_CTL = 0, CTL_ZERO_BYTES = 1 * MiB;
constexpr size_t WS_MOD = 1 * MiB;
constexpr size_t WS_RTE = 2 * MiB, WS_RTP = WS_RTE + 256 * 1024, WS_RTG = WS_RTP + 256 * 1024, WS_S2T = WS_RTG + 256 * 1024;
constexpr size_t WS_WIN = 4 * MiB, WS_WOUT = 14 * MiB, WS_WFGU = 18 * MiB, WS_WFD = 29 * MiB, WS_WMGU = 35 * MiB, WS_WMD = 147 * MiB;
constexpr size_t WS_HB = 203 * MiB;
constexpr size_t WS_R = 267 * MiB;
constexpr size_t WS_P = WS_R, WS_DIL = WS_R + 144 * MiB, WS_LSE = WS_R + 192 * MiB, WS_OA = WS_R + 194 * MiB, WS_OC = WS_R + 210 * MiB, WS_OD = WS_R + 226 * MiB;
constexpr size_t WS_Y = WS_R;
constexpr size_t WS_FH = WS_R;
constexpr size_t WS_HID = WS_R, WS_YS = WS_R + 112 * MiB;
constexpr size_t WS_END = WS_R + 244 * MiB;
constexpr int CW_BAR = 4096;
constexpr int CW_CNT = 8192;
constexpr int CW_KM = 16384;
static_assert((CW_KM + 2 * 32768 * 1) * 4 <= (int)CTL_ZERO_BYTES + 0 || true, "");
static_assert((size_t)(CW_KM + 2 * 32768) * 4 <= CTL_ZERO_BYTES, "CTL region");

constexpr int RING_BYTES = 131072, LDSX_OFF = RING_BYTES, LDS_BYTES = 147456;

#define XB_TMO      128
#define XB_XCNT(j)  (256  + 64 * (j))
#define XB_XSUB(j)  (1280 + 64 * (j))
#define XB_XGEN(j)  (2304 + 64 * (j))
#define XB_TOP      3328
#define XB_TOPGEN   3392
#define XCD_BAR_WORDS 3456
#define XB_SPIN_CAP (1u << 18)
__device__ __forceinline__ unsigned xb_ld(unsigned* p)              { return __hip_atomic_load(p, __ATOMIC_RELAXED, __HIP_MEMORY_SCOPE_AGENT); }
__device__ __forceinline__ unsigned xb_add(unsigned* p, unsigned v) { return __hip_atomic_fetch_add(p, v, __ATOMIC_RELAXED, __HIP_MEMORY_SCOPE_AGENT); }
__device__ __forceinline__ unsigned xb_xcc_id() { return (unsigned)__builtin_amdgcn_s_getreg((3 << 11) | 20) & 0xFu; }
#define XB_SPIN(cond, bar) do { unsigned _sp = 0; while (cond) { __builtin_amdgcn_s_sleep(1); \
    if ((++_sp & 255u) == 0u) { if (xb_ld(&(bar)[XB_TMO])) break; if (_sp > XB_SPIN_CAP) { atomicAdd(&(bar)[XB_TMO], 1u); break; } } } } while (0)
struct XcdBarrier { unsigned* bar; unsigned x; volatile LAS unsigned* st; };
__device__ __forceinline__ XcdBarrier xcd_barrier_post(unsigned* bar, volatile LAS unsigned* st) {
    XcdBarrier b; b.bar = bar; b.x = xb_xcc_id(); b.st = st;
    if (threadIdx.x == 0) (void)xb_add(&bar[XB_XCNT(b.x)], 1u);
    return b;
}
__device__ __forceinline__ void xcd_barrier_complete(unsigned* bar, unsigned x, unsigned& nloc, unsigned& nx) {
    const unsigned G = gridDim.x * gridDim.y * gridDim.z;
    unsigned sum, cnt, mine, sp = 0u;
    for (;;) {
        sum = 0u; cnt = 0u; mine = 0u;
#pragma unroll
        for (unsigned j = 0; j < 16; ++j) { const unsigned c = xb_ld(&bar[XB_XCNT(j)]); sum += c; cnt += (c > 0u) ? 1u : 0u; mine = (j == x) ? c : mine; }
        if (sum == G) break;
        __builtin_amdgcn_s_sleep(1);
        if ((++sp & 255u) == 0u) { if (xb_ld(&bar[XB_TMO])) break; if (sp > XB_SPIN_CAP) { atomicAdd(&bar[XB_TMO], 1u); break; } }
    }
    nloc = mine > 0u ? mine : 1u; nx = cnt > 0u ? cnt : 1u;
}
__device__ __forceinline__ void xcd_barrier(const XcdBarrier& b) {
    asm volatile("s_waitcnt vmcnt(0)" ::: "memory");
    __syncthreads();
    if (threadIdx.x == 0) {
        unsigned* bar = b.bar;
        __builtin_amdgcn_s_waitcnt(0);
        unsigned nloc = b.st[0], nx = b.st[1];
        if (nloc == 0u) { xcd_barrier_complete(bar, b.x, nloc, nx); b.st[0] = nloc; b.st[1] = nx; }
        const unsigned old = xb_add(&bar[XB_XSUB(b.x)], 1u);
        const unsigned gen = old / nloc;
        if (old + 1u == (gen + 1u) * nloc) {
            __builtin_amdgcn_fence(__ATOMIC_RELEASE, "agent");
            asm volatile("s_waitcnt vmcnt(0)" ::: "memory");
            const unsigned og = xb_add(&bar[XB_TOP], 1u);
            const unsigned tg = og / nx;
            if (og + 1u == (tg + 1u) * nx) xb_add(&bar[XB_TOPGEN], 1u);
            else XB_SPIN(xb_ld(&bar[XB_TOPGEN]) == tg, bar);
            __builtin_amdgcn_fence(__ATOMIC_ACQUIRE, "agent");
            xb_add(&bar[XB_XGEN(b.x)], 1u);
            asm volatile("s_waitcnt vmcnt(0)" ::: "memory");
        } else {
            XB_SPIN(xb_ld(&bar[XB_XGEN(b.x)]) == gen, bar);
            __builtin_amdgcn_fence(__ATOMIC_ACQUIRE, "agent");
            asm volatile("s_waitcnt vmcnt(0)" ::: "memory");
        }
    }
    __syncthreads();
}

struct Args { const void* in[26]; float* out; unsigned char* ws; int ph_lo, ph_hi; };
struct Frame {
    LAS unsigned char* lds;
    unsigned char* ws; unsigned* ctl; float* out;
    int tid, lane, wave, vcu, G;
};
typedef const __attribute__((address_space(4))) Args* ArgsP;
__device__ __forceinline__ ArgsP args_ptr() { auto p = __builtin_amdgcn_kernarg_segment_ptr(); asm volatile("" : "+s"(p)); return (ArgsP)p; }
__device__ __forceinline__ int otid() { int t = threadIdx.x; asm volatile("" : "+v"(t)); return t; }
#define REFRESH(F) do { (F).tid = otid(); (F).lane = (F).tid & 63; (F).wave = __builtin_amdgcn_readfirstlane((F).tid >> 6); } while (0)
#define INP(A, k) ((const float*)(A)->in[k])
enum { I_X = 0, I_C, I_POS, I_ADAW, I_ADAB, I_MIXPRE, I_MIXPOST, I_FFNPRE, I_FFNPOST, I_WIN, I_WOUT, I_GROUPG, I_GMLPW, I_GMLPB, I_CONVW, I_CONVB, I_CONVLNG, I_CONVLNB,
       I_FFNWG, I_FFNWU, I_FFNWD, I_ROUTW, I_ROUTB, I_MOEWG, I_MOEWU, I_MOEWD };
#define LDS_WAIT() asm volatile("s_waitcnt lgkmcnt(0)" ::: "memory")

__device__ __forceinline__ void ld_f32_row(float (&v)[16], const float* p, int lane) {
#pragma unroll
    for (int j = 0; j < 4; ++j) { const f32x4 t = ((const f32x4*)p)[lane + 64 * j]; v[4 * j] = t[0]; v[4 * j + 1] = t[1]; v[4 * j + 2] = t[2]; v[4 * j + 3] = t[3]; }
}
__device__ __forceinline__ void ld_bf16_row(float (&v)[16], const bf16* p, int lane) {
#pragma unroll
    for (int j = 0; j < 4; ++j) { const u32x2 t = ((const u32x2*)p)[lane + 64 * j]; v[4 * j] = bflo(t.x); v[4 * j + 1] = bfhi(t.x); v[4 * j + 2] = bflo(t.y); v[4 * j + 3] = bfhi(t.y); }
}
__device__ __forceinline__ void st_f32_row(const float (&v)[16], float* p, int lane) {
#pragma unroll
    for (int j = 0; j < 4; ++j) ((f32x4*)p)[lane + 64 * j] = (f32x4){v[4 * j], v[4 * j + 1], v[4 * j + 2], v[4 * j + 3]};
}
__device__ __forceinline__ void st_bf16_row(const float (&v)[16], bf16* p, int lane) {
#pragma unroll
    for (int j = 0; j < 4; ++j) { u32x2 t; t.x = cvtpk(v[4 * j], v[4 * j + 1]); t.y = cvtpk(v[4 * j + 2], v[4 * j + 3]); ((u32x2*)p)[lane + 64 * j] = t; }
}
__device__ __forceinline__ float row_rstd(const float (&v)[16]) {
    float s = 0.f;
#pragma unroll
    for (int i = 0; i < 16; ++i) s += v[i] * v[i];
    return __builtin_amdgcn_rsqf(wave_sum(s) * (1.0f / D) + EPS);
}
__device__ __forceinline__ const float* mod_ptr(const Frame& F, int layer, int b, int part) { return (const float*)(F.ws + WS_MOD) + ((size_t)(layer * 16 + b) * 6 + part) * 1024; }

__device__ __forceinline__ int dst_row(int type, int n) {
    if (type == 0) return n;
    if (type == 1) return 256 * (n >> 7) + (n & 127);
    if (type == 2) return 256 * (n >> 7) + 128 + (n & 127);
    const int sl = n >> 8, cc = n & 255;
    if (sl == 0 || sl == 1 || sl == 3 || sl == 4) { const int hh = cc >> 6, d = cc & 63; return 256 * sl + 64 * hh + 32 * ((d >> 4) & 1) + 8 * ((d >> 2) & 3) + 4 * (d >> 5) + (d & 3); }
    if (sl < 8) return n;
    return 256 * (8 + ((cc >> 7) & 1)) + (sl == 9 ? 128 : 0) + (cc & 127);
}
__device__ __forceinline__ void transpose_item(const float* W, int K, int N, bf16* WT, int type, LAS float* scr, int item, int lane) {
    const int nblk = N / 32, kb = item / nblk, nb = item % nblk, k0 = 64 * kb, n0 = 32 * nb;
#pragma unroll 8
    for (int i = 0; i < 32; ++i) { const int kk = 2 * i + (lane >> 5); scr[kk * 33 + (lane & 31)] = W[(size_t)(k0 + kk) * N + n0 + (lane & 31)]; }
    LDS_WAIT(); asm volatile("" ::: "memory");
    const int c = lane & 7;
#pragma unroll
    for (int j = 0; j < 4; ++j) { const int n = (lane >> 3) + 8 * j; const LAS float* s = scr + (8 * c) * 33 + n;
        u32x4 o; o.x = cvtpk(s[0 * 33], s[1 * 33]); o.y = cvtpk(s[2 * 33], s[3 * 33]); o.z = cvtpk(s[4 * 33], s[5 * 33]); o.w = cvtpk(s[6 * 33], s[7 * 33]);
        *(u32x4*)(WT + (size_t)dst_row(type, n0 + n) * K + k0 + 8 * c) = o; }
    LDS_WAIT(); asm volatile("" ::: "memory");
}
__device__ __forceinline__ void ada_item(Frame& F, ArgsP A, int a, LAS float* scr) {
    const int layer = a / 96, n = 64 * (a % 96) + F.lane; const float* cin = INP(A, I_C); const float* ada_w = INP(A, I_ADAW);
    float acc[16];
#pragma unroll
    for (int b = 0; b < 16; ++b) acc[b] = 0.f;
    for (int kc = 0; kc < 4; ++kc) {
        for (int i = 0; i < 64; ++i) { const int idx = F.lane + 64 * i, b = idx >> 8, kk = idx & 255; scr[idx] = siluf_(cin[b * 1024 + kc * 256 + kk]); }
        LDS_WAIT(); asm volatile("" ::: "memory");
        const float* wp = ada_w + ((size_t)layer * 1024 + kc * 256) * 6144 + n;
#pragma unroll 4
        for (int kk = 0; kk < 256; ++kk) { const float w = wp[(size_t)kk * 6144];
#pragma unroll
            for (int b = 0; b < 16; ++b) acc[b] += scr[b * 256 + kk] * w; }
        LDS_WAIT(); asm volatile("" ::: "memory");
    }
    float* mod = (float*)(F.ws + WS_MOD);
    const float bias = INP(A, I_ADAB)[layer * 6144 + n];
#pragma unroll
    for (int b = 0; b < 16; ++b) mod[(size_t)(layer * 16 + b) * 6144 + n] = acc[b] + bias;
}
__device__ __forceinline__ void phase_prologue(Frame& F) {
    REFRESH(F);
    LAS float* scr = (LAS float*)(F.lds + F.wave * 16384);
    const int gw = F.vcu * 8 + F.wave, NGW = F.G * 8; ArgsP A = args_ptr();
    for (int a = gw; a < 192; a += NGW) ada_item(F, A, a, scr);
    constexpr int I_IN = 16 * 80, I_OUT = 16 * 32, I_FG = 16 * 88, I_FD = 44 * 32, I_MG = 16 * 112, I_MD = 56 * 32;
    constexpr int NITEMS = 2 * I_IN + 2 * I_OUT + 2 * I_FG + I_FD + 16 * I_MG + 8 * I_MD;
    bf16* WIN = (bf16*)(F.ws + WS_WIN); bf16* WOUT = (bf16*)(F.ws + WS_WOUT); bf16* WFGU = (bf16*)(F.ws + WS_WFGU); bf16* WFD = (bf16*)(F.ws + WS_WFD);
    bf16* WMGU = (bf16*)(F.ws + WS_WMGU); bf16* WMD = (bf16*)(F.ws + WS_WMD);
    for (int it = NITEMS - 1 - gw; it >= 0; it -= NGW) {
        int r = it;
        if (r < 2 * I_IN) { const int L = r / I_IN; transpose_item(INP(A, I_WIN) + (size_t)L * 1024 * NIN, 1024, NIN, WIN + (size_t)L * NIN * 1024, 3, scr, r % I_IN, F.lane); continue; } r -= 2 * I_IN;
        if (r < 2 * I_OUT) { const int L = r / I_OUT; transpose_item(INP(A, I_WOUT) + (size_t)L * 1024 * 1024, 1024, 1024, WOUT + (size_t)L * 1024 * 1024, 0, scr, r % I_OUT, F.lane); continue; } r -= 2 * I_OUT;
        if (r < I_FG) { transpose_item(INP(A, I_FFNWG), 1024, FFD, WFGU, 1, scr, r, F.lane); continue; } r -= I_FG;
        if (r < I_FG) { transpose_item(INP(A, I_FFNWU), 1024, FFD, WFGU, 2, scr, r, F.lane); continue; } r -= I_FG;
        if (r < I_FD) { transpose_item(INP(A, I_FFNWD), FFD, 1024, WFD, 0, scr, r, F.lane); continue; } r -= I_FD;
        if (r < 8 * I_MG) { const int e = r / I_MG; transpose_item(INP(A, I_MOEWG) + (size_t)e * 1024 * FFE, 1024, FFE, WMGU + (size_t)e * 2 * FFE * 1024, 1, scr, r % I_MG, F.lane); continue; } r -= 8 * I_MG;
        if (r < 8 * I_MG) { const int e = r / I_MG; transpose_item(INP(A, I_MOEWU) + (size_t)e * 1024 * FFE, 1024, FFE, WMGU + (size_t)e * 2 * FFE * 1024, 2, scr, r % I_MG, F.lane); continue; } r -= 8 * I_MG;
        { const int e = r / I_MD; transpose_item(INP(A, I_MOEWD) + (size_t)e * FFE * 1024, FFE, 1024, WMD + (size_t)e * 1024 * FFE, 0, scr, r % I_MD, F.lane); }
    }
}

__device__ __forceinline__ void norm_mod_store(const float (&x)[16], const float* g, const float* sc, const float* sh, bf16* dst, int lane, float (&h)[16]) {
    const float r = row_rstd(x);
    float gv[16], scv[16], shv[16]; ld_f32_row(gv, g, lane); ld_f32_row(scv, sc, lane); ld_f32_row(shv, sh, lane);
#pragma unroll
    for (int i = 0; i < 16; ++i) h[i] = x[i] * r * gv[i] * (1.0f + scv[i]) + shv[i];
    st_bf16_row(h, dst, lane);
}
__device__ __forceinline__ void phase_prenorm0(Frame& F) {
    REFRESH(F);
    const int rpw = M / (F.G * 8); bf16* HB = (bf16*)(F.ws + WS_HB); ArgsP A = args_ptr(); const float* x_in = INP(A, I_X); const float* mix_pre_g = INP(A, I_MIXPRE);
    for (int k = 0; k < rpw; ++k) { const int m = (F.vcu * 8 + F.wave) * rpw + k, b = m >> 11;
        float x[16], h[16]; ld_f32_row(x, x_in + (size_t)m * D, F.lane);
        norm_mod_store(x, mix_pre_g, mod_ptr(F, 0, b, 1), mod_ptr(F, 0, b, 0), HB + (size_t)m * D, F.lane, h); }
}
__device__ __forceinline__ void phase_postmix(Frame& F, int layer, bool moe) {
    REFRESH(F);
    const int rpw = M / (F.G * 8); bf16* HB = (bf16*)(F.ws + WS_HB); const bf16* Y = (const bf16*)(F.ws + WS_Y);
    ArgsP A = args_ptr(); const float* xsrc = layer == 0 ? INP(A, I_X) : F.out;
    const float* mix_post_g = INP(A, I_MIXPOST); const float* ffn_pre_g = INP(A, I_FFNPRE); const float* router_w = INP(A, I_ROUTW); const float* router_b = INP(A, I_ROUTB);
    LAS int* lcnt = (LAS int*)(F.lds + LDSX_OFF + 256);
    LAS int* lbase = lcnt + 8; LAS int* rinfo = lcnt + 16;
    if (moe) { if (F.tid < 16) lcnt[F.tid] = 0; __syncthreads(); }
    for (int k = 0; k < rpw; ++k) { const int rl = F.wave * rpw + k, m = F.vcu * 8 * rpw + rl, b = m >> 11;
        float x[16], y[16], g[16], gt[16], h[16];
        ld_f32_row(x, xsrc + (size_t)m * D, F.lane); ld_bf16_row(y, Y + (size_t)m * D, F.lane);
        const float ry = row_rstd(y);
        ld_f32_row(g, mix_post_g + layer * D, F.lane); ld_f32_row(gt, mod_ptr(F, layer, b, 2), F.lane);
#pragma unroll
        for (int i = 0; i < 16; ++i) x[i] += gt[i] * (y[i] * ry * g[i]);
        st_f32_row(x, F.out + (size_t)m * D, F.lane);
        norm_mod_store(x, ffn_pre_g + layer * D, mod_ptr(F, layer, b, 4), mod_ptr(F, layer, b, 3), HB + (size_t)m * D, F.lane, h);
        if (moe) {
            float lg[8];
#pragma unroll
            for (int e = 0; e < 8; ++e) lg[e] = 0.f;
#pragma unroll
            for (int j = 0; j < 4; ++j)
#pragma unroll
                for (int e4 = 0; e4 < 4; ++e4) { const float* rw = router_w + (size_t)(256 * j + 4 * F.lane + e4) * 8; const f32x4 w0 = *(const f32x4*)rw, w1 = *(const f32x4*)(rw + 4); const float hv = h[4 * j + e4];
                    lg[0] += hv * w0[0]; lg[1] += hv * w0[1]; lg[2] += hv * w0[2]; lg[3] += hv * w0[3]; lg[4] += hv * w1[0]; lg[5] += hv * w1[1]; lg[6] += hv * w1[2]; lg[7] += hv * w1[3]; }
#pragma unroll
            for (int e = 0; e < 8; ++e) lg[e] = wave_sum(lg[e]) + router_b[e];
            int e0 = 0; float l0 = lg[0];
#pragma unroll
            for (int e = 1; e < 8; ++e) if (lg[e] > l0) { l0 = lg[e]; e0 = e; }
            int e1 = -1; float l1 = -INFINITY;
#pragma unroll
            for (int e = 0; e < 8; ++e) if (e != e0 && lg[e] > l1) { l1 = lg[e]; e1 = e; }
            if (F.lane == 0) {
                const float g0 = fast_rcp(1.0f + __expf(l1 - l0));
                const int p0 = atomicAdd((int*)(lcnt + e0), 1), p1 = atomicAdd((int*)(lcnt + e1), 1);
                rinfo[rl * 4 + 0] = e0; rinfo[rl * 4 + 1] = e1; rinfo[rl * 4 + 2] = p0; rinfo[rl * 4 + 3] = p1;
                float* RTG = (float*)(F.ws + WS_RTG); RTG[2 * m] = g0; RTG[2 * m + 1] = 1.0f - g0;
            }
        }
    }
    if (moe) {
        __syncthreads();
        if (F.tid < 8) lbase[F.tid] = (int)__hip_atomic_fetch_add(F.ctl + CW_CNT + F.tid, (unsigned)lcnt[F.tid], __ATOMIC_RELAXED, __HIP_MEMORY_SCOPE_AGENT);
        __syncthreads();
        const int nrows = 8 * rpw;
        int* RTE = (int*)(F.ws + WS_RTE); int* RTP = (int*)(F.ws + WS_RTP);
        for (int rl = F.tid; rl < nrows; rl += 512) { const int m = F.vcu * nrows + rl; const int e0 = rinfo[rl * 4], e1 = rinfo[rl * 4 + 1];
            RTE[2 * m] = e0; RTE[2 * m + 1] = e1; RTP[2 * m] = lbase[e0] + rinfo[rl * 4 + 2]; RTP[2 * m + 1] = lbase[e1] + rinfo[rl * 4 + 3]; }
    }
}
__device__ __forceinline__ void moe_tiles(const Frame& F, int (&ts)[9], int (&cnt)[8]) {
    int acc = 0;
#pragma unroll
    for (int e = 0; e < 8; ++e) { cnt[e] = (int)__hip_atomic_load(F.ctl + CW_CNT + e, __ATOMIC_RELAXED, __HIP_MEMORY_SCOPE_AGENT); ts[e] = acc; acc += (cnt[e] + 255) >> 8; }
    ts[8] = acc;
}
__device__ __forceinline__ void phase_moe_index(Frame& F) {
    REFRESH(F);
    int ts[9], cnt[8]; moe_tiles(F, ts, cnt);
    int* S2T = (int*)(F.ws + WS_S2T); const int* RTE = (const int*)(F.ws + WS_RTE); const int* RTP = (const int*)(F.ws + WS_RTP);
    const int gt = F.vcu * 512 + F.tid, NT = F.G * 512;
    for (int s = gt; s < ts[8] * 256; s += NT) { const int tile = s >> 8; int e = 0;
#pragma unroll
        for (int k = 1; k < 8; ++k) e += (tile >= ts[k]) ? 1 : 0;
        int c = 0, t0 = 0;
#pragma unroll
        for (int k = 0; k < 8; ++k) { c = (k == e) ? cnt[k] : c; t0 = (k == e) ? ts[k] : t0; }
        if (s - 256 * t0 >= c) S2T[s] = 0; }
    for (int a = gt; a < 2 * M; a += NT) { const int e = RTE[a]; int t0 = 0;
#pragma unroll
        for (int k = 0; k < 8; ++k) t0 = (k == e) ? ts[k] : t0;
        S2T[256 * t0 + RTP[a]] = a >> 1; }
}
__device__ __forceinline__ void phase_postffn(Frame& F, int layer, bool moe) {
    REFRESH(F);
    const int rpw = M / (F.G * 8); bf16* HB = (bf16*)(F.ws + WS_HB);
    int ts[9], cnt[8]; if (moe) moe_tiles(F, ts, cnt);
    ArgsP A = args_ptr(); const float* ffn_post_g = INP(A, I_FFNPOST); const float* mix_pre_g = INP(A, I_MIXPRE);
    for (int k = 0; k < rpw; ++k) { const int m = (F.vcu * 8 + F.wave) * rpw + k, b = m >> 11;
        float x[16], y[16], g[16], gt[16], h[16];
        ld_f32_row(x, F.out + (size_t)m * D, F.lane);
        if (moe) {
            const int* RTE = (const int*)(F.ws + WS_RTE); const int* RTP = (const int*)(F.ws + WS_RTP); const float* RTG = (const float*)(F.ws + WS_RTG); const bf16* YS = (const bf16*)(F.ws + WS_YS);
            const int e0 = RTE[2 * m], e1 = RTE[2 * m + 1]; int t0 = 0, t1 = 0;
#pragma unroll
            for (int q = 0; q < 8; ++q) { t0 = (q == e0) ? ts[q] : t0; t1 = (q == e1) ? ts[q] : t1; }
            const size_t s0 = (size_t)256 * t0 + RTP[2 * m], s1 = (size_t)256 * t1 + RTP[2 * m + 1];
            const float g0 = RTG[2 * m], g1 = RTG[2 * m + 1];
            float ya[16], yb[16]; ld_bf16_row(ya, YS + s0 * D, F.lane); ld_bf16_row(yb, YS + s1 * D, F.lane);
#pragma unroll
            for (int i = 0; i < 16; ++i) y[i] = g0 * ya[i] + g1 * yb[i];
        } else ld_bf16_row(y, HB + (size_t)m * D, F.lane);
        const float ry = row_rstd(y);
        ld_f32_row(g, ffn_post_g + layer * D, F.lane); ld_f32_row(gt, mod_ptr(F, layer, b, 5), F.lane);
#pragma unroll
        for (int i = 0; i < 16; ++i) x[i] += gt[i] * (y[i] * ry * g[i]);
        st_f32_row(x, F.out + (size_t)m * D, F.lane);
        if (layer == 0) norm_mod_store(x, mix_pre_g + D, mod_ptr(F, 1, b, 1), mod_ptr(F, 1, b, 0), HB + (size_t)m * D, F.lane, h);
    }
}
__device__ __forceinline__ void phase_mixnorm(Frame& F, int layer) {
    REFRESH(F);
    const int rpw = M / (F.G * 8); bf16* MIXN = (bf16*)(F.ws + WS_HB);
    const bf16* OA = (const bf16*)(F.ws + WS_OA); const bf16* OC = (const bf16*)(F.ws + WS_OC); const bf16* OD = (const bf16*)(F.ws + WS_OD);
    const bf16* DIL = (const bf16*)(F.ws + WS_DIL); const float* LSE = (const float*)(F.ws + WS_LSE);
    const int lane = F.lane, hh = lane >> 4; ArgsP A = args_ptr(); const float* group_g = INP(A, I_GROUPG);
    for (int k = 0; k < rpw; ++k) { const size_t m = (size_t)(F.vcu * 8 + F.wave) * rpw + k;
        float v[4][4];
        { const u32x2 t = ((const u32x2*)(OA + m * 256))[lane]; v[0][0] = bflo(t.x); v[0][1] = bfhi(t.x); v[0][2] = bflo(t.y); v[0][3] = bfhi(t.y); }
        { const float l0 = LSE[m * 4 + hh], l1 = LSE[((size_t)M + m) * 4 + hh], l2 = LSE[((size_t)2 * M + m) * 4 + hh];
          const float mx = fmaxf(l0, fmaxf(l1, l2)); float w0 = fast_exp2(l0 - mx), w1 = fast_exp2(l1 - mx), w2 = fast_exp2(l2 - mx); const float inv = fast_rcp(w0 + w1 + w2); w0 *= inv; w1 *= inv; w2 *= inv;
          const u32x2 a = ((const u32x2*)(DIL + m * 256))[lane], bq = ((const u32x2*)(DIL + ((size_t)M + m) * 256))[lane], cq = ((const u32x2*)(DIL + ((size_t)2 * M + m) * 256))[lane];
          v[1][0] = w0 * bflo(a.x) + w1 * bflo(bq.x) + w2 * bflo(cq.x); v[1][1] = w0 * bfhi(a.x) + w1 * bfhi(bq.x) + w2 * bfhi(cq.x);
          v[1][2] = w0 * bflo(a.y) + w1 * bflo(bq.y) + w2 * bflo(cq.y); v[1][3] = w0 * bfhi(a.y) + w1 * bfhi(bq.y) + w2 * bfhi(cq.y); }
        { const u32x2 t = ((const u32x2*)(OC + m * 256))[lane]; v[2][0] = bflo(t.x); v[2][1] = bfhi(t.x); v[2][2] = bflo(t.y); v[2][3] = bfhi(t.y); }
        { const u32x2 t = ((const u32x2*)(OD + m * 256))[lane]; v[3][0] = bflo(t.x); v[3][1] = bfhi(t.x); v[3][2] = bflo(t.y); v[3][3] = bfhi(t.y); }
#pragma unroll
        for (int g = 0; g < 4; ++g) {
            const float ss = wave_sum(v[g][0] * v[g][0] + v[g][1] * v[g][1] + v[g][2] * v[g][2] + v[g][3] * v[g][3]);
            const float r = __builtin_amdgcn_rsqf(ss * (1.0f / 256.0f) + EPS);
            const f32x4 gg = *(const f32x4*)(group_g + (size_t)(layer * 4 + g) * 256 + 4 * lane);
            u32x2 t; t.x = cvtpk(v[g][0] * r * gg[0], v[g][1] * r * gg[1]); t.y = cvtpk(v[g][2] * r * gg[2], v[g][3] * r * gg[3]);
            ((u32x2*)(MIXN + m * D + 256 * g))[lane] = t; }
    }
}

__device__ __forceinline__ void gmlp_unit(Frame& F, int layer, int b, int ch) {
    const bf16* P = (const bf16*)(F.ws + WS_P); bf16* OC = (bf16*)(F.ws + WS_OC);
    const size_t R0 = (size_t)b * SEQ + 128 * ch;
    LAS bf16* VT = (LAS bf16*)F.lds;
    const int lane = F.lane, w = F.wave;
    for (int k = 0; k < 16; ++k) { const int s = 16 * w + k;
        const u32x2 t = ((const u32x2*)(P + (R0 + s) * PW + P_GV))[lane];
        float v0 = bflo(t.x), v1 = bfhi(t.x), v2 = bflo(t.y), v3 = bfhi(t.y);
        const float mean = wave_sum((v0 + v1) + (v2 + v3)) * (1.0f / 256.0f);
        v0 -= mean; v1 -= mean; v2 -= mean; v3 -= mean;
        const float rstd = __builtin_amdgcn_rsqf(wave_sum((v0 * v0 + v1 * v1) + (v2 * v2 + v3 * v3)) * (1.0f / 256.0f) + EPS);
        const unsigned p0 = cvtpk(v0 * rstd, v1 * rstd), p1 = cvtpk(v2 * rstd, v3 * rstd);
        VT[(4 * lane + 0) * 136 + s] = (bf16)(p0 & 0xffffu); VT[(4 * lane + 1) * 136 + s] = (bf16)(p0 >> 16);
        VT[(4 * lane + 2) * 136 + s] = (bf16)(p1 & 0xffffu); VT[(4 * lane + 3) * 136 + s] = (bf16)(p1 >> 16); }
    __syncthreads();
    const int g = w >> 1, cb = 64 * g + 32 * (w & 1), r = lane & 31, h = lane >> 5;
    ArgsP A = args_ptr();
    const float* W = INP(A, I_GMLPW) + (size_t)(layer * 4 + g) * 128 * 128;
    const float* bias = INP(A, I_GMLPB) + (size_t)(layer * 4 + g) * 128;
    for (int tt = 0; tt < 4; ++tt) {
        f32x16 acc;
#pragma unroll
        for (int i = 0; i < 16; ++i) acc[i] = 0.f;
        const int t = 32 * tt + r;
        for (int ks = 0; ks < 2 * (tt + 1); ++ks) {
            const int s0 = 16 * ks + 8 * h;
            const f32x4 a = *(const f32x4*)(W + (size_t)t * 128 + s0), c = *(const f32x4*)(W + (size_t)t * 128 + s0 + 4);
            float v[8] = {a[0], a[1], a[2], a[3], c[0], c[1], c[2], c[3]};
#pragma unroll
            for (int e = 0; e < 8; ++e) v[e] = (s0 + e <= t) ? v[e] : 0.f;
            u32x4 aw; aw.x = cvtpk(v[0], v[1]); aw.y = cvtpk(v[2], v[3]); aw.z = cvtpk(v[4], v[5]); aw.w = cvtpk(v[6], v[7]);
            const bf16x8 bfrag = *(const LAS bf16x8*)(VT + (cb + r) * 136 + s0);
            acc = MFMA32(__builtin_bit_cast(bf16x8, aw), bfrag, acc);
        }
#pragma unroll
        for (int i = 0; i < 16; ++i) { const int to = 32 * tt + crow(i, h); const float z = acc[i] + bias[to];
            const float u = bf2f(P[(R0 + to) * PW + P_GU + cb + r]);
            OC[(R0 + to) * 256 + cb + r] = (bf16)(cvtpk(u * z, 0.f) & 0xffffu); }
    }
    __syncthreads();
}
__device__ __forceinline__ void conv_unit(Frame& F, int layer, int b, int ch) {
    const bf16* P = (const bf16*)(F.ws + WS_P); bf16* OD = (bf16*)(F.ws + WS_OD);
    const int t0 = 64 * ch; const size_t Rb = (size_t)b * SEQ;
    LAS bf16* XT = (LAS bf16*)F.lds;
    LAS float* YT = (LAS float*)(F.lds + 48128);
    for (int id = F.tid; id < 94 * 32; id += 512) { const int row = id >> 5, piece = id & 31, t = t0 - 30 + row;
        u32x4 v = (u32x4){0u, 0u, 0u, 0u};
        if (t >= 0) v = *(const u32x4*)(P + (Rb + t) * PW + P_GLU + 8 * piece);
        *(LAS u32x4*)(XT + row * 256 + 8 * piece) = v; }
    __syncthreads();
    ArgsP A = args_ptr();
    { const int c = F.tid & 255, half = F.tid >> 8; const float* conv_w = INP(A, I_CONVW);
      float wk[31];
#pragma unroll
      for (int k = 0; k < 31; ++k) wk[k] = conv_w[(size_t)(layer * 31 + k) * 256 + c];
      const float cb = INP(A, I_CONVB)[layer * 256 + c];
      float xs[62];
#pragma unroll
      for (int i = 0; i < 62; ++i) xs[i] = bf2f(XT[(32 * half + i) * 256 + c]);
#pragma unroll
      for (int j = 0; j < 32; ++j) { float y = cb;
#pragma unroll
          for (int k = 0; k < 31; ++k) y += wk[k] * xs[j + k];
          YT[(32 * half + j) * 260 + c] = y; } }
    __syncthreads();
    { const int lane = F.lane;
      const f32x4 lg = *(const f32x4*)(INP(A, I_CONVLNG) + layer * 256 + 4 * lane), lb = *(const f32x4*)(INP(A, I_CONVLNB) + layer * 256 + 4 * lane);
      for (int k = 0; k < 8; ++k) { const int t = 8 * F.wave + k;
          f32x4 y = *(const LAS f32x4*)(YT + t * 260 + 4 * lane);
          const float mean = wave_sum((y[0] + y[1]) + (y[2] + y[3])) * (1.0f / 256.0f);
          y = y - mean;
          const float rstd = __builtin_amdgcn_rsqf(wave_sum((y[0] * y[0] + y[1] * y[1]) + (y[2] * y[2] + y[3] * y[3])) * (1.0f / 256.0f) + EPS);
          float o[4];
#pragma unroll
          for (int e = 0; e < 4; ++e) o[e] = siluf_(y[e] * rstd * lg[e] + lb[e]);
          u32x2 w; w.x = cvtpk(o[0], o[1]); w.y = cvtpk(o[2], o[3]);
          ((u32x2*)(OD + (Rb + t0 + t) * 256))[lane] = w; } }
    __syncthreads();
}
__device__ __forceinline__ void phase_mixers(Frame& F, int layer) {
    REFRESH(F);
    for (int u = F.vcu; u < 256; u += F.G) gmlp_unit(F, layer, u >> 4, u & 15);
    for (int u = F.vcu; u < 512; u += F.G) conv_unit(F, layer, u >> 5, u & 31);
    const bf16* P = (const bf16*)(F.ws + WS_P);
    const float* kms = (const float*)(F.ctl + CW_KM) + (size_t)layer * 32768;
    LAS char* vt = (LAS char*)(F.lds + F.wave * 4096);
    const int gw = F.vcu * 8 + F.wave, NGW = F.G * 8;
    for (int p = gw; p < 2048; p += NGW) { const int bh = p >> 5, q0 = p & 31;
        moba_item(P, kms, (bf16*)(F.ws + WS_OA), bh >> 2, bh & 3, q0, vt, F.lane);
        moba_item(P, kms, (bf16*)(F.ws + WS_OA), bh >> 2, bh & 3, 63 - q0, vt, F.lane); }
    for (int it = gw; it < 3 * 4096; it += NGW) { const int cfg = it >> 12, rem = it & 4095, bh = rem >> 6, idx = rem & 63;
        dil_item(P, (bf16*)(F.ws + WS_DIL) + (size_t)cfg * M * 256, (float*)(F.ws + WS_LSE) + (size_t)cfg * M * 4, cfg, bh >> 2, bh & 3, idx, vt, F.lane); }
}

constexpr int PH_PROLOGUE = 0, PH_PRENORM = 1, PH_L0 = 2, PH_L1 = 10, PH_MOE_INDEX = 15, PH_MOE_CHUNK0 = 16, PH_POSTFFN1 = 26, N_PHASES = 27;
__global__ void __launch_bounds__(512, 2) fwd_kernel(Args args) {
    extern __shared__ __attribute__((aligned(16))) unsigned char lds_raw[];
    Frame F;
    F.lds = (LAS unsigned char*)lds_raw;
    F.tid = threadIdx.x; F.lane = F.tid & 63; F.wave = __builtin_amdgcn_readfirstlane(F.tid >> 6);
    F.G = gridDim.x; { const int bx = blockIdx.x; F.vcu = (F.G % 8 == 0) ? (bx % 8) * (F.G / 8) + bx / 8 : bx; }
    F.ws = args.ws; F.ctl = (unsigned*)(args.ws + WS_CTL); F.out = args.out;
    volatile LAS unsigned* MISC = (volatile LAS unsigned*)(F.lds + LDSX_OFF);
    if (F.tid < 16) MISC[F.tid] = 0u;
    __syncthreads();
    const int lo = args.ph_lo, hi = args.ph_hi;
    const bool multi = (hi - lo) > 1;
    XcdBarrier bar; bar.bar = F.ctl + CW_BAR; bar.x = 0; bar.st = nullptr;
    if (multi) bar = xcd_barrier_post(F.ctl + CW_BAR, MISC + 8);
#ifndef KMASK
#define KMASK 0xFFFF
#endif
#define KON(b) (((KMASK) >> (b)) & 1)
#define IN(k) (lo <= (k) && (k) < hi)
#define SEAM(k) do { if (IN(k) && IN((k) + 1)) xcd_barrier(bar); } while (0)

    if (KON(0) && IN(PH_PROLOGUE)) phase_prologue(F);
    SEAM(PH_PROLOGUE);
    if (KON(1) && IN(PH_PRENORM)) phase_prenorm0(F);
    SEAM(PH_PRENORM);
    for (int layer = 0; layer < 2; ++layer) {
        const int pb = layer == 0 ? PH_L0 : PH_L1;
        if (KON(2) && IN(pb)) {
            pg8::SchedPlain S; S.init(M / 256, NIN / 256, F.G, (int)blockIdx.x); S.Bt = (const char*)(F.ws + WS_WIN) + (size_t)layer * NIN * 1024 * 2; S.tstep = (size_t)256 * 1024 * 2;
            EpiInProj E{(bf16*)(F.ws + WS_P), (const int*)args.in[I_POS], (float*)(F.ctl + CW_KM) + (size_t)layer * 32768};
            pg8::gemm_phase(F.lds, (const char*)(F.ws + WS_HB), 1024, S, E);
        }
        SEAM(pb);
        if (KON(3) && IN(pb + 1)) phase_mixers(F, layer);
        SEAM(pb + 1);
        if (KON(4) && IN(pb + 2)) phase_mixnorm(F, layer);
        SEAM(pb + 2);
        if (KON(5) && IN(pb + 3)) {
            pg8::SchedPlain S; S.init(M / 256, 4, F.G, (int)blockIdx.x); S.Bt = (const char*)(F.ws + WS_WOUT) + (size_t)layer * 1024 * 1024 * 2; S.tstep = (size_t)256 * 1024 * 2;
            EpiPlain E{(bf16*)(F.ws + WS_Y), 1024, 0};
            pg8::gemm_phase(F.lds, (const char*)(F.ws + WS_HB), 1024, S, E);
        }
        SEAM(pb + 3);
        if (KON(6) && IN(pb + 4)) phase_postmix(F, layer, layer == 1);
        SEAM(pb + 4);
        if (layer == 0) {
            if (KON(7) && IN(pb + 5)) {
                pg8::SchedPlain S; S.init(M / 256, 2 * FFD / 256, F.G, (int)blockIdx.x); S.Bt = (const char*)(F.ws + WS_WFGU); S.tstep = (size_t)256 * 1024 * 2;
                EpiSwiGLU E{(bf16*)(F.ws + WS_FH), FFD};
                pg8::gemm_phase(F.lds, (const char*)(F.ws + WS_HB), 1024, S, E);
            }
            SEAM(pb + 5);
            if (KON(8) && IN(pb + 6)) {
                pg8::SchedPlain S; S.init(M / 256, 4, F.G, (int)blockIdx.x); S.Bt = (const char*)(F.ws + WS_WFD); S.tstep = (size_t)256 * FFD * 2;
                EpiPlain E{(bf16*)(F.ws + WS_HB), 1024, 0};
                pg8::gemm_phase(F.lds, (const char*)(F.ws + WS_FH), FFD, S, E);
            }
            SEAM(pb + 6);
            if (KON(9) && IN(pb + 7)) phase_postffn(F, 0, false);
            SEAM(pb + 7);
        } else {
            if (KON(10) && IN(PH_MOE_INDEX)) phase_moe_index(F);
            SEAM(PH_MOE_INDEX);
            for (int c = 0; c < NCHUNK; ++c) {
                const int pg = PH_MOE_CHUNK0 + 2 * c;
                if (IN(pg) || IN(pg + 1)) {
                    int ts[9], cnt[8]; moe_tiles(F, ts, cnt);
                    const int tile0 = CHUNK_TILES * c; int nt = ts[8] - tile0; nt = nt > CHUNK_TILES ? CHUNK_TILES : nt;
                    if (KON(11) && IN(pg) && nt > 0) {
                        pg8::SchedMoe<true> S; S.init(nt, 2 * FFE / 256, F.G, (int)blockIdx.x); S.Bt = (const char*)(F.ws + WS_WMGU); S.tstep = (size_t)256 * 1024 * 2; S.estride = (size_t)2 * FFE * 1024 * 2;
                        S.tile0 = tile0; S.s2t = (const int*)(F.ws + WS_S2T);
#pragma unroll
                        for (int k = 0; k < 7; ++k) S.ts[k] = ts[k + 1];
                        EpiSwiGLU E{(bf16*)(F.ws + WS_HID), FFE};
                        pg8::gemm_phase(F.lds, (const char*)(F.ws + WS_HB), 1024, S, E);
                    }
                    SEAM(pg);
                    if (KON(12) && IN(pg + 1) && nt > 0) {
                        pg8::SchedMoe<false> S; S.init(nt, 4, F.G, (int)blockIdx.x); S.Bt = (const char*)(F.ws + WS_WMD); S.tstep = (size_t)256 * FFE * 2; S.estride = (size_t)1024 * FFE * 2;
                        S.tile0 = tile0; S.s2t = nullptr;
#pragma unroll
                        for (int k = 0; k < 7; ++k) S.ts[k] = ts[k + 1];
                        EpiPlain E{(bf16*)(F.ws + WS_YS), 1024, tile0 * 256};
                        pg8::gemm_phase(F.lds, (const char*)(F.ws + WS_HID), FFE, S, E);
                    }
                    SEAM(pg + 1);
                }
            }
            if (KON(13) && IN(PH_POSTFFN1)) phase_postffn(F, 1, true);
        }
    }
#undef IN
#undef SEAM
}

extern "C" void kernel_launch(void* const* d_in, const int* in_sizes, int n_in, void* d_out, int out_size, void* d_ws, size_t ws_size, hipStream_t stream) {
    static int grid = 0;
    if (grid == 0) {
        if (n_in != 26 || out_size != M * D || ws_size < WS_END) { fprintf(stderr, "kernel_launch: unexpected problem: n_in %d out %d ws %zu (need %zu)\n", n_in, out_size, ws_size, (size_t)WS_END); grid = -1; return; }
        int dev = 0, cus = 0, per_cu = 0;
        if (hipGetDevice(&dev) != hipSuccess || hipDeviceGetAttribute(&cus, hipDeviceAttributeMultiprocessorCount, dev) != hipSuccess) { grid = -1; return; }
        if (hipFuncSetAttribute((const void*)fwd_kernel, hipFuncAttributeMaxDynamicSharedMemorySize, LDS_BYTES) != hipSuccess) { fprintf(stderr, "kernel_launch: hipFuncSetAttribute failed\n"); grid = -1; return; }
        if (hipOccupancyMaxActiveBlocksPerMultiprocessor(&per_cu, (const void*)fwd_kernel, 512, LDS_BYTES) != hipSuccess || per_cu < 1) fprintf(stderr, "kernel_launch: occupancy query says %d\n", per_cu);
        (void)hipGetLastError();
        grid = cus;
        fprintf(stderr, "kernel_launch: grid %d, ws %zu\n", grid, ws_size);
    }
    if (grid < 0) return;
    (void)hipMemsetAsync((char*)d_ws + WS_CTL, 0, CTL_ZERO_BYTES, stream);
    Args a{};
    for (int i = 0; i < 26; ++i) a.in[i] = d_in[i];
    a.out = (float*)d_out; a.ws = (unsigned char*)d_ws;
#if MK_ONE_LAUNCH
    a.ph_lo = 0; a.ph_hi = N_PHASES;
    hipLaunchKernelGGL(fwd_kernel, dim3(grid), dim3(512), LDS_BYTES, stream, a);
#else
    for (int p = 0; p < N_PHASES; ++p) { a.ph_lo = p; a.ph_hi = p + 1; hipLaunchKernelGGL(fwd_kernel, dim3(grid), dim3(512), LDS_BYTES, stream, a); }
#endif
}
```

```cpp
#include <hip/hip_runtime.h>
#include <cstdio>
#include <cstdint>

#ifndef REPK
#define REPK -1
#endif
#ifndef MK_ONE_LAUNCH
#define MK_ONE_LAUNCH 1
#endif

#define GAS __attribute__((address_space(1)))
#define LAS __attribute__((address_space(3)))
typedef unsigned short bf16;
typedef short bf16x8 __attribute__((ext_vector_type(8)));
typedef float f32x4 __attribute__((ext_vector_type(4)));
typedef float f32x16 __attribute__((ext_vector_type(16)));
typedef unsigned u32x4 __attribute__((ext_vector_type(4)));
typedef unsigned u32x2 __attribute__((ext_vector_type(2)));
typedef float f32x2_t __attribute__((ext_vector_type(2)));
typedef __bf16 bf16x2_t __attribute__((ext_vector_type(2)));
typedef short v4i16_t __attribute__((ext_vector_type(4)));
typedef GAS unsigned gu32;

constexpr int BATCH = 16, SEQ = 2048, D = 1024, M = BATCH * SEQ;
constexpr int NIN = 2560, PW = 2304;
constexpr int FFD = 2816, FFE = 3584, NEXP = 8;
constexpr float EPS = 1e-6f;
constexpr int NWG = 256;
constexpr float C2 = 0.125f * 1.4426950408889634f;
constexpr int P_QA = 0, P_KA = 256, P_VA = 512, P_QB = 768, P_KB = 1024, P_VB = 1280, P_GU = 1536, P_GV = 1792, P_GLU = 2048;
constexpr int MOE_TILES_MAX = 264, CHUNK_TILES = 64, NCHUNK = 5;
constexpr float MOE_WGU_SC = 32.f, MOE_WD_SC = 64.f, MOE_HID_SC = 4.f;
constexpr int E8_WGU = 0x7a7a7a7a, E8_WD = 0x79797979, E8_HID = 0x7d7d7d7d, E8_ONE = 0x7f7f7f7f;

__device__ __forceinline__ unsigned cvtpk(float lo, float hi) { f32x2_t v = {lo, hi}; bf16x2_t b = __builtin_convertvector(v, bf16x2_t); return __builtin_bit_cast(unsigned, b); }
__device__ __forceinline__ unsigned pk4_fp8(float a, float b, float c, float d) {
    a = __builtin_amdgcn_fmed3f(a, -448.f, 448.f); b = __builtin_amdgcn_fmed3f(b, -448.f, 448.f); c = __builtin_amdgcn_fmed3f(c, -448.f, 448.f); d = __builtin_amdgcn_fmed3f(d, -448.f, 448.f);
    int p = __builtin_amdgcn_cvt_pk_fp8_f32(a, b, 0, false); p = __builtin_amdgcn_cvt_pk_fp8_f32(c, d, p, true); return (unsigned)p; }
__device__ __forceinline__ float bf2f(unsigned short b) { return __uint_as_float((unsigned)b << 16); }
__device__ __forceinline__ float bflo(unsigned w) { return __uint_as_float(w << 16); }
__device__ __forceinline__ float bfhi(unsigned w) { return __uint_as_float(w & 0xffff0000u); }
__device__ __forceinline__ float fast_exp2(float x) { return __builtin_amdgcn_exp2f(x); }
__device__ __forceinline__ float fast_rcp(float x) { return __builtin_amdgcn_rcpf(x); }
__device__ __forceinline__ float sigmoidf_(float x) { return fast_rcp(1.0f + fast_exp2(-1.4426950408889634f * x)); }
__device__ __forceinline__ float siluf_(float x) { return x * sigmoidf_(x); }
__device__ __forceinline__ float gelu_tanh(float x) { const float u = x + 0.044715f * x * x * x; return x * fast_rcp(1.0f + fast_exp2(-2.3022081982f * u)); }
__device__ __forceinline__ int lane_id() { int l; asm volatile("v_mbcnt_lo_u32_b32 %0, -1, 0\n\tv_mbcnt_hi_u32_b32 %0, -1, %0" : "=v"(l)); return l; }
template <int CTRL> __device__ __forceinline__ float dpp_f(float v) { return __builtin_bit_cast(float, __builtin_amdgcn_update_dpp(0, __builtin_bit_cast(int, v), CTRL, 0xf, 0xf, false)); }
__device__ __forceinline__ float sum16(float v) {
    v += dpp_f<0xB1>(v); v += dpp_f<0x4E>(v); v += dpp_f<0x141>(v); v += dpp_f<0x140>(v); return v; }
__device__ __forceinline__ float pair16_sum(float v) { const auto r = __builtin_amdgcn_permlane16_swap(__float_as_uint(v), __float_as_uint(v), false, false); return __uint_as_float(r[0]) + __uint_as_float(r[1]); }
__device__ __forceinline__ float pair32_sum(float v) { const auto r = __builtin_amdgcn_permlane32_swap(__float_as_uint(v), __float_as_uint(v), false, false); return __uint_as_float(r[0]) + __uint_as_float(r[1]); }
__device__ __forceinline__ float pair32_max(float v) { const auto r = __builtin_amdgcn_permlane32_swap(__float_as_uint(v), __float_as_uint(v), false, false); return fmaxf(__uint_as_float(r[0]), __uint_as_float(r[1])); }
__device__ __forceinline__ float pair32_other(float v, int h) { const auto r = __builtin_amdgcn_permlane32_swap(__float_as_uint(v), __float_as_uint(v), false, false); return __uint_as_float(h ? r[0] : r[1]); }
__device__ __forceinline__ float wave_sum(float v) { return pair32_sum(pair16_sum(sum16(v))); }

namespace pg8 {
constexpr int BM = 256, BK = 64, HALF = 128, HTB = HALF * BK * 2, STAGE_BYTES = 8 * HTB, NXCD = 8, WGM = 8;
__host__ __device__ __forceinline__ int lds_byte(int r, int c) { const int st = (r >> 4) * 2 + (c >> 5), rr = r & 15, cc = c & 31, ob = rr * 64 + cc * 2; return st * 1024 + (ob ^ (((ob >> 9) & 1) << 5)); }
__host__ __device__ __forceinline__ void stage_rc(int b, int& R, int& C) { const int st = b / 1024, sb = b % 1024, swz = sb ^ (((sb >> 9) & 1) << 5); R = (st >> 1) * 16 + swz / 64; C = (st & 1) * 32 + (swz % 64) / 2; }
__host__ __device__ __forceinline__ int perm32(int rho) { const int n = rho >> 4, i = rho & 15; return 8 * (i >> 2) + 4 * n + (i & 3); }

struct Unit { int pm, pn; };
struct StaticOrder {
    int nM, nN, nwg, G, c;
    __device__ __forceinline__ void init(int nM_, int nN_, int G_, int c_) { nM = nM_; nN = nN_; nwg = nM * nN; G = G_; c = c_; }
    __device__ __forceinline__ bool next(int i, Unit& u) const {
        const long L = (long)i * G + c; if (L >= nwg) return false;
        int wgid = (int)L; { const int q = nwg / NXCD, r = nwg % NXCD, xcd = wgid % NXCD, off = wgid / NXCD; wgid = (xcd < r ? xcd * (q + 1) : r * (q + 1) + (xcd - r) * q) + off; }
        const int nig = WGM * nN, gid = wgid / nig, fm = gid * WGM, gsz = (nM - fm) < WGM ? (nM - fm) : WGM;
        u.pm = fm + ((wgid % nig) % gsz); u.pn = (wgid % nig) / gsz; return true;
    }
};
struct SchedPlain : StaticOrder {
    static constexpr bool GATHER = false;
    const char* Bt; size_t tstep;
    __device__ __forceinline__ int arow(const Unit& u, int rr) const { return u.pm * BM + rr; }
    __device__ __forceinline__ const char* bptr(const Unit& u) const { return Bt + (size_t)u.pn * tstep; }
};
template <bool GATHER_> struct SchedMoe : StaticOrder {
    static constexpr bool GATHER = GATHER_;
    const char* Bt; size_t tstep, estride; int tile0; const int* s2t; int ts[7];
    __device__ __forceinline__ int expert(int pmg) const { int e = 0;
#pragma unroll
        for (int k = 0; k < 7; ++k) e += (pmg >= ts[k]) ? 1 : 0;
        return e; }
    __device__ __forceinline__ int arow(const Unit& u, int rr) const { return u.pm * BM + rr; }
    const LAS int* tab;
    __device__ __forceinline__ u32x4 arow4(int ui, int R0) const { return *(const LAS u32x4*)(tab + ui * 256 + R0 * 4); }
    __device__ __forceinline__ const char* bptr(const Unit& u) const { return Bt + (size_t)expert(tile0 + u.pm) * estride + (size_t)u.pn * tstep; }
};

typedef int v8i32 __attribute__((ext_vector_type(8)));
template <class Epi, class Sched, bool FP8 = false>
__device__ __forceinline__ void gemm_phase(LAS unsigned char* lds, const int wave0, const char* Abase, const int KB, const Sched& S, const Epi& E, const int sW = 0x7f7f7f7f, const int sX = 0x7f7f7f7f) {
    int tid = wave0 * 64 + lane_id(); asm volatile("" : "+v"(tid)); const int wid = __builtin_amdgcn_readfirstlane(tid >> 6), lane = tid & 63, wr = wid >> 2, wc = wid & 3, fr = lane & 15, fq = lane >> 4;
    const int nt = KB / 128;
    int R0, C0; stage_rc(tid * 16, R0, C0);
    const unsigned voffA = (unsigned)(R0 * KB + C0 * 2), voffB = (unsigned)(((R0 & ~31) + perm32(R0 & 31)) * KB + C0 * 2);
    const size_t kstep = (size_t)(BK * 2);
    const size_t hstep = (size_t)HALF * KB;
    const unsigned rowb = (unsigned)KB, colb = (unsigned)C0 * 2u;
    const size_t q64 = (size_t)64 * KB;
    const unsigned ldsw = (unsigned)wid * 1024u;
    const int aoff = lds_byte(wr * 64 + fr, fq * 8), boff = lds_byte(wc * 32 + fr, fq * 8);
#define PG8_SA(b, h) (((b) * 2 + (h)) * HTB)
#define PG8_SB(b, h) ((4 + (b) * 2 + (h)) * HTB)
#define PG8_GLDS(gp, bufoff, i) __builtin_amdgcn_global_load_lds((const unsigned*)(gp), (LAS unsigned*)(lds + (bufoff) + ldsw + (i) * 8192), 16, 0, 0)
#define PG8_STAGE_B(bufoff, gbase) do { PG8_GLDS((const char*)(gbase) + voffB, bufoff, 0); PG8_GLDS((const char*)(gbase) + q64 + voffB, bufoff, 1); } while (0)
#define PG8_STAGE_A(bufoff, h, kb, NX) do { \
        if constexpr (Sched::GATHER) { const unsigned _o0 = (NX) ? ((h) ? n2 : n0) : ((h) ? va2 : va0), _o1 = (NX) ? ((h) ? n3 : n1) : ((h) ? va3 : va1); \
            PG8_GLDS(Abase + (kb) + _o0, bufoff, 0); PG8_GLDS(Abase + (kb) + _o1, bufoff, 1); } \
        else { const char* _b = ((NX) ? nA : cA) + (size_t)(h) * hstep + (kb); PG8_GLDS(_b + voffA, bufoff, 0); PG8_GLDS(_b + q64 + voffA, bufoff, 1); } } while (0)
#define PG8_LDA(dst, b, h) do { _Pragma("unroll") for (int m = 0; m < 4; ++m) _Pragma("unroll") for (int k = 0; k < 2; ++k) dst[m][k] = *(const LAS bf16x8*)(lds + PG8_SA(b, h) + aoff + m * 2048 + k * 1024); } while (0)
#define PG8_LDB(dst, b, h) do { _Pragma("unroll") for (int n = 0; n < 2; ++n) _Pragma("unroll") for (int k = 0; k < 2; ++k) dst[n][k] = *(const LAS bf16x8*)(lds + PG8_SB(b, h) + boff + n * 2048 + k * 1024); } while (0)
#define PG8_CAT(x, y) __builtin_shufflevector(__builtin_bit_cast(u32x4, x), __builtin_bit_cast(u32x4, y), 0, 1, 2, 3, 4, 5, 6, 7)
#define PG8_MMA(ai, bj, At, Bt) do { __builtin_amdgcn_s_setprio(1); \
        if constexpr (FP8) { _Pragma("unroll") for (int m = 0; m < 4; ++m) _Pragma("unroll") for (int n = 0; n < 2; ++n) { \
            const v8i32 b8_ = __builtin_bit_cast(v8i32, PG8_CAT(Bt[n][0], Bt[n][1])), a8_ = __builtin_bit_cast(v8i32, PG8_CAT(At[m][0], At[m][1])); \
            asm volatile("s_nop 1\n\tv_mfma_scale_f32_16x16x128_f8f6f4 %0, %1, %2, %0, %3, %4 op_sel_hi:[0,0,0]" : "+v"(acc[ai][bj][m][n]) : "v"(b8_), "v"(a8_), "v"(sW), "v"(sX)); } } \
        else { _Pragma("unroll") for (int m = 0; m < 4; ++m) _Pragma("unroll") for (int n = 0; n < 2; ++n) _Pragma("unroll") for (int k = 0; k < 2; ++k) \
            acc[ai][bj][m][n] = __builtin_amdgcn_mfma_f32_16x16x32_bf16(Bt[n][k], At[m][k], acc[ai][bj][m][n], 0, 0, 0); } \
        __builtin_amdgcn_s_setprio(0); } while (0)
#define PG8_WAIT_V(n) asm volatile("s_waitcnt vmcnt(" #n ")" ::: "memory")
#define PG8_WAIT_L(n) asm volatile("s_waitcnt lgkmcnt(" #n ")" ::: "memory")
#define PG8_BAR __builtin_amdgcn_s_barrier()
#define PG8_SCHED __builtin_amdgcn_sched_barrier(0)
    Unit cur, nxt; int ui = 0;
    if (!S.next(0, cur)) return;
#define PG8_PIN8(a, b) asm volatile("" : "+v"(acc[a][b][0][0]), "+v"(acc[a][b][0][1]), "+v"(acc[a][b][1][0]), "+v"(acc[a][b][1][1]), "+v"(acc[a][b][2][0]), "+v"(acc[a][b][2][1]), "+v"(acc[a][b][3][0]), "+v"(acc[a][b][3][1]))
#define PG8_PINACC() do { PG8_PIN8(0, 0); PG8_PIN8(0, 1); PG8_PIN8(1, 0); PG8_PIN8(1, 1); } while (0)
    f32x4 acc[2][2][4][2];
#pragma unroll
    for (int a = 0; a < 2; ++a)
#pragma unroll
        for (int b = 0; b < 2; ++b)
#pragma unroll
            for (int m = 0; m < 4; ++m)
#pragma unroll
                for (int n = 0; n < 2; ++n) acc[a][b][m][n] = (f32x4){0.f, 0.f, 0.f, 0.f};
    PG8_PINACC();
    bf16x8 At[4][2], B0[2][2], B1[2][2];
    unsigned va0 = 0, va1 = 0, va2 = 0, va3 = 0, na0 = 0, na1 = 0, na2 = 0, na3 = 0;
    const char* cA = Abase; const char* nA = Abase;
    if constexpr (Sched::GATHER) { const u32x4 ci = S.arow4(0, R0); va0 = ci.x * rowb + colb; va1 = ci.y * rowb + colb; va2 = ci.z * rowb + colb; va3 = ci.w * rowb + colb; }
    else cA = Abase + (size_t)S.arow(cur, 0) * rowb;
    const char* cB = S.bptr(cur);
    { const unsigned n0 = 0, n1 = 0, n2 = 0, n3 = 0; (void)n0; (void)n1; (void)n2; (void)n3;
    PG8_STAGE_B(PG8_SB(0, 0), cB); PG8_STAGE_B(PG8_SB(0, 1), cB + hstep); PG8_STAGE_A(PG8_SA(0, 0), 0, 0, false); PG8_STAGE_A(PG8_SA(0, 1), 1, 0, false);
    if (wr == 1) PG8_BAR;
    PG8_WAIT_V(2); PG8_BAR;
    PG8_STAGE_B(PG8_SB(1, 0), cB + kstep); PG8_STAGE_A(PG8_SA(1, 0), 0, kstep, false); PG8_STAGE_B(PG8_SB(1, 1), cB + hstep + kstep);
    PG8_WAIT_V(6); PG8_BAR; }
    for (;;) {
        const bool has_next = S.next(ui + 1, nxt);
        const char* nB = has_next ? S.bptr(nxt) : cB;
        if constexpr (Sched::GATHER) {
            { const u32x4 ni = S.arow4(has_next ? ui + 1 : ui, R0); na0 = ni.x * rowb + colb; na1 = ni.y * rowb + colb; na2 = ni.z * rowb + colb; na3 = ni.w * rowb + colb; }
        } else nA = has_next ? Abase + (size_t)S.arow(nxt, 0) * rowb : cA;
        for (int t = 0; t < nt; t += 2) {
            const bool last = (t == nt - 2);
            const size_t k1 = (size_t)(t + 1) * kstep, k2 = last ? 0 : (size_t)(t + 2) * kstep, k3 = k2 + kstep;
            const char* b2 = last ? nB : cB + (size_t)(t + 2) * kstep; const char* b3 = b2 + kstep;
            const unsigned n0 = last ? na0 : va0, n1 = last ? na1 : va1, n2 = last ? na2 : va2, n3 = last ? na3 : va3;
            PG8_LDB(B0, 0, 0); PG8_LDB(B1, 0, 1); PG8_SCHED; PG8_LDA(At, 0, 0); PG8_STAGE_A(PG8_SA(1, 1), 1, k1, false);
            PG8_WAIT_V(8); PG8_WAIT_L(0); PG8_BAR; PG8_MMA(0, 0, At, B0); PG8_MMA(0, 1, At, B1); PG8_BAR; PG8_SCHED;
            PG8_LDA(At, 0, 1); PG8_STAGE_B(PG8_SB(0, 0), b2); PG8_STAGE_B(PG8_SB(0, 1), b2 + hstep); PG8_STAGE_A(PG8_SA(0, 0), 0, k2, last);
            PG8_WAIT_V(8); PG8_WAIT_L(0); PG8_BAR; PG8_MMA(1, 0, At, B0); PG8_MMA(1, 1, At, B1); PG8_BAR; PG8_SCHED;
            PG8_LDB(B0, 1, 0); PG8_LDB(B1, 1, 1); PG8_SCHED; PG8_LDA(At, 1, 0); PG8_STAGE_A(PG8_SA(0, 1), 1, k2, last);
            PG8_WAIT_V(8); PG8_WAIT_L(0); PG8_BAR; PG8_MMA(0, 0, At, B0); PG8_MMA(0, 1, At, B1); PG8_BAR; PG8_SCHED;
            PG8_LDA(At, 1, 1); PG8_STAGE_B(PG8_SB(1, 0), b3); PG8_STAGE_B(PG8_SB(1, 1), b3 + hstep); PG8_STAGE_A(PG8_SA(1, 0), 0, k3, last);
            PG8_WAIT_V(8); PG8_WAIT_L(0); PG8_BAR; PG8_MMA(1, 0, At, B0); PG8_MMA(1, 1, At, B1); PG8_BAR; PG8_SCHED;
        }
        if (wr == 0) PG8_BAR;
        if constexpr (FP8) asm volatile("s_nop 15\n\ts_nop 15" ::: "memory");
        E(acc, cur, wr, wc, fr, fq);
        if (!has_next) break;
#pragma unroll
        for (int a = 0; a < 2; ++a)
#pragma unroll
            for (int b = 0; b < 2; ++b)
#pragma unroll
                for (int m = 0; m < 4; ++m)
#pragma unroll
                    for (int n = 0; n < 2; ++n) acc[a][b][m][n] = (f32x4){0.f, 0.f, 0.f, 0.f};
        PG8_PINACC();
        cur = nxt; cB = nB; cA = nA; ++ui;
        if constexpr (Sched::GATHER) { va0 = na0; va1 = na1; va2 = na2; va3 = na3; }
        if (wr == 1) PG8_BAR;
    }
    PG8_WAIT_V(0);
    PG8_BAR;
#undef PG8_SA
#undef PG8_SB
#undef PG8_GLDS
#undef PG8_STAGE_A
#undef PG8_STAGE_B
#undef PG8_LDA
#undef PG8_LDB
#undef PG8_MMA
#undef PG8_PIN8
#undef PG8_PINACC
#undef PG8_CAT
#undef PG8_WAIT_V
#undef PG8_WAIT_L
#undef PG8_BAR
#undef PG8_SCHED
}
}

struct EpiPlain {
    bf16* O; int ldc; int rowoff;
    __device__ __forceinline__ void operator()(const f32x4 (&acc)[2][2][4][2], const pg8::Unit& u, int wr, int wc, int fr, int fq) const {
        const int row0 = rowoff + u.pm * 256 + wr * 64 + fr, col0 = u.pn * 256 + wc * 32 + 8 * fq;
#pragma unroll
        for (int ai = 0; ai < 2; ++ai)
#pragma unroll
            for (int m = 0; m < 4; ++m) { bf16* rowp = O + (size_t)(row0 + ai * 128 + m * 16) * ldc + col0;
#pragma unroll
                for (int bj = 0; bj < 2; ++bj) { const f32x4 v0 = acc[ai][bj][m][0], v1 = acc[ai][bj][m][1];
                    u32x4 w; w.x = cvtpk(v0[0], v0[1]); w.y = cvtpk(v0[2], v0[3]); w.z = cvtpk(v1[0], v1[1]); w.w = cvtpk(v1[2], v1[3]);
                    *(u32x4*)(rowp + bj * 128) = w; } }
    }
};
struct EpiSwiGLU {
    bf16* O; int ldc;
    __device__ __forceinline__ void operator()(const f32x4 (&acc)[2][2][4][2], const pg8::Unit& u, int wr, int wc, int fr, int fq) const {
        const int row0 = u.pm * 256 + wr * 64 + fr, col0 = u.pn * 128 + wc * 32 + 8 * fq;
#pragma unroll
        for (int ai = 0; ai < 2; ++ai)
#pragma unroll
            for (int m = 0; m < 4; ++m) { bf16* rowp = O + (size_t)(row0 + ai * 128 + m * 16) * ldc + col0;
                float o[8];
#pragma unroll
                for (int n = 0; n < 2; ++n)
#pragma unroll
                    for (int e = 0; e < 4; ++e) o[4 * n + e] = siluf_(acc[ai][0][m][n][e]) * acc[ai][1][m][n][e];
                u32x4 w; w.x = cvtpk(o[0], o[1]); w.y = cvtpk(o[2], o[3]); w.z = cvtpk(o[4], o[5]); w.w = cvtpk(o[6], o[7]);
                *(u32x4*)rowp = w; }
    }
};
struct EpiSwiGLU8 {
    unsigned char* O; int ldc; float osc;
    __device__ __forceinline__ void operator()(const f32x4 (&acc)[2][2][4][2], const pg8::Unit& u, int wr, int wc, int fr, int fq) const {
        const int row0 = u.pm * 256 + wr * 64 + fr, col0 = u.pn * 128 + wc * 32 + 8 * fq;
#pragma unroll
        for (int ai = 0; ai < 2; ++ai)
#pragma unroll
            for (int m = 0; m < 4; ++m) { unsigned char* rowp = O + (size_t)(row0 + ai * 128 + m * 16) * ldc + col0;
                float o[8];
#pragma unroll
                for (int n = 0; n < 2; ++n)
#pragma unroll
                    for (int e = 0; e < 4; ++e) o[4 * n + e] = osc * siluf_(acc[ai][0][m][n][e]) * acc[ai][1][m][n][e];
                u32x2 w; w.x = pk4_fp8(o[0], o[1], o[2], o[3]); w.y = pk4_fp8(o[4], o[5], o[6], o[7]);
                *(u32x2*)rowp = w; }
    }
};
struct EpiInProj {
    bf16* P; const int* pos; float* kmsum;
    __device__ __forceinline__ void operator()(const f32x4 (&acc)[2][2][4][2], const pg8::Unit& u, int wr, int wc, int fr, int fq) const {
        const int pn = u.pn, row0 = u.pm * 256 + wr * 64 + fr;
        if (pn == 0 || pn == 1 || pn == 3 || pn == 4) {
            const int g = wc & 1, i0 = 16 * g + 4 * fq;
            float invf[4];
#pragma unroll
            for (int e = 0; e < 4; ++e) invf[e] = fast_exp2(-(float)(i0 + e) * 0.4152410118609203f);
            const float sc = (pn == 0 || pn == 3) ? C2 : 1.0f;
            float ks[2][2][4];
#pragma unroll
            for (int a = 0; a < 2; ++a)
#pragma unroll
                for (int b = 0; b < 2; ++b)
#pragma unroll
                    for (int e = 0; e < 4; ++e) ks[a][b][e] = 0.f;
#pragma unroll
            for (int ai = 0; ai < 2; ++ai)
#pragma unroll
                for (int m = 0; m < 4; ++m) { const int row = row0 + ai * 128 + m * 16; const float p = (float)pos[row];
                    float cs[4], sn[4];
#pragma unroll
                    for (int e = 0; e < 4; ++e) { const float ang = p * invf[e]; const float k = rintf(ang * 0.15915494309189535f);
                        float r = fmaf(-k, 6.2831854820251465f, ang); r = fmaf(-k, -1.7484556000744883e-07f, r); const float rev = r * 0.15915494309189535f;
                        cs[e] = __builtin_amdgcn_cosf(rev); sn[e] = __builtin_amdgcn_sinf(rev); }
                    bf16* rowp = P + (size_t)row * PW + 256 * pn;
#pragma unroll
                    for (int bj = 0; bj < 2; ++bj) { const int hh = 2 * bj + (wc >> 1); const f32x4 v0 = acc[ai][bj][m][0], v1 = acc[ai][bj][m][1];
                        float o0[4], o1[4];
#pragma unroll
                        for (int e = 0; e < 4; ++e) { o0[e] = (v0[e] * cs[e] - v1[e] * sn[e]) * sc; o1[e] = (v1[e] * cs[e] + v0[e] * sn[e]) * sc; ks[bj][0][e] += o0[e]; ks[bj][1][e] += o1[e]; }
                        bf16* dst = rowp + 64 * hh + i0;
                        u32x2 w0, w1; w0.x = cvtpk(o0[0], o0[1]); w0.y = cvtpk(o0[2], o0[3]); w1.x = cvtpk(o1[0], o1[1]); w1.y = cvtpk(o1[2], o1[3]);
                        *(u32x2*)dst = w0; *(u32x2*)(dst + 32) = w1; } }
            if (pn == 1) {
#pragma unroll
                for (int bj = 0; bj < 2; ++bj)
#pragma unroll
                    for (int n = 0; n < 2; ++n)
#pragma unroll
                        for (int e = 0; e < 4; ++e) { const float v = sum16(ks[bj][n][e]);
                            if (fr == 0) atomicAdd(kmsum + (size_t)(u.pm * 4 + 2 * bj + (wc >> 1)) * 64 + 32 * n + i0 + e, v); }
            }
        } else if (pn >= 8) {
            const int col0 = P_GLU + 128 * (pn - 8) + wc * 32 + 8 * fq;
#pragma unroll
            for (int ai = 0; ai < 2; ++ai)
#pragma unroll
                for (int m = 0; m < 4; ++m) { bf16* rowp = P + (size_t)(row0 + ai * 128 + m * 16) * PW + col0;
                    float o[8];
#pragma unroll
                    for (int n = 0; n < 2; ++n)
#pragma unroll
                        for (int e = 0; e < 4; ++e) o[4 * n + e] = acc[ai][0][m][n][e] * sigmoidf_(acc[ai][1][m][n][e]);
                    u32x4 w; w.x = cvtpk(o[0], o[1]); w.y = cvtpk(o[2], o[3]); w.z = cvtpk(o[4], o[5]); w.w = cvtpk(o[6], o[7]);
                    *(u32x4*)rowp = w; }
        } else {
            const bool act = (pn >= 6);
            const int col0 = 256 * pn + wc * 32 + 8 * fq;
#pragma unroll
            for (int ai = 0; ai < 2; ++ai)
#pragma unroll
                for (int m = 0; m < 4; ++m) { bf16* rowp = P + (size_t)(row0 + ai * 128 + m * 16) * PW + col0;
#pragma unroll
                    for (int bj = 0; bj < 2; ++bj) { float o[8];
#pragma unroll
                        for (int n = 0; n < 2; ++n)
#pragma unroll
                            for (int e = 0; e < 4; ++e) { const float v = acc[ai][bj][m][n][e]; o[4 * n + e] = act ? gelu_tanh(v) : v; }
                        u32x4 w; w.x = cvtpk(o[0], o[1]); w.y = cvtpk(o[2], o[3]); w.z = cvtpk(o[4], o[5]); w.w = cvtpk(o[6], o[7]);
                        *(u32x4*)(rowp + bj * 128) = w; } }
        }
    }
};

#define MFMA32(a, b, c) __builtin_amdgcn_mfma_f32_32x32x16_bf16((a), (b), (c), 0, 0, 0)
__device__ __forceinline__ int crow(int i, int h) { return (i & 3) + 8 * (i >> 2) + 4 * h; }
__device__ __forceinline__ v4i16_t vtr(const LAS char* p) { return __builtin_amdgcn_ds_read_tr16_b64_v4i16((LAS v4i16_t*)p); }

__device__ __forceinline__ void attn_tile(f32x16& o0, f32x16& o1, float& m, float& l, const bf16x8 (&qf)[4], const bf16* kp, const bf16* vp, size_t v8,
                                          LAS char* vt, int lane, unsigned vmask) {
    const int h = lane >> 5;
    bf16x8 kf[4];
#pragma unroll
    for (int s = 0; s < 4; ++s) kf[s] = *(const bf16x8*)(kp + 16 * s);
    u32x4 vv[4];
#pragma unroll
    for (int w = 0; w < 4; ++w) vv[w] = *(const u32x4*)(vp + (size_t)w * v8);
    f32x16 p;
#pragma unroll
    for (int i = 0; i < 16; ++i) p[i] = 0.f;
#pragma unroll
    for (int s = 0; s < 4; ++s) p = MFMA32(kf[s], qf[s], p);
    { const int piece = lane & 7, key0 = lane >> 3;
#pragma unroll
      for (int w = 0; w < 4; ++w) *(LAS u32x4*)(vt + (2 * w + (piece >> 2)) * 512 + key0 * 64 + (piece & 3) * 16) = vv[w]; }
    float tm = -INFINITY;
#pragma unroll
    for (int i = 0; i < 16; ++i) { p[i] = ((vmask >> i) & 1u) ? p[i] : -INFINITY; tm = fmaxf(tm, p[i]); }
    tm = pair32_max(tm);
    const float mn = fmaxf(m, tm), alpha = fast_exp2(m - mn); m = mn;
    float rs = 0.f;
#pragma unroll
    for (int i = 0; i < 16; ++i) { p[i] = fast_exp2(p[i] - mn); rs += p[i]; }
    l = l * alpha + rs;
#pragma unroll
    for (int i = 0; i < 16; ++i) { o0[i] *= alpha; o1[i] *= alpha; }
    u32x4 w0, w1;
    w0.x = cvtpk(p[0], p[1]); w0.y = cvtpk(p[2], p[3]); w0.z = cvtpk(p[4], p[5]); w0.w = cvtpk(p[6], p[7]);
    w1.x = cvtpk(p[8], p[9]); w1.y = cvtpk(p[10], p[11]); w1.z = cvtpk(p[12], p[13]); w1.w = cvtpk(p[14], p[15]);
    const bf16x8 pf0 = __builtin_bit_cast(bf16x8, w0), pf1 = __builtin_bit_cast(bf16x8, w1);
    const LAS char* vb = vt + (4 * h + ((lane & 15) >> 2)) * 64 + ((lane >> 4) & 1) * 32 + (lane & 3) * 8;
#pragma unroll
    for (int s2 = 0; s2 < 2; ++s2) {
        const v4i16_t a0 = vtr(vb + (4 * s2 + 0) * 512), a1 = vtr(vb + (4 * s2 + 2) * 512);
        const v4i16_t b0 = vtr(vb + (4 * s2 + 1) * 512), b1 = vtr(vb + (4 * s2 + 3) * 512);
        const bf16x8 vf0 = (bf16x8){a0[0], a0[1], a0[2], a0[3], a1[0], a1[1], a1[2], a1[3]};
        const bf16x8 vf1 = (bf16x8){b0[0], b0[1], b0[2], b0[3], b1[0], b1[1], b1[2], b1[3]};
        o0 = MFMA32(vf0, s2 ? pf1 : pf0, o0);
        o1 = MFMA32(vf1, s2 ? pf1 : pf0, o1);
    }
}
__device__ __forceinline__ void attn_store(const f32x16& o0, const f32x16& o1, float inv, bf16* dst, int h) {
#pragma unroll
    for (int g = 0; g < 4; ++g) {
        u32x2 a, b; a.x = cvtpk(o0[4 * g] * inv, o0[4 * g + 1] * inv); a.y = cvtpk(o0[4 * g + 2] * inv, o0[4 * g + 3] * inv);
        b.x = cvtpk(o1[4 * g] * inv, o1[4 * g + 1] * inv); b.y = cvtpk(o1[4 * g + 2] * inv, o1[4 * g + 3] * inv);
        *(u32x2*)(dst + 8 * g + 4 * h) = a; *(u32x2*)(dst + 32 + 8 * g + 4 * h) = b; }
}
__device__ __forceinline__ void moba_item(const bf16* P, const float* kmsum, bf16* OA, int b, int hh, int qt, LAS char* vt, int lane) {
    const int r = lane & 31, h = lane >> 5, j = qt >> 3;
    const bf16* Pb = P + (size_t)b * SEQ * PW;
    const bf16* qp = Pb + (size_t)(32 * qt + r) * PW + P_QA + 64 * hh + 8 * h;
    bf16x8 qf[4];
#pragma unroll
    for (int s = 0; s < 4; ++s) qf[s] = *(const bf16x8*)(qp + 16 * s);
    unsigned sel = (1u << j) - 1u;
    if (j > 3) {
        f32x16 g;
#pragma unroll
        for (int i = 0; i < 16; ++i) g[i] = 0.f;
        const float* kmr = kmsum + (size_t)((b * 8 + (r & 7)) * 4 + hh) * 64 + 8 * h;
#pragma unroll
        for (int s = 0; s < 4; ++s) {
            f32x4 a = (f32x4){0.f, 0.f, 0.f, 0.f}, c = a;
            if (r < j) { a = *(const f32x4*)(kmr + 16 * s); c = *(const f32x4*)(kmr + 16 * s + 4); }
            float v[8] = {a[0], a[1], a[2], a[3], c[0], c[1], c[2], c[3]}; unsigned hi[4], lo[4];
#pragma unroll
            for (int e = 0; e < 4; ++e) { hi[e] = cvtpk(v[2 * e], v[2 * e + 1]); lo[e] = cvtpk(v[2 * e] - bflo(hi[e]), v[2 * e + 1] - bfhi(hi[e])); }
            const bf16x8 khi = __builtin_bit_cast(bf16x8, ((u32x4){hi[0], hi[1], hi[2], hi[3]})), klo = __builtin_bit_cast(bf16x8, ((u32x4){lo[0], lo[1], lo[2], lo[3]}));
            g = MFMA32(khi, qf[s], g); g = MFMA32(klo, qf[s], g);
        }
        float gate[8];
#pragma unroll
        for (int i = 0; i < 4; ++i) { const float o = pair32_other(g[i], h); gate[i] = h ? o : g[i]; gate[4 + i] = h ? g[i] : o; }
        sel = 0u;
#pragma unroll
        for (int k = 0; k < 3; ++k) { float best = -INFINITY; int bi = 0;
#pragma unroll
            for (int n = 0; n < 8; ++n) { const bool c = (n < j) && !((sel >> n) & 1u) && (gate[n] > best); best = c ? gate[n] : best; bi = c ? n : bi; }
            sel |= 1u << bi; }
    }
    f32x16 o0, o1;
#pragma unroll
    for (int i = 0; i < 16; ++i) { o0[i] = 0.f; o1[i] = 0.f; }
    float m = -1e30f, l = 0.f;
    for (int kt = 0; kt <= qt; ++kt) {
        const int n = kt >> 3; unsigned vmask = 0xffffu;
        if (n < j) { const bool on = (sel >> n) & 1u; if (!__any(on)) continue; vmask = on ? 0xffffu : 0u; }
        else if (kt == qt) { vmask = 0u;
#pragma unroll
            for (int i = 0; i < 16; ++i) vmask |= (crow(i, h) <= r) ? (1u << i) : 0u; }
        const bf16* kp = Pb + (size_t)(32 * kt + r) * PW + P_KA + 64 * hh + 8 * h;
        const bf16* vp = Pb + (size_t)(32 * kt + (lane >> 3)) * PW + P_VA + 64 * hh + 8 * (lane & 7);
        attn_tile(o0, o1, m, l, qf, kp, vp, (size_t)8 * PW, vt, lane, vmask);
    }
    l = pair32_sum(l);
    attn_store(o0, o1, fast_rcp(l), OA + (size_t)(b * SEQ + 32 * qt + r) * 256 + 64 * hh, h);
}
__device__ __forceinline__ void dil_item(const bf16* P, bf16* DO, float* LS, int cfg, int b, int hh, int idx, LAS char* vt, int lane) {
    const int r = lane & 31, h = lane >> 5, sh = 2 * cfg, dil = 1 << sh, tsh = 6 - sh;
    const int res = idx >> tsh, qt = idx & ((1 << tsh) - 1);
    const bf16* Pb = P + ((size_t)b * SEQ + res) * PW;
    const size_t rs = (size_t)dil * PW;
    const bf16* qp = Pb + (size_t)(32 * qt + r) * rs + P_QB + 64 * hh + 8 * h;
    bf16x8 qf[4];
#pragma unroll
    for (int s = 0; s < 4; ++s) qf[s] = *(const bf16x8*)(qp + 16 * s);
    f32x16 o0, o1;
#pragma unroll
    for (int i = 0; i < 16; ++i) { o0[i] = 0.f; o1[i] = 0.f; }
    float m = -1e30f, l = 0.f;
    for (int kt = (qt > 4 ? qt - 4 : 0); kt <= qt; ++kt) {
        unsigned vmask = 0u;
#pragma unroll
        for (int i = 0; i < 16; ++i) { const int dl = 32 * (qt - kt) + r - crow(i, h); vmask |= (dl >= 0 && dl <= 128) ? (1u << i) : 0u; }
        const bf16* kp = Pb + (size_t)(32 * kt + r) * rs + P_KB + 64 * hh + 8 * h;
        const bf16* vp = Pb + (size_t)(32 * kt + (lane >> 3)) * rs + P_VB + 64 * hh + 8 * (lane & 7);
        attn_tile(o0, o1, m, l, qf, kp, vp, 8 * rs, vt, lane, vmask);
    }
    l = pair32_sum(l);
    const size_t row = (size_t)b * SEQ + (size_t)(32 * qt + r) * dil + res;
    attn_store(o0, o1, fast_rcp(l), DO + row * 256 + 64 * hh, h);
    if (h == 0) LS[row * 4 + hh] = m + __builtin_amdgcn_logf(l);
}

#include <hip/hip_bf16.h>
#include <cmath>
namespace attn_body {
using bf16=__hip_bfloat16;
using bf16x8=__attribute__((ext_vector_type(8)))short;
using s16x4=__attribute__((ext_vector_type(4)))short;
using f32x16=__attribute__((ext_vector_type(16)))float;
using f32x4=__attribute__((ext_vector_type(4)))float;
using u32x4=__attribute__((ext_vector_type(4)))unsigned;
constexpr int SEQ=2048,D=64,DM=2304,OP=256;
constexpr int NW=8,QBLK=32,QB=QBLK*NW,KVBLK=64,NQB=SEQ/QB;
__device__ __forceinline__ int crow(int r,int hi){return (r&3)+8*(r>>2)+4*hi;}
#define SBAR() __builtin_amdgcn_sched_barrier(0)
__device__ __forceinline__ void cmask(f32x16&p0,f32x16&p1,int jb,int qrel,int hi){
  const float NEG=-INFINITY; int kb=64*jb+4*hi;
  #pragma unroll
  for(int r=0;r<16;++r){int kv=kb+(r&3)+8*(r>>2); if(kv>qrel)p0[r]=NEG; if(kv+32>qrel)p1[r]=NEG;}
}

constexpr int NSLOT=3, SLOTB=8192;
constexpr int LDS_K=0, LDS_V=NSLOT*SLOTB, LDS_WS=2*NSLOT*SLOTB, LDS_OST=LDS_WS+NW*64*4, LDS_BYTES=LDS_OST+NW*4096;
constexpr float C2=0.125f*1.4426950408889634f;
__device__ __forceinline__ void glds16(const void*gsrc,unsigned lds_dst){unsigned keep;
  asm volatile("s_mov_b32 %0, m0\n\ts_mov_b32 m0, %2\n\ts_nop 0\n\tglobal_load_lds_dwordx4 %1, off\n\ts_mov_b32 m0, %0":"=&s"(keep):"v"(gsrc),"s"(lds_dst):"memory");}
__device__ __forceinline__ float max3f(float a,float b,float c){float r;asm("v_max3_f32 %0, %1, %2, %3":"=v"(r):"v"(a),"v"(b),"v"(c));return r;}
__device__ __forceinline__ float max2f(float a,float b){float r;asm("v_max_f32_e32 %0, %1, %2":"=v"(r):"v"(a),"v"(b));return r;}
__device__ __forceinline__ float fadd_s(float a,float b){float r;asm("v_add_f32_e32 %0, %1, %2":"=v"(r):"v"(a),"v"(b));return r;}
__device__ __forceinline__ float fsub_s(float a,float b){float r;asm("v_sub_f32_e32 %0, %1, %2":"=v"(r):"v"(a),"v"(b));return r;}
typedef float f32x2_t __attribute__((ext_vector_type(2))); typedef __bf16 bf16x2_t __attribute__((ext_vector_type(2)));
__device__ __forceinline__ unsigned cvtpk_s(float lo,float hi){f32x2_t v={lo,hi};bf16x2_t b=__builtin_convertvector(v,bf16x2_t);return __builtin_bit_cast(unsigned,b);}
#define WAIT_BAR(N) asm volatile("s_waitcnt vmcnt(" #N ") lgkmcnt(0)\n\ts_barrier":::"memory")

__device__ __forceinline__ void qkt(f32x16&p0,f32x16&p1,const char*Kslot,const bf16x8*qr,const f32x16&negm,int r32,int hi){
  const char*kb=Kslot+hi*1024+r32*16;
  #pragma unroll
  for(int d0=0;d0<4;++d0){
    const bf16x8 b0=*reinterpret_cast<const bf16x8*>(kb+d0*2048);
    const bf16x8 b1=*reinterpret_cast<const bf16x8*>(kb+d0*2048+512);
    if(d0==0){p0=__builtin_amdgcn_mfma_f32_32x32x16_bf16(b0,qr[0],negm,0,0,0);p1=__builtin_amdgcn_mfma_f32_32x32x16_bf16(b1,qr[0],negm,0,0,0);}
    else{p0=__builtin_amdgcn_mfma_f32_32x32x16_bf16(b0,qr[d0],p0,0,0,0);p1=__builtin_amdgcn_mfma_f32_32x32x16_bf16(b1,qr[d0],p1,0,0,0);}}
}
typedef __attribute__((address_space(3))) const char* lds_cptr;
typedef short v4i16_t __attribute__((ext_vector_type(4)));
__device__ __forceinline__ void kload8(bf16x8*kf,lds_cptr kp){
  kf[0]=*(const __attribute__((address_space(3))) bf16x8*)(kp);      kf[1]=*(const __attribute__((address_space(3))) bf16x8*)(kp+512);
  kf[2]=*(const __attribute__((address_space(3))) bf16x8*)(kp+2048); kf[3]=*(const __attribute__((address_space(3))) bf16x8*)(kp+2560);
  kf[4]=*(const __attribute__((address_space(3))) bf16x8*)(kp+4096); kf[5]=*(const __attribute__((address_space(3))) bf16x8*)(kp+4608);
  kf[6]=*(const __attribute__((address_space(3))) bf16x8*)(kp+6144); kf[7]=*(const __attribute__((address_space(3))) bf16x8*)(kp+6656);
}
__device__ __forceinline__ void kload2(bf16x8*kf,lds_cptr kp,int j){ kf[2*j]=*(const __attribute__((address_space(3))) bf16x8*)(kp+j*2048); kf[2*j+1]=*(const __attribute__((address_space(3))) bf16x8*)(kp+j*2048+512); }
__device__ __forceinline__ s16x4 vtr(lds_cptr p){ return __builtin_bit_cast(s16x4,__builtin_amdgcn_ds_read_tr16_b64_v4i16((__attribute__((address_space(3))) v4i16_t*)p)); }
__device__ __forceinline__ float rowmax(const f32x16&p0,const f32x16&p1){
  float a=max3f(p0[0],p0[1],p1[0]),b=max3f(p0[2],p0[3],p1[1]);a=max3f(a,p1[2],p1[3]);
  #pragma unroll
  for(int r=4;r<16;r+=4){a=max3f(a,p0[r],p0[r+1]);b=max3f(b,p0[r+2],p0[r+3]);a=max3f(a,p1[r],p1[r+1]);b=max3f(b,p1[r+2],p1[r+3]);}
  const float m=max2f(a,b);
  auto rr=__builtin_amdgcn_permlane32_swap(__float_as_uint(m),__float_as_uint(m),false,false);
  return max2f(__uint_as_float(rr[0]),__uint_as_float(rr[1]));
}
__device__ __forceinline__ void pv(f32x16*o,int vb,bf16x8 pa0,bf16x8 pa1,bf16x8 pa2,bf16x8 pa3){
  #pragma unroll
  for(int d0=0;d0<2;++d0){s16x4 lo[4],hi[4];
    #pragma unroll
    for(int ks=0;ks<4;++ks){
      asm volatile("ds_read_b64_tr_b16 %0,%1 offset:%c2":"=&v"(lo[ks]):"v"(vb),"i"(d0*4096+ks*1024):"memory");
      asm volatile("ds_read_b64_tr_b16 %0,%1 offset:%c2":"=&v"(hi[ks]):"v"(vb),"i"(d0*4096+ks*1024+512):"memory");}
    asm volatile("s_waitcnt lgkmcnt(0)":::"memory");SBAR();
    #define PK(k) (bf16x8){lo[k][0],lo[k][1],lo[k][2],lo[k][3],hi[k][0],hi[k][1],hi[k][2],hi[k][3]}
    o[d0]=__builtin_amdgcn_mfma_f32_32x32x16_bf16(pa0,PK(0),o[d0],0,0,0);
    o[d0]=__builtin_amdgcn_mfma_f32_32x32x16_bf16(pa1,PK(1),o[d0],0,0,0);
    o[d0]=__builtin_amdgcn_mfma_f32_32x32x16_bf16(pa2,PK(2),o[d0],0,0,0);
    o[d0]=__builtin_amdgcn_mfma_f32_32x32x16_bf16(pa3,PK(3),o[d0],0,0,0);
    #undef PK
  }
}

#ifndef ATTN_STORE16
#define ATTN_STORE16(p,v) (*(u32x4*)(p)=(v))
#endif
template<int THRL> __device__ __forceinline__ void attn_unit(int tid,int b,int h,int qb,const bf16*Q,const bf16*__restrict__ K,const bf16*__restrict__ V,bf16*O,const float*__restrict__ kms,char*shm){
  asm volatile("":"+v"(tid));
  const int lane=tid&63,r32=lane&31,hi=lane>>5; const int wid=__builtin_amdgcn_readfirstlane(tid>>6);
  const long rowbase=(long)b*SEQ; const int q0=qb*QB;
  const bf16*Qw=Q+(rowbase+q0+wid*QBLK)*DM+h*D;
  const bf16*Kh=K+rowbase*DM+h*D,*Vh=V+rowbase*DM+h*D;
  const unsigned lds0=(unsigned)(uintptr_t)shm;
  float*wsf=(float*)(shm+LDS_WS)+wid*64;
  const bf16*ksrc=Kh+(long)lane*DM+wid*8;
  const bf16*vsrc=Vh+(long)(16*(wid&3)+(lane>>2))*DM+(wid>>2)*32+(lane&3)*8;
  const unsigned kdst=lds0+LDS_K+wid*1024, vdst=lds0+LDS_V+wid*1024;
  #define DMA_K(t,slot) glds16(ksrc+(long)(t)*KVBLK*DM,(unsigned)__builtin_amdgcn_readfirstlane(kdst+(slot)))
  #define DMA_V(t,slot) glds16(vsrc+(long)(t)*KVBLK*DM,(unsigned)__builtin_amdgcn_readfirstlane(vdst+(slot)))
  const int vb0=(int)(lds0+LDS_V)+((lane>>4)&1)*32+(lane&3)*8+(4*hi+((lane&15)>>2))*64;
  const char*Kbase=shm+LDS_K; bf16x8 kf[8];
  const lds_cptr shm3=(lds_cptr)shm; const lds_cptr kp0=shm3+LDS_K+hi*1024+r32*16; const lds_cptr vp0=shm3+LDS_V+((lane>>4)&1)*32+(lane&3)*8+(4*hi+((lane&15)>>2))*64;
  const int NT=(q0+QB)/KVBLK;
  DMA_K(0,0);DMA_V(0,0);DMA_K(1,SLOTB);
  bf16x8 qr[4];
  #pragma unroll
  for(int d0=0;d0<4;++d0)qr[d0]=*reinterpret_cast<const bf16x8*>(&Qw[(long)r32*DM+d0*16+hi*8]);
  unsigned sel=(1u<<qb)-1u;
  if(qb>3){
    f32x16 g=f32x16{};
    const float*kmr=kms+(long)((b*8+(r32&7))*4+h)*64+8*hi;
    #pragma unroll
    for(int s=0;s<4;++s){
      f32x4 a=f32x4{0.f,0.f,0.f,0.f},c=a;
      if(r32<qb){a=*reinterpret_cast<const f32x4*>(kmr+16*s);c=*reinterpret_cast<const f32x4*>(kmr+16*s+4);}
      const float v[8]={a[0],a[1],a[2],a[3],c[0],c[1],c[2],c[3]}; unsigned hw[4],lw[4];
      #pragma unroll
      for(int e=0;e<4;++e){hw[e]=cvtpk_s(v[2*e],v[2*e+1]);lw[e]=cvtpk_s(v[2*e]-__uint_as_float(hw[e]<<16),v[2*e+1]-__uint_as_float(hw[e]&0xffff0000u));}
      const bf16x8 khi=__builtin_bit_cast(bf16x8,(u32x4){hw[0],hw[1],hw[2],hw[3]}),klo=__builtin_bit_cast(bf16x8,(u32x4){lw[0],lw[1],lw[2],lw[3]});
      g=__builtin_amdgcn_mfma_f32_32x32x16_bf16(khi,qr[s],g,0,0,0);g=__builtin_amdgcn_mfma_f32_32x32x16_bf16(klo,qr[s],g,0,0,0);
    }
    float gate[8];
    #pragma unroll
    for(int i=0;i<4;++i){auto rr=__builtin_amdgcn_permlane32_swap(__float_as_uint(g[i]),__float_as_uint(g[i]),false,false);const float oth=__uint_as_float(hi?rr[0]:rr[1]);gate[i]=hi?oth:g[i];gate[4+i]=hi?g[i]:oth;}
    sel=0u;
    #pragma unroll
    for(int k=0;k<3;++k){float best=-INFINITY;int bi=0;
      #pragma unroll
      for(int n=0;n<8;++n){const bool c=(n<qb)&&!((sel>>n)&1u)&&(gate[n]>best);best=c?gate[n]:best;bi=c?n:bi;}
      sel|=1u<<bi;}
  }
  float mhat=0.f,l_reg=0.f;f32x16 o[2];o[0]=f32x16{};o[1]=f32x16{};f32x16 negm=f32x16{};asm volatile("":"+v"(negm));
  const int qrel=wid*QBLK+r32;
  #define CMASK(P0,P1,t) do{int jb_=(t)-(NT-4); if(jb_>=0)cmask(P0,P1,jb_,qrel,hi);}while(0)
  bool resc=false;
  #define START(P0,P1) do{ const float rm=rowmax(P0,P1); resc=false; \
    { const float dl=fmaxf(rm,-128.f); mhat=fadd_s(mhat,dl); \
      _Pragma("unroll") for(int r=0;r<16;++r){P0[r]=fsub_s(P0[r],dl);P1[r]=fsub_s(P1[r],dl);} \
      _Pragma("unroll") for(int r=0;r<16;++r)negm[r]=-mhat; asm volatile("":"+v"(negm)); } \
    _Pragma("unroll") for(int r=0;r<16;++r)P0[r]=__builtin_amdgcn_exp2f(P0[r]); }while(0)
  #define RESC() do{ if(resc){ asm volatile("s_waitcnt lgkmcnt(0)":::"memory"); \
      _Pragma("unroll") for(int d_=0;d_<2;++d_) _Pragma("unroll") for(int r=0;r<16;++r)o[d_][r]*=wsf[crow(r,hi)]; } }while(0)
  f32x16 pA0,pA1,pB0,pB1;
  int sl_prev=0,sl_cur=0,sl_next=SLOTB;
  #define ROT() do{sl_prev=sl_cur;sl_cur=sl_next;sl_next=(sl_next==(NSLOT-1)*SLOTB)?0:sl_next+SLOTB;}while(0)
  DMA_K(2,2*SLOTB);
  WAIT_BAR(3);
  { const float nm_=((sel&1u)||NT==4)?0.f:-INFINITY; _Pragma("unroll") for(int r_=0;r_<16;++r_)negm[r_]=nm_; asm volatile("":"+v"(negm)); }
  qkt(pA0,pA1,Kbase,qr,negm,r32,hi);asm volatile("s_nop 15\n\ts_nop 7":"+v"(pA0),"+v"(pA1));CMASK(pA0,pA1,0);
  START(pA0,pA1);
  _Pragma("unroll") for(int r=0;r<16;++r)pA1[r]=__builtin_amdgcn_exp2f(pA1[r]);
  WAIT_BAR(0);
  DMA_K(3,0);DMA_V(1,SLOTB);
  ROT();
  kload8(kf,kp0+sl_cur);
  WAIT_BAR(2);
  s16x4 vlo[8],vhi[8]; u32x4 pw0,pw1,pw2,pw3;
  #define PKW(P,B) cvtpk_s(P[B],P[B+1])
  #define PAF(k) __builtin_bit_cast(bf16x8,pw##k)
  #define VFR(i) (bf16x8){vlo[i][0],vlo[i][1],vlo[i][2],vlo[i][3],vhi[i][0],vhi[i][1],vhi[i][2],vhi[i][3]}
  #define PIN(x) asm volatile("":"+v"(x))
  #define MX3(a,b,c) __builtin_fmaxf(__builtin_fmaxf((a),(b)),(c))
  #define GAPA(MF,A0,A1,A2,A3,W0,W1,PW) do{ MF; sacc+=A0; sacc+=A1; sacc+=A2; sacc+=A3; PIN(sacc); W0; W1; PIN(PW); SBAR(); }while(0)
  #define EX(v) __builtin_amdgcn_exp2f(v)
  #define GAPB(MF,X,B) do{ MF; X[B]=EX(X[B]); X[B+1]=EX(X[B+1]); X[B+2]=EX(X[B+2]); X[B+3]=EX(X[B+3]); PIN(X); SBAR(); }while(0)
  #define VRD(i) do{ vlo[i]=vtr(vp_+(((i)>>2)*4096+((i)&3)*1024)); vhi[i]=vtr(vp_+(((i)>>2)*4096+((i)&3)*1024+512)); }while(0)
  #define KRD(G,j) do{ if(G){ kload2(kf,kp0+sl_next,j); SBAR(); } }while(0)
  #define STEP(C0,C1,P0,P1,t,GK,GV,GL) do{ SBAR(); \
    { const float nm_=(((sel>>((t)>>2))&1u)||((t)>=NT-4))?-mhat:-INFINITY; _Pragma("unroll") for(int r_=0;r_<16;++r_)negm[r_]=nm_; asm volatile("":"+v"(negm)); } \
    const lds_cptr vp_=vp0+sl_prev; \
    VRD(0); SBAR(); float sacc=(P0[0]+P0[1]); \
    GAPA(C0=__builtin_amdgcn_mfma_f32_32x32x16_bf16(kf[0],qr[0],negm,0,0,0), P0[2],P0[3],P0[4],P0[5],     pw0[0]=PKW(P0,0), pw0[1]=PKW(P0,2), pw0); \
    VRD(4); SBAR(); GAPA(C1=__builtin_amdgcn_mfma_f32_32x32x16_bf16(kf[1],qr[0],negm,0,0,0), P0[6],P0[7],P0[8],P0[9],     pw0[2]=PKW(P0,4), pw0[3]=PKW(P0,6), pw0); \
    VRD(1); SBAR(); GAPA(C0=__builtin_amdgcn_mfma_f32_32x32x16_bf16(kf[2],qr[1],C0,0,0,0),   P0[10],P0[11],P0[12],P0[13], pw1[0]=PKW(P0,8), pw1[1]=PKW(P0,10), pw1); \
    VRD(5); SBAR(); GAPA(C1=__builtin_amdgcn_mfma_f32_32x32x16_bf16(kf[3],qr[1],C1,0,0,0),   P0[14],P0[15],P1[0],P1[1],   pw1[2]=PKW(P0,12),pw1[3]=PKW(P0,14), pw1); \
    VRD(2); SBAR(); GAPA(C0=__builtin_amdgcn_mfma_f32_32x32x16_bf16(kf[4],qr[2],C0,0,0,0),   P1[2],P1[3],P1[4],P1[5],     pw2[0]=PKW(P1,0), pw2[1]=PKW(P1,2), pw2); \
    VRD(6); SBAR(); GAPA(C1=__builtin_amdgcn_mfma_f32_32x32x16_bf16(kf[5],qr[2],C1,0,0,0),   P1[6],P1[7],P1[8],P1[9],     pw2[2]=PKW(P1,4), pw2[3]=PKW(P1,6), pw2); \
    VRD(3); SBAR(); GAPA(C0=__builtin_amdgcn_mfma_f32_32x32x16_bf16(kf[6],qr[3],C0,0,0,0),   P1[10],P1[11],P1[12],P1[13], pw3[0]=PKW(P1,8), pw3[1]=PKW(P1,10), pw3); \
    VRD(7); SBAR(); GAPA(C1=__builtin_amdgcn_mfma_f32_32x32x16_bf16(kf[7],qr[3],C1,0,0,0),   P1[14],P1[15],0.f,0.f,       pw3[2]=PKW(P1,12),pw3[3]=PKW(P1,14), pw3); \
    l_reg+=sacc; \
    if(GK){DMA_K((t)+3,sl_cur);} if(GV){DMA_V((t)+1,sl_next);} \
    CMASK(C0,C1,t); \
    { float a=MX3(C0[0],C0[1],C1[0]),b=MX3(C0[2],C0[3],C1[1]); a=MX3(a,C1[2],C1[3]); \
      _Pragma("unroll") for(int r=4;r<16;r+=4){a=MX3(a,C0[r],C0[r+1]);b=MX3(b,C0[r+2],C0[r+3]);a=MX3(a,C1[r],C1[r+1]);b=MX3(b,C1[r+2],C1[r+3]);} \
      float rm=__builtin_fmaxf(a,b); { auto rr=__builtin_amdgcn_permlane32_swap(__float_as_uint(rm),__float_as_uint(rm),false,false); rm=__builtin_fmaxf(__uint_as_float(rr[0]),__uint_as_float(rr[1])); } \
      resc=false; \
      if(__builtin_expect(__any(rm>(float)THRL),0)){ const float dl=__builtin_fmaxf(rm,0.f); mhat+=dl; \
        _Pragma("unroll") for(int r=0;r<16;++r){C0[r]-=dl;C1[r]-=dl;} \
        _Pragma("unroll") for(int r=0;r<16;++r)negm[r]=-mhat; asm volatile("":"+v"(negm)); \
        const float f=__builtin_amdgcn_exp2f(-dl); l_reg*=f; if(hi==0)wsf[r32]=f; resc=true; } } \
    SBAR(); \
    GAPB(o[0]=__builtin_amdgcn_mfma_f32_32x32x16_bf16(PAF(0),VFR(0),o[0],0,0,0), C0,0); \
    GAPB(o[1]=__builtin_amdgcn_mfma_f32_32x32x16_bf16(PAF(0),VFR(4),o[1],0,0,0), C0,4); \
    KRD(GL,0); GAPB(o[0]=__builtin_amdgcn_mfma_f32_32x32x16_bf16(PAF(1),VFR(1),o[0],0,0,0), C0,8); \
    KRD(GL,1); GAPB(o[1]=__builtin_amdgcn_mfma_f32_32x32x16_bf16(PAF(1),VFR(5),o[1],0,0,0), C0,12); \
    KRD(GL,2); GAPB(o[0]=__builtin_amdgcn_mfma_f32_32x32x16_bf16(PAF(2),VFR(2),o[0],0,0,0), C1,0); \
    KRD(GL,3); GAPB(o[1]=__builtin_amdgcn_mfma_f32_32x32x16_bf16(PAF(2),VFR(6),o[1],0,0,0), C1,4); \
    GAPB(o[0]=__builtin_amdgcn_mfma_f32_32x32x16_bf16(PAF(3),VFR(3),o[0],0,0,0), C1,8); \
    GAPB(o[1]=__builtin_amdgcn_mfma_f32_32x32x16_bf16(PAF(3),VFR(7),o[1],0,0,0), C1,12); \
    }while(0)
  int t=1;
  #undef CMASK
  #define CMASK(P0,P1,t) do{}while(0)
  for(;t+5<NT;t+=2){
    STEP(pB0,pB1,pA0,pA1,t,true,true,true);     WAIT_BAR(2); RESC(); ROT();
    STEP(pA0,pA1,pB0,pB1,t+1,true,true,true);   WAIT_BAR(2); RESC(); ROT();
  }
  #undef CMASK
  #define CMASK(P0,P1,t) do{int jb_=(t)-(NT-4); if(jb_>=0)cmask(P0,P1,jb_,qrel,hi);}while(0)
  #define ENDW(tt) do{ if((tt)+3<NT){WAIT_BAR(2);} else if((tt)+2<NT){WAIT_BAR(1);} else {WAIT_BAR(0);} }while(0)
  for(;t+1<NT;t+=2){
    STEP(pB0,pB1,pA0,pA1,t,(t+3<NT),(t+1<NT),(t+1<NT));       ENDW(t);   RESC(); ROT();
    STEP(pA0,pA1,pB0,pB1,t+1,(t+4<NT),(t+2<NT),(t+2<NT));     ENDW(t+1); RESC(); ROT();
  }
  STEP(pB0,pB1,pA0,pA1,NT-1,false,false,false); RESC();
  { float sacc=pB0[0]+pB0[1]; _Pragma("unroll") for(int r=2;r<16;++r)sacc+=pB0[r]; _Pragma("unroll") for(int r=0;r<16;++r)sacc+=pB1[r]; l_reg+=sacc;
    pw0=(u32x4){PKW(pB0,0),PKW(pB0,2),PKW(pB0,4),PKW(pB0,6)};pw1=(u32x4){PKW(pB0,8),PKW(pB0,10),PKW(pB0,12),PKW(pB0,14)};pw2=(u32x4){PKW(pB1,0),PKW(pB1,2),PKW(pB1,4),PKW(pB1,6)};pw3=(u32x4){PKW(pB1,8),PKW(pB1,10),PKW(pB1,12),PKW(pB1,14)};
    SBAR(); pv(o,vb0+sl_cur,PAF(0),PAF(1),PAF(2),PAF(3)); }
  #undef PKW
  #undef PAF
  #undef VFR
  #undef PIN
  #undef MX3
  #undef GAPA
  #undef GAPB
  #undef EX
  #undef VRD
  #undef KRD
  #undef STEP
  #undef ENDW
  {auto rr=__builtin_amdgcn_permlane32_swap(__float_as_uint(l_reg),__float_as_uint(l_reg),false,false);l_reg=__uint_as_float(rr[0])+__uint_as_float(rr[1]);}
  if(hi==0)wsf[32+r32]=l_reg;asm volatile("s_waitcnt lgkmcnt(0)":::"memory");
  float rli[16];
  #pragma unroll
  for(int r=0;r<16;++r)rli[r]=__builtin_amdgcn_rcpf(wsf[32+crow(r,hi)]);
  bf16*Ow=O+(rowbase+q0+wid*QBLK)*OP+h*D;
  { bf16*stg=(bf16*)(shm+LDS_OST)+wid*2048;
    #pragma unroll
    for(int r=0;r<16;++r){const int orow=crow(r,hi);
      #pragma unroll
      for(int d0=0;d0<2;++d0)stg[orow*64+d0*32+r32]=__float2bfloat16(o[d0][r]*rli[r]);}
    asm volatile("s_waitcnt lgkmcnt(0)":::"memory");
    #pragma unroll
    for(int i=0;i<4;++i){const int row=i*8+(lane>>3),ch=lane&7; const u32x4 v=*(const u32x4*)(stg+row*64+ch*8); ATTN_STORE16(Ow+(long)row*OP+ch*8,v);} }
  asm volatile("s_waitcnt lgkmcnt(0)\n\ts_barrier":::"memory");
  #undef DMA_K
  #undef DMA_V
  #undef CMASK
  #undef START
  #undef RESC
  #undef ROT
}
constexpr int ATTN_LDS_BYTES=LDS_BYTES;
#undef SBAR
#undef WAIT_BAR
}

constexpr size_t MiB = 1u << 20;
constexpr size_t WS_CTL = 0, CTL_ZERO_BYTES = 1 * MiB;
constexpr size_t WS_MOD = 1 * MiB;
constexpr size_t WS_RTE = 2 * MiB, WS_RTP = WS_RTE + 256 * 1024, WS_RTG = WS_RTP + 256 * 1024, WS_S2T = WS_RTG + 256 * 1024;
constexpr size_t WS_WIN = 4 * MiB, WS_WOUT = 14 * MiB, WS_WFGU = 18 * MiB, WS_WFD = 29 * MiB, WS_WMGU = 35 * MiB, WS_WMD = 147 * MiB;
constexpr size_t WS_HB = 203 * MiB;
constexpr size_t WS_R = 267 * MiB;
constexpr size_t WS_P = WS_R, WS_DIL = WS_R + 144 * MiB, WS_LSE = WS_R + 192 * MiB, WS_OA = WS_R + 194 * MiB, WS_OC = WS_R + 210 * MiB, WS_OD = WS_R + 226 * MiB;
constexpr size_t WS_Y = WS_R;
constexpr size_t WS_FH = WS_R;
constexpr size_t WS_HID = WS_R, WS_YS = WS_R + 112 * MiB;
constexpr size_t WS_END = WS_R + 244 * MiB;
constexpr int CW_BAR = 4096;
constexpr int CW_CNT = 8192;
constexpr int CW_KM = 16384;
static_assert((CW_KM + 2 * 32768 * 1) * 4 <= (int)CTL_ZERO_BYTES + 0 || true, "");
static_assert((size_t)(CW_KM + 2 * 32768) * 4 <= CTL_ZERO_BYTES, "CTL region");

constexpr int RING_BYTES = 131072, LDSX_OFF = RING_BYTES, LDS_BYTES = 147456;

#define XB_TMO      128
#define XB_XCNT(j)  (256  + 64 * (j))
#define XB_XSUB(j)  (1280 + 64 * (j))
#define XB_XGEN(j)  (2304 + 64 * (j))
#define XB_TOP      3328
#define XB_TOPGEN   3392
#define XCD_BAR_WORDS 3456
#define XB_SPIN_CAP (1u << 18)
__device__ __forceinline__ unsigned xb_ld(unsigned* p)              { return __hip_atomic_load(p, __ATOMIC_RELAXED, __HIP_MEMORY_SCOPE_AGENT); }
__device__ __forceinline__ unsigned xb_add(unsigned* p, unsigned v) { return __hip_atomic_fetch_add(p, v, __ATOMIC_RELAXED, __HIP_MEMORY_SCOPE_AGENT); }
__device__ __forceinline__ unsigned xb_xcc_id() { return (unsigned)__builtin_amdgcn_s_getreg((3 << 11) | 20) & 0xFu; }
#define XB_SPIN(cond, bar) do { unsigned _sp = 0; while (cond) { __builtin_amdgcn_s_sleep(1); \
    if ((++_sp & 255u) == 0u) { if (xb_ld(&(bar)[XB_TMO])) break; if (_sp > XB_SPIN_CAP) { atomicAdd(&(bar)[XB_TMO], 1u); break; } } } } while (0)
struct XcdBarrier { unsigned* bar; unsigned x; volatile LAS unsigned* st; };
__device__ __forceinline__ XcdBarrier xcd_barrier_post(unsigned* bar, volatile LAS unsigned* st, int tid) {
    XcdBarrier b; b.bar = bar; b.x = xb_xcc_id(); b.st = st;
    if (tid == 0) (void)xb_add(&bar[XB_XCNT(b.x)], 1u);
    return b;
}
__device__ __forceinline__ void xcd_barrier_complete(unsigned* bar, unsigned x, unsigned& nloc, unsigned& nx) {
    const unsigned G = gridDim.x * gridDim.y * gridDim.z;
    unsigned sum, cnt, mine, sp = 0u;
    for (;;) {
        sum = 0u; cnt = 0u; mine = 0u;
#pragma unroll
        for (unsigned j = 0; j < 16; ++j) { const unsigned c = xb_ld(&bar[XB_XCNT(j)]); sum += c; cnt += (c > 0u) ? 1u : 0u; mine = (j == x) ? c : mine; }
        if (sum == G) break;
        __builtin_amdgcn_s_sleep(1);
        if ((++sp & 255u) == 0u) { if (xb_ld(&bar[XB_TMO])) break; if (sp > XB_SPIN_CAP) { atomicAdd(&bar[XB_TMO], 1u); break; } }
    }
    nloc = mine > 0u ? mine : 1u; nx = cnt > 0u ? cnt : 1u;
}
__device__ __forceinline__ void xcd_barrier(const XcdBarrier& b, int tid) {
    asm volatile("s_waitcnt vmcnt(0)" ::: "memory");
    __syncthreads();
    if (tid == 0) {
        unsigned* bar = b.bar;
        __builtin_amdgcn_s_waitcnt(0);
        unsigned nloc = b.st[0], nx = b.st[1];
        if (nloc == 0u) { xcd_barrier_complete(bar, b.x, nloc, nx); b.st[0] = nloc; b.st[1] = nx; }
        const unsigned old = xb_add(&bar[XB_XSUB(b.x)], 1u);
        const unsigned gen = old / nloc;
        if (old + 1u == (gen + 1u) * nloc) {
            __builtin_amdgcn_fence(__ATOMIC_RELEASE, "agent");
            asm volatile("s_waitcnt vmcnt(0)" ::: "memory");
            const unsigned og = xb_add(&bar[XB_TOP], 1u);
            const unsigned tg = og / nx;
            if (og + 1u == (tg + 1u) * nx) xb_add(&bar[XB_TOPGEN], 1u);
            else XB_SPIN(xb_ld(&bar[XB_TOPGEN]) == tg, bar);
            __builtin_amdgcn_fence(__ATOMIC_ACQUIRE, "agent");
            xb_add(&bar[XB_XGEN(b.x)], 1u);
            asm volatile("s_waitcnt vmcnt(0)" ::: "memory");
        } else {
            XB_SPIN(xb_ld(&bar[XB_XGEN(b.x)]) == gen, bar);
            __builtin_amdgcn_fence(__ATOMIC_ACQUIRE, "agent");
            asm volatile("s_waitcnt vmcnt(0)" ::: "memory");
        }
    }
    __syncthreads();
}

struct Args { const void* in[26]; float* out; unsigned char* ws; int ph_lo, ph_hi; };
struct Frame {
    LAS unsigned char* lds;
    unsigned char* ws0; unsigned char* ws; unsigned* ctl; float* out;
    int tid, lane, wave, wave0, vcu;
};
typedef const __attribute__((address_space(4))) Args* ArgsP;
__device__ __forceinline__ ArgsP args_ptr() { auto p = __builtin_amdgcn_kernarg_segment_ptr(); asm volatile("" : "+s"(p)); return (ArgsP)p; }
__device__ __forceinline__ int otid(int wave0) { int t = wave0 * 64 + lane_id(); asm volatile("" : "+v"(t)); return t; }
#define REFRESH(F) do { (F).tid = otid((F).wave0); (F).lane = (F).tid & 63; (F).wave = __builtin_amdgcn_readfirstlane((F).tid >> 6); { long z_ = 0; asm volatile("" : "+s"(z_)); (F).ws = (F).ws0 + z_; } (F).ctl = (unsigned*)(F).ws; } while (0)
#define INP(A, k) ((const float*)(A)->in[k])
enum { I_X = 0, I_C, I_POS, I_ADAW, I_ADAB, I_MIXPRE, I_MIXPOST, I_FFNPRE, I_FFNPOST, I_WIN, I_WOUT, I_GROUPG, I_GMLPW, I_GMLPB, I_CONVW, I_CONVB, I_CONVLNG, I_CONVLNB,
       I_FFNWG, I_FFNWU, I_FFNWD, I_ROUTW, I_ROUTB, I_MOEWG, I_MOEWU, I_MOEWD };
#define LDS_WAIT() asm volatile("s_waitcnt lgkmcnt(0)" ::: "memory")

__device__ __forceinline__ void ld_f32_row(float (&v)[16], const float* p, int lane) {
#pragma unroll
    for (int j = 0; j < 4; ++j) { const f32x4 t = ((const f32x4*)p)[lane + 64 * j]; v[4 * j] = t[0]; v[4 * j + 1] = t[1]; v[4 * j + 2] = t[2]; v[4 * j + 3] = t[3]; }
}
__device__ __forceinline__ void ld_bf16_row(float (&v)[16], const bf16* p, int lane) {
#pragma unroll
    for (int j = 0; j < 4; ++j) { const u32x2 t = ((const u32x2*)p)[lane + 64 * j]; v[4 * j] = bflo(t.x); v[4 * j + 1] = bfhi(t.x); v[4 * j + 2] = bflo(t.y); v[4 * j + 3] = bfhi(t.y); }
}
__device__ __forceinline__ void st_f32_row(const float (&v)[16], float* p, int lane) {
#pragma unroll
    for (int j = 0; j < 4; ++j) ((f32x4*)p)[lane + 64 * j] = (f32x4){v[4 * j], v[4 * j + 1], v[4 * j + 2], v[4 * j + 3]};
}
__device__ __forceinline__ void st_bf16_row(const float (&v)[16], bf16* p, int lane) {
#pragma unroll
    for (int j = 0; j < 4; ++j) { u32x2 t; t.x = cvtpk(v[4 * j], v[4 * j + 1]); t.y = cvtpk(v[4 * j + 2], v[4 * j + 3]); ((u32x2*)p)[lane + 64 * j] = t; }
}
__device__ __forceinline__ float row_rstd(const float (&v)[16]) {
    float s = 0.f;
#pragma unroll
    for (int i = 0; i < 16; ++i) s += v[i] * v[i];
    return __builtin_amdgcn_rsqf(wave_sum(s) * (1.0f / D) + EPS);
}
__device__ __forceinline__ const float* mod_ptr(const Frame& F, int layer, int b, int part) { return (const float*)(F.ws + WS_MOD) + ((size_t)(layer * 16 + b) * 6 + part) * 1024; }

__device__ __forceinline__ int dst_row(int type, int n) {
    if (type == 0) return n;
    if (type == 1) return 256 * (n >> 7) + (n & 127);
    if (type == 2) return 256 * (n >> 7) + 128 + (n & 127);
    const int sl = n >> 8, cc = n & 255;
    if (sl == 0 || sl == 1 || sl == 3 || sl == 4) { const int hh = cc >> 6, d = cc & 63; return 256 * sl + 64 * hh + 32 * ((d >> 4) & 1) + 8 * ((d >> 2) & 3) + 4 * (d >> 5) + (d & 3); }
    if (sl < 8) return n;
    return 256 * (8 + ((cc >> 7) & 1)) + (sl == 9 ? 128 : 0) + (cc & 127);
}
__device__ __forceinline__ void transpose_item(const float* W, int K, int N, bf16* WT, int type, LAS float* scr, int item, int lane) {
    const int nblk = N / 32, kb = item / nblk, nb = item % nblk, k0 = 64 * kb, n0 = 32 * nb;
#pragma unroll 8
    for (int i = 0; i < 32; ++i) { const int kk = 2 * i + (lane >> 5); scr[kk * 33 + (lane & 31)] = W[(size_t)(k0 + kk) * N + n0 + (lane & 31)]; }
    LDS_WAIT(); asm volatile("" ::: "memory");
    const int c = lane & 7;
#pragma unroll
    for (int j = 0; j < 4; ++j) { const int n = (lane >> 3) + 8 * j; const LAS float* s = scr + (8 * c) * 33 + n;
        u32x4 o; o.x = cvtpk(s[0 * 33], s[1 * 33]); o.y = cvtpk(s[2 * 33], s[3 * 33]); o.z = cvtpk(s[4 * 33], s[5 * 33]); o.w = cvtpk(s[6 * 33], s[7 * 33]);
        *(u32x4*)(WT + (size_t)dst_row(type, n0 + n) * K + k0 + 8 * c) = o; }
    LDS_WAIT(); asm volatile("" ::: "memory");
}
__device__ __forceinline__ void transpose_item8(const float* W, int K, int N, unsigned char* WT, int type, float wsc, LAS float* scr, int item, int lane) {
    const int nblk = N / 32, kb = item / nblk, nb = item % nblk, k0 = 64 * kb, n0 = 32 * nb;
#pragma unroll 8
    for (int i = 0; i < 32; ++i) { const int kk = 2 * i + (lane >> 5); scr[kk * 33 + (lane & 31)] = W[(size_t)(k0 + kk) * N + n0 + (lane & 31)] * wsc; }
    LDS_WAIT(); asm volatile("" ::: "memory");
    const int c = lane & 7;
#pragma unroll
    for (int j = 0; j < 4; ++j) { const int n = (lane >> 3) + 8 * j; const LAS float* s = scr + (8 * c) * 33 + n;
        u32x2 o; o.x = pk4_fp8(s[0 * 33], s[1 * 33], s[2 * 33], s[3 * 33]); o.y = pk4_fp8(s[4 * 33], s[5 * 33], s[6 * 33], s[7 * 33]);
        *(u32x2*)(WT + (size_t)dst_row(type, n0 + n) * K + k0 + 8 * c) = o; }
    LDS_WAIT(); asm volatile("" ::: "memory");
}
__device__ __forceinline__ void ada_item(Frame& F, ArgsP A, int a, LAS float* scr) {
    const int layer = a / 96, n = 64 * (a % 96) + F.lane; const float* cin = INP(A, I_C); const float* ada_w = INP(A, I_ADAW);
    float acc[16];
#pragma unroll
    for (int b = 0; b < 16; ++b) acc[b] = 0.f;
    for (int kc = 0; kc < 4; ++kc) {
        for (int i = 0; i < 64; ++i) { const int idx = F.lane + 64 * i, b = idx >> 8, kk = idx & 255; scr[idx] = siluf_(cin[b * 1024 + kc * 256 + kk]); }
        LDS_WAIT(); asm volatile("" ::: "memory");
        const float* wp = ada_w + ((size_t)layer * 1024 + kc * 256) * 6144 + n;
#pragma unroll 4
        for (int kk = 0; kk < 256; ++kk) { const float w = wp[(size_t)kk * 6144];
#pragma unroll
            for (int b = 0; b < 16; ++b) acc[b] += scr[b * 256 + kk] * w; }
        LDS_WAIT(); asm volatile("" ::: "memory");
    }
    float* mod = (float*)(F.ws + WS_MOD);
    const float bias = INP(A, I_ADAB)[layer * 6144 + n];
#pragma unroll
    for (int b = 0; b < 16; ++b) mod[(size_t)(layer * 16 + b) * 6144 + n] = acc[b] + bias;
}
__device__ __forceinline__ void phase_prologue(Frame& F) {
    REFRESH(F);
    LAS float* scr = (LAS float*)(F.lds + F.wave * 16384);
    const int gw = F.vcu * 8 + F.wave, NGW = NWG * 8; ArgsP A = args_ptr();
    for (int a = gw; a < 192; a += NGW) ada_item(F, A, a, scr);
    constexpr int I_IN = 16 * 80, I_OUT = 16 * 32, I_FG = 16 * 88, I_FD = 44 * 32, I_MG = 16 * 112, I_MD = 56 * 32;
    constexpr int NITEMS = 2 * I_IN + 2 * I_OUT + 2 * I_FG + I_FD + 16 * I_MG + 8 * I_MD;
    bf16* WIN = (bf16*)(F.ws + WS_WIN); bf16* WOUT = (bf16*)(F.ws + WS_WOUT); bf16* WFGU = (bf16*)(F.ws + WS_WFGU); bf16* WFD = (bf16*)(F.ws + WS_WFD);
    unsigned char* WMGU8 = F.ws + WS_WMGU; unsigned char* WMD8 = F.ws + WS_WMD;
    for (int it = NITEMS - 1 - gw; it >= 0; it -= NGW) {
        int r = it;
        if (r < 2 * I_IN) { const int L = r / I_IN; transpose_item(INP(A, I_WIN) + (size_t)L * 1024 * NIN, 1024, NIN, WIN + (size_t)L * NIN * 1024, 3, scr, r % I_IN, F.lane); continue; } r -= 2 * I_IN;
        if (r < 2 * I_OUT) { const int L = r / I_OUT; transpose_item(INP(A, I_WOUT) + (size_t)L * 1024 * 1024, 1024, 1024, WOUT + (size_t)L * 1024 * 1024, 0, scr, r % I_OUT, F.lane); continue; } r -= 2 * I_OUT;
        if (r < I_FG) { transpose_item(INP(A, I_FFNWG), 1024, FFD, WFGU, 1, scr, r, F.lane); continue; } r -= I_FG;
        if (r < I_FG) { transpose_item(INP(A, I_FFNWU), 1024, FFD, WFGU, 2, scr, r, F.lane); continue; } r -= I_FG;
        if (r < I_FD) { transpose_item(INP(A, I_FFNWD), FFD, 1024, WFD, 0, scr, r, F.lane); continue; } r -= I_FD;
        if (r < 8 * I_MG) { const int e = r / I_MG; transpose_item8(INP(A, I_MOEWG) + (size_t)e * 1024 * FFE, 1024, FFE, WMGU8 + (size_t)e * 2 * FFE * 1024, 1, MOE_WGU_SC, scr, r % I_MG, F.lane); continue; } r -= 8 * I_MG;
        if (r < 8 * I_MG) { const int e = r / I_MG; transpose_item8(INP(A, I_MOEWU) + (size_t)e * 1024 * FFE, 1024, FFE, WMGU8 + (size_t)e * 2 * FFE * 1024, 2, MOE_WGU_SC, scr, r % I_MG, F.lane); continue; } r -= 8 * I_MG;
        { const int e = r / I_MD; transpose_item8(INP(A, I_MOEWD) + (size_t)e * FFE * 1024, FFE, 1024, WMD8 + (size_t)e * 1024 * FFE, 0, MOE_WD_SC, scr, r % I_MD, F.lane); }
    }
}

__device__ __forceinline__ void norm_mod_store(const float (&x)[16], const float* g, const float* sc, const float* sh, bf16* dst, int lane, float (&h)[16]) {
    const float r = row_rstd(x);
    float gv[16], scv[16], shv[16]; ld_f32_row(gv, g, lane); ld_f32_row(scv, sc, lane); ld_f32_row(shv, sh, lane);
#pragma unroll
    for (int i = 0; i < 16; ++i) h[i] = x[i] * r * gv[i] * (1.0f + scv[i]) + shv[i];
    if (dst) st_bf16_row(h, dst, lane);
}
__device__ __forceinline__ void phase_prenorm0(Frame& F) {
    REFRESH(F);
    const int rpw = M / (NWG * 8); bf16* HB = (bf16*)(F.ws + WS_HB); ArgsP A = args_ptr(); const float* x_in = INP(A, I_X); const float* mix_pre_g = INP(A, I_MIXPRE);
    for (int k = 0; k < rpw; ++k) { const int m = (F.vcu * 8 + F.wave) * rpw + k, b = m >> 11;
        float x[16], h[16]; ld_f32_row(x, x_in + (size_t)m * D, F.lane);
        norm_mod_store(x, mix_pre_g, mod_ptr(F, 0, b, 1), mod_ptr(F, 0, b, 0), HB + (size_t)m * D, F.lane, h); }
}
__device__ __forceinline__ void phase_postmix(Frame& F, int layer, bool moe) {
    REFRESH(F);
    const int rpw = M / (NWG * 8); bf16* HB = (bf16*)(F.ws + WS_HB); const bf16* Y = (const bf16*)(F.ws + WS_Y);
    ArgsP A = args_ptr(); const float* xsrc = layer == 0 ? INP(A, I_X) : F.out;
    const float* mix_post_g = INP(A, I_MIXPOST); const float* ffn_pre_g = INP(A, I_FFNPRE); const float* router_w = INP(A, I_ROUTW); const float* router_b = INP(A, I_ROUTB);
    LAS int* lcnt = (LAS int*)(F.lds + LDSX_OFF + 256);
    LAS int* lbase = lcnt + 8; LAS int* rinfo = lcnt + 16;
    if (moe) { if (F.tid < 16) lcnt[F.tid] = 0; __syncthreads(); }
    for (int k = 0; k < rpw; ++k) { const int rl = F.wave * rpw + k, m = F.vcu * 8 * rpw + rl, b = m >> 11;
        float x[16], y[16], g[16], gt[16], h[16];
        ld_f32_row(x, xsrc + (size_t)m * D, F.lane); ld_bf16_row(y, Y + (size_t)m * D, F.lane);
        const float ry = row_rstd(y);
        ld_f32_row(g, mix_post_g + layer * D, F.lane); ld_f32_row(gt, mod_ptr(F, layer, b, 2), F.lane);
#pragma unroll
        for (int i = 0; i < 16; ++i) x[i] += gt[i] * (y[i] * ry * g[i]);
        st_f32_row(x, F.out + (size_t)m * D, F.lane);
        norm_mod_store(x, ffn_pre_g + layer * D, mod_ptr(F, layer, b, 4), mod_ptr(F, layer, b, 3), moe ? nullptr : HB + (size_t)m * D, F.lane, h);
        if (moe) {
            { unsigned* h8 = (unsigned*)(F.ws + WS_HB + (size_t)m * D);
#pragma unroll
              for (int j = 0; j < 4; ++j) h8[F.lane + 64 * j] = pk4_fp8(h[4 * j], h[4 * j + 1], h[4 * j + 2], h[4 * j + 3]); }
            float lg[8];
#pragma unroll
            for (int e = 0; e < 8; ++e) lg[e] = 0.f;
#pragma unroll
            for (int j = 0; j < 4; ++j)
#pragma unroll
                for (int e4 = 0; e4 < 4; ++e4) { const float* rw = router_w + (size_t)(256 * j + 4 * F.lane + e4) * 8; const f32x4 w0 = *(const f32x4*)rw, w1 = *(const f32x4*)(rw + 4); const float hv = h[4 * j + e4];
                    lg[0] += hv * w0[0]; lg[1] += hv * w0[1]; lg[2] += hv * w0[2]; lg[3] += hv * w0[3]; lg[4] += hv * w1[0]; lg[5] += hv * w1[1]; lg[6] += hv * w1[2]; lg[7] += hv * w1[3]; }
#pragma unroll
            for (int e = 0; e < 8; ++e) lg[e] = wave_sum(lg[e]) + router_b[e];
            int e0 = 0; float l0 = lg[0];
#pragma unroll
            for (int e = 1; e < 8; ++e) if (lg[e] > l0) { l0 = lg[e]; e0 = e; }
            int e1 = -1; float l1 = -INFINITY;
#pragma unroll
            for (int e = 0; e < 8; ++e) if (e != e0 && lg[e] > l1) { l1 = lg[e]; e1 = e; }
            if (F.lane == 0) {
                const float g0 = fast_rcp(1.0f + __expf(l1 - l0));
                const int p0 = atomicAdd((int*)(lcnt + e0), 1), p1 = atomicAdd((int*)(lcnt + e1), 1);
                rinfo[rl * 4 + 0] = e0; rinfo[rl * 4 + 1] = e1; rinfo[rl * 4 + 2] = p0; rinfo[rl * 4 + 3] = p1;
                float* RTG = (float*)(F.ws + WS_RTG); RTG[2 * m] = g0; RTG[2 * m + 1] = 1.0f - g0;
            }
        }
    }
    if (moe) {
        __syncthreads();
        if (F.tid < 8) lbase[F.tid] = (int)__hip_atomic_fetch_add(F.ctl + CW_CNT + F.tid, (unsigned)lcnt[F.tid], __ATOMIC_RELAXED, __HIP_MEMORY_SCOPE_AGENT);
        __syncthreads();
        const int nrows = 8 * rpw;
        int* RTE = (int*)(F.ws + WS_RTE); int* RTP = (int*)(F.ws + WS_RTP);
        for (int rl = F.tid; rl < nrows; rl += 512) { const int m = F.vcu * nrows + rl; const int e0 = rinfo[rl * 4], e1 = rinfo[rl * 4 + 1];
            RTE[2 * m] = e0; RTE[2 * m + 1] = e1; RTP[2 * m] = lbase[e0] + rinfo[rl * 4 + 2]; RTP[2 * m + 1] = lbase[e1] + rinfo[rl * 4 + 3]; }
    }
}
__device__ __forceinline__ void moe_tiles(const Frame& F, int (&ts)[9], int (&cnt)[8]) {
    int acc = 0;
#pragma unroll
    for (int e = 0; e < 8; ++e) { cnt[e] = __builtin_amdgcn_readfirstlane((int)__hip_atomic_load(F.ctl + CW_CNT + e, __ATOMIC_RELAXED, __HIP_MEMORY_SCOPE_AGENT)); ts[e] = acc; acc += (cnt[e] + 255) >> 8; }
    ts[8] = acc;
}
__device__ __forceinline__ void phase_moe_index(Frame& F) {
    REFRESH(F);
    int ts[9], cnt[8]; moe_tiles(F, ts, cnt);
    int* S2T = (int*)(F.ws + WS_S2T); const int* RTE = (const int*)(F.ws + WS_RTE); const int* RTP = (const int*)(F.ws + WS_RTP);
    const int gt = F.vcu * 512 + F.tid, NT = NWG * 512;
    for (int s = gt; s < ts[8] * 256; s += NT) { const int tile = s >> 8; int e = 0;
#pragma unroll
        for (int k = 1; k < 8; ++k) e += (tile >= ts[k]) ? 1 : 0;
        int c = 0, t0 = 0;
#pragma unroll
        for (int k = 0; k < 8; ++k) { c = (k == e) ? cnt[k] : c; t0 = (k == e) ? ts[k] : t0; }
        if (s - 256 * t0 >= c) S2T[((s >> 8) * 64 + (s & 63)) * 4 + ((s >> 6) & 3)] = 0; }
    for (int a = gt; a < 2 * M; a += NT) { const int e = RTE[a]; int t0 = 0;
#pragma unroll
        for (int k = 0; k < 8; ++k) t0 = (k == e) ? ts[k] : t0;
        { const int sl = 256 * t0 + RTP[a]; S2T[((sl >> 8) * 64 + (sl & 63)) * 4 + ((sl >> 6) & 3)] = a >> 1; } }
}
__device__ __forceinline__ void phase_postffn(Frame& F, int layer, bool moe) {
    REFRESH(F);
    const int rpw = M / (NWG * 8); bf16* HB = (bf16*)(F.ws + WS_HB);
    int ts[9], cnt[8]; if (moe) moe_tiles(F, ts, cnt);
    ArgsP A = args_ptr(); const float* ffn_post_g = INP(A, I_FFNPOST); const float* mix_pre_g = INP(A, I_MIXPRE);
    for (int k = 0; k < rpw; ++k) { const int m = (F.vcu * 8 + F.wave) * rpw + k, b = m >> 11;
        float x[16], y[16], g[16], gt[16], h[16];
        ld_f32_row(x, F.out + (size_t)m * D, F.lane);
        if (moe) {
            const int* RTE = (const int*)(F.ws + WS_RTE); const int* RTP = (const int*)(F.ws + WS_RTP); const float* RTG = (const float*)(F.ws + WS_RTG); const bf16* YS = (const bf16*)(F.ws + WS_YS);
            const int e0 = RTE[2 * m], e1 = RTE[2 * m + 1]; int t0 = 0, t1 = 0;
#pragma unroll
            for (int q = 0; q < 8; ++q) { t0 = (q == e0) ? ts[q] : t0; t1 = (q == e1) ? ts[q] : t1; }
            const size_t s0 = (size_t)256 * t0 + RTP[2 * m], s1 = (size_t)256 * t1 + RTP[2 * m + 1];
            const float g0 = RTG[2 * m], g1 = RTG[2 * m + 1];
            float ya[16], yb[16]; ld_bf16_row(ya, YS + s0 * D, F.lane); ld_bf16_row(yb, YS + s1 * D, F.lane);
#pragma unroll
            for (int i = 0; i < 16; ++i) y[i] = g0 * ya[i] + g1 * yb[i];
        } else ld_bf16_row(y, HB + (size_t)m * D, F.lane);
        const float ry = row_rstd(y);
        ld_f32_row(g, ffn_post_g + layer * D, F.lane); ld_f32_row(gt, mod_ptr(F, layer, b, 5), F.lane);
#pragma unroll
        for (int i = 0; i < 16; ++i) x[i] += gt[i] * (y[i] * ry * g[i]);
        st_f32_row(x, F.out + (size_t)m * D, F.lane);
        if (layer == 0) norm_mod_store(x, mix_pre_g + D, mod_ptr(F, 1, b, 1), mod_ptr(F, 1, b, 0), HB + (size_t)m * D, F.lane, h);
    }
}
__device__ __forceinline__ void phase_mixnorm(Frame& F, int layer) {
    REFRESH(F);
    const int rpw = M / (NWG * 8); bf16* MIXN = (bf16*)(F.ws + WS_HB);
    const bf16* OA = (const bf16*)(F.ws + WS_OA); const bf16* OC = (const bf16*)(F.ws + WS_OC); const bf16* OD = (const bf16*)(F.ws + WS_OD);
    const bf16* DIL = (const bf16*)(F.ws + WS_DIL); const float* LSE = (const float*)(F.ws + WS_LSE);
    const int lane = F.lane, hh = lane >> 4; ArgsP A = args_ptr(); const float* group_g = INP(A, I_GROUPG);
    for (int k = 0; k < rpw; ++k) { const size_t m = (size_t)(F.vcu * 8 + F.wave) * rpw + k;
        float v[4][4];
        { const u32x2 t = ((const u32x2*)(OA + m * 256))[lane]; v[0][0] = bflo(t.x); v[0][1] = bfhi(t.x); v[0][2] = bflo(t.y); v[0][3] = bfhi(t.y); }
        { const float l0 = LSE[m * 4 + hh], l1 = LSE[((size_t)M + m) * 4 + hh], l2 = LSE[((size_t)2 * M + m) * 4 + hh];
          const float mx = fmaxf(l0, fmaxf(l1, l2)); float w0 = fast_exp2(l0 - mx), w1 = fast_exp2(l1 - mx), w2 = fast_exp2(l2 - mx); const float inv = fast_rcp(w0 + w1 + w2); w0 *= inv; w1 *= inv; w2 *= inv;
          const u32x2 a = ((const u32x2*)(DIL + m * 256))[lane], bq = ((const u32x2*)(DIL + ((size_t)M + m) * 256))[lane], cq = ((const u32x2*)(DIL + ((size_t)2 * M + m) * 256))[lane];
          v[1][0] = w0 * bflo(a.x) + w1 * bflo(bq.x) + w2 * bflo(cq.x); v[1][1] = w0 * bfhi(a.x) + w1 * bfhi(bq.x) + w2 * bfhi(cq.x);
          v[1][2] = w0 * bflo(a.y) + w1 * bflo(bq.y) + w2 * bflo(cq.y); v[1][3] = w0 * bfhi(a.y) + w1 * bfhi(bq.y) + w2 * bfhi(cq.y); }
        { const u32x2 t = ((const u32x2*)(OC + m * 256))[lane]; v[2][0] = bflo(t.x); v[2][1] = bfhi(t.x); v[2][2] = bflo(t.y); v[2][3] = bfhi(t.y); }
        { const u32x2 t = ((const u32x2*)(OD + m * 256))[lane]; v[3][0] = bflo(t.x); v[3][1] = bfhi(t.x); v[3][2] = bflo(t.y); v[3][3] = bfhi(t.y); }
#pragma unroll
        for (int g = 0; g < 4; ++g) {
            const float ss = wave_sum(v[g][0] * v[g][0] + v[g][1] * v[g][1] + v[g][2] * v[g][2] + v[g][3] * v[g][3]);
            const float r = __builtin_amdgcn_rsqf(ss * (1.0f / 256.0f) + EPS);
            const f32x4 gg = *(const f32x4*)(group_g + (size_t)(layer * 4 + g) * 256 + 4 * lane);
            u32x2 t; t.x = cvtpk(v[g][0] * r * gg[0], v[g][1] * r * gg[1]); t.y = cvtpk(v[g][2] * r * gg[2], v[g][3] * r * gg[3]);
            ((u32x2*)(MIXN + m * D + 256 * g))[lane] = t; }
    }
}

__device__ __forceinline__ void gmlp_unit(Frame& F, int layer, int b, int ch) {
    const bf16* P = (const bf16*)(F.ws + WS_P); bf16* OC = (bf16*)(F.ws + WS_OC);
    const size_t R0 = (size_t)b * SEQ + 128 * ch;
    LAS bf16* VT = (LAS bf16*)F.lds;
    const int lane = F.lane, w = F.wave;
    for (int k = 0; k < 16; ++k) { const int s = 16 * w + k;
        const u32x2 t = ((const u32x2*)(P + (R0 + s) * PW + P_GV))[lane];
        float v0 = bflo(t.x), v1 = bfhi(t.x), v2 = bflo(t.y), v3 = bfhi(t.y);
        const float mean = wave_sum((v0 + v1) + (v2 + v3)) * (1.0f / 256.0f);
        v0 -= mean; v1 -= mean; v2 -= mean; v3 -= mean;
        const float rstd = __builtin_amdgcn_rsqf(wave_sum((v0 * v0 + v1 * v1) + (v2 * v2 + v3 * v3)) * (1.0f / 256.0f) + EPS);
        const unsigned p0 = cvtpk(v0 * rstd, v1 * rstd), p1 = cvtpk(v2 * rstd, v3 * rstd);
        VT[(4 * lane + 0) * 136 + s] = (bf16)(p0 & 0xffffu); VT[(4 * lane + 1) * 136 + s] = (bf16)(p0 >> 16);
        VT[(4 * lane + 2) * 136 + s] = (bf16)(p1 & 0xffffu); VT[(4 * lane + 3) * 136 + s] = (bf16)(p1 >> 16); }
    __syncthreads();
    const int g = w >> 1, cb = 64 * g + 32 * (w & 1), r = lane & 31, h = lane >> 5;
    ArgsP A = args_ptr();
    const float* W = INP(A, I_GMLPW) + (size_t)(layer * 4 + g) * 128 * 128;
    const float* bias = INP(A, I_GMLPB) + (size_t)(layer * 4 + g) * 128;
    for (int tt = 0; tt < 4; ++tt) {
        f32x16 acc;
#pragma unroll
        for (int i = 0; i < 16; ++i) acc[i] = 0.f;
        const int t = 32 * tt + r;
        for (int ks = 0; ks < 2 * (tt + 1); ++ks) {
            const int s0 = 16 * ks + 8 * h;
            const f32x4 a = *(const f32x4*)(W + (size_t)t * 128 + s0), c = *(const f32x4*)(W + (size_t)t * 128 + s0 + 4);
            float v[8] = {a[0], a[1], a[2], a[3], c[0], c[1], c[2], c[3]};
#pragma unroll
            for (int e = 0; e < 8; ++e) v[e] = (s0 + e <= t) ? v[e] : 0.f;
            u32x4 aw; aw.x = cvtpk(v[0], v[1]); aw.y = cvtpk(v[2], v[3]); aw.z = cvtpk(v[4], v[5]); aw.w = cvtpk(v[6], v[7]);
            const bf16x8 bfrag = *(const LAS bf16x8*)(VT + (cb + r) * 136 + s0);
            acc = MFMA32(__builtin_bit_cast(bf16x8, aw), bfrag, acc);
        }
#pragma unroll
        for (int i = 0; i < 16; ++i) { const int to = 32 * tt + crow(i, h); const float z = acc[i] + bias[to];
            const float u = bf2f(P[(R0 + to) * PW + P_GU + cb + r]);
            OC[(R0 + to) * 256 + cb + r] = (bf16)(cvtpk(u * z, 0.f) & 0xffffu); }
    }
    __syncthreads();
}
__device__ __forceinline__ void conv_unit(Frame& F, int layer, int b, int ch) {
    const bf16* P = (const bf16*)(F.ws + WS_P); bf16* OD = (bf16*)(F.ws + WS_OD);
    const int t0 = 64 * ch; const size_t Rb = (size_t)b * SEQ;
    LAS bf16* XT = (LAS bf16*)F.lds;
    LAS float* YT = (LAS float*)(F.lds + 48128);
    for (int id = F.tid; id < 94 * 32; id += 512) { const int row = id >> 5, piece = id & 31, t = t0 - 30 + row;
        u32x4 v = (u32x4){0u, 0u, 0u, 0u};
        if (t >= 0) v = *(const u32x4*)(P + (Rb + t) * PW + P_GLU + 8 * piece);
        *(LAS u32x4*)(XT + row * 256 + 8 * piece) = v; }
    __syncthreads();
    ArgsP A = args_ptr();
    { const int c = F.tid & 255, half = F.tid >> 8; const float* conv_w = INP(A, I_CONVW);
      float wk[31];
#pragma unroll
      for (int k = 0; k < 31; ++k) wk[k] = conv_w[(size_t)(layer * 31 + k) * 256 + c];
      const float cb = INP(A, I_CONVB)[layer * 256 + c];
      float xs[62];
#pragma unroll
      for (int i = 0; i < 62; ++i) xs[i] = bf2f(XT[(32 * half + i) * 256 + c]);
#pragma unroll
      for (int j = 0; j < 32; ++j) { float y = cb;
#pragma unroll
          for (int k = 0; k < 31; ++k) y += wk[k] * xs[j + k];
          YT[(32 * half + j) * 260 + c] = y; } }
    __syncthreads();
    { const int lane = F.lane;
      const f32x4 lg = *(const f32x4*)(INP(A, I_CONVLNG) + layer * 256 + 4 * lane), lb = *(const f32x4*)(INP(A, I_CONVLNB) + layer * 256 + 4 * lane);
      for (int k = 0; k < 8; ++k) { const int t = 8 * F.wave + k;
          f32x4 y = *(const LAS f32x4*)(YT + t * 260 + 4 * lane);
          const float mean = wave_sum((y[0] + y[1]) + (y[2] + y[3])) * (1.0f / 256.0f);
          y = y - mean;
          const float rstd = __builtin_amdgcn_rsqf(wave_sum((y[0] * y[0] + y[1] * y[1]) + (y[2] * y[2] + y[3] * y[3])) * (1.0f / 256.0f) + EPS);
          float o[4];
#pragma unroll
          for (int e = 0; e < 4; ++e) o[e] = siluf_(y[e] * rstd * lg[e] + lb[e]);
          u32x2 w; w.x = cvtpk(o[0], o[1]); w.y = cvtpk(o[2], o[3]);
          ((u32x2*)(OD + (Rb + t0 + t) * 256))[lane] = w; } }
    __syncthreads();
}
__device__ __forceinline__ void phase_mixers(Frame& F, int layer) {
    REFRESH(F);
    __syncthreads();
    const bf16* P = (const bf16*)(F.ws + WS_P);
    const float* kms = (const float*)(F.ctl + CW_KM) + (size_t)layer * 32768;
    for (int rq = (REPK == 16 ? 2 : 1); rq > 0; --rq)
    for (int u = F.vcu; u < 256; u += NWG) { const int bh = u >> 2, sq = u & 3; const attn_body::bf16* Pq = (const attn_body::bf16*)P;
        for (int k2 = 0; k2 < 2; ++k2)
            attn_body::attn_unit<8>(F.tid, bh >> 2, bh & 3, k2 ? 7 - sq : sq, Pq + P_QA, Pq + P_KA, Pq + P_VA, (attn_body::bf16*)(F.ws + WS_OA), kms, (char*)F.lds); }
    REFRESH(F);
    for (int rq = (REPK == 17 ? 2 : 1); rq > 0; --rq)
    for (int u = F.vcu; u < 256; u += NWG) gmlp_unit(F, layer, u >> 4, u & 15);
    REFRESH(F);
    for (int rq = (REPK == 18 ? 2 : 1); rq > 0; --rq)
    for (int u = F.vcu; u < 512; u += NWG) conv_unit(F, layer, u >> 5, u & 31);
    REFRESH(F);
    LAS char* vt = (LAS char*)(F.lds + F.wave * 4096);
    const int gw = F.vcu * 8 + F.wave, NGW = NWG * 8;
    for (int rq = (REPK == 19 ? 2 : 1); rq > 0; --rq)
    for (int it = gw; it < 3 * 4096; it += NGW) { const int cfg = it >> 12, rem = it & 4095, bh = rem >> 6, idx = rem & 63;
        dil_item(P, (bf16*)(F.ws + WS_DIL) + (size_t)cfg * M * 256, (float*)(F.ws + WS_LSE) + (size_t)cfg * M * 4, cfg, bh >> 2, bh & 3, idx, vt, F.lane); }
}

constexpr int PH_PROLOGUE = 0, PH_PRENORM = 1, PH_L0 = 2, PH_L1 = 10, PH_MOE_INDEX = 15, PH_MOE_CHUNK0 = 16, PH_POSTFFN1 = 26, N_PHASES = 27;
__global__ void __launch_bounds__(512, 2) fwd_kernel(Args args) {
    extern __shared__ __attribute__((aligned(16))) unsigned char lds_raw[];
    Frame F;
    F.lds = (LAS unsigned char*)lds_raw;
    F.ws0 = args.ws; F.ws = args.ws; F.ctl = (unsigned*)(args.ws + WS_CTL); F.out = args.out;
    F.wave0 = __builtin_amdgcn_readfirstlane((int)threadIdx.x >> 6); REFRESH(F);
    { const int bx = blockIdx.x; F.vcu = (bx % 8) * (NWG / 8) + bx / 8; }
    volatile LAS unsigned* MISC = (volatile LAS unsigned*)(F.lds + LDSX_OFF);
    if (F.tid < 16) MISC[F.tid] = 0u;
    __syncthreads();
    const int lo = args.ph_lo, hi = args.ph_hi;
    int nrep2 = 2; asm volatile("" : "+s"(nrep2));
    const bool multi = (hi - lo) > 1;
    XcdBarrier bar; bar.bar = F.ctl + CW_BAR; bar.x = 0; bar.st = nullptr;
    if (multi) bar = xcd_barrier_post(F.ctl + CW_BAR, MISC + 8, F.tid);
#ifndef KMASK
#define KMASK 0xFFFF
#endif
#define KON(b) (((KMASK) >> (b)) & 1)
#define NREP(b) (((REPK) == (b)) ? nrep2 : 1)
#define IN(k) (lo <= (k) && (k) < hi)
#define SEAM(k) do { if (IN(k) && IN((k) + 1)) xcd_barrier(bar, F.wave0 * 64 + lane_id()); } while (0)

    if (KON(0) && IN(PH_PROLOGUE)) for (int rp = NREP(0); rp > 0; --rp) phase_prologue(F);
    SEAM(PH_PROLOGUE);
    if (KON(1) && IN(PH_PRENORM)) for (int rp = NREP(1); rp > 0; --rp) phase_prenorm0(F);
    SEAM(PH_PRENORM);
    for (int layer = 0; layer < 2; ++layer) {
        const int pb = layer == 0 ? PH_L0 : PH_L1;
        if (KON(2) && IN(pb)) for (int rp = NREP(2); rp > 0; --rp) {
            REFRESH(F);
            pg8::SchedPlain S; S.init(M / 256, NIN / 256, NWG, (int)blockIdx.x); S.Bt = (const char*)(F.ws + WS_WIN) + (size_t)layer * NIN * 1024 * 2; S.tstep = (size_t)256 * 1024 * 2;
            EpiInProj E{(bf16*)(F.ws + WS_P), (const int*)args.in[I_POS], (float*)(F.ctl + CW_KM) + (size_t)layer * 32768};
            pg8::gemm_phase(F.lds, F.wave0, (const char*)(F.ws + WS_HB), 2 * 1024, S, E);
        }
        SEAM(pb);
        if (KON(3) && IN(pb + 1)) for (int rp = NREP(3); rp > 0; --rp) phase_mixers(F, layer);
        SEAM(pb + 1);
        if (KON(4) && IN(pb + 2)) for (int rp = NREP(4); rp > 0; --rp) phase_mixnorm(F, layer);
        SEAM(pb + 2);
        if (KON(5) && IN(pb + 3)) for (int rp = NREP(5); rp > 0; --rp) {
            REFRESH(F);
            pg8::SchedPlain S; S.init(M / 256, 4, NWG, (int)blockIdx.x); S.Bt = (const char*)(F.ws + WS_WOUT) + (size_t)layer * 1024 * 1024 * 2; S.tstep = (size_t)256 * 1024 * 2;
            EpiPlain E{(bf16*)(F.ws + WS_Y), 1024, 0};
            pg8::gemm_phase(F.lds, F.wave0, (const char*)(F.ws + WS_HB), 2 * 1024, S, E);
        }
        SEAM(pb + 3);
        if (KON(6) && IN(pb + 4)) for (int rp = (layer == 0 ? NREP(6) : 1); rp > 0; --rp) phase_postmix(F, layer, layer == 1);
        SEAM(pb + 4);
        if (layer == 0) {
            if (KON(7) && IN(pb + 5)) for (int rp = NREP(7); rp > 0; --rp) {
                REFRESH(F);
                pg8::SchedPlain S; S.init(M / 256, 2 * FFD / 256, NWG, (int)blockIdx.x); S.Bt = (const char*)(F.ws + WS_WFGU); S.tstep = (size_t)256 * 1024 * 2;
                EpiSwiGLU E{(bf16*)(F.ws + WS_FH), FFD};
                pg8::gemm_phase(F.lds, F.wave0, (const char*)(F.ws + WS_HB), 2 * 1024, S, E);
            }
            SEAM(pb + 5);
            if (KON(8) && IN(pb + 6)) for (int rp = NREP(8); rp > 0; --rp) {
                REFRESH(F);
                pg8::SchedPlain S; S.init(M / 256, 4, NWG, (int)blockIdx.x); S.Bt = (const char*)(F.ws + WS_WFD); S.tstep = (size_t)256 * FFD * 2;
                EpiPlain E{(bf16*)(F.ws + WS_HB), 1024, 0};
                pg8::gemm_phase(F.lds, F.wave0, (const char*)(F.ws + WS_FH), 2 * FFD, S, E);
            }
            SEAM(pb + 6);
            if (KON(9) && IN(pb + 7)) phase_postffn(F, 0, false);
            SEAM(pb + 7);
        } else {
            if (KON(10) && IN(PH_MOE_INDEX)) for (int rp = NREP(10); rp > 0; --rp) phase_moe_index(F);
            SEAM(PH_MOE_INDEX);
            for (int rp14 = NREP(14); rp14 > 0; --rp14)
            for (int c = 0; c < NCHUNK; ++c) {
                const int pg = PH_MOE_CHUNK0 + 2 * c;
                if (IN(pg) || IN(pg + 1)) {
                    REFRESH(F);
                    int ts[9], cnt[8]; moe_tiles(F, ts, cnt);
                    const int tile0 = CHUNK_TILES * c; int nt = ts[8] - tile0; nt = nt > CHUNK_TILES ? CHUNK_TILES : nt;
                    if (KON(11) && IN(pg) && nt > 0) for (int rp = NREP(11); rp > 0; --rp) {
                        pg8::SchedMoe<true> S; S.init(nt, 2 * FFE / 256, NWG, (int)blockIdx.x); S.Bt = (const char*)(F.ws + WS_WMGU); S.tstep = (size_t)256 * 1024; S.estride = (size_t)2 * FFE * 1024;
                        S.tile0 = tile0; S.s2t = (const int*)(F.ws + WS_S2T);
#pragma unroll
                        for (int k = 0; k < 7; ++k) S.ts[k] = ts[k + 1];
                        { LAS int* tab = (LAS int*)(F.lds + LDSX_OFF + 1024); S.tab = tab;
                          pg8::StaticOrder so; so.init(nt, 2 * FFE / 256, NWG, (int)blockIdx.x); const int* s2t = (const int*)(F.ws + WS_S2T);
#pragma unroll 1
                          for (int i = 0; i < 8; ++i) { pg8::Unit u; const bool ok = so.next(i, u); if (ok && F.tid < 256) tab[i * 256 + F.tid] = s2t[(size_t)(tile0 + u.pm) * 256 + F.tid]; }
                          __syncthreads(); }
                        EpiSwiGLU8 E{F.ws + WS_HID, FFE, MOE_HID_SC};
                        pg8::gemm_phase<EpiSwiGLU8, pg8::SchedMoe<true>, true>(F.lds, F.wave0, (const char*)(F.ws + WS_HB), 1024, S, E, E8_WGU, E8_ONE);
                    }
                    SEAM(pg);
                    if (KON(12) && IN(pg + 1) && nt > 0) for (int rp = NREP(12); rp > 0; --rp) {
                        pg8::SchedMoe<false> S; S.init(nt, 4, NWG, (int)blockIdx.x); S.Bt = (const char*)(F.ws + WS_WMD); S.tstep = (size_t)256 * FFE; S.estride = (size_t)1024 * FFE;
                        S.tile0 = tile0; S.s2t = nullptr; S.tab = nullptr;
#pragma unroll
                        for (int k = 0; k < 7; ++k) S.ts[k] = ts[k + 1];
                        EpiPlain E{(bf16*)(F.ws + WS_YS), 1024, tile0 * 256};
                        pg8::gemm_phase<EpiPlain, pg8::SchedMoe<false>, true>(F.lds, F.wave0, (const char*)(F.ws + WS_HID), FFE, S, E, E8_WD, E8_HID);
                    }
                    SEAM(pg + 1);
                }
            }
            if (KON(13) && IN(PH_POSTFFN1)) phase_postffn(F, 1, true);
        }
    }
#undef IN
#undef SEAM
}

extern "C" void kernel_launch(void* const* d_in, const int* in_sizes, int n_in, void* d_out, int out_size, void* d_ws, size_t ws_size, hipStream_t stream) {
    static int grid = 0;
    if (grid == 0) {
        if (n_in != 26 || out_size != M * D || ws_size < WS_END) { fprintf(stderr, "kernel_launch: unexpected problem: n_in %d out %d ws %zu (need %zu)\n", n_in, out_size, ws_size, (size_t)WS_END); grid = -1; return; }
        int dev = 0, cus = 0, per_cu = 0;
        if (hipGetDevice(&dev) != hipSuccess || hipDeviceGetAttribute(&cus, hipDeviceAttributeMultiprocessorCount, dev) != hipSuccess) { grid = -1; return; }
        if (hipFuncSetAttribute((const void*)fwd_kernel, hipFuncAttributeMaxDynamicSharedMemorySize, LDS_BYTES) != hipSuccess) { fprintf(stderr, "kernel_launch: hipFuncSetAttribute failed\n"); grid = -1; return; }
        if (hipOccupancyMaxActiveBlocksPerMultiprocessor(&per_cu, (const void*)fwd_kernel, 512, LDS_BYTES) != hipSuccess || per_cu < 1) fprintf(stderr, "kernel_launch: occupancy query says %d\n", per_cu);
        (void)hipGetLastError();
        if (cus != NWG) { fprintf(stderr, "kernel_launch: built for a %d-CU device, found %d\n", NWG, cus); grid = -1; return; }
        grid = NWG;
        fprintf(stderr, "kernel_launch: grid %d, ws %zu\n", grid, ws_size);
    }
    if (grid < 0) return;
    (void)hipMemsetAsync((char*)d_ws + WS_CTL, 0, CTL_ZERO_BYTES, stream);
    Args a{};
    for (int i = 0; i < 26; ++i) a.in[i] = d_in[i];
    a.out = (float*)d_out; a.ws = (unsigned char*)d_ws;
#if MK_ONE_LAUNCH
    a.ph_lo = 0; a.ph_hi = N_PHASES;
    hipLaunchKernelGGL(fwd_kernel, dim3(grid), dim3(512), LDS_BYTES, stream, a);
#else
    for (int p = 0; p < N_PHASES; ++p) { a.ph_lo = p; a.ph_hi = p + 1; hipLaunchKernelGGL(fwd_kernel, dim3(grid), dim3(512), LDS_BYTES, stream, a); }
#endif
}
```

```cpp
#include <hip/hip_runtime.h>
#include <cstdio>
#include <cstdint>

#ifndef REPK
#define REPK -1
#endif
#ifndef MK_ONE_LAUNCH
#define MK_ONE_LAUNCH 1
#endif

#define GAS __attribute__((address_space(1)))
#define LAS __attribute__((address_space(3)))
typedef unsigned short bf16;
typedef short bf16x8 __attribute__((ext_vector_type(8)));
typedef float f32x4 __attribute__((ext_vector_type(4)));
typedef float f32x16 __attribute__((ext_vector_type(16)));
typedef unsigned u32x4 __attribute__((ext_vector_type(4)));
typedef unsigned u32x2 __attribute__((ext_vector_type(2)));
typedef float f32x2_t __attribute__((ext_vector_type(2)));
typedef __bf16 bf16x2_t __attribute__((ext_vector_type(2)));
typedef short v4i16_t __attribute__((ext_vector_type(4)));
typedef GAS unsigned gu32;

constexpr int BATCH = 16, SEQ = 2048, D = 1024, M = BATCH * SEQ;
constexpr int NIN = 2560, PW = 2304;
constexpr int FFD = 2816, FFE = 3584, NEXP = 8;
constexpr float EPS = 1e-6f;
constexpr int NWG = 256;
constexpr float C2 = 0.125f * 1.4426950408889634f;
constexpr int P_QA = 0, P_KA = 256, P_VA = 512, P_QB = 768, P_KB = 1024, P_VB = 1280, P_GU = 1536, P_GV = 1792, P_GLU = 2048;
constexpr int MOE_TILES_MAX = 264, CHUNK_TILES = 64, NCHUNK = 5;
constexpr float MOE_WGU_SC = 32.f, MOE_WD_SC = 64.f, MOE_HID_SC = 4.f;
constexpr int E8_WGU = 0x7a7a7a7a, E8_WD = 0x79797979, E8_HID = 0x7d7d7d7d, E8_ONE = 0x7f7f7f7f;

__device__ __forceinline__ unsigned cvtpk(float lo, float hi) { f32x2_t v = {lo, hi}; bf16x2_t b = __builtin_convertvector(v, bf16x2_t); return __builtin_bit_cast(unsigned, b); }
__device__ __forceinline__ unsigned pk4_fp8(float a, float b, float c, float d) {
    a = __builtin_amdgcn_fmed3f(a, -448.f, 448.f); b = __builtin_amdgcn_fmed3f(b, -448.f, 448.f); c = __builtin_amdgcn_fmed3f(c, -448.f, 448.f); d = __builtin_amdgcn_fmed3f(d, -448.f, 448.f);
    int p = __builtin_amdgcn_cvt_pk_fp8_f32(a, b, 0, false); p = __builtin_amdgcn_cvt_pk_fp8_f32(c, d, p, true); return (unsigned)p; }
__device__ __forceinline__ float bf2f(unsigned short b) { return __uint_as_float((unsigned)b << 16); }
__device__ __forceinline__ float bflo(unsigned w) { return __uint_as_float(w << 16); }
__device__ __forceinline__ float bfhi(unsigned w) { return __uint_as_float(w & 0xffff0000u); }
__device__ __forceinline__ float fast_exp2(float x) { return __builtin_amdgcn_exp2f(x); }
__device__ __forceinline__ float fast_rcp(float x) { return __builtin_amdgcn_rcpf(x); }
__device__ __forceinline__ float sigmoidf_(float x) { return fast_rcp(1.0f + fast_exp2(-1.4426950408889634f * x)); }
__device__ __forceinline__ float siluf_(float x) { return x * sigmoidf_(x); }
__device__ __forceinline__ float gelu_tanh(float x) { const float u = x + 0.044715f * x * x * x; return x * fast_rcp(1.0f + fast_exp2(-2.3022081982f * u)); }
__device__ __forceinline__ int lane_id() { int l; asm volatile("v_mbcnt_lo_u32_b32 %0, -1, 0\n\tv_mbcnt_hi_u32_b32 %0, -1, %0" : "=v"(l)); return l; }
template <int CTRL> __device__ __forceinline__ float dpp_f(float v) { return __builtin_bit_cast(float, __builtin_amdgcn_update_dpp(0, __builtin_bit_cast(int, v), CTRL, 0xf, 0xf, false)); }
__device__ __forceinline__ float sum16(float v) {
    v += dpp_f<0xB1>(v); v += dpp_f<0x4E>(v); v += dpp_f<0x141>(v); v += dpp_f<0x140>(v); return v; }
__device__ __forceinline__ float pair16_sum(float v) { const auto r = __builtin_amdgcn_permlane16_swap(__float_as_uint(v), __float_as_uint(v), false, false); return __uint_as_float(r[0]) + __uint_as_float(r[1]); }
__device__ __forceinline__ float pair32_sum(float v) { const auto r = __builtin_amdgcn_permlane32_swap(__float_as_uint(v), __float_as_uint(v), false, false); return __uint_as_float(r[0]) + __uint_as_float(r[1]); }
__device__ __forceinline__ float pair32_max(float v) { const auto r = __builtin_amdgcn_permlane32_swap(__float_as_uint(v), __float_as_uint(v), false, false); return fmaxf(__uint_as_float(r[0]), __uint_as_float(r[1])); }
__device__ __forceinline__ float pair32_other(float v, int h) { const auto r = __builtin_amdgcn_permlane32_swap(__float_as_uint(v), __float_as_uint(v), false, false); return __uint_as_float(h ? r[0] : r[1]); }
__device__ __forceinline__ float wave_sum(float v) { return pair32_sum(pair16_sum(sum16(v))); }

namespace pg8 {
constexpr int BM = 256, BK = 64, HALF = 128, HTB = HALF * BK * 2, STAGE_BYTES = 8 * HTB, NXCD = 8, WGM = 8;
__host__ __device__ __forceinline__ int lds_byte(int r, int c) { const int st = (r >> 4) * 2 + (c >> 5), rr = r & 15, cc = c & 31, ob = rr * 64 + cc * 2; return st * 1024 + (ob ^ (((ob >> 9) & 1) << 5)); }
__host__ __device__ __forceinline__ void stage_rc(int b, int& R, int& C) { const int st = b / 1024, sb = b % 1024, swz = sb ^ (((sb >> 9) & 1) << 5); R = (st >> 1) * 16 + swz / 64; C = (st & 1) * 32 + (swz % 64) / 2; }
__host__ __device__ __forceinline__ int perm32(int rho) { const int n = rho >> 4, i = rho & 15; return 8 * (i >> 2) + 4 * n + (i & 3); }

struct Unit { int pm, pn; };
struct StaticOrder {
    int nM, nN, nwg, G, c;
    __device__ __forceinline__ void init(int nM_, int nN_, int G_, int c_) { nM = nM_; nN = nN_; nwg = nM * nN; G = G_; c = c_; }
    __device__ __forceinline__ bool next(int i, Unit& u) const {
        const long L = (long)i * G + c; if (L >= nwg) return false;
        int wgid = (int)L; { const int q = nwg / NXCD, r = nwg % NXCD, xcd = wgid % NXCD, off = wgid / NXCD; wgid = (xcd < r ? xcd * (q + 1) : r * (q + 1) + (xcd - r) * q) + off; }
        const int nig = WGM * nN, gid = wgid / nig, fm = gid * WGM, gsz = (nM - fm) < WGM ? (nM - fm) : WGM;
        u.pm = fm + ((wgid % nig) % gsz); u.pn = (wgid % nig) / gsz; return true;
    }
};
struct SchedPlain : StaticOrder {
    static constexpr bool GATHER = false;
    const char* Bt; size_t tstep;
    __device__ __forceinline__ int arow(const Unit& u, int rr) const { return u.pm * BM + rr; }
    __device__ __forceinline__ const char* bptr(const Unit& u) const { return Bt + (size_t)u.pn * tstep; }
};
template <bool GATHER_> struct SchedMoe : StaticOrder {
    static constexpr bool GATHER = GATHER_;
    const char* Bt; size_t tstep, estride; int tile0; const int* s2t; int ts[7];
    __device__ __forceinline__ int expert(int pmg) const { int e = 0;
#pragma unroll
        for (int k = 0; k < 7; ++k) e += (pmg >= ts[k]) ? 1 : 0;
        return e; }
    __device__ __forceinline__ int arow(const Unit& u, int rr) const { return u.pm * BM + rr; }
    const LAS int* tab;
    __device__ __forceinline__ u32x4 arow4(int ui, int R0) const { return *(const LAS u32x4*)(tab + ui * 256 + R0 * 4); }
    __device__ __forceinline__ const char* bptr(const Unit& u) const { return Bt + (size_t)expert(tile0 + u.pm) * estride + (size_t)u.pn * tstep; }
};

typedef int v8i32 __attribute__((ext_vector_type(8)));
template <class Epi, class Sched, bool FP8 = false>
__device__ __forceinline__ void gemm_phase(LAS unsigned char* lds, const int wave0, const char* Abase, const int KB, const Sched& S, const Epi& E, const int sW = 0x7f7f7f7f, const int sX = 0x7f7f7f7f) {
    int tid = wave0 * 64 + lane_id(); asm volatile("" : "+v"(tid)); const int wid = __builtin_amdgcn_readfirstlane(tid >> 6), lane = tid & 63, wr = wid >> 2, wc = wid & 3, fr = lane & 15, fq = lane >> 4;
    const int nt = KB / 128;
    int R0, C0; stage_rc(tid * 16, R0, C0);
    const unsigned voffA = (unsigned)(R0 * KB + C0 * 2), voffB = (unsigned)(((R0 & ~31) + perm32(R0 & 31)) * KB + C0 * 2);
    const size_t kstep = (size_t)(BK * 2);
    const size_t hstep = (size_t)HALF * KB;
    const unsigned rowb = (unsigned)KB, colb = (unsigned)C0 * 2u;
    const size_t q64 = (size_t)64 * KB;
    const unsigned ldsw = (unsigned)wid * 1024u;
    const int aoff = lds_byte(wr * 64 + fr, fq * 8), boff = lds_byte(wc * 32 + fr, fq * 8);
#define PG8_SA(b, h) (((b) * 2 + (h)) * HTB)
#define PG8_SB(b, h) ((4 + (b) * 2 + (h)) * HTB)
#define PG8_GLDS(gp, bufoff, i) __builtin_amdgcn_global_load_lds((const unsigned*)(gp), (LAS unsigned*)(lds + (bufoff) + ldsw + (i) * 8192), 16, 0, 0)
#define PG8_STAGE_B(bufoff, gbase) do { PG8_GLDS((const char*)(gbase) + voffB, bufoff, 0); PG8_GLDS((const char*)(gbase) + q64 + voffB, bufoff, 1); } while (0)
#define PG8_STAGE_A(bufoff, h, kb, NX) do { \
        if constexpr (Sched::GATHER) { const unsigned _o0 = (NX) ? ((h) ? n2 : n0) : ((h) ? va2 : va0), _o1 = (NX) ? ((h) ? n3 : n1) : ((h) ? va3 : va1); \
            PG8_GLDS(Abase + (kb) + _o0, bufoff, 0); PG8_GLDS(Abase + (kb) + _o1, bufoff, 1); } \
        else { const char* _b = ((NX) ? nA : cA) + (size_t)(h) * hstep + (kb); PG8_GLDS(_b + voffA, bufoff, 0); PG8_GLDS(_b + q64 + voffA, bufoff, 1); } } while (0)
#define PG8_LDA(dst, b, h) do { _Pragma("unroll") for (int m = 0; m < 4; ++m) _Pragma("unroll") for (int k = 0; k < 2; ++k) dst[m][k] = *(const LAS bf16x8*)(lds + PG8_SA(b, h) + aoff + m * 2048 + k * 1024); } while (0)
#define PG8_LDB(dst, b, h) do { _Pragma("unroll") for (int n = 0; n < 2; ++n) _Pragma("unroll") for (int k = 0; k < 2; ++k) dst[n][k] = *(const LAS bf16x8*)(lds + PG8_SB(b, h) + boff + n * 2048 + k * 1024); } while (0)
#define PG8_CAT(x, y) __builtin_shufflevector(__builtin_bit_cast(u32x4, x), __builtin_bit_cast(u32x4, y), 0, 1, 2, 3, 4, 5, 6, 7)
#define PG8_MMA(ai, bj, At, Bt) do { __builtin_amdgcn_s_setprio(1); \
        if constexpr (FP8) { _Pragma("unroll") for (int m = 0; m < 4; ++m) _Pragma("unroll") for (int n = 0; n < 2; ++n) { \
            const v8i32 b8_ = __builtin_bit_cast(v8i32, PG8_CAT(Bt[n][0], Bt[n][1])), a8_ = __builtin_bit_cast(v8i32, PG8_CAT(At[m][0], At[m][1])); \
            asm volatile("s_nop 1\n\tv_mfma_scale_f32_16x16x128_f8f6f4 %0, %1, %2, %0, %3, %4 op_sel_hi:[0,0,0]" : "+v"(acc[ai][bj][m][n]) : "v"(b8_), "v"(a8_), "v"(sW), "v"(sX)); } } \
        else { _Pragma("unroll") for (int m = 0; m < 4; ++m) _Pragma("unroll") for (int n = 0; n < 2; ++n) _Pragma("unroll") for (int k = 0; k < 2; ++k) \
            acc[ai][bj][m][n] = __builtin_amdgcn_mfma_f32_16x16x32_bf16(Bt[n][k], At[m][k], acc[ai][bj][m][n], 0, 0, 0); } \
        __builtin_amdgcn_s_setprio(0); } while (0)
#define PG8_WAIT_V(n) asm volatile("s_waitcnt vmcnt(" #n ")" ::: "memory")
#define PG8_WAIT_L(n) asm volatile("s_waitcnt lgkmcnt(" #n ")" ::: "memory")
#define PG8_BAR __builtin_amdgcn_s_barrier()
#define PG8_SCHED __builtin_amdgcn_sched_barrier(0)
    Unit cur, nxt; int ui = 0;
    if (!S.next(0, cur)) return;
#define PG8_PIN8(a, b) asm volatile("" : "+v"(acc[a][b][0][0]), "+v"(acc[a][b][0][1]), "+v"(acc[a][b][1][0]), "+v"(acc[a][b][1][1]), "+v"(acc[a][b][2][0]), "+v"(acc[a][b][2][1]), "+v"(acc[a][b][3][0]), "+v"(acc[a][b][3][1]))
#define PG8_PINACC() do { PG8_PIN8(0, 0); PG8_PIN8(0, 1); PG8_PIN8(1, 0); PG8_PIN8(1, 1); } while (0)
    f32x4 acc[2][2][4][2];
#pragma unroll
    for (int a = 0; a < 2; ++a)
#pragma unroll
        for (int b = 0; b < 2; ++b)
#pragma unroll
            for (int m = 0; m < 4; ++m)
#pragma unroll
                for (int n = 0; n < 2; ++n) acc[a][b][m][n] = (f32x4){0.f, 0.f, 0.f, 0.f};
    PG8_PINACC();
    bf16x8 At[4][2], B0[2][2], B1[2][2];
    unsigned va0 = 0, va1 = 0, va2 = 0, va3 = 0, na0 = 0, na1 = 0, na2 = 0, na3 = 0;
    const char* cA = Abase; const char* nA = Abase;
    if constexpr (Sched::GATHER) { const u32x4 ci = S.arow4(0, R0); va0 = ci.x * rowb + colb; va1 = ci.y * rowb + colb; va2 = ci.z * rowb + colb; va3 = ci.w * rowb + colb; }
    else cA = Abase + (size_t)S.arow(cur, 0) * rowb;
    const char* cB = S.bptr(cur);
    { const unsigned n0 = 0, n1 = 0, n2 = 0, n3 = 0; (void)n0; (void)n1; (void)n2; (void)n3;
    PG8_STAGE_B(PG8_SB(0, 0), cB); PG8_STAGE_B(PG8_SB(0, 1), cB + hstep); PG8_STAGE_A(PG8_SA(0, 0), 0, 0, false); PG8_STAGE_A(PG8_SA(0, 1), 1, 0, false);
    if (wr == 1) PG8_BAR;
    PG8_WAIT_V(2); PG8_BAR;
    PG8_STAGE_B(PG8_SB(1, 0), cB + kstep); PG8_STAGE_A(PG8_SA(1, 0), 0, kstep, false); PG8_STAGE_B(PG8_SB(1, 1), cB + hstep + kstep);
    PG8_WAIT_V(6); PG8_BAR; }
    for (;;) {
        const bool has_next = S.next(ui + 1, nxt);
        const char* nB = has_next ? S.bptr(nxt) : cB;
        if constexpr (Sched::GATHER) {
            { const u32x4 ni = S.arow4(has_next ? ui + 1 : ui, R0); na0 = ni.x * rowb + colb; na1 = ni.y * rowb + colb; na2 = ni.z * rowb + colb; na3 = ni.w * rowb + colb; }
        } else nA = has_next ? Abase + (size_t)S.arow(nxt, 0) * rowb : cA;
        for (int t = 0; t < nt; t += 2) {
            const bool last = (t == nt - 2);
            const size_t k1 = (size_t)(t + 1) * kstep, k2 = last ? 0 : (size_t)(t + 2) * kstep, k3 = k2 + kstep;
            const char* b2 = last ? nB : cB + (size_t)(t + 2) * kstep; const char* b3 = b2 + kstep;
            const unsigned n0 = last ? na0 : va0, n1 = last ? na1 : va1, n2 = last ? na2 : va2, n3 = last ? na3 : va3;
            PG8_LDB(B0, 0, 0); PG8_LDB(B1, 0, 1); PG8_SCHED; PG8_LDA(At, 0, 0); PG8_STAGE_A(PG8_SA(1, 1), 1, k1, false);
            PG8_WAIT_V(8); PG8_WAIT_L(0); PG8_BAR; PG8_MMA(0, 0, At, B0); PG8_MMA(0, 1, At, B1); PG8_BAR; PG8_SCHED;
            PG8_LDA(At, 0, 1); PG8_STAGE_B(PG8_SB(0, 0), b2); PG8_STAGE_B(PG8_SB(0, 1), b2 + hstep); PG8_STAGE_A(PG8_SA(0, 0), 0, k2, last);
            PG8_WAIT_V(8); PG8_WAIT_L(0); PG8_BAR; PG8_MMA(1, 0, At, B0); PG8_MMA(1, 1, At, B1); PG8_BAR; PG8_SCHED;
            PG8_LDB(B0, 1, 0); PG8_LDB(B1, 1, 1); PG8_SCHED; PG8_LDA(At, 1, 0); PG8_STAGE_A(PG8_SA(0, 1), 1, k2, last);
            PG8_WAIT_V(8); PG8_WAIT_L(0); PG8_BAR; PG8_MMA(0, 0, At, B0); PG8_MMA(0, 1, At, B1); PG8_BAR; PG8_SCHED;
            PG8_LDA(At, 1, 1); PG8_STAGE_B(PG8_SB(1, 0), b3); PG8_STAGE_B(PG8_SB(1, 1), b3 + hstep); PG8_STAGE_A(PG8_SA(1, 0), 0, k3, last);
            PG8_WAIT_V(8); PG8_WAIT_L(0); PG8_BAR; PG8_MMA(1, 0, At, B0); PG8_MMA(1, 1, At, B1); PG8_BAR; PG8_SCHED;
        }
        if (wr == 0) PG8_BAR;
        if constexpr (FP8) asm volatile("s_nop 15\n\ts_nop 15" ::: "memory");
        E(acc, cur, wr, wc, fr, fq);
        if (!has_next) break;
#pragma unroll
        for (int a = 0; a < 2; ++a)
#pragma unroll
            for (int b = 0; b < 2; ++b)
#pragma unroll
                for (int m = 0; m < 4; ++m)
#pragma unroll
                    for (int n = 0; n < 2; ++n) acc[a][b][m][n] = (f32x4){0.f, 0.f, 0.f, 0.f};
        PG8_PINACC();
        cur = nxt; cB = nB; cA = nA; ++ui;
        if constexpr (Sched::GATHER) { va0 = na0; va1 = na1; va2 = na2; va3 = na3; }
        if (wr == 1) PG8_BAR;
    }
    PG8_WAIT_V(0);
    PG8_BAR;
#undef PG8_SA
#undef PG8_SB
#undef PG8_GLDS
#undef PG8_STAGE_A
#undef PG8_STAGE_B
#undef PG8_LDA
#undef PG8_LDB
#undef PG8_MMA
#undef PG8_PIN8
#undef PG8_PINACC
#undef PG8_CAT
#undef PG8_WAIT_V
#undef PG8_WAIT_L
#undef PG8_BAR
#undef PG8_SCHED
}
}

struct EpiPlain {
    bf16* O; int ldc; int rowoff;
    __device__ __forceinline__ void operator()(const f32x4 (&acc)[2][2][4][2], const pg8::Unit& u, int wr, int wc, int fr, int fq) const {
        const int row0 = rowoff + u.pm * 256 + wr * 64 + fr, col0 = u.pn * 256 + wc * 32 + 8 * fq;
#pragma unroll
        for (int ai = 0; ai < 2; ++ai)
#pragma unroll
            for (int m = 0; m < 4; ++m) { bf16* rowp = O + (size_t)(row0 + ai * 128 + m * 16) * ldc + col0;
#pragma unroll
                for (int bj = 0; bj < 2; ++bj) { const f32x4 v0 = acc[ai][bj][m][0], v1 = acc[ai][bj][m][1];
                    u32x4 w; w.x = cvtpk(v0[0], v0[1]); w.y = cvtpk(v0[2], v0[3]); w.z = cvtpk(v1[0], v1[1]); w.w = cvtpk(v1[2], v1[3]);
                    *(u32x4*)(rowp + bj * 128) = w; } }
    }
};
struct EpiSwiGLU {
    bf16* O; int ldc;
    __device__ __forceinline__ void operator()(const f32x4 (&acc)[2][2][4][2], const pg8::Unit& u, int wr, int wc, int fr, int fq) const {
        const int row0 = u.pm * 256 + wr * 64 + fr, col0 = u.pn * 128 + wc * 32 + 8 * fq;
#pragma unroll
        for (int ai = 0; ai < 2; ++ai)
#pragma unroll
            for (int m = 0; m < 4; ++m) { bf16* rowp = O + (size_t)(row0 + ai * 128 + m * 16) * ldc + col0;
                float o[8];
#pragma unroll
                for (int n = 0; n < 2; ++n)
#pragma unroll
                    for (int e = 0; e < 4; ++e) o[4 * n + e] = siluf_(acc[ai][0][m][n][e]) * acc[ai][1][m][n][e];
                u32x4 w; w.x = cvtpk(o[0], o[1]); w.y = cvtpk(o[2], o[3]); w.z = cvtpk(o[4], o[5]); w.w = cvtpk(o[6], o[7]);
                *(u32x4*)rowp = w; }
    }
};
struct EpiSwiGLU8 {
    unsigned char* O; int ldc; float osc;
    __device__ __forceinline__ void operator()(const f32x4 (&acc)[2][2][4][2], const pg8::Unit& u, int wr, int wc, int fr, int fq) const {
        const int row0 = u.pm * 256 + wr * 64 + fr, col0 = u.pn * 128 + wc * 32 + 8 * fq;
#pragma unroll
        for (int ai = 0; ai < 2; ++ai)
#pragma unroll
            for (int m = 0; m < 4; ++m) { unsigned char* rowp = O + (size_t)(row0 + ai * 128 + m * 16) * ldc + col0;
                float o[8];
#pragma unroll
                for (int n = 0; n < 2; ++n)
#pragma unroll
                    for (int e = 0; e < 4; ++e) o[4 * n + e] = osc * siluf_(acc[ai][0][m][n][e]) * acc[ai][1][m][n][e];
                u32x2 w; w.x = pk4_fp8(o[0], o[1], o[2], o[3]); w.y = pk4_fp8(o[4], o[5], o[6], o[7]);
                *(u32x2*)rowp = w; }
    }
};
struct EpiInProj {
    bf16* P; const int* pos; float* kmsum;
    __device__ __forceinline__ void operator()(const f32x4 (&acc)[2][2][4][2], const pg8::Unit& u, int wr, int wc, int fr, int fq) const {
        const int pn = u.pn, row0 = u.pm * 256 + wr * 64 + fr;
        if (pn == 0 || pn == 1 || pn == 3 || pn == 4) {
            const int g = wc & 1, i0 = 16 * g + 4 * fq;
            float invf[4];
#pragma unroll
            for (int e = 0; e < 4; ++e) invf[e] = fast_exp2(-(float)(i0 + e) * 0.4152410118609203f);
            const float sc = (pn == 0 || pn == 3) ? C2 : 1.0f;
            float ks[2][2][4];
#pragma unroll
            for (int a = 0; a < 2; ++a)
#pragma unroll
                for (int b = 0; b < 2; ++b)
#pragma unroll
                    for (int e = 0; e < 4; ++e) ks[a][b][e] = 0.f;
#pragma unroll
            for (int ai = 0; ai < 2; ++ai)
#pragma unroll
                for (int m = 0; m < 4; ++m) { const int row = row0 + ai * 128 + m * 16; const float p = (float)pos[row];
                    float cs[4], sn[4];
#pragma unroll
                    for (int e = 0; e < 4; ++e) { const float ang = p * invf[e]; const float k = rintf(ang * 0.15915494309189535f);
                        float r = fmaf(-k, 6.2831854820251465f, ang); r = fmaf(-k, -1.7484556000744883e-07f, r); const float rev = r * 0.15915494309189535f;
                        cs[e] = __builtin_amdgcn_cosf(rev); sn[e] = __builtin_amdgcn_sinf(rev); }
                    bf16* rowp = P + (size_t)row * PW + 256 * pn;
#pragma unroll
                    for (int bj = 0; bj < 2; ++bj) { const int hh = 2 * bj + (wc >> 1); const f32x4 v0 = acc[ai][bj][m][0], v1 = acc[ai][bj][m][1];
                        float o0[4], o1[4];
#pragma unroll
                        for (int e = 0; e < 4; ++e) { o0[e] = (v0[e] * cs[e] - v1[e] * sn[e]) * sc; o1[e] = (v1[e] * cs[e] + v0[e] * sn[e]) * sc; ks[bj][0][e] += o0[e]; ks[bj][1][e] += o1[e]; }
                        bf16* dst = rowp + 64 * hh + i0;
                        u32x2 w0, w1; w0.x = cvtpk(o0[0], o0[1]); w0.y = cvtpk(o0[2], o0[3]); w1.x = cvtpk(o1[0], o1[1]); w1.y = cvtpk(o1[2], o1[3]);
                        *(u32x2*)dst = w0; *(u32x2*)(dst + 32) = w1; } }
            if (pn == 1) {
#pragma unroll
                for (int bj = 0; bj < 2; ++bj)
#pragma unroll
                    for (int n = 0; n < 2; ++n)
#pragma unroll
                        for (int e = 0; e < 4; ++e) { const float v = sum16(ks[bj][n][e]);
                            if (fr == 0) atomicAdd(kmsum + (size_t)(u.pm * 4 + 2 * bj + (wc >> 1)) * 64 + 32 * n + i0 + e, v); }
            }
        } else if (pn >= 8) {
            const int col0 = P_GLU + 128 * (pn - 8) + wc * 32 + 8 * fq;
#pragma unroll
            for (int ai = 0; ai < 2; ++ai)
#pragma unroll
                for (int m = 0; m < 4; ++m) { bf16* rowp = P + (size_t)(row0 + ai * 128 + m * 16) * PW + col0;
                    float o[8];
#pragma unroll
                    for (int n = 0; n < 2; ++n)
#pragma unroll
                        for (int e = 0; e < 4; ++e) o[4 * n + e] = acc[ai][0][m][n][e] * sigmoidf_(acc[ai][1][m][n][e]);
                    u32x4 w; w.x = cvtpk(o[0], o[1]); w.y = cvtpk(o[2], o[3]); w.z = cvtpk(o[4], o[5]); w.w = cvtpk(o[6], o[7]);
                    *(u32x4*)rowp = w; }
        } else {
            const bool act = (pn >= 6);
            const int col0 = 256 * pn + wc * 32 + 8 * fq;
#pragma unroll
            for (int ai = 0; ai < 2; ++ai)
#pragma unroll
                for (int m = 0; m < 4; ++m) { bf16* rowp = P + (size_t)(row0 + ai * 128 + m * 16) * PW + col0;
#pragma unroll
                    for (int bj = 0; bj < 2; ++bj) { float o[8];
#pragma unroll
                        for (int n = 0; n < 2; ++n)
#pragma unroll
                            for (int e = 0; e < 4; ++e) { const float v = acc[ai][bj][m][n][e]; o[4 * n + e] = act ? gelu_tanh(v) : v; }
                        u32x4 w; w.x = cvtpk(o[0], o[1]); w.y = cvtpk(o[2], o[3]); w.z = cvtpk(o[4], o[5]); w.w = cvtpk(o[6], o[7]);
                        *(u32x4*)(rowp + bj * 128) = w; } }
        }
    }
};

#define MFMA32(a, b, c) __builtin_amdgcn_mfma_f32_32x32x16_bf16((a), (b), (c), 0, 0, 0)
__device__ __forceinline__ int crow(int i, int h) { return (i & 3) + 8 * (i >> 2) + 4 * h; }
__device__ __forceinline__ v4i16_t vtr(const LAS char* p) { return __builtin_amdgcn_ds_read_tr16_b64_v4i16((LAS v4i16_t*)p); }

__device__ __forceinline__ void attn_tile(f32x16& o0, f32x16& o1, float& m, float& l, const bf16x8 (&qf)[4], const bf16* kp, const bf16* vp, size_t v8,
                                          LAS char* vt, int lane, unsigned vmask) {
    const int h = lane >> 5;
    bf16x8 kf[4];
#pragma unroll
    for (int s = 0; s < 4; ++s) kf[s] = *(const bf16x8*)(kp + 16 * s);
    u32x4 vv[4];
#pragma unroll
    for (int w = 0; w < 4; ++w) vv[w] = *(const u32x4*)(vp + (size_t)w * v8);
    f32x16 p;
#pragma unroll
    for (int i = 0; i < 16; ++i) p[i] = 0.f;
#pragma unroll
    for (int s = 0; s < 4; ++s) p = MFMA32(kf[s], qf[s], p);
    { const int piece = lane & 7, key0 = lane >> 3;
#pragma unroll
      for (int w = 0; w < 4; ++w) *(LAS u32x4*)(vt + (2 * w + (piece >> 2)) * 512 + key0 * 64 + (piece & 3) * 16) = vv[w]; }
    float tm = -INFINITY;
#pragma unroll
    for (int i = 0; i < 16; ++i) { p[i] = ((vmask >> i) & 1u) ? p[i] : -INFINITY; tm = fmaxf(tm, p[i]); }
    tm = pair32_max(tm);
    const float mn = fmaxf(m, tm), alpha = fast_exp2(m - mn); m = mn;
    float rs = 0.f;
#pragma unroll
    for (int i = 0; i < 16; ++i) { p[i] = fast_exp2(p[i] - mn); rs += p[i]; }
    l = l * alpha + rs;
#pragma unroll
    for (int i = 0; i < 16; ++i) { o0[i] *= alpha; o1[i] *= alpha; }
    u32x4 w0, w1;
    w0.x = cvtpk(p[0], p[1]); w0.y = cvtpk(p[2], p[3]); w0.z = cvtpk(p[4], p[5]); w0.w = cvtpk(p[6], p[7]);
    w1.x = cvtpk(p[8], p[9]); w1.y = cvtpk(p[10], p[11]); w1.z = cvtpk(p[12], p[13]); w1.w = cvtpk(p[14], p[15]);
    const bf16x8 pf0 = __builtin_bit_cast(bf16x8, w0), pf1 = __builtin_bit_cast(bf16x8, w1);
    const LAS char* vb = vt + (4 * h + ((lane & 15) >> 2)) * 64 + ((lane >> 4) & 1) * 32 + (lane & 3) * 8;
#pragma unroll
    for (int s2 = 0; s2 < 2; ++s2) {
        const v4i16_t a0 = vtr(vb + (4 * s2 + 0) * 512), a1 = vtr(vb + (4 * s2 + 2) * 512);
        const v4i16_t b0 = vtr(vb + (4 * s2 + 1) * 512), b1 = vtr(vb + (4 * s2 + 3) * 512);
        const bf16x8 vf0 = (bf16x8){a0[0], a0[1], a0[2], a0[3], a1[0], a1[1], a1[2], a1[3]};
        const bf16x8 vf1 = (bf16x8){b0[0], b0[1], b0[2], b0[3], b1[0], b1[1], b1[2], b1[3]};
        o0 = MFMA32(vf0, s2 ? pf1 : pf0, o0);
        o1 = MFMA32(vf1, s2 ? pf1 : pf0, o1);
    }
}
__device__ __forceinline__ void attn_store(const f32x16& o0, const f32x16& o1, float inv, bf16* dst, int h) {
#pragma unroll
    for (int g = 0; g < 4; ++g) {
        u32x2 a, b; a.x = cvtpk(o0[4 * g] * inv, o0[4 * g + 1] * inv); a.y = cvtpk(o0[4 * g + 2] * inv, o0[4 * g + 3] * inv);
        b.x = cvtpk(o1[4 * g] * inv, o1[4 * g + 1] * inv); b.y = cvtpk(o1[4 * g + 2] * inv, o1[4 * g + 3] * inv);
        *(u32x2*)(dst + 8 * g + 4 * h) = a; *(u32x2*)(dst + 32 + 8 * g + 4 * h) = b; }
}
__device__ __forceinline__ void moba_item(const bf16* P, const float* kmsum, bf16* OA, int b, int hh, int qt, LAS char* vt, int lane) {
    const int r = lane & 31, h = lane >> 5, j = qt >> 3;
    const bf16* Pb = P + (size_t)b * SEQ * PW;
    const bf16* qp = Pb + (size_t)(32 * qt + r) * PW + P_QA + 64 * hh + 8 * h;
    bf16x8 qf[4];
#pragma unroll
    for (int s = 0; s < 4; ++s) qf[s] = *(const bf16x8*)(qp + 16 * s);
    unsigned sel = (1u << j) - 1u;
    if (j > 3) {
        f32x16 g;
#pragma unroll
        for (int i = 0; i < 16; ++i) g[i] = 0.f;
        const float* kmr = kmsum + (size_t)((b * 8 + (r & 7)) * 4 + hh) * 64 + 8 * h;
#pragma unroll
        for (int s = 0; s < 4; ++s) {
            f32x4 a = (f32x4){0.f, 0.f, 0.f, 0.f}, c = a;
            if (r < j) { a = *(const f32x4*)(kmr + 16 * s); c = *(const f32x4*)(kmr + 16 * s + 4); }
            float v[8] = {a[0], a[1], a[2], a[3], c[0], c[1], c[2], c[3]}; unsigned hi[4], lo[4];
#pragma unroll
            for (int e = 0; e < 4; ++e) { hi[e] = cvtpk(v[2 * e], v[2 * e + 1]); lo[e] = cvtpk(v[2 * e] - bflo(hi[e]), v[2 * e + 1] - bfhi(hi[e])); }
            const bf16x8 khi = __builtin_bit_cast(bf16x8, ((u32x4){hi[0], hi[1], hi[2], hi[3]})), klo = __builtin_bit_cast(bf16x8, ((u32x4){lo[0], lo[1], lo[2], lo[3]}));
            g = MFMA32(khi, qf[s], g); g = MFMA32(klo, qf[s], g);
        }
        float gate[8];
#pragma unroll
        for (int i = 0; i < 4; ++i) { const float o = pair32_other(g[i], h); gate[i] = h ? o : g[i]; gate[4 + i] = h ? g[i] : o; }
        sel = 0u;
#pragma unroll
        for (int k = 0; k < 3; ++k) { float best = -INFINITY; int bi = 0;
#pragma unroll
            for (int n = 0; n < 8; ++n) { const bool c = (n < j) && !((sel >> n) & 1u) && (gate[n] > best); best = c ? gate[n] : best; bi = c ? n : bi; }
            sel |= 1u << bi; }
    }
    f32x16 o0, o1;
#pragma unroll
    for (int i = 0; i < 16; ++i) { o0[i] = 0.f; o1[i] = 0.f; }
    float m = -1e30f, l = 0.f;
    for (int kt = 0; kt <= qt; ++kt) {
        const int n = kt >> 3; unsigned vmask = 0xffffu;
        if (n < j) { const bool on = (sel >> n) & 1u; if (!__any(on)) continue; vmask = on ? 0xffffu : 0u; }
        else if (kt == qt) { vmask = 0u;
#pragma unroll
            for (int i = 0; i < 16; ++i) vmask |= (crow(i, h) <= r) ? (1u << i) : 0u; }
        const bf16* kp = Pb + (size_t)(32 * kt + r) * PW + P_KA + 64 * hh + 8 * h;
        const bf16* vp = Pb + (size_t)(32 * kt + (lane >> 3)) * PW + P_VA + 64 * hh + 8 * (lane & 7);
        attn_tile(o0, o1, m, l, qf, kp, vp, (size_t)8 * PW, vt, lane, vmask);
    }
    l = pair32_sum(l);
    attn_store(o0, o1, fast_rcp(l), OA + (size_t)(b * SEQ + 32 * qt + r) * 256 + 64 * hh, h);
}
__device__ __forceinline__ void dil_item(const bf16* P, bf16* DO, float* LS, int cfg, int b, int hh, int idx, LAS char* vt, int lane) {
    const int r = lane & 31, h = lane >> 5, sh = 2 * cfg, dil = 1 << sh, tsh = 6 - sh;
    const int res = idx >> tsh, qt = idx & ((1 << tsh) - 1);
    const bf16* Pb = P + ((size_t)b * SEQ + res) * PW;
    const size_t rs = (size_t)dil * PW;
    const bf16* qp = Pb + (size_t)(32 * qt + r) * rs + P_QB + 64 * hh + 8 * h;
    bf16x8 qf[4];
#pragma unroll
    for (int s = 0; s < 4; ++s) qf[s] = *(const bf16x8*)(qp + 16 * s);
    f32x16 o0, o1;
#pragma unroll
    for (int i = 0; i < 16; ++i) { o0[i] = 0.f; o1[i] = 0.f; }
    float m = -1e30f, l = 0.f;
    for (int kt = (qt > 4 ? qt - 4 : 0); kt <= qt; ++kt) {
        unsigned vmask = 0u;
#pragma unroll
        for (int i = 0; i < 16; ++i) { const int dl = 32 * (qt - kt) + r - crow(i, h); vmask |= (dl >= 0 && dl <= 128) ? (1u << i) : 0u; }
        const bf16* kp = Pb + (size_t)(32 * kt + r) * rs + P_KB + 64 * hh + 8 * h;
        const bf16* vp = Pb + (size_t)(32 * kt + (lane >> 3)) * rs + P_VB + 64 * hh + 8 * (lane & 7);
        attn_tile(o0, o1, m, l, qf, kp, vp, 8 * rs, vt, lane, vmask);
    }
    l = pair32_sum(l);
    const size_t row = (size_t)b * SEQ + (size_t)(32 * qt + r) * dil + res;
    attn_store(o0, o1, fast_rcp(l), DO + row * 256 + 64 * hh, h);
    if (h == 0) LS[row * 4 + hh] = m + __builtin_amdgcn_logf(l);
}

#include <hip/hip_bf16.h>
#include <cmath>
namespace attn_body {
using bf16=__hip_bfloat16;
using bf16x8=__attribute__((ext_vector_type(8)))short;
using s16x4=__attribute__((ext_vector_type(4)))short;
using f32x16=__attribute__((ext_vector_type(16)))float;
using f32x4=__attribute__((ext_vector_type(4)))float;
using u32x4=__attribute__((ext_vector_type(4)))unsigned;
constexpr int SEQ=2048,D=64,DM=2304,OP=256;
constexpr int NW=8,QBLK=32,QB=QBLK*NW,KVBLK=64,NQB=SEQ/QB;
__device__ __forceinline__ int crow(int r,int hi){return (r&3)+8*(r>>2)+4*hi;}
#define SBAR() __builtin_amdgcn_sched_barrier(0)
__device__ __forceinline__ void cmask(f32x16&p0,f32x16&p1,int jb,int qrel,int hi){
  const float NEG=-INFINITY; int kb=64*jb+4*hi;
  #pragma unroll
  for(int r=0;r<16;++r){int kv=kb+(r&3)+8*(r>>2); if(kv>qrel)p0[r]=NEG; if(kv+32>qrel)p1[r]=NEG;}
}

constexpr int NSLOT=3, SLOTB=8192;
constexpr int LDS_K=0, LDS_V=NSLOT*SLOTB, LDS_WS=2*NSLOT*SLOTB, LDS_OST=LDS_WS+NW*64*4, LDS_BYTES=LDS_OST+NW*4096;
constexpr float C2=0.125f*1.4426950408889634f;
__device__ __forceinline__ void glds16(const void*gsrc,unsigned lds_dst){unsigned keep;
  asm volatile("s_mov_b32 %0, m0\n\ts_mov_b32 m0, %2\n\ts_nop 0\n\tglobal_load_lds_dwordx4 %1, off\n\ts_mov_b32 m0, %0":"=&s"(keep):"v"(gsrc),"s"(lds_dst):"memory");}
__device__ __forceinline__ float max3f(float a,float b,float c){float r;asm("v_max3_f32 %0, %1, %2, %3":"=v"(r):"v"(a),"v"(b),"v"(c));return r;}
__device__ __forceinline__ float max2f(float a,float b){float r;asm("v_max_f32_e32 %0, %1, %2":"=v"(r):"v"(a),"v"(b));return r;}
__device__ __forceinline__ float fadd_s(float a,float b){float r;asm("v_add_f32_e32 %0, %1, %2":"=v"(r):"v"(a),"v"(b));return r;}
__device__ __forceinline__ float fsub_s(float a,float b){float r;asm("v_sub_f32_e32 %0, %1, %2":"=v"(r):"v"(a),"v"(b));return r;}
typedef float f32x2_t __attribute__((ext_vector_type(2))); typedef __bf16 bf16x2_t __attribute__((ext_vector_type(2)));
__device__ __forceinline__ unsigned cvtpk_s(float lo,float hi){f32x2_t v={lo,hi};bf16x2_t b=__builtin_convertvector(v,bf16x2_t);return __builtin_bit_cast(unsigned,b);}
#define WAIT_BAR(N) asm volatile("s_waitcnt vmcnt(" #N ") lgkmcnt(0)\n\ts_barrier":::"memory")

__device__ __forceinline__ void qkt(f32x16&p0,f32x16&p1,const char*Kslot,const bf16x8*qr,const f32x16&negm,int r32,int hi){
  const char*kb=Kslot+hi*1024+r32*16;
  #pragma unroll
  for(int d0=0;d0<4;++d0){
    const bf16x8 b0=*reinterpret_cast<const bf16x8*>(kb+d0*2048);
    const bf16x8 b1=*reinterpret_cast<const bf16x8*>(kb+d0*2048+512);
    if(d0==0){p0=__builtin_amdgcn_mfma_f32_32x32x16_bf16(b0,qr[0],negm,0,0,0);p1=__builtin_amdgcn_mfma_f32_32x32x16_bf16(b1,qr[0],negm,0,0,0);}
    else{p0=__builtin_amdgcn_mfma_f32_32x32x16_bf16(b0,qr[d0],p0,0,0,0);p1=__builtin_amdgcn_mfma_f32_32x32x16_bf16(b1,qr[d0],p1,0,0,0);}}
}
typedef __attribute__((address_space(3))) const char* lds_cptr;
typedef short v4i16_t __attribute__((ext_vector_type(4)));
__device__ __forceinline__ void kload8(bf16x8*kf,lds_cptr kp){
  kf[0]=*(const __attribute__((address_space(3))) bf16x8*)(kp);      kf[1]=*(const __attribute__((address_space(3))) bf16x8*)(kp+512);
  kf[2]=*(const __attribute__((address_space(3))) bf16x8*)(kp+2048); kf[3]=*(const __attribute__((address_space(3))) bf16x8*)(kp+2560);
  kf[4]=*(const __attribute__((address_space(3))) bf16x8*)(kp+4096); kf[5]=*(const __attribute__((address_space(3))) bf16x8*)(kp+4608);
  kf[6]=*(const __attribute__((address_space(3))) bf16x8*)(kp+6144); kf[7]=*(const __attribute__((address_space(3))) bf16x8*)(kp+6656);
}
__device__ __forceinline__ void kload2(bf16x8*kf,lds_cptr kp,int j){ kf[2*j]=*(const __attribute__((address_space(3))) bf16x8*)(kp+j*2048); kf[2*j+1]=*(const __attribute__((address_space(3))) bf16x8*)(kp+j*2048+512); }
__device__ __forceinline__ s16x4 vtr(lds_cptr p){ return __builtin_bit_cast(s16x4,__builtin_amdgcn_ds_read_tr16_b64_v4i16((__attribute__((address_space(3))) v4i16_t*)p)); }
__device__ __forceinline__ float rowmax(const f32x16&p0,const f32x16&p1){
  float a=max3f(p0[0],p0[1],p1[0]),b=max3f(p0[2],p0[3],p1[1]);a=max3f(a,p1[2],p1[3]);
  #pragma unroll
  for(int r=4;r<16;r+=4){a=max3f(a,p0[r],p0[r+1]);b=max3f(b,p0[r+2],p0[r+3]);a=max3f(a,p1[r],p1[r+1]);b=max3f(b,p1[r+2],p1[r+3]);}
  const float m=max2f(a,b);
  auto rr=__builtin_amdgcn_permlane32_swap(__float_as_uint(m),__float_as_uint(m),false,false);
  return max2f(__uint_as_float(rr[0]),__uint_as_float(rr[1]));
}
__device__ __forceinline__ void pv(f32x16*o,int vb,bf16x8 pa0,bf16x8 pa1,bf16x8 pa2,bf16x8 pa3){
  #pragma unroll
  for(int d0=0;d0<2;++d0){s16x4 lo[4],hi[4];
    #pragma unroll
    for(int ks=0;ks<4;++ks){
      asm volatile("ds_read_b64_tr_b16 %0,%1 offset:%c2":"=&v"(lo[ks]):"v"(vb),"i"(d0*4096+ks*1024):"memory");
      asm volatile("ds_read_b64_tr_b16 %0,%1 offset:%c2":"=&v"(hi[ks]):"v"(vb),"i"(d0*4096+ks*1024+512):"memory");}
    asm volatile("s_waitcnt lgkmcnt(0)":::"memory");SBAR();
    #define PK(k) (bf16x8){lo[k][0],lo[k][1],lo[k][2],lo[k][3],hi[k][0],hi[k][1],hi[k][2],hi[k][3]}
    o[d0]=__builtin_amdgcn_mfma_f32_32x32x16_bf16(pa0,PK(0),o[d0],0,0,0);
    o[d0]=__builtin_amdgcn_mfma_f32_32x32x16_bf16(pa1,PK(1),o[d0],0,0,0);
    o[d0]=__builtin_amdgcn_mfma_f32_32x32x16_bf16(pa2,PK(2),o[d0],0,0,0);
    o[d0]=__builtin_amdgcn_mfma_f32_32x32x16_bf16(pa3,PK(3),o[d0],0,0,0);
    #undef PK
  }
}

#ifndef ATTN_STORE16
#define ATTN_STORE16(p,v) (*(u32x4*)(p)=(v))
#endif
template<int THRL> __device__ __forceinline__ void attn_unit(int tid,int b,int h,int qb,const bf16*Q,const bf16*__restrict__ K,const bf16*__restrict__ V,bf16*O,const float*__restrict__ kms,char*shm){
  asm volatile("":"+v"(tid));
  const int lane=tid&63,r32=lane&31,hi=lane>>5; const int wid=__builtin_amdgcn_readfirstlane(tid>>6);
  const long rowbase=(long)b*SEQ; const int q0=qb*QB;
  const bf16*Qw=Q+(rowbase+q0+wid*QBLK)*DM+h*D;
  const bf16*Kh=K+rowbase*DM+h*D,*Vh=V+rowbase*DM+h*D;
  const unsigned lds0=(unsigned)(uintptr_t)shm;
  float*wsf=(float*)(shm+LDS_WS)+wid*64;
  const bf16*ksrc=Kh+(long)lane*DM+wid*8;
  const bf16*vsrc=Vh+(long)(16*(wid&3)+(lane>>2))*DM+(wid>>2)*32+(lane&3)*8;
  const unsigned kdst=lds0+LDS_K+wid*1024, vdst=lds0+LDS_V+wid*1024;
  #define DMA_K(t,slot) glds16(ksrc+(long)(t)*KVBLK*DM,(unsigned)__builtin_amdgcn_readfirstlane(kdst+(slot)))
  #define DMA_V(t,slot) glds16(vsrc+(long)(t)*KVBLK*DM,(unsigned)__builtin_amdgcn_readfirstlane(vdst+(slot)))
  const int vb0=(int)(lds0+LDS_V)+((lane>>4)&1)*32+(lane&3)*8+(4*hi+((lane&15)>>2))*64;
  const char*Kbase=shm+LDS_K; bf16x8 kf[8];
  const lds_cptr shm3=(lds_cptr)shm; const lds_cptr kp0=shm3+LDS_K+hi*1024+r32*16; const lds_cptr vp0=shm3+LDS_V+((lane>>4)&1)*32+(lane&3)*8+(4*hi+((lane&15)>>2))*64;
  const int NT=(q0+QB)/KVBLK;
  DMA_K(0,0);DMA_V(0,0);DMA_K(1,SLOTB);
  bf16x8 qr[4];
  #pragma unroll
  for(int d0=0;d0<4;++d0)qr[d0]=*reinterpret_cast<const bf16x8*>(&Qw[(long)r32*DM+d0*16+hi*8]);
  unsigned sel=(1u<<qb)-1u;
  if(qb>3){
    f32x16 g=f32x16{};
    const float*kmr=kms+(long)((b*8+(r32&7))*4+h)*64+8*hi;
    #pragma unroll
    for(int s=0;s<4;++s){
      f32x4 a=f32x4{0.f,0.f,0.f,0.f},c=a;
      if(r32<qb){a=*reinterpret_cast<const f32x4*>(kmr+16*s);c=*reinterpret_cast<const f32x4*>(kmr+16*s+4);}
      const float v[8]={a[0],a[1],a[2],a[3],c[0],c[1],c[2],c[3]}; unsigned hw[4],lw[4];
      #pragma unroll
      for(int e=0;e<4;++e){hw[e]=cvtpk_s(v[2*e],v[2*e+1]);lw[e]=cvtpk_s(v[2*e]-__uint_as_float(hw[e]<<16),v[2*e+1]-__uint_as_float(hw[e]&0xffff0000u));}
      const bf16x8 khi=__builtin_bit_cast(bf16x8,(u32x4){hw[0],hw[1],hw[2],hw[3]}),klo=__builtin_bit_cast(bf16x8,(u32x4){lw[0],lw[1],lw[2],lw[3]});
      g=__builtin_amdgcn_mfma_f32_32x32x16_bf16(khi,qr[s],g,0,0,0);g=__builtin_amdgcn_mfma_f32_32x32x16_bf16(klo,qr[s],g,0,0,0);
    }
    float gate[8];
    #pragma unroll
    for(int i=0;i<4;++i){auto rr=__builtin_amdgcn_permlane32_swap(__float_as_uint(g[i]),__float_as_uint(g[i]),false,false);const float oth=__uint_as_float(hi?rr[0]:rr[1]);gate[i]=hi?oth:g[i];gate[4+i]=hi?g[i]:oth;}
    sel=0u;
    #pragma unroll
    for(int k=0;k<3;++k){float best=-INFINITY;int bi=0;
      #pragma unroll
      for(int n=0;n<8;++n){const bool c=(n<qb)&&!((sel>>n)&1u)&&(gate[n]>best);best=c?gate[n]:best;bi=c?n:bi;}
      sel|=1u<<bi;}
  }
  float mhat=0.f,l_reg=0.f;f32x16 o[2];o[0]=f32x16{};o[1]=f32x16{};f32x16 negm=f32x16{};asm volatile("":"+v"(negm));
  const int qrel=wid*QBLK+r32;
  #define CMASK(P0,P1,t) do{int jb_=(t)-(NT-4); if(jb_>=0)cmask(P0,P1,jb_,qrel,hi);}while(0)
  bool resc=false;
  #define START(P0,P1) do{ const float rm=rowmax(P0,P1); resc=false; \
    { const float dl=fmaxf(rm,-128.f); mhat=fadd_s(mhat,dl); \
      _Pragma("unroll") for(int r=0;r<16;++r){P0[r]=fsub_s(P0[r],dl);P1[r]=fsub_s(P1[r],dl);} \
      _Pragma("unroll") for(int r=0;r<16;++r)negm[r]=-mhat; asm volatile("":"+v"(negm)); } \
    _Pragma("unroll") for(int r=0;r<16;++r)P0[r]=__builtin_amdgcn_exp2f(P0[r]); }while(0)
  #define RESC() do{ if(resc){ asm volatile("s_waitcnt lgkmcnt(0)":::"memory"); \
      _Pragma("unroll") for(int d_=0;d_<2;++d_) _Pragma("unroll") for(int r=0;r<16;++r)o[d_][r]*=wsf[crow(r,hi)]; } }while(0)
  f32x16 pA0,pA1,pB0,pB1;
  int sl_prev=0,sl_cur=0,sl_next=SLOTB;
  #define ROT() do{sl_prev=sl_cur;sl_cur=sl_next;sl_next=(sl_next==(NSLOT-1)*SLOTB)?0:sl_next+SLOTB;}while(0)
  DMA_K(2,2*SLOTB);
  WAIT_BAR(3);
  { const float nm_=((sel&1u)||NT==4)?0.f:-INFINITY; _Pragma("unroll") for(int r_=0;r_<16;++r_)negm[r_]=nm_; asm volatile("":"+v"(negm)); }
  qkt(pA0,pA1,Kbase,qr,negm,r32,hi);asm volatile("s_nop 15\n\ts_nop 7":"+v"(pA0),"+v"(pA1));CMASK(pA0,pA1,0);
  START(pA0,pA1);
  _Pragma("unroll") for(int r=0;r<16;++r)pA1[r]=__builtin_amdgcn_exp2f(pA1[r]);
  WAIT_BAR(0);
  DMA_K(3,0);DMA_V(1,SLOTB);
  ROT();
  kload8(kf,kp0+sl_cur);
  WAIT_BAR(2);
  s16x4 vlo[8],vhi[8]; u32x4 pw0,pw1,pw2,pw3;
  #define PKW(P,B) cvtpk_s(P[B],P[B+1])
  #define PAF(k) __builtin_bit_cast(bf16x8,pw##k)
  #define VFR(i) (bf16x8){vlo[i][0],vlo[i][1],vlo[i][2],vlo[i][3],vhi[i][0],vhi[i][1],vhi[i][2],vhi[i][3]}
  #define PIN(x) asm volatile("":"+v"(x))
  #define MX3(a,b,c) __builtin_fmaxf(__builtin_fmaxf((a),(b)),(c))
  #define GAPA(MF,A0,A1,A2,A3,W0,W1,PW) do{ MF; sacc+=A0; sacc+=A1; sacc+=A2; sacc+=A3; PIN(sacc); W0; W1; PIN(PW); SBAR(); }while(0)
  #define EX(v) __builtin_amdgcn_exp2f(v)
  #define GAPB(MF,X,B) do{ MF; X[B]=EX(X[B]); X[B+1]=EX(X[B+1]); X[B+2]=EX(X[B+2]); X[B+3]=EX(X[B+3]); PIN(X); SBAR(); }while(0)
  #define VRD(i) do{ vlo[i]=vtr(vp_+(((i)>>2)*4096+((i)&3)*1024)); vhi[i]=vtr(vp_+(((i)>>2)*4096+((i)&3)*1024+512)); }while(0)
  #define KRD(G,j) do{ if(G){ kload2(kf,kp0+sl_next,j); SBAR(); } }while(0)
  #define STEP(C0,C1,P0,P1,t,GK,GV,GL) do{ SBAR(); \
    { const float nm_=(((sel>>((t)>>2))&1u)||((t)>=NT-4))?-mhat:-INFINITY; _Pragma("unroll") for(int r_=0;r_<16;++r_)negm[r_]=nm_; asm volatile("":"+v"(negm)); } \
    const lds_cptr vp_=vp0+sl_prev; \
    VRD(0); SBAR(); float sacc=(P0[0]+P0[1]); \
    GAPA(C0=__builtin_amdgcn_mfma_f32_32x32x16_bf16(kf[0],qr[0],negm,0,0,0), P0[2],P0[3],P0[4],P0[5],     pw0[0]=PKW(P0,0), pw0[1]=PKW(P0,2), pw0); \
    VRD(4); SBAR(); GAPA(C1=__builtin_amdgcn_mfma_f32_32x32x16_bf16(kf[1],qr[0],negm,0,0,0), P0[6],P0[7],P0[8],P0[9],     pw0[2]=PKW(P0,4), pw0[3]=PKW(P0,6), pw0); \
    VRD(1); SBAR(); GAPA(C0=__builtin_amdgcn_mfma_f32_32x32x16_bf16(kf[2],qr[1],C0,0,0,0),   P0[10],P0[11],P0[12],P0[13], pw1[0]=PKW(P0,8), pw1[1]=PKW(P0,10), pw1); \
    VRD(5); SBAR(); GAPA(C1=__builtin_amdgcn_mfma_f32_32x32x16_bf16(kf[3],qr[1],C1,0,0,0),   P0[14],P0[15],P1[0],P1[1],   pw1[2]=PKW(P0,12),pw1[3]=PKW(P0,14), pw1); \
    VRD(2); SBAR(); GAPA(C0=__builtin_amdgcn_mfma_f32_32x32x16_bf16(kf[4],qr[2],C0,0,0,0),   P1[2],P1[3],P1[4],P1[5],     pw2[0]=PKW(P1,0), pw2[1]=PKW(P1,2), pw2); \
    VRD(6); SBAR(); GAPA(C1=__builtin_amdgcn_mfma_f32_32x32x16_bf16(kf[5],qr[2],C1,0,0,0),   P1[6],P1[7],P1[8],P1[9],     pw2[2]=PKW(P1,4), pw2[3]=PKW(P1,6), pw2); \
    VRD(3); SBAR(); GAPA(C0=__builtin_amdgcn_mfma_f32_32x32x16_bf16(kf[6],qr[3],C0,0,0,0),   P1[10],P1[11],P1[12],P1[13], pw3[0]=PKW(P1,8), pw3[1]=PKW(P1,10), pw3); \
    VRD(7); SBAR(); GAPA(C1=__builtin_amdgcn_mfma_f32_32x32x16_bf16(kf[7],qr[3],C1,0,0,0),   P1[14],P1[15],0.f,0.f,       pw3[2]=PKW(P1,12),pw3[3]=PKW(P1,14), pw3); \
    l_reg+=sacc; \
    if(GK){DMA_K((t)+3,sl_cur);} if(GV){DMA_V((t)+1,sl_next);} \
    CMASK(C0,C1,t); \
    { float a=MX3(C0[0],C0[1],C1[0]),b=MX3(C0[2],C0[3],C1[1]); a=MX3(a,C1[2],C1[3]); \
      _Pragma("unroll") for(int r=4;r<16;r+=4){a=MX3(a,C0[r],C0[r+1]);b=MX3(b,C0[r+2],C0[r+3]);a=MX3(a,C1[r],C1[r+1]);b=MX3(b,C1[r+2],C1[r+3]);} \
      float rm=__builtin_fmaxf(a,b); { auto rr=__builtin_amdgcn_permlane32_swap(__float_as_uint(rm),__float_as_uint(rm),false,false); rm=__builtin_fmaxf(__uint_as_float(rr[0]),__uint_as_float(rr[1])); } \
      resc=false; \
      if(__builtin_expect(__any(rm>(float)THRL),0)){ const float dl=__builtin_fmaxf(rm,0.f); mhat+=dl; \
        _Pragma("unroll") for(int r=0;r<16;++r){C0[r]-=dl;C1[r]-=dl;} \
        _Pragma("unroll") for(int r=0;r<16;++r)negm[r]=-mhat; asm volatile("":"+v"(negm)); \
        const float f=__builtin_amdgcn_exp2f(-dl); l_reg*=f; if(hi==0)wsf[r32]=f; resc=true; } } \
    SBAR(); \
    GAPB(o[0]=__builtin_amdgcn_mfma_f32_32x32x16_bf16(PAF(0),VFR(0),o[0],0,0,0), C0,0); \
    GAPB(o[1]=__builtin_amdgcn_mfma_f32_32x32x16_bf16(PAF(0),VFR(4),o[1],0,0,0), C0,4); \
    KRD(GL,0); GAPB(o[0]=__builtin_amdgcn_mfma_f32_32x32x16_bf16(PAF(1),VFR(1),o[0],0,0,0), C0,8); \
    KRD(GL,1); GAPB(o[1]=__builtin_amdgcn_mfma_f32_32x32x16_bf16(PAF(1),VFR(5),o[1],0,0,0), C0,12); \
    KRD(GL,2); GAPB(o[0]=__builtin_amdgcn_mfma_f32_32x32x16_bf16(PAF(2),VFR(2),o[0],0,0,0), C1,0); \
    KRD(GL,3); GAPB(o[1]=__builtin_amdgcn_mfma_f32_32x32x16_bf16(PAF(2),VFR(6),o[1],0,0,0), C1,4); \
    GAPB(o[0]=__builtin_amdgcn_mfma_f32_32x32x16_bf16(PAF(3),VFR(3),o[0],0,0,0), C1,8); \
    GAPB(o[1]=__builtin_amdgcn_mfma_f32_32x32x16_bf16(PAF(3),VFR(7),o[1],0,0,0), C1,12); \
    }while(0)
  int t=1;
  #undef CMASK
  #define CMASK(P0,P1,t) do{}while(0)
  for(;t+5<NT;t+=2){
    STEP(pB0,pB1,pA0,pA1,t,true,true,true);     WAIT_BAR(2); RESC(); ROT();
    STEP(pA0,pA1,pB0,pB1,t+1,true,true,true);   WAIT_BAR(2); RESC(); ROT();
  }
  #undef CMASK
  #define CMASK(P0,P1,t) do{int jb_=(t)-(NT-4); if(jb_>=0)cmask(P0,P1,jb_,qrel,hi);}while(0)
  #define ENDW(tt) do{ if((tt)+3<NT){WAIT_BAR(2);} else if((tt)+2<NT){WAIT_BAR(1);} else {WAIT_BAR(0);} }while(0)
  for(;t+1<NT;t+=2){
    STEP(pB0,pB1,pA0,pA1,t,(t+3<NT),(t+1<NT),(t+1<NT));       ENDW(t);   RESC(); ROT();
    STEP(pA0,pA1,pB0,pB1,t+1,(t+4<NT),(t+2<NT),(t+2<NT));     ENDW(t+1); RESC(); ROT();
  }
  STEP(pB0,pB1,pA0,pA1,NT-1,false,false,false); RESC();
  { float sacc=pB0[0]+pB0[1]; _Pragma("unroll") for(int r=2;r<16;++r)sacc+=pB0[r]; _Pragma("unroll") for(int r=0;r<16;++r)sacc+=pB1[r]; l_reg+=sacc;
    pw0=(u32x4){PKW(pB0,0),PKW(pB0,2),PKW(pB0,4),PKW(pB0,6)};pw1=(u32x4){PKW(pB0,8),PKW(pB0,10),PKW(pB0,12),PKW(pB0,14)};pw2=(u32x4){PKW(pB1,0),PKW(pB1,2),PKW(pB1,4),PKW(pB1,6)};pw3=(u32x4){PKW(pB1,8),PKW(pB1,10),PKW(pB1,12),PKW(pB1,14)};
    SBAR(); pv(o,vb0+sl_cur,PAF(0),PAF(1),PAF(2),PAF(3)); }
  #undef PKW
  #undef PAF
  #undef VFR
  #undef PIN
  #undef MX3
  #undef GAPA
  #undef GAPB
  #undef EX
  #undef VRD
  #undef KRD
  #undef STEP
  #undef ENDW
  {auto rr=__builtin_amdgcn_permlane32_swap(__float_as_uint(l_reg),__float_as_uint(l_reg),false,false);l_reg=__uint_as_float(rr[0])+__uint_as_float(rr[1]);}
  if(hi==0)wsf[32+r32]=l_reg;asm volatile("s_waitcnt lgkmcnt(0)":::"memory");
  float rli[16];
  #pragma unroll
  for(int r=0;r<16;++r)rli[r]=__builtin_amdgcn_rcpf(wsf[32+crow(r,hi)]);
  bf16*Ow=O+(rowbase+q0+wid*QBLK)*OP+h*D;
  { bf16*stg=(bf16*)(shm+LDS_OST)+wid*2048;
    #pragma unroll
    for(int r=0;r<16;++r){const int orow=crow(r,hi);
      #pragma unroll
      for(int d0=0;d0<2;++d0)stg[orow*64+d0*32+r32]=__float2bfloat16(o[d0][r]*rli[r]);}
    asm volatile("s_waitcnt lgkmcnt(0)":::"memory");
    #pragma unroll
    for(int i=0;i<4;++i){const int row=i*8+(lane>>3),ch=lane&7; const u32x4 v=*(const u32x4*)(stg+row*64+ch*8); ATTN_STORE16(Ow+(long)row*OP+ch*8,v);} }
  asm volatile("s_waitcnt lgkmcnt(0)\n\ts_barrier":::"memory");
  #undef DMA_K
  #undef DMA_V
  #undef CMASK
  #undef START
  #undef RESC
  #undef ROT
}
constexpr int ATTN_LDS_BYTES=LDS_BYTES;
#undef SBAR
#undef WAIT_BAR
}

constexpr size_t MiB = 1u << 20;
constexpr size_t WS_CTL = 0, CTL_ZERO_BYTES = 1 * MiB;
constexpr size_t WS_MOD = 1 * MiB;
constexpr size_t WS_RTE = 2 * MiB, WS_RTP = WS_RTE + 256 * 1024, WS_RTG = WS_RTP + 256 * 1024, WS_S2T = WS_RTG + 256 * 1024;
constexpr size_t WS_WIN = 4 * MiB, WS_WOUT = 14 * MiB, WS_WFGU = 18 * MiB, WS_WFD = 29 * MiB, WS_WMGU = 35 * MiB, WS_WMD = 147 * MiB;
constexpr size_t WS_HB = 203 * MiB;
constexpr size_t WS_R = 267 * MiB;
constexpr size_t WS_P = WS_R, WS_DIL = WS_R + 144 * MiB, WS_LSE = WS_R + 192 * MiB, WS_OA = WS_R + 194 * MiB, WS_OC = WS_R + 210 * MiB, WS_OD = WS_R + 226 * MiB;
constexpr size_t WS_Y = WS_R;
constexpr size_t WS_FH = WS_R;
constexpr size_t WS_HID = WS_R, WS_YS = WS_R + 112 * MiB;
constexpr size_t WS_END = WS_R + 244 * MiB;
constexpr int CW_BAR = 4096;
constexpr int CW_CNT = 8192;
constexpr int CW_KM = 16384;
static_assert((CW_KM + 2 * 32768 * 1) * 4 <= (int)CTL_ZERO_BYTES + 0 || true, "");
static_assert((size_t)(CW_KM + 2 * 32768) * 4 <= CTL_ZERO_BYTES, "CTL region");

constexpr int RING_BYTES = 131072, LDSX_OFF = RING_BYTES, LDS_BYTES = 147456;

#define XB_TMO      128
#define XB_XCNT(j)  (256  + 64 * (j))
#define XB_XSUB(j)  (1280 + 64 * (j))
#define XB_XGEN(j)  (2304 + 64 * (j))
#define XB_TOP      3328
#define XB_TOPGEN   3392
#define XCD_BAR_WORDS 3456
#define XB_SPIN_CAP (1u << 18)
__device__ __forceinline__ unsigned xb_ld(unsigned* p)              { return __hip_atomic_load(p, __ATOMIC_RELAXED, __HIP_MEMORY_SCOPE_AGENT); }
__device__ __forceinline__ unsigned xb_add(unsigned* p, unsigned v) { return __hip_atomic_fetch_add(p, v, __ATOMIC_RELAXED, __HIP_MEMORY_SCOPE_AGENT); }
__device__ __forceinline__ unsigned xb_xcc_id() { return (unsigned)__builtin_amdgcn_s_getreg((3 << 11) | 20) & 0xFu; }
#define XB_SPIN(cond, bar) do { unsigned _sp = 0; while (cond) { __builtin_amdgcn_s_sleep(1); \
    if ((++_sp & 255u) == 0u) { if (xb_ld(&(bar)[XB_TMO])) break; if (_sp > XB_SPIN_CAP) { atomicAdd(&(bar)[XB_TMO], 1u); break; } } } } while (0)
struct XcdBarrier { unsigned* bar; unsigned x; volatile LAS unsigned* st; };
__device__ __forceinline__ XcdBarrier xcd_barrier_post(unsigned* bar, volatile LAS unsigned* st, int tid) {
    XcdBarrier b; b.bar = bar; b.x = xb_xcc_id(); b.st = st;
    if (tid == 0) (void)xb_add(&bar[XB_XCNT(b.x)], 1u);
    return b;
}
__device__ __forceinline__ void xcd_barrier_complete(unsigned* bar, unsigned x, unsigned& nloc, unsigned& nx) {
    const unsigned G = gridDim.x * gridDim.y * gridDim.z;
    unsigned sum, cnt, mine, sp = 0u;
    for (;;) {
        sum = 0u; cnt = 0u; mine = 0u;
#pragma unroll
        for (unsigned j = 0; j < 16; ++j) { const unsigned c = xb_ld(&bar[XB_XCNT(j)]); sum += c; cnt += (c > 0u) ? 1u : 0u; mine = (j == x) ? c : mine; }
        if (sum == G) break;
        __builtin_amdgcn_s_sleep(1);
        if ((++sp & 255u) == 0u) { if (xb_ld(&bar[XB_TMO])) break; if (sp > XB_SPIN_CAP) { atomicAdd(&bar[XB_TMO], 1u); break; } }
    }
    nloc = mine > 0u ? mine : 1u; nx = cnt > 0u ? cnt : 1u;
}
__device__ __forceinline__ void xcd_barrier(const XcdBarrier& b, int tid) {
    asm volatile("s_waitcnt vmcnt(0)" ::: "memory");
    __syncthreads();
    if (tid == 0) {
        unsigned* bar = b.bar;
        __builtin_amdgcn_s_waitcnt(0);
        unsigned nloc = b.st[0], nx = b.st[1];
        if (nloc == 0u) { xcd_barrier_complete(bar, b.x, nloc, nx); b.st[0] = nloc; b.st[1] = nx; }
        const unsigned old = xb_add(&bar[XB_XSUB(b.x)], 1u);
        const unsigned gen = old / nloc;
        if (old + 1u == (gen + 1u) * nloc) {
            __builtin_amdgcn_fence(__ATOMIC_RELEASE, "agent");
            asm volatile("s_waitcnt vmcnt(0)" ::: "memory");
            const unsigned og = xb_add(&bar[XB_TOP], 1u);
            const unsigned tg = og / nx;
            if (og + 1u == (tg + 1u) * nx) xb_add(&bar[XB_TOPGEN], 1u);
            else XB_SPIN(xb_ld(&bar[XB_TOPGEN]) == tg, bar);
            __builtin_amdgcn_fence(__ATOMIC_ACQUIRE, "agent");
            xb_add(&bar[XB_XGEN(b.x)], 1u);
            asm volatile("s_waitcnt vmcnt(0)" ::: "memory");
        } else {
            XB_SPIN(xb_ld(&bar[XB_XGEN(b.x)]) == gen, bar);
            __builtin_amdgcn_fence(__ATOMIC_ACQUIRE, "agent");
            asm volatile("s_waitcnt vmcnt(0)" ::: "memory");
        }
    }
    __syncthreads();
}

struct Args { const void* in[26]; float* out; unsigned char* ws; int ph_lo, ph_hi; };
struct Frame {
    LAS unsigned char* lds;
    unsigned char* ws0; unsigned char* ws; unsigned* ctl; float* out;
    int tid, lane, wave, wave0, vcu;
};
typedef const __attribute__((address_space(4))) Args* ArgsP;
__device__ __forceinline__ ArgsP args_ptr() { auto p = __builtin_amdgcn_kernarg_segment_ptr(); asm volatile("" : "+s"(p)); return (ArgsP)p; }
__device__ __forceinline__ int otid(int wave0) { int t = wave0 * 64 + lane_id(); asm volatile("" : "+v"(t)); return t; }
#define REFRESH(F) do { (F).tid = otid((F).wave0); (F).lane = (F).tid & 63; (F).wave = __builtin_amdgcn_readfirstlane((F).tid >> 6); { long z_ = 0; asm volatile("" : "+s"(z_)); (F).ws = (F).ws0 + z_; } (F).ctl = (unsigned*)(F).ws; } while (0)
#define INP(A, k) ((const float*)(A)->in[k])
enum { I_X = 0, I_C, I_POS, I_ADAW, I_ADAB, I_MIXPRE, I_MIXPOST, I_FFNPRE, I_FFNPOST, I_WIN, I_WOUT, I_GROUPG, I_GMLPW, I_GMLPB, I_CONVW, I_CONVB, I_CONVLNG, I_CONVLNB,
       I_FFNWG, I_FFNWU, I_FFNWD, I_ROUTW, I_ROUTB, I_MOEWG, I_MOEWU, I_MOEWD };
#define LDS_WAIT() asm volatile("s_waitcnt lgkmcnt(0)" ::: "memory")

__device__ __forceinline__ void ld_f32_row(float (&v)[16], const float* p, int lane) {
#pragma unroll
    for (int j = 0; j < 4; ++j) { const f32x4 t = ((const f32x4*)p)[lane + 64 * j]; v[4 * j] = t[0]; v[4 * j + 1] = t[1]; v[4 * j + 2] = t[2]; v[4 * j + 3] = t[3]; }
}
__device__ __forceinline__ void ld_bf16_row(float (&v)[16], const bf16* p, int lane) {
#pragma unroll
    for (int j = 0; j < 4; ++j) { const u32x2 t = ((const u32x2*)p)[lane + 64 * j]; v[4 * j] = bflo(t.x); v[4 * j + 1] = bfhi(t.x); v[4 * j + 2] = bflo(t.y); v[4 * j + 3] = bfhi(t.y); }
}
__device__ __forceinline__ void st_f32_row(const float (&v)[16], float* p, int lane) {
#pragma unroll
    for (int j = 0; j < 4; ++j) ((f32x4*)p)[lane + 64 * j] = (f32x4){v[4 * j], v[4 * j + 1], v[4 * j + 2], v[4 * j + 3]};
}
__device__ __forceinline__ void st_bf16_row(const float (&v)[16], bf16* p, int lane) {
#pragma unroll
    for (int j = 0; j < 4; ++j) { u32x2 t; t.x = cvtpk(v[4 * j], v[4 * j + 1]); t.y = cvtpk(v[4 * j + 2], v[4 * j + 3]); ((u32x2*)p)[lane + 64 * j] = t; }
}
__device__ __forceinline__ float row_rstd(const float (&v)[16]) {
    float s = 0.f;
#pragma unroll
    for (int i = 0; i < 16; ++i) s += v[i] * v[i];
    return __builtin_amdgcn_rsqf(wave_sum(s) * (1.0f / D) + EPS);
}
__device__ __forceinline__ const float* mod_ptr(const Frame& F, int layer, int b, int part) { return (const float*)(F.ws + WS_MOD) + ((size_t)(layer * 16 + b) * 6 + part) * 1024; }

__device__ __forceinline__ int dst_row(int type, int n) {
    if (type == 0) return n;
    if (type == 1) return 256 * (n >> 7) + (n & 127);
    if (type == 2) return 256 * (n >> 7) + 128 + (n & 127);
    const int sl = n >> 8, cc = n & 255;
    if (sl == 0 || sl == 1 || sl == 3 || sl == 4) { const int hh = cc >> 6, d = cc & 63; return 256 * sl + 64 * hh + 32 * ((d >> 4) & 1) + 8 * ((d >> 2) & 3) + 4 * (d >> 5) + (d & 3); }
    if (sl < 8) return n;
    return 256 * (8 + ((cc >> 7) & 1)) + (sl == 9 ? 128 : 0) + (cc & 127);
}
__device__ __forceinline__ void transpose_item(const float* W, int K, int N, bf16* WT, int type, LAS float* scr, int item, int lane) {
    const int nblk = N / 32, kb = item / nblk, nb = item % nblk, k0 = 64 * kb, n0 = 32 * nb;
#pragma unroll 8
    for (int i = 0; i < 32; ++i) { const int kk = 2 * i + (lane >> 5); scr[kk * 33 + (lane & 31)] = W[(size_t)(k0 + kk) * N + n0 + (lane & 31)]; }
    LDS_WAIT(); asm volatile("" ::: "memory");
    const int c = lane & 7;
#pragma unroll
    for (int j = 0; j < 4; ++j) { const int n = (lane >> 3) + 8 * j; const LAS float* s = scr + (8 * c) * 33 + n;
        u32x4 o; o.x = cvtpk(s[0 * 33], s[1 * 33]); o.y = cvtpk(s[2 * 33], s[3 * 33]); o.z = cvtpk(s[4 * 33], s[5 * 33]); o.w = cvtpk(s[6 * 33], s[7 * 33]);
        *(u32x4*)(WT + (size_t)dst_row(type, n0 + n) * K + k0 + 8 * c) = o; }
    LDS_WAIT(); asm volatile("" ::: "memory");
}
__device__ __forceinline__ void transpose_item8(const float* W, int K, int N, unsigned char* WT, int type, float wsc, LAS float* scr, int item, int lane) {
    const int nblk = N / 32, kb = item / nblk, nb = item % nblk, k0 = 64 * kb, n0 = 32 * nb;
#pragma unroll 8
    for (int i = 0; i < 32; ++i) { const int kk = 2 * i + (lane >> 5); scr[kk * 33 + (lane & 31)] = W[(size_t)(k0 + kk) * N + n0 + (lane & 31)] * wsc; }
    LDS_WAIT(); asm volatile("" ::: "memory");
    const int c = lane & 7;
#pragma unroll
    for (int j = 0; j < 4; ++j) { const int n = (lane >> 3) + 8 * j; const LAS float* s = scr + (8 * c) * 33 + n;
        u32x2 o; o.x = pk4_fp8(s[0 * 33], s[1 * 33], s[2 * 33], s[3 * 33]); o.y = pk4_fp8(s[4 * 33], s[5 * 33], s[6 * 33], s[7 * 33]);
        *(u32x2*)(WT + (size_t)dst_row(type, n0 + n) * K + k0 + 8 * c) = o; }
    LDS_WAIT(); asm volatile("" ::: "memory");
}
__device__ __forceinline__ void ada_item(Frame& F, ArgsP A, int a, LAS float* scr) {
    const int layer = a / 96, n = 64 * (a % 96) + F.lane; const float* cin = INP(A, I_C); const float* ada_w = INP(A, I_ADAW);
    float acc[16];
#pragma unroll
    for (int b = 0; b < 16; ++b) acc[b] = 0.f;
    for (int kc = 0; kc < 4; ++kc) {
        for (int i = 0; i < 64; ++i) { const int idx = F.lane + 64 * i, b = idx >> 8, kk = idx & 255; scr[idx] = siluf_(cin[b * 1024 + kc * 256 + kk]); }
        LDS_WAIT(); asm volatile("" ::: "memory");
        const float* wp = ada_w + ((size_t)layer * 1024 + kc * 256) * 6144 + n;
#pragma unroll 4
        for (int kk = 0; kk < 256; ++kk) { const float w = wp[(size_t)kk * 6144];
#pragma unroll
            for (int b = 0; b < 16; ++b) acc[b] += scr[b * 256 + kk] * w; }
        LDS_WAIT(); asm volatile("" ::: "memory");
    }
    float* mod = (float*)(F.ws + WS_MOD);
    const float bias = INP(A, I_ADAB)[layer * 6144 + n];
#pragma unroll
    for (int b = 0; b < 16; ++b) mod[(size_t)(layer * 16 + b) * 6144 + n] = acc[b] + bias;
}
__device__ __forceinline__ void phase_prologue(Frame& F) {
    REFRESH(F);
    LAS float* scr = (LAS float*)(F.lds + F.wave * 16384);
    const int gw = F.vcu * 8 + F.wave, NGW = NWG * 8; ArgsP A = args_ptr();
    for (int a = gw; a < 192; a += NGW) ada_item(F, A, a, scr);
    constexpr int I_IN = 16 * 80, I_OUT = 16 * 32, I_FG = 16 * 88, I_FD = 44 * 32, I_MG = 16 * 112, I_MD = 56 * 32;
    constexpr int NITEMS = 2 * I_IN + 2 * I_OUT + 2 * I_FG + I_FD + 16 * I_MG + 8 * I_MD;
    bf16* WIN = (bf16*)(F.ws + WS_WIN); bf16* WOUT = (bf16*)(F.ws + WS_WOUT); bf16* WFGU = (bf16*)(F.ws + WS_WFGU); bf16* WFD = (bf16*)(F.ws + WS_WFD);
    unsigned char* WMGU8 = F.ws + WS_WMGU; unsigned char* WMD8 = F.ws + WS_WMD;
    for (int it = NITEMS - 1 - gw; it >= 0; it -= NGW) {
        int r = it;
        if (r < 2 * I_IN) { const int L = r / I_IN; transpose_item(INP(A, I_WIN) + (size_t)L * 1024 * NIN, 1024, NIN, WIN + (size_t)L * NIN * 1024, 3, scr, r % I_IN, F.lane); continue; } r -= 2 * I_IN;
        if (r < 2 * I_OUT) { const int L = r / I_OUT; transpose_item(INP(A, I_WOUT) + (size_t)L * 1024 * 1024, 1024, 1024, WOUT + (size_t)L * 1024 * 1024, 0, scr, r % I_OUT, F.lane); continue; } r -= 2 * I_OUT;
        if (r < I_FG) { transpose_item(INP(A, I_FFNWG), 1024, FFD, WFGU, 1, scr, r, F.lane); continue; } r -= I_FG;
        if (r < I_FG) { transpose_item(INP(A, I_FFNWU), 1024, FFD, WFGU, 2, scr, r, F.lane); continue; } r -= I_FG;
        if (r < I_FD) { transpose_item8(INP(A, I_FFNWD), FFD, 1024, (unsigned char*)WFD, 0, MOE_WD_SC, scr, r, F.lane); continue; } r -= I_FD;
        if (r < 8 * I_MG) { const int e = r / I_MG; transpose_item8(INP(A, I_MOEWG) + (size_t)e * 1024 * FFE, 1024, FFE, WMGU8 + (size_t)e * 2 * FFE * 1024, 1, MOE_WGU_SC, scr, r % I_MG, F.lane); continue; } r -= 8 * I_MG;
        if (r < 8 * I_MG) { const int e = r / I_MG; transpose_item8(INP(A, I_MOEWU) + (size_t)e * 1024 * FFE, 1024, FFE, WMGU8 + (size_t)e * 2 * FFE * 1024, 2, MOE_WGU_SC, scr, r % I_MG, F.lane); continue; } r -= 8 * I_MG;
        { const int e = r / I_MD; transpose_item8(INP(A, I_MOEWD) + (size_t)e * FFE * 1024, FFE, 1024, WMD8 + (size_t)e * 1024 * FFE, 0, MOE_WD_SC, scr, r % I_MD, F.lane); }
    }
}

__device__ __forceinline__ void norm_mod_store(const float (&x)[16], const float* g, const float* sc, const float* sh, bf16* dst, int lane, float (&h)[16]) {
    const float r = row_rstd(x);
    float gv[16], scv[16], shv[16]; ld_f32_row(gv, g, lane); ld_f32_row(scv, sc, lane); ld_f32_row(shv, sh, lane);
#pragma unroll
    for (int i = 0; i < 16; ++i) h[i] = x[i] * r * gv[i] * (1.0f + scv[i]) + shv[i];
    if (dst) st_bf16_row(h, dst, lane);
}
__device__ __forceinline__ void phase_prenorm0(Frame& F) {
    REFRESH(F);
    const int rpw = M / (NWG * 8); bf16* HB = (bf16*)(F.ws + WS_HB); ArgsP A = args_ptr(); const float* x_in = INP(A, I_X); const float* mix_pre_g = INP(A, I_MIXPRE);
    for (int k = 0; k < rpw; ++k) { const int m = (F.vcu * 8 + F.wave) * rpw + k, b = m >> 11;
        float x[16], h[16]; ld_f32_row(x, x_in + (size_t)m * D, F.lane);
        norm_mod_store(x, mix_pre_g, mod_ptr(F, 0, b, 1), mod_ptr(F, 0, b, 0), HB + (size_t)m * D, F.lane, h); }
}
__device__ __forceinline__ void phase_postmix(Frame& F, int layer, bool moe) {
    REFRESH(F);
    const int rpw = M / (NWG * 8); bf16* HB = (bf16*)(F.ws + WS_HB); const bf16* Y = (const bf16*)(F.ws + WS_Y);
    ArgsP A = args_ptr(); const float* xsrc = layer == 0 ? INP(A, I_X) : F.out;
    const float* mix_post_g = INP(A, I_MIXPOST); const float* ffn_pre_g = INP(A, I_FFNPRE); const float* router_w = INP(A, I_ROUTW); const float* router_b = INP(A, I_ROUTB);
    LAS int* lcnt = (LAS int*)(F.lds + LDSX_OFF + 256);
    LAS int* lbase = lcnt + 8; LAS int* rinfo = lcnt + 16;
    if (moe) { if (F.tid < 16) lcnt[F.tid] = 0; __syncthreads(); }
    for (int k = 0; k < rpw; ++k) { const int rl = F.wave * rpw + k, m = F.vcu * 8 * rpw + rl, b = m >> 11;
        float x[16], y[16], g[16], gt[16], h[16];
        ld_f32_row(x, xsrc + (size_t)m * D, F.lane); ld_bf16_row(y, Y + (size_t)m * D, F.lane);
        const float ry = row_rstd(y);
        ld_f32_row(g, mix_post_g + layer * D, F.lane); ld_f32_row(gt, mod_ptr(F, layer, b, 2), F.lane);
#pragma unroll
        for (int i = 0; i < 16; ++i) x[i] += gt[i] * (y[i] * ry * g[i]);
        st_f32_row(x, F.out + (size_t)m * D, F.lane);
        norm_mod_store(x, ffn_pre_g + layer * D, mod_ptr(F, layer, b, 4), mod_ptr(F, layer, b, 3), moe ? nullptr : HB + (size_t)m * D, F.lane, h);
        if (moe) {
            { unsigned* h8 = (unsigned*)(F.ws + WS_HB + (size_t)m * D);
#pragma unroll
              for (int j = 0; j < 4; ++j) h8[F.lane + 64 * j] = pk4_fp8(h[4 * j], h[4 * j + 1], h[4 * j + 2], h[4 * j + 3]); }
            float lg[8];
#pragma unroll
            for (int e = 0; e < 8; ++e) lg[e] = 0.f;
#pragma unroll
            for (int j = 0; j < 4; ++j)
#pragma unroll
                for (int e4 = 0; e4 < 4; ++e4) { const float* rw = router_w + (size_t)(256 * j + 4 * F.lane + e4) * 8; const f32x4 w0 = *(const f32x4*)rw, w1 = *(const f32x4*)(rw + 4); const float hv = h[4 * j + e4];
                    lg[0] += hv * w0[0]; lg[1] += hv * w0[1]; lg[2] += hv * w0[2]; lg[3] += hv * w0[3]; lg[4] += hv * w1[0]; lg[5] += hv * w1[1]; lg[6] += hv * w1[2]; lg[7] += hv * w1[3]; }
#pragma unroll
            for (int e = 0; e < 8; ++e) lg[e] = wave_sum(lg[e]) + router_b[e];
            int e0 = 0; float l0 = lg[0];
#pragma unroll
            for (int e = 1; e < 8; ++e) if (lg[e] > l0) { l0 = lg[e]; e0 = e; }
            int e1 = -1; float l1 = -INFINITY;
#pragma unroll
            for (int e = 0; e < 8; ++e) if (e != e0 && lg[e] > l1) { l1 = lg[e]; e1 = e; }
            if (F.lane == 0) {
                const float g0 = fast_rcp(1.0f + __expf(l1 - l0));
                const int p0 = atomicAdd((int*)(lcnt + e0), 1), p1 = atomicAdd((int*)(lcnt + e1), 1);
                rinfo[rl * 4 + 0] = e0; rinfo[rl * 4 + 1] = e1; rinfo[rl * 4 + 2] = p0; rinfo[rl * 4 + 3] = p1;
                float* RTG = (float*)(F.ws + WS_RTG); RTG[2 * m] = g0; RTG[2 * m + 1] = 1.0f - g0;
            }
        }
    }
    if (moe) {
        __syncthreads();
        if (F.tid < 8) lbase[F.tid] = (int)__hip_atomic_fetch_add(F.ctl + CW_CNT + F.tid, (unsigned)lcnt[F.tid], __ATOMIC_RELAXED, __HIP_MEMORY_SCOPE_AGENT);
        __syncthreads();
        const int nrows = 8 * rpw;
        int* RTE = (int*)(F.ws + WS_RTE); int* RTP = (int*)(F.ws + WS_RTP);
        for (int rl = F.tid; rl < nrows; rl += 512) { const int m = F.vcu * nrows + rl; const int e0 = rinfo[rl * 4], e1 = rinfo[rl * 4 + 1];
            RTE[2 * m] = e0; RTE[2 * m + 1] = e1; RTP[2 * m] = lbase[e0] + rinfo[rl * 4 + 2]; RTP[2 * m + 1] = lbase[e1] + rinfo[rl * 4 + 3]; }
    }
}
__device__ __forceinline__ void moe_tiles(const Frame& F, int (&ts)[9], int (&cnt)[8]) {
    int acc = 0;
#pragma unroll
    for (int e = 0; e < 8; ++e) { cnt[e] = __builtin_amdgcn_readfirstlane((int)__hip_atomic_load(F.ctl + CW_CNT + e, __ATOMIC_RELAXED, __HIP_MEMORY_SCOPE_AGENT)); ts[e] = acc; acc += (cnt[e] + 255) >> 8; }
    ts[8] = acc;
}
__device__ __forceinline__ void phase_moe_index(Frame& F) {
    REFRESH(F);
    int ts[9], cnt[8]; moe_tiles(F, ts, cnt);
    int* S2T = (int*)(F.ws + WS_S2T); const int* RTE = (const int*)(F.ws + WS_RTE); const int* RTP = (const int*)(F.ws + WS_RTP);
    const int gt = F.vcu * 512 + F.tid, NT = NWG * 512;
    for (int s = gt; s < ts[8] * 256; s += NT) { const int tile = s >> 8; int e = 0;
#pragma unroll
        for (int k = 1; k < 8; ++k) e += (tile >= ts[k]) ? 1 : 0;
        int c = 0, t0 = 0;
#pragma unroll
        for (int k = 0; k < 8; ++k) { c = (k == e) ? cnt[k] : c; t0 = (k == e) ? ts[k] : t0; }
        if (s - 256 * t0 >= c) S2T[((s >> 8) * 64 + (s & 63)) * 4 + ((s >> 6) & 3)] = 0; }
    for (int a = gt; a < 2 * M; a += NT) { const int e = RTE[a]; int t0 = 0;
#pragma unroll
        for (int k = 0; k < 8; ++k) t0 = (k == e) ? ts[k] : t0;
        { const int sl = 256 * t0 + RTP[a]; S2T[((sl >> 8) * 64 + (sl & 63)) * 4 + ((sl >> 6) & 3)] = a >> 1; } }
}
__device__ __forceinline__ void phase_postffn(Frame& F, int layer, bool moe) {
    REFRESH(F);
    const int rpw = M / (NWG * 8); bf16* HB = (bf16*)(F.ws + WS_HB);
    int ts[9], cnt[8]; if (moe) moe_tiles(F, ts, cnt);
    ArgsP A = args_ptr(); const float* ffn_post_g = INP(A, I_FFNPOST); const float* mix_pre_g = INP(A, I_MIXPRE);
    for (int k = 0; k < rpw; ++k) { const int m = (F.vcu * 8 + F.wave) * rpw + k, b = m >> 11;
        float x[16], y[16], g[16], gt[16], h[16];
        ld_f32_row(x, F.out + (size_t)m * D, F.lane);
        if (moe) {
            const int* RTE = (const int*)(F.ws + WS_RTE); const int* RTP = (const int*)(F.ws + WS_RTP); const float* RTG = (const float*)(F.ws + WS_RTG); const bf16* YS = (const bf16*)(F.ws + WS_YS);
            const int e0 = RTE[2 * m], e1 = RTE[2 * m + 1]; int t0 = 0, t1 = 0;
#pragma unroll
            for (int q = 0; q < 8; ++q) { t0 = (q == e0) ? ts[q] : t0; t1 = (q == e1) ? ts[q] : t1; }
            const size_t s0 = (size_t)256 * t0 + RTP[2 * m], s1 = (size_t)256 * t1 + RTP[2 * m + 1];
            const float g0 = RTG[2 * m], g1 = RTG[2 * m + 1];
            float ya[16], yb[16]; ld_bf16_row(ya, YS + s0 * D, F.lane); ld_bf16_row(yb, YS + s1 * D, F.lane);
#pragma unroll
            for (int i = 0; i < 16; ++i) y[i] = g0 * ya[i] + g1 * yb[i];
        } else ld_bf16_row(y, HB + (size_t)m * D, F.lane);
        const float ry = row_rstd(y);
        ld_f32_row(g, ffn_post_g + layer * D, F.lane); ld_f32_row(gt, mod_ptr(F, layer, b, 5), F.lane);
#pragma unroll
        for (int i = 0; i < 16; ++i) x[i] += gt[i] * (y[i] * ry * g[i]);
        st_f32_row(x, F.out + (size_t)m * D, F.lane);
        if (layer == 0) norm_mod_store(x, mix_pre_g + D, mod_ptr(F, 1, b, 1), mod_ptr(F, 1, b, 0), HB + (size_t)m * D, F.lane, h);
    }
}
__device__ __forceinline__ void phase_mixnorm(Frame& F, int layer) {
    REFRESH(F);
    const int rpw = M / (NWG * 8); bf16* MIXN = (bf16*)(F.ws + WS_HB);
    const bf16* OA = (const bf16*)(F.ws + WS_OA); const bf16* OC = (const bf16*)(F.ws + WS_OC); const bf16* OD = (const bf16*)(F.ws + WS_OD);
    const bf16* DIL = (const bf16*)(F.ws + WS_DIL); const float* LSE = (const float*)(F.ws + WS_LSE);
    const int lane = F.lane, hh = lane >> 4; ArgsP A = args_ptr(); const float* group_g = INP(A, I_GROUPG);
    for (int k = 0; k < rpw; ++k) { const size_t m = (size_t)(F.vcu * 8 + F.wave) * rpw + k;
        float v[4][4];
        { const u32x2 t = ((const u32x2*)(OA + m * 256))[lane]; v[0][0] = bflo(t.x); v[0][1] = bfhi(t.x); v[0][2] = bflo(t.y); v[0][3] = bfhi(t.y); }
        { const float l0 = LSE[m * 4 + hh], l1 = LSE[((size_t)M + m) * 4 + hh], l2 = LSE[((size_t)2 * M + m) * 4 + hh];
          const float mx = fmaxf(l0, fmaxf(l1, l2)); float w0 = fast_exp2(l0 - mx), w1 = fast_exp2(l1 - mx), w2 = fast_exp2(l2 - mx); const float inv = fast_rcp(w0 + w1 + w2); w0 *= inv; w1 *= inv; w2 *= inv;
          const u32x2 a = ((const u32x2*)(DIL + m * 256))[lane], bq = ((const u32x2*)(DIL + ((size_t)M + m) * 256))[lane], cq = ((const u32x2*)(DIL + ((size_t)2 * M + m) * 256))[lane];
          v[1][0] = w0 * bflo(a.x) + w1 * bflo(bq.x) + w2 * bflo(cq.x); v[1][1] = w0 * bfhi(a.x) + w1 * bfhi(bq.x) + w2 * bfhi(cq.x);
          v[1][2] = w0 * bflo(a.y) + w1 * bflo(bq.y) + w2 * bflo(cq.y); v[1][3] = w0 * bfhi(a.y) + w1 * bfhi(bq.y) + w2 * bfhi(cq.y); }
        { const u32x2 t = ((const u32x2*)(OC + m * 256))[lane]; v[2][0] = bflo(t.x); v[2][1] = bfhi(t.x); v[2][2] = bflo(t.y); v[2][3] = bfhi(t.y); }
        { const u32x2 t = ((const u32x2*)(OD + m * 256))[lane]; v[3][0] = bflo(t.x); v[3][1] = bfhi(t.x); v[3][2] = bflo(t.y); v[3][3] = bfhi(t.y); }
#pragma unroll
        for (int g = 0; g < 4; ++g) {
            const float ss = wave_sum(v[g][0] * v[g][0] + v[g][1] * v[g][1] + v[g][2] * v[g][2] + v[g][3] * v[g][3]);
            const float r = __builtin_amdgcn_rsqf(ss * (1.0f / 256.0f) + EPS);
            const f32x4 gg = *(const f32x4*)(group_g + (size_t)(layer * 4 + g) * 256 + 4 * lane);
            u32x2 t; t.x = cvtpk(v[g][0] * r * gg[0], v[g][1] * r * gg[1]); t.y = cvtpk(v[g][2] * r * gg[2], v[g][3] * r * gg[3]);
            ((u32x2*)(MIXN + m * D + 256 * g))[lane] = t; }
    }
}

__device__ __forceinline__ void gmlp_unit(Frame& F, int layer, int b, int ch) {
    const bf16* P = (const bf16*)(F.ws + WS_P); bf16* OC = (bf16*)(F.ws + WS_OC);
    const size_t R0 = (size_t)b * SEQ + 128 * ch;
    LAS bf16* VT = (LAS bf16*)F.lds;
    const int lane = F.lane, w = F.wave;
    for (int k = 0; k < 16; ++k) { const int s = 16 * w + k;
        const u32x2 t = ((const u32x2*)(P + (R0 + s) * PW + P_GV))[lane];
        float v0 = bflo(t.x), v1 = bfhi(t.x), v2 = bflo(t.y), v3 = bfhi(t.y);
        const float mean = wave_sum((v0 + v1) + (v2 + v3)) * (1.0f / 256.0f);
        v0 -= mean; v1 -= mean; v2 -= mean; v3 -= mean;
        const float rstd = __builtin_amdgcn_rsqf(wave_sum((v0 * v0 + v1 * v1) + (v2 * v2 + v3 * v3)) * (1.0f / 256.0f) + EPS);
        const unsigned p0 = cvtpk(v0 * rstd, v1 * rstd), p1 = cvtpk(v2 * rstd, v3 * rstd);
        VT[(4 * lane + 0) * 136 + s] = (bf16)(p0 & 0xffffu); VT[(4 * lane + 1) * 136 + s] = (bf16)(p0 >> 16);
        VT[(4 * lane + 2) * 136 + s] = (bf16)(p1 & 0xffffu); VT[(4 * lane + 3) * 136 + s] = (bf16)(p1 >> 16); }
    __syncthreads();
    const int g = w >> 1, cb = 64 * g + 32 * (w & 1), r = lane & 31, h = lane >> 5;
    ArgsP A = args_ptr();
    const float* W = INP(A, I_GMLPW) + (size_t)(layer * 4 + g) * 128 * 128;
    const float* bias = INP(A, I_GMLPB) + (size_t)(layer * 4 + g) * 128;
    for (int tt = 0; tt < 4; ++tt) {
        f32x16 acc;
#pragma unroll
        for (int i = 0; i < 16; ++i) acc[i] = 0.f;
        const int t = 32 * tt + r;
        for (int ks = 0; ks < 2 * (tt + 1); ++ks) {
            const int s0 = 16 * ks + 8 * h;
            const f32x4 a = *(const f32x4*)(W + (size_t)t * 128 + s0), c = *(const f32x4*)(W + (size_t)t * 128 + s0 + 4);
            float v[8] = {a[0], a[1], a[2], a[3], c[0], c[1], c[2], c[3]};
#pragma unroll
            for (int e = 0; e < 8; ++e) v[e] = (s0 + e <= t) ? v[e] : 0.f;
            u32x4 aw; aw.x = cvtpk(v[0], v[1]); aw.y = cvtpk(v[2], v[3]); aw.z = cvtpk(v[4], v[5]); aw.w = cvtpk(v[6], v[7]);
            const bf16x8 bfrag = *(const LAS bf16x8*)(VT + (cb + r) * 136 + s0);
            acc = MFMA32(__builtin_bit_cast(bf16x8, aw), bfrag, acc);
        }
#pragma unroll
        for (int i = 0; i < 16; ++i) { const int to = 32 * tt + crow(i, h); const float z = acc[i] + bias[to];
            const float u = bf2f(P[(R0 + to) * PW + P_GU + cb + r]);
            OC[(R0 + to) * 256 + cb + r] = (bf16)(cvtpk(u * z, 0.f) & 0xffffu); }
    }
    __syncthreads();
}
__device__ __forceinline__ void conv_unit(Frame& F, int layer, int b, int ch) {
    const bf16* P = (const bf16*)(F.ws + WS_P); bf16* OD = (bf16*)(F.ws + WS_OD);
    const int t0 = 64 * ch; const size_t Rb = (size_t)b * SEQ;
    LAS bf16* XT = (LAS bf16*)F.lds;
    LAS float* YT = (LAS float*)(F.lds + 48128);
    for (int id = F.tid; id < 94 * 32; id += 512) { const int row = id >> 5, piece = id & 31, t = t0 - 30 + row;
        u32x4 v = (u32x4){0u, 0u, 0u, 0u};
        if (t >= 0) v = *(const u32x4*)(P + (Rb + t) * PW + P_GLU + 8 * piece);
        *(LAS u32x4*)(XT + row * 256 + 8 * piece) = v; }
    __syncthreads();
    ArgsP A = args_ptr();
    { const int c = F.tid & 255, half = F.tid >> 8; const float* conv_w = INP(A, I_CONVW);
      float wk[31];
#pragma unroll
      for (int k = 0; k < 31; ++k) wk[k] = conv_w[(size_t)(layer * 31 + k) * 256 + c];
      const float cb = INP(A, I_CONVB)[layer * 256 + c];
      float xs[62];
#pragma unroll
      for (int i = 0; i < 62; ++i) xs[i] = bf2f(XT[(32 * half + i) * 256 + c]);
#pragma unroll
      for (int j = 0; j < 32; ++j) { float y = cb;
#pragma unroll
          for (int k = 0; k < 31; ++k) y += wk[k] * xs[j + k];
          YT[(32 * half + j) * 260 + c] = y; } }
    __syncthreads();
    { const int lane = F.lane;
      const f32x4 lg = *(const f32x4*)(INP(A, I_CONVLNG) + layer * 256 + 4 * lane), lb = *(const f32x4*)(INP(A, I_CONVLNB) + layer * 256 + 4 * lane);
      for (int k = 0; k < 8; ++k) { const int t = 8 * F.wave + k;
          f32x4 y = *(const LAS f32x4*)(YT + t * 260 + 4 * lane);
          const float mean = wave_sum((y[0] + y[1]) + (y[2] + y[3])) * (1.0f / 256.0f);
          y = y - mean;
          const float rstd = __builtin_amdgcn_rsqf(wave_sum((y[0] * y[0] + y[1] * y[1]) + (y[2] * y[2] + y[3] * y[3])) * (1.0f / 256.0f) + EPS);
          float o[4];
#pragma unroll
          for (int e = 0; e < 4; ++e) o[e] = siluf_(y[e] * rstd * lg[e] + lb[e]);
          u32x2 w; w.x = cvtpk(o[0], o[1]); w.y = cvtpk(o[2], o[3]);
          ((u32x2*)(OD + (Rb + t0 + t) * 256))[lane] = w; } }
    __syncthreads();
}
__device__ __forceinline__ void phase_mixers(Frame& F, int layer) {
    REFRESH(F);
    __syncthreads();
    const bf16* P = (const bf16*)(F.ws + WS_P);
    const float* kms = (const float*)(F.ctl + CW_KM) + (size_t)layer * 32768;
    for (int rq = (REPK == 16 ? 2 : 1); rq > 0; --rq)
    for (int u = F.vcu; u < 256; u += NWG) { const int bh = u >> 2, sq = u & 3; const attn_body::bf16* Pq = (const attn_body::bf16*)P;
        for (int k2 = 0; k2 < 2; ++k2)
            attn_body::attn_unit<8>(F.tid, bh >> 2, bh & 3, k2 ? 7 - sq : sq, Pq + P_QA, Pq + P_KA, Pq + P_VA, (attn_body::bf16*)(F.ws + WS_OA), kms, (char*)F.lds); }
    REFRESH(F);
    for (int rq = (REPK == 17 ? 2 : 1); rq > 0; --rq)
    for (int u = F.vcu; u < 256; u += NWG) gmlp_unit(F, layer, u >> 4, u & 15);
    REFRESH(F);
    for (int rq = (REPK == 18 ? 2 : 1); rq > 0; --rq)
    for (int u = F.vcu; u < 512; u += NWG) conv_unit(F, layer, u >> 5, u & 31);
    REFRESH(F);
    LAS char* vt = (LAS char*)(F.lds + F.wave * 4096);
    const int gw = F.vcu * 8 + F.wave, NGW = NWG * 8;
    for (int rq = (REPK == 19 ? 2 : 1); rq > 0; --rq)
    for (int it = gw; it < 3 * 4096; it += NGW) { const int cfg = it >> 12, rem = it & 4095, bh = rem >> 6, idx = rem & 63;
        dil_item(P, (bf16*)(F.ws + WS_DIL) + (size_t)cfg * M * 256, (float*)(F.ws + WS_LSE) + (size_t)cfg * M * 4, cfg, bh >> 2, bh & 3, idx, vt, F.lane); }
}

constexpr int PH_PROLOGUE = 0, PH_PRENORM = 1, PH_L0 = 2, PH_L1 = 10, PH_MOE_INDEX = 15, PH_MOE_CHUNK0 = 16, PH_POSTFFN1 = 26, N_PHASES = 27;
__global__ void __launch_bounds__(512, 2) fwd_kernel(Args args) {
    extern __shared__ __attribute__((aligned(16))) unsigned char lds_raw[];
    Frame F;
    F.lds = (LAS unsigned char*)lds_raw;
    F.ws0 = args.ws; F.ws = args.ws; F.ctl = (unsigned*)(args.ws + WS_CTL); F.out = args.out;
    F.wave0 = __builtin_amdgcn_readfirstlane((int)threadIdx.x >> 6); REFRESH(F);
    { const int bx = blockIdx.x; F.vcu = (bx % 8) * (NWG / 8) + bx / 8; }
    volatile LAS unsigned* MISC = (volatile LAS unsigned*)(F.lds + LDSX_OFF);
    if (F.tid < 16) MISC[F.tid] = 0u;
    __syncthreads();
    const int lo = args.ph_lo, hi = args.ph_hi;
    int nrep2 = 2; asm volatile("" : "+s"(nrep2));
    const bool multi = (hi - lo) > 1;
    XcdBarrier bar; bar.bar = F.ctl + CW_BAR; bar.x = 0; bar.st = nullptr;
    if (multi) bar = xcd_barrier_post(F.ctl + CW_BAR, MISC + 8, F.tid);
#ifndef KMASK
#define KMASK 0xFFFF
#endif
#define KON(b) (((KMASK) >> (b)) & 1)
#define NREP(b) (((REPK) == (b)) ? nrep2 : 1)
#define IN(k) (lo <= (k) && (k) < hi)
#define SEAM(k) do { if (IN(k) && IN((k) + 1)) xcd_barrier(bar, F.wave0 * 64 + lane_id()); } while (0)

    if (KON(0) && IN(PH_PROLOGUE)) for (int rp = NREP(0); rp > 0; --rp) phase_prologue(F);
    SEAM(PH_PROLOGUE);
    if (KON(1) && IN(PH_PRENORM)) for (int rp = NREP(1); rp > 0; --rp) phase_prenorm0(F);
    SEAM(PH_PRENORM);
    for (int layer = 0; layer < 2; ++layer) {
        const int pb = layer == 0 ? PH_L0 : PH_L1;
        if (KON(2) && IN(pb)) for (int rp = NREP(2); rp > 0; --rp) {
            REFRESH(F);
            pg8::SchedPlain S; S.init(M / 256, NIN / 256, NWG, (int)blockIdx.x); S.Bt = (const char*)(F.ws + WS_WIN) + (size_t)layer * NIN * 1024 * 2; S.tstep = (size_t)256 * 1024 * 2;
            EpiInProj E{(bf16*)(F.ws + WS_P), (const int*)args.in[I_POS], (float*)(F.ctl + CW_KM) + (size_t)layer * 32768};
            pg8::gemm_phase(F.lds, F.wave0, (const char*)(F.ws + WS_HB), 2 * 1024, S, E);
        }
        SEAM(pb);
        if (KON(3) && IN(pb + 1)) for (int rp = NREP(3); rp > 0; --rp) phase_mixers(F, layer);
        SEAM(pb + 1);
        if (KON(4) && IN(pb + 2)) for (int rp = NREP(4); rp > 0; --rp) phase_mixnorm(F, layer);
        SEAM(pb + 2);
        if (KON(5) && IN(pb + 3)) for (int rp = NREP(5); rp > 0; --rp) {
            REFRESH(F);
            pg8::SchedPlain S; S.init(M / 256, 4, NWG, (int)blockIdx.x); S.Bt = (const char*)(F.ws + WS_WOUT) + (size_t)layer * 1024 * 1024 * 2; S.tstep = (size_t)256 * 1024 * 2;
            EpiPlain E{(bf16*)(F.ws + WS_Y), 1024, 0};
            pg8::gemm_phase(F.lds, F.wave0, (const char*)(F.ws + WS_HB), 2 * 1024, S, E);
        }
        SEAM(pb + 3);
        if (KON(6) && IN(pb + 4)) for (int rp = (layer == 0 ? NREP(6) : 1); rp > 0; --rp) phase_postmix(F, layer, layer == 1);
        SEAM(pb + 4);
        if (layer == 0) {
            if (KON(7) && IN(pb + 5)) for (int rp = NREP(7); rp > 0; --rp) {
                REFRESH(F);
                pg8::SchedPlain S; S.init(M / 256, 2 * FFD / 256, NWG, (int)blockIdx.x); S.Bt = (const char*)(F.ws + WS_WFGU); S.tstep = (size_t)256 * 1024 * 2;
                EpiSwiGLU8 E{F.ws + WS_FH, FFD, MOE_HID_SC};
                pg8::gemm_phase(F.lds, F.wave0, (const char*)(F.ws + WS_HB), 2 * 1024, S, E);
            }
            SEAM(pb + 5);
            if (KON(8) && IN(pb + 6)) for (int rp = NREP(8); rp > 0; --rp) {
                REFRESH(F);
                pg8::SchedPlain S; S.init(M / 256, 4, NWG, (int)blockIdx.x); S.Bt = (const char*)(F.ws + WS_WFD); S.tstep = (size_t)256 * FFD;
                EpiPlain E{(bf16*)(F.ws + WS_HB), 1024, 0};
                pg8::gemm_phase<EpiPlain, pg8::SchedPlain, true>(F.lds, F.wave0, (const char*)(F.ws + WS_FH), FFD, S, E, E8_WD, E8_HID);
            }
            SEAM(pb + 6);
            if (KON(9) && IN(pb + 7)) phase_postffn(F, 0, false);
            SEAM(pb + 7);
        } else {
            if (KON(10) && IN(PH_MOE_INDEX)) for (int rp = NREP(10); rp > 0; --rp) phase_moe_index(F);
            SEAM(PH_MOE_INDEX);
            for (int rp14 = NREP(14); rp14 > 0; --rp14)
            for (int c = 0; c < NCHUNK; ++c) {
                const int pg = PH_MOE_CHUNK0 + 2 * c;
                if (IN(pg) || IN(pg + 1)) {
                    REFRESH(F);
                    int ts[9], cnt[8]; moe_tiles(F, ts, cnt);
                    const int tile0 = CHUNK_TILES * c; int nt = ts[8] - tile0; nt = nt > CHUNK_TILES ? CHUNK_TILES : nt;
                    if (KON(11) && IN(pg) && nt > 0) for (int rp = NREP(11); rp > 0; --rp) {
                        pg8::SchedMoe<true> S; S.init(nt, 2 * FFE / 256, NWG, (int)blockIdx.x); S.Bt = (const char*)(F.ws + WS_WMGU); S.tstep = (size_t)256 * 1024; S.estride = (size_t)2 * FFE * 1024;
                        S.tile0 = tile0; S.s2t = (const int*)(F.ws + WS_S2T);
#pragma unroll
                        for (int k = 0; k < 7; ++k) S.ts[k] = ts[k + 1];
                        { LAS int* tab = (LAS int*)(F.lds + LDSX_OFF + 1024); S.tab = tab;
                          pg8::StaticOrder so; so.init(nt, 2 * FFE / 256, NWG, (int)blockIdx.x); const int* s2t = (const int*)(F.ws + WS_S2T);
#pragma unroll 1
                          for (int i = 0; i < 8; ++i) { pg8::Unit u; const bool ok = so.next(i, u); if (ok && F.tid < 256) tab[i * 256 + F.tid] = s2t[(size_t)(tile0 + u.pm) * 256 + F.tid]; }
                          __syncthreads(); }
                        EpiSwiGLU8 E{F.ws + WS_HID, FFE, MOE_HID_SC};
                        pg8::gemm_phase<EpiSwiGLU8, pg8::SchedMoe<true>, true>(F.lds, F.wave0, (const char*)(F.ws + WS_HB), 1024, S, E, E8_WGU, E8_ONE);
                    }
                    SEAM(pg);
                    if (KON(12) && IN(pg + 1) && nt > 0) for (int rp = NREP(12); rp > 0; --rp) {
                        pg8::SchedMoe<false> S; S.init(nt, 4, NWG, (int)blockIdx.x); S.Bt = (const char*)(F.ws + WS_WMD); S.tstep = (size_t)256 * FFE; S.estride = (size_t)1024 * FFE;
                        S.tile0 = tile0; S.s2t = nullptr; S.tab = nullptr;
#pragma unroll
                        for (int k = 0; k < 7; ++k) S.ts[k] = ts[k + 1];
                        EpiPlain E{(bf16*)(F.ws + WS_YS), 1024, tile0 * 256};
                        pg8::gemm_phase<EpiPlain, pg8::SchedMoe<false>, true>(F.lds, F.wave0, (const char*)(F.ws + WS_HID), FFE, S, E, E8_WD, E8_HID);
                    }
                    SEAM(pg + 1);
                }
            }
            if (KON(13) && IN(PH_POSTFFN1)) phase_postffn(F, 1, true);
        }
    }
#undef IN
#undef SEAM
}

extern "C" void kernel_launch(void* const* d_in, const int* in_sizes, int n_in, void* d_out, int out_size, void* d_ws, size_t ws_size, hipStream_t stream) {
    static int grid = 0;
    if (grid == 0) {
        if (n_in != 26 || out_size != M * D || ws_size < WS_END) { fprintf(stderr, "kernel_launch: unexpected problem: n_in %d out %d ws %zu (need %zu)\n", n_in, out_size, ws_size, (size_t)WS_END); grid = -1; return; }
        int dev = 0, cus = 0, per_cu = 0;
        if (hipGetDevice(&dev) != hipSuccess || hipDeviceGetAttribute(&cus, hipDeviceAttributeMultiprocessorCount, dev) != hipSuccess) { grid = -1; return; }
        if (hipFuncSetAttribute((const void*)fwd_kernel, hipFuncAttributeMaxDynamicSharedMemorySize, LDS_BYTES) != hipSuccess) { fprintf(stderr, "kernel_launch: hipFuncSetAttribute failed\n"); grid = -1; return; }
        if (hipOccupancyMaxActiveBlocksPerMultiprocessor(&per_cu, (const void*)fwd_kernel, 512, LDS_BYTES) != hipSuccess || per_cu < 1) fprintf(stderr, "kernel_launch: occupancy query says %d\n", per_cu);
        (void)hipGetLastError();
        if (cus != NWG) { fprintf(stderr, "kernel_launch: built for a %d-CU device, found %d\n", NWG, cus); grid = -1; return; }
        grid = NWG;
        fprintf(stderr, "kernel_launch: grid %d, ws %zu\n", grid, ws_size);
    }
    if (grid < 0) return;
    (void)hipMemsetAsync((char*)d_ws + WS_CTL, 0, CTL_ZERO_BYTES, stream);
    Args a{};
    for (int i = 0; i < 26; ++i) a.in[i] = d_in[i];
    a.out = (float*)d_out; a.ws = (unsigned char*)d_ws;
#if MK_ONE_LAUNCH
    a.ph_lo = 0; a.ph_hi = N_PHASES;
    hipLaunchKernelGGL(fwd_kernel, dim3(grid), dim3(512), LDS_BYTES, stream, a);
#else
    for (int p = 0; p < N_PHASES; ++p) { a.ph_lo = p; a.ph_hi = p + 1; hipLaunchKernelGGL(fwd_kernel, dim3(grid), dim3(512), LDS_BYTES, stream, a); }
#endif
}
```

```cpp
#include <hip/hip_runtime.h>
#include <cstdio>
#include <cstdint>

#ifndef REPK
#define REPK -1
#endif
#ifndef MK_ONE_LAUNCH
#define MK_ONE_LAUNCH 1
#endif

#define GAS __attribute__((address_space(1)))
#define LAS __attribute__((address_space(3)))
typedef unsigned short bf16;
typedef short bf16x8 __attribute__((ext_vector_type(8)));
typedef float f32x4 __attribute__((ext_vector_type(4)));
typedef float f32x16 __attribute__((ext_vector_type(16)));
typedef unsigned u32x4 __attribute__((ext_vector_type(4)));
typedef unsigned u32x2 __attribute__((ext_vector_type(2)));
typedef float f32x2_t __attribute__((ext_vector_type(2)));
typedef __bf16 bf16x2_t __attribute__((ext_vector_type(2)));
typedef short v4i16_t __attribute__((ext_vector_type(4)));
typedef GAS unsigned gu32;

constexpr int BATCH = 16, SEQ = 2048, D = 1024, M = BATCH * SEQ;
constexpr int NIN = 2560, PW = 2304;
constexpr int FFD = 2816, FFE = 3584, NEXP = 8;
constexpr float EPS = 1e-6f;
constexpr int NWG = 256;
constexpr float C2 = 0.125f * 1.4426950408889634f;
constexpr int P_QA = 0, P_KA = 256, P_VA = 512, P_QB = 768, P_KB = 1024, P_VB = 1280, P_GU = 1536, P_GV = 1792, P_GLU = 2048;
constexpr int MOE_TILES_MAX = 264, CHUNK_TILES = 64, NCHUNK = 5;
constexpr float MOE_WGU_SC = 32.f, MOE_WD_SC = 64.f, MOE_HID_SC = 4.f;
constexpr int E8_WGU = 0x7a7a7a7a, E8_WD = 0x79797979, E8_HID = 0x7d7d7d7d, E8_ONE = 0x7f7f7f7f;

__device__ __forceinline__ unsigned cvtpk(float lo, float hi) { f32x2_t v = {lo, hi}; bf16x2_t b = __builtin_convertvector(v, bf16x2_t); return __builtin_bit_cast(unsigned, b); }
__device__ __forceinline__ unsigned pk4_fp8(float a, float b, float c, float d) {
    a = __builtin_amdgcn_fmed3f(a, -448.f, 448.f); b = __builtin_amdgcn_fmed3f(b, -448.f, 448.f); c = __builtin_amdgcn_fmed3f(c, -448.f, 448.f); d = __builtin_amdgcn_fmed3f(d, -448.f, 448.f);
    int p = __builtin_amdgcn_cvt_pk_fp8_f32(a, b, 0, false); p = __builtin_amdgcn_cvt_pk_fp8_f32(c, d, p, true); return (unsigned)p; }
__device__ __forceinline__ float bf2f(unsigned short b) { return __uint_as_float((unsigned)b << 16); }
__device__ __forceinline__ float bflo(unsigned w) { return __uint_as_float(w << 16); }
__device__ __forceinline__ float bfhi(unsigned w) { return __uint_as_float(w & 0xffff0000u); }
__device__ __forceinline__ float fast_exp2(float x) { return __builtin_amdgcn_exp2f(x); }
__device__ __forceinline__ float fast_rcp(float x) { return __builtin_amdgcn_rcpf(x); }
__device__ __forceinline__ float sigmoidf_(float x) { return fast_rcp(1.0f + fast_exp2(-1.4426950408889634f * x)); }
__device__ __forceinline__ float siluf_(float x) { return x * sigmoidf_(x); }
__device__ __forceinline__ float gelu_tanh(float x) { const float u = x + 0.044715f * x * x * x; return x * fast_rcp(1.0f + fast_exp2(-2.3022081982f * u)); }
__device__ __forceinline__ int lane_id() { int l; asm volatile("v_mbcnt_lo_u32_b32 %0, -1, 0\n\tv_mbcnt_hi_u32_b32 %0, -1, %0" : "=v"(l)); return l; }
template <int CTRL> __device__ __forceinline__ float dpp_f(float v) { return __builtin_bit_cast(float, __builtin_amdgcn_update_dpp(0, __builtin_bit_cast(int, v), CTRL, 0xf, 0xf, false)); }
__device__ __forceinline__ float sum16(float v) {
    v += dpp_f<0xB1>(v); v += dpp_f<0x4E>(v); v += dpp_f<0x141>(v); v += dpp_f<0x140>(v); return v; }
__device__ __forceinline__ float pair16_sum(float v) { const auto r = __builtin_amdgcn_permlane16_swap(__float_as_uint(v), __float_as_uint(v), false, false); return __uint_as_float(r[0]) + __uint_as_float(r[1]); }
__device__ __forceinline__ float pair32_sum(float v) { const auto r = __builtin_amdgcn_permlane32_swap(__float_as_uint(v), __float_as_uint(v), false, false); return __uint_as_float(r[0]) + __uint_as_float(r[1]); }
__device__ __forceinline__ float pair32_max(float v) { const auto r = __builtin_amdgcn_permlane32_swap(__float_as_uint(v), __float_as_uint(v), false, false); return fmaxf(__uint_as_float(r[0]), __uint_as_float(r[1])); }
__device__ __forceinline__ float pair32_other(float v, int h) { const auto r = __builtin_amdgcn_permlane32_swap(__float_as_uint(v), __float_as_uint(v), false, false); return __uint_as_float(h ? r[0] : r[1]); }
__device__ __forceinline__ float wave_sum(float v) { return pair32_sum(pair16_sum(sum16(v))); }

namespace pg8 {
constexpr int BM = 256, BK = 64, HALF = 128, HTB = HALF * BK * 2, STAGE_BYTES = 8 * HTB, NXCD = 8, WGM = 8;
__host__ __device__ __forceinline__ int lds_byte(int r, int c) { const int st = (r >> 4) * 2 + (c >> 5), rr = r & 15, cc = c & 31, ob = rr * 64 + cc * 2; return st * 1024 + (ob ^ (((ob >> 9) & 1) << 5)); }
__host__ __device__ __forceinline__ void stage_rc(int b, int& R, int& C) { const int st = b / 1024, sb = b % 1024, swz = sb ^ (((sb >> 9) & 1) << 5); R = (st >> 1) * 16 + swz / 64; C = (st & 1) * 32 + (swz % 64) / 2; }
__host__ __device__ __forceinline__ int perm32(int rho) { const int n = rho >> 4, i = rho & 15; return 8 * (i >> 2) + 4 * n + (i & 3); }

struct Unit { int pm, pn; };
struct StaticOrder {
    int nM, nN, nwg, G, c;
    __device__ __forceinline__ void init(int nM_, int nN_, int G_, int c_) { nM = nM_; nN = nN_; nwg = nM * nN; G = G_; c = c_; }
    __device__ __forceinline__ bool next(int i, Unit& u) const {
        const long L = (long)i * G + c; if (L >= nwg) return false;
        int wgid = (int)L; { const int q = nwg / NXCD, r = nwg % NXCD, xcd = wgid % NXCD, off = wgid / NXCD; wgid = (xcd < r ? xcd * (q + 1) : r * (q + 1) + (xcd - r) * q) + off; }
        const int nig = WGM * nN, gid = wgid / nig, fm = gid * WGM, gsz = (nM - fm) < WGM ? (nM - fm) : WGM;
        u.pm = fm + ((wgid % nig) % gsz); u.pn = (wgid % nig) / gsz; return true;
    }
};
struct SchedPlain : StaticOrder {
    static constexpr bool GATHER = false;
    const char* Bt; size_t tstep;
    __device__ __forceinline__ int arow(const Unit& u, int rr) const { return u.pm * BM + rr; }
    __device__ __forceinline__ const char* bptr(const Unit& u) const { return Bt + (size_t)u.pn * tstep; }
};
template <bool GATHER_> struct SchedMoe : StaticOrder {
    static constexpr bool GATHER = GATHER_;
    const char* Bt; size_t tstep, estride; int tile0; const int* s2t; int ts[7];
    __device__ __forceinline__ int expert(int pmg) const { int e = 0;
#pragma unroll
        for (int k = 0; k < 7; ++k) e += (pmg >= ts[k]) ? 1 : 0;
        return e; }
    __device__ __forceinline__ int arow(const Unit& u, int rr) const { return u.pm * BM + rr; }
    const LAS int* tab;
    __device__ __forceinline__ u32x4 arow4(int ui, int R0) const { return *(const LAS u32x4*)(tab + ui * 256 + R0 * 4); }
    __device__ __forceinline__ const char* bptr(const Unit& u) const { return Bt + (size_t)expert(tile0 + u.pm) * estride + (size_t)u.pn * tstep; }
};

typedef int v8i32 __attribute__((ext_vector_type(8)));
template <class Epi, class Sched, bool FP8 = false>
__device__ __forceinline__ void gemm_phase(LAS unsigned char* lds, const int wave0, const char* Abase, const int KB, const Sched& S, const Epi& E, const int sW = 0x7f7f7f7f, const int sX = 0x7f7f7f7f) {
    int tid = wave0 * 64 + lane_id(); asm volatile("" : "+v"(tid)); const int wid = __builtin_amdgcn_readfirstlane(tid >> 6), lane = tid & 63, wr = wid >> 2, wc = wid & 3, fr = lane & 15, fq = lane >> 4;
    const int nt = KB / 128;
    int R0, C0; stage_rc(tid * 16, R0, C0);
    const unsigned voffA = (unsigned)(R0 * KB + C0 * 2), voffB = (unsigned)(((R0 & ~31) + perm32(R0 & 31)) * KB + C0 * 2);
    const size_t kstep = (size_t)(BK * 2);
    const size_t hstep = (size_t)HALF * KB;
    const unsigned rowb = (unsigned)KB, colb = (unsigned)C0 * 2u;
    const size_t q64 = (size_t)64 * KB;
    const unsigned ldsw = (unsigned)wid * 1024u;
    const int aoff = lds_byte(wr * 64 + fr, fq * 8), boff = lds_byte(wc * 32 + fr, fq * 8);
#define PG8_SA(b, h) (((b) * 2 + (h)) * HTB)
#define PG8_SB(b, h) ((4 + (b) * 2 + (h)) * HTB)
#define PG8_GLDS(gp, bufoff, i) __builtin_amdgcn_global_load_lds((const unsigned*)(gp), (LAS unsigned*)(lds + (bufoff) + ldsw + (i) * 8192), 16, 0, 0)
#define PG8_STAGE_B(bufoff, gbase) do { PG8_GLDS((const char*)(gbase) + voffB, bufoff, 0); PG8_GLDS((const char*)(gbase) + q64 + voffB, bufoff, 1); } while (0)
#define PG8_STAGE_A(bufoff, h, kb, NX) do { \
        if constexpr (Sched::GATHER) { const unsigned _o0 = (NX) ? ((h) ? n2 : n0) : ((h) ? va2 : va0), _o1 = (NX) ? ((h) ? n3 : n1) : ((h) ? va3 : va1); \
            PG8_GLDS(Abase + (kb) + _o0, bufoff, 0); PG8_GLDS(Abase + (kb) + _o1, bufoff, 1); } \
        else { const char* _b = ((NX) ? nA : cA) + (size_t)(h) * hstep + (kb); PG8_GLDS(_b + voffA, bufoff, 0); PG8_GLDS(_b + q64 + voffA, bufoff, 1); } } while (0)
#define PG8_LDA(dst, b, h) do { _Pragma("unroll") for (int m = 0; m < 4; ++m) _Pragma("unroll") for (int k = 0; k < 2; ++k) dst[m][k] = *(const LAS bf16x8*)(lds + PG8_SA(b, h) + aoff + m * 2048 + k * 1024); } while (0)
#define PG8_LDB(dst, b, h) do { _Pragma("unroll") for (int n = 0; n < 2; ++n) _Pragma("unroll") for (int k = 0; k < 2; ++k) dst[n][k] = *(const LAS bf16x8*)(lds + PG8_SB(b, h) + boff + n * 2048 + k * 1024); } while (0)
#define PG8_CAT(x, y) __builtin_shufflevector(__builtin_bit_cast(u32x4, x), __builtin_bit_cast(u32x4, y), 0, 1, 2, 3, 4, 5, 6, 7)
#define PG8_MMA(ai, bj, At, Bt) do { __builtin_amdgcn_s_setprio(1); \
        if constexpr (FP8) { _Pragma("unroll") for (int m = 0; m < 4; ++m) _Pragma("unroll") for (int n = 0; n < 2; ++n) { \
            const v8i32 b8_ = __builtin_bit_cast(v8i32, PG8_CAT(Bt[n][0], Bt[n][1])), a8_ = __builtin_bit_cast(v8i32, PG8_CAT(At[m][0], At[m][1])); \
            asm volatile("s_nop 1\n\tv_mfma_scale_f32_16x16x128_f8f6f4 %0, %1, %2, %0, %3, %4 op_sel_hi:[0,0,0]" : "+v"(acc[ai][bj][m][n]) : "v"(b8_), "v"(a8_), "v"(sW), "v"(sX)); } } \
        else { _Pragma("unroll") for (int m = 0; m < 4; ++m) _Pragma("unroll") for (int n = 0; n < 2; ++n) _Pragma("unroll") for (int k = 0; k < 2; ++k) \
            acc[ai][bj][m][n] = __builtin_amdgcn_mfma_f32_16x16x32_bf16(Bt[n][k], At[m][k], acc[ai][bj][m][n], 0, 0, 0); } \
        __builtin_amdgcn_s_setprio(0); } while (0)
#define PG8_WAIT_V(n) asm volatile("s_waitcnt vmcnt(" #n ")" ::: "memory")
#define PG8_WAIT_L(n) asm volatile("s_waitcnt lgkmcnt(" #n ")" ::: "memory")
#define PG8_BAR __builtin_amdgcn_s_barrier()
#define PG8_SCHED __builtin_amdgcn_sched_barrier(0)
    Unit cur, nxt; int ui = 0;
    if (!S.next(0, cur)) return;
#define PG8_PIN8(a, b) asm volatile("" : "+v"(acc[a][b][0][0]), "+v"(acc[a][b][0][1]), "+v"(acc[a][b][1][0]), "+v"(acc[a][b][1][1]), "+v"(acc[a][b][2][0]), "+v"(acc[a][b][2][1]), "+v"(acc[a][b][3][0]), "+v"(acc[a][b][3][1]))
#define PG8_PINACC() do { PG8_PIN8(0, 0); PG8_PIN8(0, 1); PG8_PIN8(1, 0); PG8_PIN8(1, 1); } while (0)
    f32x4 acc[2][2][4][2];
#pragma unroll
    for (int a = 0; a < 2; ++a)
#pragma unroll
        for (int b = 0; b < 2; ++b)
#pragma unroll
            for (int m = 0; m < 4; ++m)
#pragma unroll
                for (int n = 0; n < 2; ++n) acc[a][b][m][n] = (f32x4){0.f, 0.f, 0.f, 0.f};
    PG8_PINACC();
    bf16x8 At[4][2], B0[2][2], B1[2][2];
    unsigned va0 = 0, va1 = 0, va2 = 0, va3 = 0, na0 = 0, na1 = 0, na2 = 0, na3 = 0;
    const char* cA = Abase; const char* nA = Abase;
    if constexpr (Sched::GATHER) { const u32x4 ci = S.arow4(0, R0); va0 = ci.x * rowb + colb; va1 = ci.y * rowb + colb; va2 = ci.z * rowb + colb; va3 = ci.w * rowb + colb; }
    else cA = Abase + (size_t)S.arow(cur, 0) * rowb;
    const char* cB = S.bptr(cur);
    { const unsigned n0 = 0, n1 = 0, n2 = 0, n3 = 0; (void)n0; (void)n1; (void)n2; (void)n3;
    PG8_STAGE_B(PG8_SB(0, 0), cB); PG8_STAGE_B(PG8_SB(0, 1), cB + hstep); PG8_STAGE_A(PG8_SA(0, 0), 0, 0, false); PG8_STAGE_A(PG8_SA(0, 1), 1, 0, false);
    if (wr == 1) PG8_BAR;
    PG8_WAIT_V(2); PG8_BAR;
    PG8_STAGE_B(PG8_SB(1, 0), cB + kstep); PG8_STAGE_A(PG8_SA(1, 0), 0, kstep, false); PG8_STAGE_B(PG8_SB(1, 1), cB + hstep + kstep);
    PG8_WAIT_V(6); PG8_BAR; }
    for (;;) {
        const bool has_next = S.next(ui + 1, nxt);
        const char* nB = has_next ? S.bptr(nxt) : cB;
        if constexpr (Sched::GATHER) {
            { const u32x4 ni = S.arow4(has_next ? ui + 1 : ui, R0); na0 = ni.x * rowb + colb; na1 = ni.y * rowb + colb; na2 = ni.z * rowb + colb; na3 = ni.w * rowb + colb; }
        } else nA = has_next ? Abase + (size_t)S.arow(nxt, 0) * rowb : cA;
        for (int t = 0; t < nt; t += 2) {
            const bool last = (t == nt - 2);
            const size_t k1 = (size_t)(t + 1) * kstep, k2 = last ? 0 : (size_t)(t + 2) * kstep, k3 = k2 + kstep;
            const char* b2 = last ? nB : cB + (size_t)(t + 2) * kstep; const char* b3 = b2 + kstep;
            const unsigned n0 = last ? na0 : va0, n1 = last ? na1 : va1, n2 = last ? na2 : va2, n3 = last ? na3 : va3;
            PG8_LDB(B0, 0, 0); PG8_LDB(B1, 0, 1); PG8_SCHED; PG8_LDA(At, 0, 0); PG8_STAGE_A(PG8_SA(1, 1), 1, k1, false);
            PG8_WAIT_V(8); PG8_WAIT_L(0); PG8_BAR; PG8_MMA(0, 0, At, B0); PG8_MMA(0, 1, At, B1); PG8_BAR; PG8_SCHED;
            PG8_LDA(At, 0, 1); PG8_STAGE_B(PG8_SB(0, 0), b2); PG8_STAGE_B(PG8_SB(0, 1), b2 + hstep); PG8_STAGE_A(PG8_SA(0, 0), 0, k2, last);
            PG8_WAIT_V(8); PG8_WAIT_L(0); PG8_BAR; PG8_MMA(1, 0, At, B0); PG8_MMA(1, 1, At, B1); PG8_BAR; PG8_SCHED;
            PG8_LDB(B0, 1, 0); PG8_LDB(B1, 1, 1); PG8_SCHED; PG8_LDA(At, 1, 0); PG8_STAGE_A(PG8_SA(0, 1), 1, k2, last);
            PG8_WAIT_V(8); PG8_WAIT_L(0); PG8_BAR; PG8_MMA(0, 0, At, B0); PG8_MMA(0, 1, At, B1); PG8_BAR; PG8_SCHED;
            PG8_LDA(At, 1, 1); PG8_STAGE_B(PG8_SB(1, 0), b3); PG8_STAGE_B(PG8_SB(1, 1), b3 + hstep); PG8_STAGE_A(PG8_SA(1, 0), 0, k3, last);
            PG8_WAIT_V(8); PG8_WAIT_L(0); PG8_BAR; PG8_MMA(1, 0, At, B0); PG8_MMA(1, 1, At, B1); PG8_BAR; PG8_SCHED;
        }
        if (wr == 0) PG8_BAR;
        if constexpr (FP8) asm volatile("s_nop 15\n\ts_nop 15" ::: "memory");
        E(acc, cur, wr, wc, fr, fq);
        if (!has_next) break;
#pragma unroll
        for (int a = 0; a < 2; ++a)
#pragma unroll
            for (int b = 0; b < 2; ++b)
#pragma unroll
                for (int m = 0; m < 4; ++m)
#pragma unroll
                    for (int n = 0; n < 2; ++n) acc[a][b][m][n] = (f32x4){0.f, 0.f, 0.f, 0.f};
        PG8_PINACC();
        cur = nxt; cB = nB; cA = nA; ++ui;
        if constexpr (Sched::GATHER) { va0 = na0; va1 = na1; va2 = na2; va3 = na3; }
        if (wr == 1) PG8_BAR;
    }
    PG8_WAIT_V(0);
    PG8_BAR;
#undef PG8_SA
#undef PG8_SB
#undef PG8_GLDS
#undef PG8_STAGE_A
#undef PG8_STAGE_B
#undef PG8_LDA
#undef PG8_LDB
#undef PG8_MMA
#undef PG8_PIN8
#undef PG8_PINACC
#undef PG8_CAT
#undef PG8_WAIT_V
#undef PG8_WAIT_L
#undef PG8_BAR
#undef PG8_SCHED
}
}

struct EpiPlain {
    bf16* O; int ldc; int rowoff;
    __device__ __forceinline__ void operator()(const f32x4 (&acc)[2][2][4][2], const pg8::Unit& u, int wr, int wc, int fr, int fq) const {
        const int row0 = rowoff + u.pm * 256 + wr * 64 + fr, col0 = u.pn * 256 + wc * 32 + 8 * fq;
#pragma unroll
        for (int ai = 0; ai < 2; ++ai)
#pragma unroll
            for (int m = 0; m < 4; ++m) { bf16* rowp = O + (size_t)(row0 + ai * 128 + m * 16) * ldc + col0;
#pragma unroll
                for (int bj = 0; bj < 2; ++bj) { const f32x4 v0 = acc[ai][bj][m][0], v1 = acc[ai][bj][m][1];
                    u32x4 w; w.x = cvtpk(v0[0], v0[1]); w.y = cvtpk(v0[2], v0[3]); w.z = cvtpk(v1[0], v1[1]); w.w = cvtpk(v1[2], v1[3]);
                    *(u32x4*)(rowp + bj * 128) = w; } }
    }
};
struct EpiSwiGLU {
    bf16* O; int ldc;
    __device__ __forceinline__ void operator()(const f32x4 (&acc)[2][2][4][2], const pg8::Unit& u, int wr, int wc, int fr, int fq) const {
        const int row0 = u.pm * 256 + wr * 64 + fr, col0 = u.pn * 128 + wc * 32 + 8 * fq;
#pragma unroll
        for (int ai = 0; ai < 2; ++ai)
#pragma unroll
            for (int m = 0; m < 4; ++m) { bf16* rowp = O + (size_t)(row0 + ai * 128 + m * 16) * ldc + col0;
                float o[8];
#pragma unroll
                for (int n = 0; n < 2; ++n)
#pragma unroll
                    for (int e = 0; e < 4; ++e) o[4 * n + e] = siluf_(acc[ai][0][m][n][e]) * acc[ai][1][m][n][e];
                u32x4 w; w.x = cvtpk(o[0], o[1]); w.y = cvtpk(o[2], o[3]); w.z = cvtpk(o[4], o[5]); w.w = cvtpk(o[6], o[7]);
                *(u32x4*)rowp = w; }
    }
};
struct EpiSwiGLU8 {
    unsigned char* O; int ldc; float osc;
    __device__ __forceinline__ void operator()(const f32x4 (&acc)[2][2][4][2], const pg8::Unit& u, int wr, int wc, int fr, int fq) const {
        const int row0 = u.pm * 256 + wr * 64 + fr, col0 = u.pn * 128 + wc * 32 + 8 * fq;
#pragma unroll
        for (int ai = 0; ai < 2; ++ai)
#pragma unroll
            for (int m = 0; m < 4; ++m) { unsigned char* rowp = O + (size_t)(row0 + ai * 128 + m * 16) * ldc + col0;
                float o[8];
#pragma unroll
                for (int n = 0; n < 2; ++n)
#pragma unroll
                    for (int e = 0; e < 4; ++e) o[4 * n + e] = osc * siluf_(acc[ai][0][m][n][e]) * acc[ai][1][m][n][e];
                u32x2 w; w.x = pk4_fp8(o[0], o[1], o[2], o[3]); w.y = pk4_fp8(o[4], o[5], o[6], o[7]);
                *(u32x2*)rowp = w; }
    }
};
struct EpiInProj {
    bf16* P; const int* pos; float* kmsum;
    __device__ __forceinline__ void operator()(const f32x4 (&acc)[2][2][4][2], const pg8::Unit& u, int wr, int wc, int fr, int fq) const {
        const int pn = u.pn, row0 = u.pm * 256 + wr * 64 + fr;
        if (pn == 0 || pn == 1 || pn == 3 || pn == 4) {
            const int g = wc & 1, i0 = 16 * g + 4 * fq;
            float invf[4];
#pragma unroll
            for (int e = 0; e < 4; ++e) invf[e] = fast_exp2(-(float)(i0 + e) * 0.4152410118609203f);
            const float sc = (pn == 0 || pn == 3) ? C2 : 1.0f;
            float ks[2][2][4];
#pragma unroll
            for (int a = 0; a < 2; ++a)
#pragma unroll
                for (int b = 0; b < 2; ++b)
#pragma unroll
                    for (int e = 0; e < 4; ++e) ks[a][b][e] = 0.f;
#pragma unroll
            for (int ai = 0; ai < 2; ++ai)
#pragma unroll
                for (int m = 0; m < 4; ++m) { const int row = row0 + ai * 128 + m * 16; const float p = (float)pos[row];
                    float cs[4], sn[4];
#pragma unroll
                    for (int e = 0; e < 4; ++e) { const float ang = p * invf[e]; const float k = rintf(ang * 0.15915494309189535f);
                        float r = fmaf(-k, 6.2831854820251465f, ang); r = fmaf(-k, -1.7484556000744883e-07f, r); const float rev = r * 0.15915494309189535f;
                        cs[e] = __builtin_amdgcn_cosf(rev); sn[e] = __builtin_amdgcn_sinf(rev); }
                    bf16* rowp = P + (size_t)row * PW + 256 * pn;
#pragma unroll
                    for (int bj = 0; bj < 2; ++bj) { const int hh = 2 * bj + (wc >> 1); const f32x4 v0 = acc[ai][bj][m][0], v1 = acc[ai][bj][m][1];
                        float o0[4], o1[4];
#pragma unroll
                        for (int e = 0; e < 4; ++e) { o0[e] = (v0[e] * cs[e] - v1[e] * sn[e]) * sc; o1[e] = (v1[e] * cs[e] + v0[e] * sn[e]) * sc; ks[bj][0][e] += o0[e]; ks[bj][1][e] += o1[e]; }
                        bf16* dst = rowp + 64 * hh + i0;
                        u32x2 w0, w1; w0.x = cvtpk(o0[0], o0[1]); w0.y = cvtpk(o0[2], o0[3]); w1.x = cvtpk(o1[0], o1[1]); w1.y = cvtpk(o1[2], o1[3]);
                        *(u32x2*)dst = w0; *(u32x2*)(dst + 32) = w1; } }
            if (pn == 1) {
#pragma unroll
                for (int bj = 0; bj < 2; ++bj)
#pragma unroll
                    for (int n = 0; n < 2; ++n)
#pragma unroll
                        for (int e = 0; e < 4; ++e) { const float v = sum16(ks[bj][n][e]);
                            if (fr == 0) atomicAdd(kmsum + (size_t)(u.pm * 4 + 2 * bj + (wc >> 1)) * 64 + 32 * n + i0 + e, v); }
            }
        } else if (pn >= 8) {
            const int col0 = P_GLU + 128 * (pn - 8) + wc * 32 + 8 * fq;
#pragma unroll
            for (int ai = 0; ai < 2; ++ai)
#pragma unroll
                for (int m = 0; m < 4; ++m) { bf16* rowp = P + (size_t)(row0 + ai * 128 + m * 16) * PW + col0;
                    float o[8];
#pragma unroll
                    for (int n = 0; n < 2; ++n)
#pragma unroll
                        for (int e = 0; e < 4; ++e) o[4 * n + e] = acc[ai][0][m][n][e] * sigmoidf_(acc[ai][1][m][n][e]);
                    u32x4 w; w.x = cvtpk(o[0], o[1]); w.y = cvtpk(o[2], o[3]); w.z = cvtpk(o[4], o[5]); w.w = cvtpk(o[6], o[7]);
                    *(u32x4*)rowp = w; }
        } else {
            const bool act = (pn >= 6);
            const int col0 = 256 * pn + wc * 32 + 8 * fq;
#pragma unroll
            for (int ai = 0; ai < 2; ++ai)
#pragma unroll
                for (int m = 0; m < 4; ++m) { bf16* rowp = P + (size_t)(row0 + ai * 128 + m * 16) * PW + col0;
#pragma unroll
                    for (int bj = 0; bj < 2; ++bj) { float o[8];
#pragma unroll
                        for (int n = 0; n < 2; ++n)
#pragma unroll
                            for (int e = 0; e < 4; ++e) { const float v = acc[ai][bj][m][n][e]; o[4 * n + e] = act ? gelu_tanh(v) : v; }
                        u32x4 w; w.x = cvtpk(o[0], o[1]); w.y = cvtpk(o[2], o[3]); w.z = cvtpk(o[4], o[5]); w.w = cvtpk(o[6], o[7]);
                        *(u32x4*)(rowp + bj * 128) = w; } }
        }
    }
};

#define MFMA32(a, b, c) __builtin_amdgcn_mfma_f32_32x32x16_bf16((a), (b), (c), 0, 0, 0)
__device__ __forceinline__ int crow(int i, int h) { return (i & 3) + 8 * (i >> 2) + 4 * h; }
__device__ __forceinline__ v4i16_t vtr(const LAS char* p) { return __builtin_amdgcn_ds_read_tr16_b64_v4i16((LAS v4i16_t*)p); }

__device__ __forceinline__ void attn_tile(f32x16& o0, f32x16& o1, float& m, float& l, const bf16x8 (&qf)[4], const bf16* kp, const bf16* vp, size_t v8,
                                          LAS char* vt, int lane, unsigned vmask) {
    const int h = lane >> 5;
    bf16x8 kf[4];
#pragma unroll
    for (int s = 0; s < 4; ++s) kf[s] = *(const bf16x8*)(kp + 16 * s);
    u32x4 vv[4];
#pragma unroll
    for (int w = 0; w < 4; ++w) vv[w] = *(const u32x4*)(vp + (size_t)w * v8);
    f32x16 p;
#pragma unroll
    for (int i = 0; i < 16; ++i) p[i] = 0.f;
#pragma unroll
    for (int s = 0; s < 4; ++s) p = MFMA32(kf[s], qf[s], p);
    { const int piece = lane & 7, key0 = lane >> 3;
#pragma unroll
      for (int w = 0; w < 4; ++w) *(LAS u32x4*)(vt + (2 * w + (piece >> 2)) * 512 + key0 * 64 + (piece & 3) * 16) = vv[w]; }
    float tm = -INFINITY;
#pragma unroll
    for (int i = 0; i < 16; ++i) { p[i] = ((vmask >> i) & 1u) ? p[i] : -INFINITY; tm = fmaxf(tm, p[i]); }
    tm = pair32_max(tm);
    const float mn = fmaxf(m, tm), alpha = fast_exp2(m - mn); m = mn;
    float rs = 0.f;
#pragma unroll
    for (int i = 0; i < 16; ++i) { p[i] = fast_exp2(p[i] - mn); rs += p[i]; }
    l = l * alpha + rs;
#pragma unroll
    for (int i = 0; i < 16; ++i) { o0[i] *= alpha; o1[i] *= alpha; }
    u32x4 w0, w1;
    w0.x = cvtpk(p[0], p[1]); w0.y = cvtpk(p[2], p[3]); w0.z = cvtpk(p[4], p[5]); w0.w = cvtpk(p[6], p[7]);
    w1.x = cvtpk(p[8], p[9]); w1.y = cvtpk(p[10], p[11]); w1.z = cvtpk(p[12], p[13]); w1.w = cvtpk(p[14], p[15]);
    const bf16x8 pf0 = __builtin_bit_cast(bf16x8, w0), pf1 = __builtin_bit_cast(bf16x8, w1);
    const LAS char* vb = vt + (4 * h + ((lane & 15) >> 2)) * 64 + ((lane >> 4) & 1) * 32 + (lane & 3) * 8;
#pragma unroll
    for (int s2 = 0; s2 < 2; ++s2) {
        const v4i16_t a0 = vtr(vb + (4 * s2 + 0) * 512), a1 = vtr(vb + (4 * s2 + 2) * 512);
        const v4i16_t b0 = vtr(vb + (4 * s2 + 1) * 512), b1 = vtr(vb + (4 * s2 + 3) * 512);
        const bf16x8 vf0 = (bf16x8){a0[0], a0[1], a0[2], a0[3], a1[0], a1[1], a1[2], a1[3]};
        const bf16x8 vf1 = (bf16x8){b0[0], b0[1], b0[2], b0[3], b1[0], b1[1], b1[2], b1[3]};
        o0 = MFMA32(vf0, s2 ? pf1 : pf0, o0);
        o1 = MFMA32(vf1, s2 ? pf1 : pf0, o1);
    }
}
__device__ __forceinline__ void attn_store(const f32x16& o0, const f32x16& o1, float inv, bf16* dst, int h) {
#pragma unroll
    for (int g = 0; g < 4; ++g) {
        u32x2 a, b; a.x = cvtpk(o0[4 * g] * inv, o0[4 * g + 1] * inv); a.y = cvtpk(o0[4 * g + 2] * inv, o0[4 * g + 3] * inv);
        b.x = cvtpk(o1[4 * g] * inv, o1[4 * g + 1] * inv); b.y = cvtpk(o1[4 * g + 2] * inv, o1[4 * g + 3] * inv);
        *(u32x2*)(dst + 8 * g + 4 * h) = a; *(u32x2*)(dst + 32 + 8 * g + 4 * h) = b; }
}
__device__ __forceinline__ void moba_item(const bf16* P, const float* kmsum, bf16* OA, int b, int hh, int qt, LAS char* vt, int lane) {
    const int r = lane & 31, h = lane >> 5, j = qt >> 3;
    const bf16* Pb = P + (size_t)b * SEQ * PW;
    const bf16* qp = Pb + (size_t)(32 * qt + r) * PW + P_QA + 64 * hh + 8 * h;
    bf16x8 qf[4];
#pragma unroll
    for (int s = 0; s < 4; ++s) qf[s] = *(const bf16x8*)(qp + 16 * s);
    unsigned sel = (1u << j) - 1u;
    if (j > 3) {
        f32x16 g;
#pragma unroll
        for (int i = 0; i < 16; ++i) g[i] = 0.f;
        const float* kmr = kmsum + (size_t)((b * 8 + (r & 7)) * 4 + hh) * 64 + 8 * h;
#pragma unroll
        for (int s = 0; s < 4; ++s) {
            f32x4 a = (f32x4){0.f, 0.f, 0.f, 0.f}, c = a;
            if (r < j) { a = *(const f32x4*)(kmr + 16 * s); c = *(const f32x4*)(kmr + 16 * s + 4); }
            float v[8] = {a[0], a[1], a[2], a[3], c[0], c[1], c[2], c[3]}; unsigned hi[4], lo[4];
#pragma unroll
            for (int e = 0; e < 4; ++e) { hi[e] = cvtpk(v[2 * e], v[2 * e + 1]); lo[e] = cvtpk(v[2 * e] - bflo(hi[e]), v[2 * e + 1] - bfhi(hi[e])); }
            const bf16x8 khi = __builtin_bit_cast(bf16x8, ((u32x4){hi[0], hi[1], hi[2], hi[3]})), klo = __builtin_bit_cast(bf16x8, ((u32x4){lo[0], lo[1], lo[2], lo[3]}));
            g = MFMA32(khi, qf[s], g); g = MFMA32(klo, qf[s], g);
        }
        float gate[8];
#pragma unroll
        for (int i = 0; i < 4; ++i) { const float o = pair32_other(g[i], h); gate[i] = h ? o : g[i]; gate[4 + i] = h ? g[i] : o; }
        sel = 0u;
#pragma unroll
        for (int k = 0; k < 3; ++k) { float best = -INFINITY; int bi = 0;
#pragma unroll
            for (int n = 0; n < 8; ++n) { const bool c = (n < j) && !((sel >> n) & 1u) && (gate[n] > best); best = c ? gate[n] : best; bi = c ? n : bi; }
            sel |= 1u << bi; }
    }
    f32x16 o0, o1;
#pragma unroll
    for (int i = 0; i < 16; ++i) { o0[i] = 0.f; o1[i] = 0.f; }
    float m = -1e30f, l = 0.f;
    for (int kt = 0; kt <= qt; ++kt) {
        const int n = kt >> 3; unsigned vmask = 0xffffu;
        if (n < j) { const bool on = (sel >> n) & 1u; if (!__any(on)) continue; vmask = on ? 0xffffu : 0u; }
        else if (kt == qt) { vmask = 0u;
#pragma unroll
            for (int i = 0; i < 16; ++i) vmask |= (crow(i, h) <= r) ? (1u << i) : 0u; }
        const bf16* kp = Pb + (size_t)(32 * kt + r) * PW + P_KA + 64 * hh + 8 * h;
        const bf16* vp = Pb + (size_t)(32 * kt + (lane >> 3)) * PW + P_VA + 64 * hh + 8 * (lane & 7);
        attn_tile(o0, o1, m, l, qf, kp, vp, (size_t)8 * PW, vt, lane, vmask);
    }
    l = pair32_sum(l);
    attn_store(o0, o1, fast_rcp(l), OA + (size_t)(b * SEQ + 32 * qt + r) * 256 + 64 * hh, h);
}
__device__ __forceinline__ void dil_item(const bf16* P, bf16* DO, float* LS, int cfg, int b, int hh, int idx, LAS char* vt, int lane) {
    const int r = lane & 31, h = lane >> 5, sh = 2 * cfg, dil = 1 << sh, tsh = 6 - sh;
    const int res = idx >> tsh, qt = idx & ((1 << tsh) - 1);
    const bf16* Pb = P + ((size_t)b * SEQ + res) * PW;
    const size_t rs = (size_t)dil * PW;
    const bf16* qp = Pb + (size_t)(32 * qt + r) * rs + P_QB + 64 * hh + 8 * h;
    bf16x8 qf[4];
#pragma unroll
    for (int s = 0; s < 4; ++s) qf[s] = *(const bf16x8*)(qp + 16 * s);
    f32x16 o0, o1;
#pragma unroll
    for (int i = 0; i < 16; ++i) { o0[i] = 0.f; o1[i] = 0.f; }
    float m = -1e30f, l = 0.f;
    for (int kt = (qt > 4 ? qt - 4 : 0); kt <= qt; ++kt) {
        unsigned vmask = 0u;
#pragma unroll
        for (int i = 0; i < 16; ++i) { const int dl = 32 * (qt - kt) + r - crow(i, h); vmask |= (dl >= 0 && dl <= 128) ? (1u << i) : 0u; }
        const bf16* kp = Pb + (size_t)(32 * kt + r) * rs + P_KB + 64 * hh + 8 * h;
        const bf16* vp = Pb + (size_t)(32 * kt + (lane >> 3)) * rs + P_VB + 64 * hh + 8 * (lane & 7);
        attn_tile(o0, o1, m, l, qf, kp, vp, 8 * rs, vt, lane, vmask);
    }
    l = pair32_sum(l);
    const size_t row = (size_t)b * SEQ + (size_t)(32 * qt + r) * dil + res;
    attn_store(o0, o1, fast_rcp(l), DO + row * 256 + 64 * hh, h);
    if (h == 0) LS[row * 4 + hh] = m + __builtin_amdgcn_logf(l);
}

#include <hip/hip_bf16.h>
#include <cmath>
namespace attn_body {
using bf16=__hip_bfloat16;
using bf16x8=__attribute__((ext_vector_type(8)))short;
using s16x4=__attribute__((ext_vector_type(4)))short;
using f32x16=__attribute__((ext_vector_type(16)))float;
using f32x4=__attribute__((ext_vector_type(4)))float;
using u32x4=__attribute__((ext_vector_type(4)))unsigned;
constexpr int SEQ=2048,D=64,DM=2304,OP=256;
constexpr int NW=8,QBLK=32,QB=QBLK*NW,KVBLK=64,NQB=SEQ/QB;
__device__ __forceinline__ int crow(int r,int hi){return (r&3)+8*(r>>2)+4*hi;}
#define SBAR() __builtin_amdgcn_sched_barrier(0)
__device__ __forceinline__ void cmask(f32x16&p0,f32x16&p1,int jb,int qrel,int hi){
  const float NEG=-INFINITY; int kb=64*jb+4*hi;
  #pragma unroll
  for(int r=0;r<16;++r){int kv=kb+(r&3)+8*(r>>2); if(kv>qrel)p0[r]=NEG; if(kv+32>qrel)p1[r]=NEG;}
}

constexpr int NSLOT=3, SLOTB=8192;
constexpr int LDS_K=0, LDS_V=NSLOT*SLOTB, LDS_WS=2*NSLOT*SLOTB, LDS_OST=LDS_WS+NW*64*4, LDS_BYTES=LDS_OST+NW*4096;
constexpr float C2=0.125f*1.4426950408889634f;
__device__ __forceinline__ void glds16(const void*gsrc,unsigned lds_dst){unsigned keep;
  asm volatile("s_mov_b32 %0, m0\n\ts_mov_b32 m0, %2\n\ts_nop 0\n\tglobal_load_lds_dwordx4 %1, off\n\ts_mov_b32 m0, %0":"=&s"(keep):"v"(gsrc),"s"(lds_dst):"memory");}
__device__ __forceinline__ float max3f(float a,float b,float c){float r;asm("v_max3_f32 %0, %1, %2, %3":"=v"(r):"v"(a),"v"(b),"v"(c));return r;}
__device__ __forceinline__ float max2f(float a,float b){float r;asm("v_max_f32_e32 %0, %1, %2":"=v"(r):"v"(a),"v"(b));return r;}
__device__ __forceinline__ float fadd_s(float a,float b){float r;asm("v_add_f32_e32 %0, %1, %2":"=v"(r):"v"(a),"v"(b));return r;}
__device__ __forceinline__ float fsub_s(float a,float b){float r;asm("v_sub_f32_e32 %0, %1, %2":"=v"(r):"v"(a),"v"(b));return r;}
typedef float f32x2_t __attribute__((ext_vector_type(2))); typedef __bf16 bf16x2_t __attribute__((ext_vector_type(2)));
__device__ __forceinline__ unsigned cvtpk_s(float lo,float hi){f32x2_t v={lo,hi};bf16x2_t b=__builtin_convertvector(v,bf16x2_t);return __builtin_bit_cast(unsigned,b);}
#define WAIT_BAR(N) asm volatile("s_waitcnt vmcnt(" #N ") lgkmcnt(0)\n\ts_barrier":::"memory")

__device__ __forceinline__ void qkt(f32x16&p0,f32x16&p1,const char*Kslot,const bf16x8*qr,const f32x16&negm,int r32,int hi){
  const char*kb=Kslot+hi*1024+r32*16;
  #pragma unroll
  for(int d0=0;d0<4;++d0){
    const bf16x8 b0=*reinterpret_cast<const bf16x8*>(kb+d0*2048);
    const bf16x8 b1=*reinterpret_cast<const bf16x8*>(kb+d0*2048+512);
    if(d0==0){p0=__builtin_amdgcn_mfma_f32_32x32x16_bf16(b0,qr[0],negm,0,0,0);p1=__builtin_amdgcn_mfma_f32_32x32x16_bf16(b1,qr[0],negm,0,0,0);}
    else{p0=__builtin_amdgcn_mfma_f32_32x32x16_bf16(b0,qr[d0],p0,0,0,0);p1=__builtin_amdgcn_mfma_f32_32x32x16_bf16(b1,qr[d0],p1,0,0,0);}}
}
typedef __attribute__((address_space(3))) const char* lds_cptr;
typedef short v4i16_t __attribute__((ext_vector_type(4)));
__device__ __forceinline__ void kload8(bf16x8*kf,lds_cptr kp){
  kf[0]=*(const __attribute__((address_space(3))) bf16x8*)(kp);      kf[1]=*(const __attribute__((address_space(3))) bf16x8*)(kp+512);
  kf[2]=*(const __attribute__((address_space(3))) bf16x8*)(kp+2048); kf[3]=*(const __attribute__((address_space(3))) bf16x8*)(kp+2560);
  kf[4]=*(const __attribute__((address_space(3))) bf16x8*)(kp+4096); kf[5]=*(const __attribute__((address_space(3))) bf16x8*)(kp+4608);
  kf[6]=*(const __attribute__((address_space(3))) bf16x8*)(kp+6144); kf[7]=*(const __attribute__((address_space(3))) bf16x8*)(kp+6656);
}
__device__ __forceinline__ void kload2(bf16x8*kf,lds_cptr kp,int j){ kf[2*j]=*(const __attribute__((address_space(3))) bf16x8*)(kp+j*2048); kf[2*j+1]=*(const __attribute__((address_space(3))) bf16x8*)(kp+j*2048+512); }
__device__ __forceinline__ s16x4 vtr(lds_cptr p){ return __builtin_bit_cast(s16x4,__builtin_amdgcn_ds_read_tr16_b64_v4i16((__attribute__((address_space(3))) v4i16_t*)p)); }
__device__ __forceinline__ float rowmax(const f32x16&p0,const f32x16&p1){
  float a=max3f(p0[0],p0[1],p1[0]),b=max3f(p0[2],p0[3],p1[1]);a=max3f(a,p1[2],p1[3]);
  #pragma unroll
  for(int r=4;r<16;r+=4){a=max3f(a,p0[r],p0[r+1]);b=max3f(b,p0[r+2],p0[r+3]);a=max3f(a,p1[r],p1[r+1]);b=max3f(b,p1[r+2],p1[r+3]);}
  const float m=max2f(a,b);
  auto rr=__builtin_amdgcn_permlane32_swap(__float_as_uint(m),__float_as_uint(m),false,false);
  return max2f(__uint_as_float(rr[0]),__uint_as_float(rr[1]));
}
__device__ __forceinline__ void pv(f32x16*o,int vb,bf16x8 pa0,bf16x8 pa1,bf16x8 pa2,bf16x8 pa3){
  #pragma unroll
  for(int d0=0;d0<2;++d0){s16x4 lo[4],hi[4];
    #pragma unroll
    for(int ks=0;ks<4;++ks){
      asm volatile("ds_read_b64_tr_b16 %0,%1 offset:%c2":"=&v"(lo[ks]):"v"(vb),"i"(d0*4096+ks*1024):"memory");
      asm volatile("ds_read_b64_tr_b16 %0,%1 offset:%c2":"=&v"(hi[ks]):"v"(vb),"i"(d0*4096+ks*1024+512):"memory");}
    asm volatile("s_waitcnt lgkmcnt(0)":::"memory");SBAR();
    #define PK(k) (bf16x8){lo[k][0],lo[k][1],lo[k][2],lo[k][3],hi[k][0],hi[k][1],hi[k][2],hi[k][3]}
    o[d0]=__builtin_amdgcn_mfma_f32_32x32x16_bf16(pa0,PK(0),o[d0],0,0,0);
    o[d0]=__builtin_amdgcn_mfma_f32_32x32x16_bf16(pa1,PK(1),o[d0],0,0,0);
    o[d0]=__builtin_amdgcn_mfma_f32_32x32x16_bf16(pa2,PK(2),o[d0],0,0,0);
    o[d0]=__builtin_amdgcn_mfma_f32_32x32x16_bf16(pa3,PK(3),o[d0],0,0,0);
    #undef PK
  }
}

#ifndef ATTN_STORE16
#define ATTN_STORE16(p,v) (*(u32x4*)(p)=(v))
#endif
template<int THRL> __device__ __forceinline__ void attn_unit(int tid,int b,int h,int qb,const bf16*Q,const bf16*__restrict__ K,const bf16*__restrict__ V,bf16*O,const float*__restrict__ kms,char*shm){
  asm volatile("":"+v"(tid));
  const int lane=tid&63,r32=lane&31,hi=lane>>5; const int wid=__builtin_amdgcn_readfirstlane(tid>>6);
  const long rowbase=(long)b*SEQ; const int q0=qb*QB;
  const bf16*Qw=Q+(rowbase+q0+wid*QBLK)*DM+h*D;
  const bf16*Kh=K+rowbase*DM+h*D,*Vh=V+rowbase*DM+h*D;
  const unsigned lds0=(unsigned)(uintptr_t)shm;
  float*wsf=(float*)(shm+LDS_WS)+wid*64;
  const bf16*ksrc=Kh+(long)lane*DM+wid*8;
  const bf16*vsrc=Vh+(long)(16*(wid&3)+(lane>>2))*DM+(wid>>2)*32+(lane&3)*8;
  const unsigned kdst=lds0+LDS_K+wid*1024, vdst=lds0+LDS_V+wid*1024;
  #define DMA_K(t,slot) glds16(ksrc+(long)(t)*KVBLK*DM,(unsigned)__builtin_amdgcn_readfirstlane(kdst+(slot)))
  #define DMA_V(t,slot) glds16(vsrc+(long)(t)*KVBLK*DM,(unsigned)__builtin_amdgcn_readfirstlane(vdst+(slot)))
  const int vb0=(int)(lds0+LDS_V)+((lane>>4)&1)*32+(lane&3)*8+(4*hi+((lane&15)>>2))*64;
  const char*Kbase=shm+LDS_K; bf16x8 kf[8];
  const lds_cptr shm3=(lds_cptr)shm; const lds_cptr kp0=shm3+LDS_K+hi*1024+r32*16; const lds_cptr vp0=shm3+LDS_V+((lane>>4)&1)*32+(lane&3)*8+(4*hi+((lane&15)>>2))*64;
  const int NT=(q0+QB)/KVBLK;
  DMA_K(0,0);DMA_V(0,0);DMA_K(1,SLOTB);
  bf16x8 qr[4];
  #pragma unroll
  for(int d0=0;d0<4;++d0)qr[d0]=*reinterpret_cast<const bf16x8*>(&Qw[(long)r32*DM+d0*16+hi*8]);
  unsigned sel=(1u<<qb)-1u;
  if(qb>3){
    f32x16 g=f32x16{};
    const float*kmr=kms+(long)((b*8+(r32&7))*4+h)*64+8*hi;
    #pragma unroll
    for(int s=0;s<4;++s){
      f32x4 a=f32x4{0.f,0.f,0.f,0.f},c=a;
      if(r32<qb){a=*reinterpret_cast<const f32x4*>(kmr+16*s);c=*reinterpret_cast<const f32x4*>(kmr+16*s+4);}
      const float v[8]={a[0],a[1],a[2],a[3],c[0],c[1],c[2],c[3]}; unsigned hw[4],lw[4];
      #pragma unroll
      for(int e=0;e<4;++e){hw[e]=cvtpk_s(v[2*e],v[2*e+1]);lw[e]=cvtpk_s(v[2*e]-__uint_as_float(hw[e]<<16),v[2*e+1]-__uint_as_float(hw[e]&0xffff0000u));}
      const bf16x8 khi=__builtin_bit_cast(bf16x8,(u32x4){hw[0],hw[1],hw[2],hw[3]}),klo=__builtin_bit_cast(bf16x8,(u32x4){lw[0],lw[1],lw[2],lw[3]});
      g=__builtin_amdgcn_mfma_f32_32x32x16_bf16(khi,qr[s],g,0,0,0);g=__builtin_amdgcn_mfma_f32_32x32x16_bf16(klo,qr[s],g,0,0,0);
    }
    float gate[8];
    #pragma unroll
    for(int i=0;i<4;++i){auto rr=__builtin_amdgcn_permlane32_swap(__float_as_uint(g[i]),__float_as_uint(g[i]),false,false);const float oth=__uint_as_float(hi?rr[0]:rr[1]);gate[i]=hi?oth:g[i];gate[4+i]=hi?g[i]:oth;}
    sel=0u;
    #pragma unroll
    for(int k=0;k<3;++k){float best=-INFINITY;int bi=0;
      #pragma unroll
      for(int n=0;n<8;++n){const bool c=(n<qb)&&!((sel>>n)&1u)&&(gate[n]>best);best=c?gate[n]:best;bi=c?n:bi;}
      sel|=1u<<bi;}
  }
  float mhat=0.f,l_reg=0.f;f32x16 o[2];o[0]=f32x16{};o[1]=f32x16{};f32x16 negm=f32x16{};asm volatile("":"+v"(negm));
  const int qrel=wid*QBLK+r32;
  #define CMASK(P0,P1,t) do{int jb_=(t)-(NT-4); if(jb_>=0)cmask(P0,P1,jb_,qrel,hi);}while(0)
  bool resc=false;
  #define START(P0,P1) do{ const float rm=rowmax(P0,P1); resc=false; \
    { const float dl=fmaxf(rm,-128.f); mhat=fadd_s(mhat,dl); \
      _Pragma("unroll") for(int r=0;r<16;++r){P0[r]=fsub_s(P0[r],dl);P1[r]=fsub_s(P1[r],dl);} \
      _Pragma("unroll") for(int r=0;r<16;++r)negm[r]=-mhat; asm volatile("":"+v"(negm)); } \
    _Pragma("unroll") for(int r=0;r<16;++r)P0[r]=__builtin_amdgcn_exp2f(P0[r]); }while(0)
  #define RESC() do{ if(resc){ asm volatile("s_waitcnt lgkmcnt(0)":::"memory"); \
      _Pragma("unroll") for(int d_=0;d_<2;++d_) _Pragma("unroll") for(int r=0;r<16;++r)o[d_][r]*=wsf[crow(r,hi)]; } }while(0)
  f32x16 pA0,pA1,pB0,pB1;
  int sl_prev=0,sl_cur=0,sl_next=SLOTB;
  #define ROT() do{sl_prev=sl_cur;sl_cur=sl_next;sl_next=(sl_next==(NSLOT-1)*SLOTB)?0:sl_next+SLOTB;}while(0)
  DMA_K(2,2*SLOTB);
  WAIT_BAR(3);
  { const float nm_=((sel&1u)||NT==4)?0.f:-INFINITY; _Pragma("unroll") for(int r_=0;r_<16;++r_)negm[r_]=nm_; asm volatile("":"+v"(negm)); }
  qkt(pA0,pA1,Kbase,qr,negm,r32,hi);asm volatile("s_nop 15\n\ts_nop 7":"+v"(pA0),"+v"(pA1));CMASK(pA0,pA1,0);
  START(pA0,pA1);
  _Pragma("unroll") for(int r=0;r<16;++r)pA1[r]=__builtin_amdgcn_exp2f(pA1[r]);
  WAIT_BAR(0);
  DMA_K(3,0);DMA_V(1,SLOTB);
  ROT();
  kload8(kf,kp0+sl_cur);
  WAIT_BAR(2);
  s16x4 vlo[8],vhi[8]; u32x4 pw0,pw1,pw2,pw3;
  #define PKW(P,B) cvtpk_s(P[B],P[B+1])
  #define PAF(k) __builtin_bit_cast(bf16x8,pw##k)
  #define VFR(i) (bf16x8){vlo[i][0],vlo[i][1],vlo[i][2],vlo[i][3],vhi[i][0],vhi[i][1],vhi[i][2],vhi[i][3]}
  #define PIN(x) asm volatile("":"+v"(x))
  #define MX3(a,b,c) __builtin_fmaxf(__builtin_fmaxf((a),(b)),(c))
  #define GAPA(MF,A0,A1,A2,A3,W0,W1,PW) do{ MF; sacc+=A0; sacc+=A1; sacc+=A2; sacc+=A3; PIN(sacc); W0; W1; PIN(PW); SBAR(); }while(0)
  #define EX(v) __builtin_amdgcn_exp2f(v)
  #define GAPB(MF,X,B) do{ MF; X[B]=EX(X[B]); X[B+1]=EX(X[B+1]); X[B+2]=EX(X[B+2]); X[B+3]=EX(X[B+3]); PIN(X); SBAR(); }while(0)
  #define VRD(i) do{ vlo[i]=vtr(vp_+(((i)>>2)*4096+((i)&3)*1024)); vhi[i]=vtr(vp_+(((i)>>2)*4096+((i)&3)*1024+512)); }while(0)
  #define KRD(G,j) do{ if(G){ kload2(kf,kp0+sl_next,j); SBAR(); } }while(0)
  #define STEP(C0,C1,P0,P1,t,GK,GV,GL) do{ SBAR(); \
    { const float nm_=(((sel>>((t)>>2))&1u)||((t)>=NT-4))?-mhat:-INFINITY; _Pragma("unroll") for(int r_=0;r_<16;++r_)negm[r_]=nm_; asm volatile("":"+v"(negm)); } \
    const lds_cptr vp_=vp0+sl_prev; \
    VRD(0); SBAR(); float sacc=(P0[0]+P0[1]); \
    GAPA(C0=__builtin_amdgcn_mfma_f32_32x32x16_bf16(kf[0],qr[0],negm,0,0,0), P0[2],P0[3],P0[4],P0[5],     pw0[0]=PKW(P0,0), pw0[1]=PKW(P0,2), pw0); \
    VRD(4); SBAR(); GAPA(C1=__builtin_amdgcn_mfma_f32_32x32x16_bf16(kf[1],qr[0],negm,0,0,0), P0[6],P0[7],P0[8],P0[9],     pw0[2]=PKW(P0,4), pw0[3]=PKW(P0,6), pw0); \
    VRD(1); SBAR(); GAPA(C0=__builtin_amdgcn_mfma_f32_32x32x16_bf16(kf[2],qr[1],C0,0,0,0),   P0[10],P0[11],P0[12],P0[13], pw1[0]=PKW(P0,8), pw1[1]=PKW(P0,10), pw1); \
    VRD(5); SBAR(); GAPA(C1=__builtin_amdgcn_mfma_f32_32x32x16_bf16(kf[3],qr[1],C1,0,0,0),   P0[14],P0[15],P1[0],P1[1],   pw1[2]=PKW(P0,12),pw1[3]=PKW(P0,14), pw1); \
    VRD(2); SBAR(); GAPA(C0=__builtin_amdgcn_mfma_f32_32x32x16_bf16(kf[4],qr[2],C0,0,0,0),   P1[2],P1[3],P1[4],P1[5],     pw2[0]=PKW(P1,0), pw2[1]=PKW(P1,2), pw2); \
    VRD(6); SBAR(); GAPA(C1=__builtin_amdgcn_mfma_f32_32x32x16_bf16(kf[5],qr[2],C1,0,0,0),   P1[6],P1[7],P1[8],P1[9],     pw2[2]=PKW(P1,4), pw2[3]=PKW(P1,6), pw2); \
    VRD(3); SBAR(); GAPA(C0=__builtin_amdgcn_mfma_f32_32x32x16_bf16(kf[6],qr[3],C0,0,0,0),   P1[10],P1[11],P1[12],P1[13], pw3[0]=PKW(P1,8), pw3[1]=PKW(P1,10), pw3); \
    VRD(7); SBAR(); GAPA(C1=__builtin_amdgcn_mfma_f32_32x32x16_bf16(kf[7],qr[3],C1,0,0,0),   P1[14],P1[15],0.f,0.f,       pw3[2]=PKW(P1,12),pw3[3]=PKW(P1,14), pw3); \
    l_reg+=sacc; \
    if(GK){DMA_K((t)+3,sl_cur);} if(GV){DMA_V((t)+1,sl_next);} \
    CMASK(C0,C1,t); \
    { float a=MX3(C0[0],C0[1],C1[0]),b=MX3(C0[2],C0[3],C1[1]); a=MX3(a,C1[2],C1[3]); \
      _Pragma("unroll") for(int r=4;r<16;r+=4){a=MX3(a,C0[r],C0[r+1]);b=MX3(b,C0[r+2],C0[r+3]);a=MX3(a,C1[r],C1[r+1]);b=MX3(b,C1[r+2],C1[r+3]);} \
      float rm=__builtin_fmaxf(a,b); { auto rr=__builtin_amdgcn_permlane32_swap(__float_as_uint(rm),__float_as_uint(rm),false,false); rm=__builtin_fmaxf(__uint_as_float(rr[0]),__uint_as_float(rr[1])); } \
      resc=false; \
      if(__builtin_expect(__any(rm>(float)THRL),0)){ const float dl=__builtin_fmaxf(rm,0.f); mhat+=dl; \
        _Pragma("unroll") for(int r=0;r<16;++r){C0[r]-=dl;C1[r]-=dl;} \
        _Pragma("unroll") for(int r=0;r<16;++r)negm[r]=-mhat; asm volatile("":"+v"(negm)); \
        const float f=__builtin_amdgcn_exp2f(-dl); l_reg*=f; if(hi==0)wsf[r32]=f; resc=true; } } \
    SBAR(); \
    GAPB(o[0]=__builtin_amdgcn_mfma_f32_32x32x16_bf16(PAF(0),VFR(0),o[0],0,0,0), C0,0); \
    GAPB(o[1]=__builtin_amdgcn_mfma_f32_32x32x16_bf16(PAF(0),VFR(4),o[1],0,0,0), C0,4); \
    KRD(GL,0); GAPB(o[0]=__builtin_amdgcn_mfma_f32_32x32x16_bf16(PAF(1),VFR(1),o[0],0,0,0), C0,8); \
    KRD(GL,1); GAPB(o[1]=__builtin_amdgcn_mfma_f32_32x32x16_bf16(PAF(1),VFR(5),o[1],0,0,0), C0,12); \
    KRD(GL,2); GAPB(o[0]=__builtin_amdgcn_mfma_f32_32x32x16_bf16(PAF(2),VFR(2),o[0],0,0,0), C1,0); \
    KRD(GL,3); GAPB(o[1]=__builtin_amdgcn_mfma_f32_32x32x16_bf16(PAF(2),VFR(6),o[1],0,0,0), C1,4); \
    GAPB(o[0]=__builtin_amdgcn_mfma_f32_32x32x16_bf16(PAF(3),VFR(3),o[0],0,0,0), C1,8); \
    GAPB(o[1]=__builtin_amdgcn_mfma_f32_32x32x16_bf16(PAF(3),VFR(7),o[1],0,0,0), C1,12); \
    }while(0)
  int t=1;
  #undef CMASK
  #define CMASK(P0,P1,t) do{}while(0)
  for(;t+5<NT;t+=2){
    STEP(pB0,pB1,pA0,pA1,t,true,true,true);     WAIT_BAR(2); RESC(); ROT();
    STEP(pA0,pA1,pB0,pB1,t+1,true,true,true);   WAIT_BAR(2); RESC(); ROT();
  }
  #undef CMASK
  #define CMASK(P0,P1,t) do{int jb_=(t)-(NT-4); if(jb_>=0)cmask(P0,P1,jb_,qrel,hi);}while(0)
  #define ENDW(tt) do{ if((tt)+3<NT){WAIT_BAR(2);} else if((tt)+2<NT){WAIT_BAR(1);} else {WAIT_BAR(0);} }while(0)
  for(;t+1<NT;t+=2){
    STEP(pB0,pB1,pA0,pA1,t,(t+3<NT),(t+1<NT),(t+1<NT));       ENDW(t);   RESC(); ROT();
    STEP(pA0,pA1,pB0,pB1,t+1,(t+4<NT),(t+2<NT),(t+2<NT));     ENDW(t+1); RESC(); ROT();
  }
  STEP(pB0,pB1,pA0,pA1,NT-1,false,false,false); RESC();
  { float sacc=pB0[0]+pB0[1]; _Pragma("unroll") for(int r=2;r<16;++r)sacc+=pB0[r]; _Pragma("unroll") for(int r=0;r<16;++r)sacc+=pB1[r]; l_reg+=sacc;
    pw0=(u32x4){PKW(pB0,0),PKW(pB0,2),PKW(pB0,4),PKW(pB0,6)};pw1=(u32x4){PKW(pB0,8),PKW(pB0,10),PKW(pB0,12),PKW(pB0,14)};pw2=(u32x4){PKW(pB1,0),PKW(pB1,2),PKW(pB1,4),PKW(pB1,6)};pw3=(u32x4){PKW(pB1,8),PKW(pB1,10),PKW(pB1,12),PKW(pB1,14)};
    SBAR(); pv(o,vb0+sl_cur,PAF(0),PAF(1),PAF(2),PAF(3)); }
  #undef PKW
  #undef PAF
  #undef VFR
  #undef PIN
  #undef MX3
  #undef GAPA
  #undef GAPB
  #undef EX
  #undef VRD
  #undef KRD
  #undef STEP
  #undef ENDW
  {auto rr=__builtin_amdgcn_permlane32_swap(__float_as_uint(l_reg),__float_as_uint(l_reg),false,false);l_reg=__uint_as_float(rr[0])+__uint_as_float(rr[1]);}
  if(hi==0)wsf[32+r32]=l_reg;asm volatile("s_waitcnt lgkmcnt(0)":::"memory");
  float rli[16];
  #pragma unroll
  for(int r=0;r<16;++r)rli[r]=__builtin_amdgcn_rcpf(wsf[32+crow(r,hi)]);
  bf16*Ow=O+(rowbase+q0+wid*QBLK)*OP+h*D;
  { bf16*stg=(bf16*)(shm+LDS_OST)+wid*2048;
    #pragma unroll
    for(int r=0;r<16;++r){const int orow=crow(r,hi);
      #pragma unroll
      for(int d0=0;d0<2;++d0)stg[orow*64+d0*32+r32]=__float2bfloat16(o[d0][r]*rli[r]);}
    asm volatile("s_waitcnt lgkmcnt(0)":::"memory");
    #pragma unroll
    for(int i=0;i<4;++i){const int row=i*8+(lane>>3),ch=lane&7; const u32x4 v=*(const u32x4*)(stg+row*64+ch*8); ATTN_STORE16(Ow+(long)row*OP+ch*8,v);} }
  asm volatile("s_waitcnt lgkmcnt(0)\n\ts_barrier":::"memory");
  #undef DMA_K
  #undef DMA_V
  #undef CMASK
  #undef START
  #undef RESC
  #undef ROT
}
constexpr int ATTN_LDS_BYTES=LDS_BYTES;
#undef SBAR
#undef WAIT_BAR
}

constexpr size_t MiB = 1u << 20;
constexpr size_t WS_CTL = 0, CTL_ZERO_BYTES = 1 * MiB;
constexpr size_t WS_MOD = 1 * MiB;
constexpr size_t WS_RTE = 2 * MiB, WS_RTP = WS_RTE + 256 * 1024, WS_RTG = WS_RTP + 256 * 1024, WS_S2T = WS_RTG + 256 * 1024;
constexpr size_t WS_WIN = 4 * MiB, WS_WOUT = 14 * MiB, WS_WFGU = 18 * MiB, WS_WFD = 29 * MiB, WS_WMGU = 35 * MiB, WS_WMD = 91 * MiB;
constexpr size_t WS_XB = 119 * MiB;
constexpr size_t WS_HB = 203 * MiB;
constexpr size_t WS_R = 267 * MiB;
constexpr size_t WS_P = WS_R, WS_DIL = WS_R + 144 * MiB, WS_LSE = WS_R + 192 * MiB, WS_OA = WS_R + 194 * MiB, WS_OC = WS_R + 210 * MiB, WS_OD = WS_R + 226 * MiB;
constexpr size_t WS_Y = WS_R;
constexpr size_t WS_FH = WS_R;
constexpr size_t WS_HID = WS_R, HID_BYTES = 56 * MiB, WS_YS = WS_R + 112 * MiB;
constexpr size_t WS_END = WS_R + 244 * MiB;
constexpr int CW_BAR = 4096;
constexpr int CW_CNT = 8192;
constexpr int CW_KM = 16384;
static_assert((CW_KM + 2 * 32768 * 1) * 4 <= (int)CTL_ZERO_BYTES + 0 || true, "");
static_assert((size_t)(CW_KM + 2 * 32768) * 4 <= CTL_ZERO_BYTES, "CTL region");

constexpr int RING_BYTES = 131072, LDSX_OFF = RING_BYTES, LDS_BYTES = 147456;

#define XB_TMO      128
#define XB_XCNT(j)  (256  + 64 * (j))
#define XB_XSUB(j)  (1280 + 64 * (j))
#define XB_XGEN(j)  (2304 + 64 * (j))
#define XB_TOP      3328
#define XB_TOPGEN   3392
#define XCD_BAR_WORDS 3456
#define XB_SPIN_CAP (1u << 18)
__device__ __forceinline__ unsigned xb_ld(unsigned* p)              { return __hip_atomic_load(p, __ATOMIC_RELAXED, __HIP_MEMORY_SCOPE_AGENT); }
__device__ __forceinline__ unsigned xb_add(unsigned* p, unsigned v) { return __hip_atomic_fetch_add(p, v, __ATOMIC_RELAXED, __HIP_MEMORY_SCOPE_AGENT); }
__device__ __forceinline__ unsigned xb_xcc_id() { return (unsigned)__builtin_amdgcn_s_getreg((3 << 11) | 20) & 0xFu; }
#define XB_SPIN(cond, bar) do { unsigned _sp = 0; while (cond) { __builtin_amdgcn_s_sleep(1); \
    if ((++_sp & 255u) == 0u) { if (xb_ld(&(bar)[XB_TMO])) break; if (_sp > XB_SPIN_CAP) { atomicAdd(&(bar)[XB_TMO], 1u); break; } } } } while (0)
struct XcdBarrier { unsigned* bar; unsigned x; volatile LAS unsigned* st; };
__device__ __forceinline__ XcdBarrier xcd_barrier_post(unsigned* bar, volatile LAS unsigned* st, int tid) {
    XcdBarrier b; b.bar = bar; b.x = xb_xcc_id(); b.st = st;
    if (tid == 0) (void)xb_add(&bar[XB_XCNT(b.x)], 1u);
    return b;
}
__device__ __forceinline__ void xcd_barrier_complete(unsigned* bar, unsigned x, unsigned& nloc, unsigned& nx) {
    const unsigned G = gridDim.x * gridDim.y * gridDim.z;
    unsigned sum, cnt, mine, sp = 0u;
    for (;;) {
        sum = 0u; cnt = 0u; mine = 0u;
#pragma unroll
        for (unsigned j = 0; j < 16; ++j) { const unsigned c = xb_ld(&bar[XB_XCNT(j)]); sum += c; cnt += (c > 0u) ? 1u : 0u; mine = (j == x) ? c : mine; }
        if (sum == G) break;
        __builtin_amdgcn_s_sleep(1);
        if ((++sp & 255u) == 0u) { if (xb_ld(&bar[XB_TMO])) break; if (sp > XB_SPIN_CAP) { atomicAdd(&bar[XB_TMO], 1u); break; } }
    }
    nloc = mine > 0u ? mine : 1u; nx = cnt > 0u ? cnt : 1u;
}
__device__ __forceinline__ void xcd_barrier(const XcdBarrier& b, int tid) {
    asm volatile("s_waitcnt vmcnt(0)" ::: "memory");
    __syncthreads();
    if (tid == 0) {
        unsigned* bar = b.bar;
        __builtin_amdgcn_s_waitcnt(0);
        unsigned nloc = b.st[0], nx = b.st[1];
        if (nloc == 0u) { xcd_barrier_complete(bar, b.x, nloc, nx); b.st[0] = nloc; b.st[1] = nx; }
        const unsigned old = xb_add(&bar[XB_XSUB(b.x)], 1u);
        const unsigned gen = old / nloc;
        if (old + 1u == (gen + 1u) * nloc) {
            __builtin_amdgcn_fence(__ATOMIC_RELEASE, "agent");
            asm volatile("s_waitcnt vmcnt(0)" ::: "memory");
            const unsigned og = xb_add(&bar[XB_TOP], 1u);
            const unsigned tg = og / nx;
            if (og + 1u == (tg + 1u) * nx) xb_add(&bar[XB_TOPGEN], 1u);
            else XB_SPIN(xb_ld(&bar[XB_TOPGEN]) == tg, bar);
            __builtin_amdgcn_fence(__ATOMIC_ACQUIRE, "agent");
            xb_add(&bar[XB_XGEN(b.x)], 1u);
            asm volatile("s_waitcnt vmcnt(0)" ::: "memory");
        } else {
            XB_SPIN(xb_ld(&bar[XB_XGEN(b.x)]) == gen, bar);
            __builtin_amdgcn_fence(__ATOMIC_ACQUIRE, "agent");
            asm volatile("s_waitcnt vmcnt(0)" ::: "memory");
        }
    }
    __syncthreads();
}

struct Args { const void* in[26]; float* out; unsigned char* ws; int ph_lo, ph_hi; };
struct Frame {
    LAS unsigned char* lds;
    unsigned char* ws0; unsigned char* ws; unsigned* ctl; float* out;
    int tid, lane, wave, wave0, vcu;
};
typedef const __attribute__((address_space(4))) Args* ArgsP;
__device__ __forceinline__ ArgsP args_ptr() { auto p = __builtin_amdgcn_kernarg_segment_ptr(); asm volatile("" : "+s"(p)); return (ArgsP)p; }
__device__ __forceinline__ int otid(int wave0) { int t = wave0 * 64 + lane_id(); asm volatile("" : "+v"(t)); return t; }
#define REFRESH(F) do { (F).tid = otid((F).wave0); (F).lane = (F).tid & 63; (F).wave = __builtin_amdgcn_readfirstlane((F).tid >> 6); { long z_ = 0; asm volatile("" : "+s"(z_)); (F).ws = (F).ws0 + z_; } (F).ctl = (unsigned*)(F).ws; } while (0)
#define INP(A, k) ((const float*)(A)->in[k])
enum { I_X = 0, I_C, I_POS, I_ADAW, I_ADAB, I_MIXPRE, I_MIXPOST, I_FFNPRE, I_FFNPOST, I_WIN, I_WOUT, I_GROUPG, I_GMLPW, I_GMLPB, I_CONVW, I_CONVB, I_CONVLNG, I_CONVLNB,
       I_FFNWG, I_FFNWU, I_FFNWD, I_ROUTW, I_ROUTB, I_MOEWG, I_MOEWU, I_MOEWD };
#define LDS_WAIT() asm volatile("s_waitcnt lgkmcnt(0)" ::: "memory")

__device__ __forceinline__ void ld_f32_row(float (&v)[16], const float* p, int lane) {
#pragma unroll
    for (int j = 0; j < 4; ++j) { const f32x4 t = ((const f32x4*)p)[lane + 64 * j]; v[4 * j] = t[0]; v[4 * j + 1] = t[1]; v[4 * j + 2] = t[2]; v[4 * j + 3] = t[3]; }
}
__device__ __forceinline__ void ld_bf16_row(float (&v)[16], const bf16* p, int lane) {
#pragma unroll
    for (int j = 0; j < 4; ++j) { const u32x2 t = ((const u32x2*)p)[lane + 64 * j]; v[4 * j] = bflo(t.x); v[4 * j + 1] = bfhi(t.x); v[4 * j + 2] = bflo(t.y); v[4 * j + 3] = bfhi(t.y); }
}
__device__ __forceinline__ void st_f32_row(const float (&v)[16], float* p, int lane) {
#pragma unroll
    for (int j = 0; j < 4; ++j) ((f32x4*)p)[lane + 64 * j] = (f32x4){v[4 * j], v[4 * j + 1], v[4 * j + 2], v[4 * j + 3]};
}
__device__ __forceinline__ void st_bf16_row(const float (&v)[16], bf16* p, int lane) {
#pragma unroll
    for (int j = 0; j < 4; ++j) { u32x2 t; t.x = cvtpk(v[4 * j], v[4 * j + 1]); t.y = cvtpk(v[4 * j + 2], v[4 * j + 3]); ((u32x2*)p)[lane + 64 * j] = t; }
}
__device__ __forceinline__ float row_rstd(const float (&v)[16]) {
    float s = 0.f;
#pragma unroll
    for (int i = 0; i < 16; ++i) s += v[i] * v[i];
    return __builtin_amdgcn_rsqf(wave_sum(s) * (1.0f / D) + EPS);
}
__device__ __forceinline__ const float* mod_ptr(const Frame& F, int layer, int b, int part) { return (const float*)(F.ws + WS_MOD) + ((size_t)(layer * 16 + b) * 6 + part) * 1024; }

__device__ __forceinline__ int dst_row(int type, int n) {
    if (type == 0) return n;
    if (type == 1) return 256 * (n >> 7) + (n & 127);
    if (type == 2) return 256 * (n >> 7) + 128 + (n & 127);
    const int sl = n >> 8, cc = n & 255;
    if (sl == 0 || sl == 1 || sl == 3 || sl == 4) { const int hh = cc >> 6, d = cc & 63; return 256 * sl + 64 * hh + 32 * ((d >> 4) & 1) + 8 * ((d >> 2) & 3) + 4 * (d >> 5) + (d & 3); }
    if (sl < 8) return n;
    return 256 * (8 + ((cc >> 7) & 1)) + (sl == 9 ? 128 : 0) + (cc & 127);
}
template <bool FP8>
__device__ __forceinline__ void transpose_item_t(const float* W, int K, int N, void* WTv, int type, float wsc, LAS float* scr, int item, int lane) {
    const int nblk = N / 32, kb = item / nblk, nb = item % nblk, k0 = 64 * kb, n0 = 32 * nb;
    const int kk8 = lane >> 3, nq = lane & 7;
    f32x4 v[8];
#pragma unroll
    for (int i = 0; i < 8; ++i) v[i] = *(const f32x4*)(W + (size_t)(k0 + 8 * i + kk8) * N + n0 + 4 * nq);
#pragma unroll
    for (int i = 0; i < 8; ++i)
#pragma unroll
        for (int e = 0; e < 4; ++e) scr[(4 * nq + e) * 68 + 8 * i + kk8] = v[i][e];
    LDS_WAIT(); asm volatile("" ::: "memory");
    const int c = lane & 7;
#pragma unroll
    for (int j = 0; j < 4; ++j) { const int n = (lane >> 3) + 8 * j;
        const f32x4 a = *(const LAS f32x4*)(scr + n * 68 + 8 * c), b = *(const LAS f32x4*)(scr + n * 68 + 8 * c + 4);
        const size_t off = (size_t)dst_row(type, n0 + n) * K + k0 + 8 * c;
        if constexpr (FP8) { u32x2 o; o.x = pk4_fp8(a[0] * wsc, a[1] * wsc, a[2] * wsc, a[3] * wsc); o.y = pk4_fp8(b[0] * wsc, b[1] * wsc, b[2] * wsc, b[3] * wsc); *(u32x2*)((unsigned char*)WTv + off) = o; }
        else { u32x4 o; o.x = cvtpk(a[0], a[1]); o.y = cvtpk(a[2], a[3]); o.z = cvtpk(b[0], b[1]); o.w = cvtpk(b[2], b[3]); *(u32x4*)((bf16*)WTv + off) = o; } }
    LDS_WAIT(); asm volatile("" ::: "memory");
}
__device__ __forceinline__ void transpose_item(const float* W, int K, int N, bf16* WT, int type, LAS float* scr, int item, int lane) { transpose_item_t<false>(W, K, N, WT, type, 1.f, scr, item, lane); }
__device__ __forceinline__ void transpose_item8(const float* W, int K, int N, unsigned char* WT, int type, float wsc, LAS float* scr, int item, int lane) { transpose_item_t<true>(W, K, N, WT, type, wsc, scr, item, lane); }
__device__ __forceinline__ void ada_item(Frame& F, ArgsP A, int a, LAS float* scr) {
    const int layer = a / 96, n = 64 * (a % 96) + F.lane; const float* cin = INP(A, I_C); const float* ada_w = INP(A, I_ADAW);
    float acc[16];
#pragma unroll
    for (int b = 0; b < 16; ++b) acc[b] = 0.f;
    for (int kc = 0; kc < 4; ++kc) {
        for (int i = 0; i < 64; ++i) { const int idx = F.lane + 64 * i, b = idx >> 8, kk = idx & 255; scr[idx] = siluf_(cin[b * 1024 + kc * 256 + kk]); }
        LDS_WAIT(); asm volatile("" ::: "memory");
        const float* wp = ada_w + ((size_t)layer * 1024 + kc * 256) * 6144 + n;
#pragma unroll 2
        for (int kk = 0; kk < 256; kk += 4) { const float w0 = wp[(size_t)kk * 6144], w1 = wp[(size_t)(kk + 1) * 6144], w2 = wp[(size_t)(kk + 2) * 6144], w3 = wp[(size_t)(kk + 3) * 6144];
#pragma unroll
            for (int b = 0; b < 16; ++b) { const f32x4 c4 = *(const LAS f32x4*)(scr + b * 256 + kk); acc[b] += c4[0] * w0; acc[b] += c4[1] * w1; acc[b] += c4[2] * w2; acc[b] += c4[3] * w3; } }
        LDS_WAIT(); asm volatile("" ::: "memory");
    }
    float* mod = (float*)(F.ws + WS_MOD);
    const float bias = INP(A, I_ADAB)[layer * 6144 + n];
#pragma unroll
    for (int b = 0; b < 16; ++b) mod[(size_t)(layer * 16 + b) * 6144 + n] = acc[b] + bias;
}
__device__ __forceinline__ void phase_prologue(Frame& F) {
    REFRESH(F);
    LAS float* scr = (LAS float*)(F.lds + F.wave * 16384);
    ArgsP A = args_ptr();
    const bool ada_wave = (F.wave == 0 && F.vcu < 192);
    if (ada_wave) ada_item(F, A, F.vcu, scr);
    const int gw = F.vcu < 192 ? F.vcu * 7 + F.wave - 1 : 192 * 7 + (F.vcu - 192) * 8 + F.wave, NGW = NWG * 8 - 192;
    constexpr int I_IN = 16 * 80, I_OUT = 16 * 32, I_FG = 16 * 88, I_FD = 44 * 32, I_MG = 16 * 112, I_MD = 56 * 32;
    constexpr int NITEMS = 2 * I_IN + 2 * I_OUT + 2 * I_FG + I_FD + 16 * I_MG + 8 * I_MD;
    bf16* WIN = (bf16*)(F.ws + WS_WIN); bf16* WOUT = (bf16*)(F.ws + WS_WOUT); bf16* WFGU = (bf16*)(F.ws + WS_WFGU); bf16* WFD = (bf16*)(F.ws + WS_WFD);
    unsigned char* WMGU8 = F.ws + WS_WMGU; unsigned char* WMD8 = F.ws + WS_WMD;
    for (int it = ada_wave ? -1 : NITEMS - 1 - gw; it >= 0; it -= NGW) {
        int r = it;
        if (r < 2 * I_IN) { const int L = r / I_IN; transpose_item(INP(A, I_WIN) + (size_t)L * 1024 * NIN, 1024, NIN, WIN + (size_t)L * NIN * 1024, 3, scr, r % I_IN, F.lane); continue; } r -= 2 * I_IN;
        if (r < 2 * I_OUT) { const int L = r / I_OUT; transpose_item(INP(A, I_WOUT) + (size_t)L * 1024 * 1024, 1024, 1024, WOUT + (size_t)L * 1024 * 1024, 0, scr, r % I_OUT, F.lane); continue; } r -= 2 * I_OUT;
        if (r < I_FG) { transpose_item(INP(A, I_FFNWG), 1024, FFD, WFGU, 1, scr, r, F.lane); continue; } r -= I_FG;
        if (r < I_FG) { transpose_item(INP(A, I_FFNWU), 1024, FFD, WFGU, 2, scr, r, F.lane); continue; } r -= I_FG;
        if (r < I_FD) { transpose_item8(INP(A, I_FFNWD), FFD, 1024, (unsigned char*)WFD, 0, MOE_WD_SC, scr, r, F.lane); continue; } r -= I_FD;
        if (r < 8 * I_MG) { const int e = r / I_MG; transpose_item8(INP(A, I_MOEWG) + (size_t)e * 1024 * FFE, 1024, FFE, WMGU8 + (size_t)e * 2 * FFE * 1024, 1, MOE_WGU_SC, scr, r % I_MG, F.lane); continue; } r -= 8 * I_MG;
        if (r < 8 * I_MG) { const int e = r / I_MG; transpose_item8(INP(A, I_MOEWU) + (size_t)e * 1024 * FFE, 1024, FFE, WMGU8 + (size_t)e * 2 * FFE * 1024, 2, MOE_WGU_SC, scr, r % I_MG, F.lane); continue; } r -= 8 * I_MG;
        { const int e = r / I_MD; transpose_item8(INP(A, I_MOEWD) + (size_t)e * FFE * 1024, FFE, 1024, WMD8 + (size_t)e * 1024 * FFE, 0, MOE_WD_SC, scr, r % I_MD, F.lane); }
    }
}

__device__ __forceinline__ void norm_mod_store(const float (&x)[16], const float* g, const float* sc, const float* sh, bf16* dst, int lane, float (&h)[16]) {
    const float r = row_rstd(x);
    float gv[16], scv[16], shv[16]; ld_f32_row(gv, g, lane); ld_f32_row(scv, sc, lane); ld_f32_row(shv, sh, lane);
#pragma unroll
    for (int i = 0; i < 16; ++i) h[i] = x[i] * r * gv[i] * (1.0f + scv[i]) + shv[i];
    if (dst) st_bf16_row(h, dst, lane);
}
__device__ __forceinline__ void phase_prenorm0(Frame& F) {
    REFRESH(F);
    const int rpw = M / (NWG * 8); bf16* HB = (bf16*)(F.ws + WS_HB); ArgsP A = args_ptr(); const float* x_in = INP(A, I_X); const float* mix_pre_g = INP(A, I_MIXPRE);
    for (int k = 0; k < rpw; ++k) { const int m = (F.vcu * 8 + F.wave) * rpw + k, b = m >> 11;
        float x[16], h[16]; ld_f32_row(x, x_in + (size_t)m * D, F.lane);
        norm_mod_store(x, mix_pre_g, mod_ptr(F, 0, b, 1), mod_ptr(F, 0, b, 0), HB + (size_t)m * D, F.lane, h); }
}
__device__ __forceinline__ void phase_postmix(Frame& F, int layer, bool moe) {
    REFRESH(F);
    const int rpw = M / (NWG * 8); bf16* HB = (bf16*)(F.ws + WS_HB); const bf16* Y = (const bf16*)(F.ws + WS_Y);
    ArgsP A = args_ptr(); const float* xsrc = INP(A, I_X); bf16* XB = (bf16*)(F.ws + WS_XB);
    const float* mix_post_g = INP(A, I_MIXPOST); const float* ffn_pre_g = INP(A, I_FFNPRE); const float* router_w = INP(A, I_ROUTW); const float* router_b = INP(A, I_ROUTB);
    LAS int* lcnt = (LAS int*)(F.lds + LDSX_OFF + 256);
    LAS int* lbase = lcnt + 8; LAS int* rinfo = lcnt + 16;
    if (moe) { if (F.tid < 16) lcnt[F.tid] = 0; __syncthreads(); }
    for (int k = 0; k < rpw; ++k) { const int rl = F.wave * rpw + k, m = F.vcu * 8 * rpw + rl, b = m >> 11;
        float x[16], y[16], g[16], gt[16], h[16];
        if (layer == 0) ld_f32_row(x, xsrc + (size_t)m * D, F.lane); else ld_bf16_row(x, XB + (size_t)m * D, F.lane);
        ld_bf16_row(y, Y + (size_t)m * D, F.lane);
        const float ry = row_rstd(y);
        ld_f32_row(g, mix_post_g + layer * D, F.lane); ld_f32_row(gt, mod_ptr(F, layer, b, 2), F.lane);
#pragma unroll
        for (int i = 0; i < 16; ++i) x[i] += gt[i] * (y[i] * ry * g[i]);
        st_bf16_row(x, XB + (size_t)m * D, F.lane);
        norm_mod_store(x, ffn_pre_g + layer * D, mod_ptr(F, layer, b, 4), mod_ptr(F, layer, b, 3), moe ? nullptr : HB + (size_t)m * D, F.lane, h);
        if (moe) {
            { unsigned* h8 = (unsigned*)(F.ws + WS_HB + (size_t)m * D);
#pragma unroll
              for (int j = 0; j < 4; ++j) h8[F.lane + 64 * j] = pk4_fp8(h[4 * j], h[4 * j + 1], h[4 * j + 2], h[4 * j + 3]); }
            float lg[8];
#pragma unroll
            for (int e = 0; e < 8; ++e) lg[e] = 0.f;
#pragma unroll
            for (int j = 0; j < 4; ++j)
#pragma unroll
                for (int e4 = 0; e4 < 4; ++e4) { const float* rw = router_w + (size_t)(256 * j + 4 * F.lane + e4) * 8; const f32x4 w0 = *(const f32x4*)rw, w1 = *(const f32x4*)(rw + 4); const float hv = h[4 * j + e4];
                    lg[0] += hv * w0[0]; lg[1] += hv * w0[1]; lg[2] += hv * w0[2]; lg[3] += hv * w0[3]; lg[4] += hv * w1[0]; lg[5] += hv * w1[1]; lg[6] += hv * w1[2]; lg[7] += hv * w1[3]; }
#pragma unroll
            for (int e = 0; e < 8; ++e) lg[e] = wave_sum(lg[e]) + router_b[e];
            int e0 = 0; float l0 = lg[0];
#pragma unroll
            for (int e = 1; e < 8; ++e) if (lg[e] > l0) { l0 = lg[e]; e0 = e; }
            int e1 = -1; float l1 = -INFINITY;
#pragma unroll
            for (int e = 0; e < 8; ++e) if (e != e0 && lg[e] > l1) { l1 = lg[e]; e1 = e; }
            if (F.lane == 0) {
                const float g0 = fast_rcp(1.0f + __expf(l1 - l0));
                const int p0 = atomicAdd((int*)(lcnt + e0), 1), p1 = atomicAdd((int*)(lcnt + e1), 1);
                rinfo[rl * 4 + 0] = e0; rinfo[rl * 4 + 1] = e1; rinfo[rl * 4 + 2] = p0; rinfo[rl * 4 + 3] = p1;
                float* RTG = (float*)(F.ws + WS_RTG); RTG[2 * m] = g0; RTG[2 * m + 1] = 1.0f - g0;
            }
        }
    }
    if (moe) {
        __syncthreads();
        if (F.tid < 8) lbase[F.tid] = (int)__hip_atomic_fetch_add(F.ctl + CW_CNT + F.tid, (unsigned)lcnt[F.tid], __ATOMIC_RELAXED, __HIP_MEMORY_SCOPE_AGENT);
        __syncthreads();
        const int nrows = 8 * rpw;
        int* RTE = (int*)(F.ws + WS_RTE); int* RTP = (int*)(F.ws + WS_RTP);
        for (int rl = F.tid; rl < nrows; rl += 512) { const int m = F.vcu * nrows + rl; const int e0 = rinfo[rl * 4], e1 = rinfo[rl * 4 + 1];
            RTE[2 * m] = e0; RTE[2 * m + 1] = e1; RTP[2 * m] = lbase[e0] + rinfo[rl * 4 + 2]; RTP[2 * m + 1] = lbase[e1] + rinfo[rl * 4 + 3]; }
    }
}
__device__ __forceinline__ void moe_tiles(const Frame& F, int (&ts)[9], int (&cnt)[8]) {
    int acc = 0;
#pragma unroll
    for (int e = 0; e < 8; ++e) { cnt[e] = __builtin_amdgcn_readfirstlane((int)__hip_atomic_load(F.ctl + CW_CNT + e, __ATOMIC_RELAXED, __HIP_MEMORY_SCOPE_AGENT)); ts[e] = acc; acc += (cnt[e] + 255) >> 8; }
    ts[8] = acc;
}
__device__ __forceinline__ void phase_moe_index(Frame& F) {
    REFRESH(F);
    int ts[9], cnt[8]; moe_tiles(F, ts, cnt);
    int* S2T = (int*)(F.ws + WS_S2T); const int* RTE = (const int*)(F.ws + WS_RTE); const int* RTP = (const int*)(F.ws + WS_RTP);
    const int gt = F.vcu * 512 + F.tid, NT = NWG * 512;
    for (int s = gt; s < ts[8] * 256; s += NT) { const int tile = s >> 8; int e = 0;
#pragma unroll
        for (int k = 1; k < 8; ++k) e += (tile >= ts[k]) ? 1 : 0;
        int c = 0, t0 = 0;
#pragma unroll
        for (int k = 0; k < 8; ++k) { c = (k == e) ? cnt[k] : c; t0 = (k == e) ? ts[k] : t0; }
        if (s - 256 * t0 >= c) S2T[((s >> 8) * 64 + (s & 63)) * 4 + ((s >> 6) & 3)] = 0; }
    for (int a = gt; a < 2 * M; a += NT) { const int e = RTE[a]; int t0 = 0;
#pragma unroll
        for (int k = 0; k < 8; ++k) t0 = (k == e) ? ts[k] : t0;
        { const int sl = 256 * t0 + RTP[a]; S2T[((sl >> 8) * 64 + (sl & 63)) * 4 + ((sl >> 6) & 3)] = a >> 1; } }
}
__device__ __forceinline__ void phase_postffn(Frame& F, int layer, bool moe) {
    REFRESH(F);
    const int rpw = M / (NWG * 8); bf16* HB = (bf16*)(F.ws + WS_HB);
    int ts[9], cnt[8]; if (moe) moe_tiles(F, ts, cnt);
    ArgsP A = args_ptr(); const float* ffn_post_g = INP(A, I_FFNPOST); const float* mix_pre_g = INP(A, I_MIXPRE);
    for (int k = 0; k < rpw; ++k) { const int m = (F.vcu * 8 + F.wave) * rpw + k, b = m >> 11;
        float x[16], y[16], g[16], gt[16], h[16];
        ld_bf16_row(x, (const bf16*)(F.ws + WS_XB) + (size_t)m * D, F.lane);
        if (moe) {
            const int* RTE = (const int*)(F.ws + WS_RTE); const int* RTP = (const int*)(F.ws + WS_RTP); const float* RTG = (const float*)(F.ws + WS_RTG); const bf16* YS = (const bf16*)(F.ws + WS_YS);
            const int e0 = RTE[2 * m], e1 = RTE[2 * m + 1]; int t0 = 0, t1 = 0;
#pragma unroll
            for (int q = 0; q < 8; ++q) { t0 = (q == e0) ? ts[q] : t0; t1 = (q == e1) ? ts[q] : t1; }
            const size_t s0 = (size_t)256 * t0 + RTP[2 * m], s1 = (size_t)256 * t1 + RTP[2 * m + 1];
            const float g0 = RTG[2 * m], g1 = RTG[2 * m + 1];
            float ya[16], yb[16]; ld_bf16_row(ya, YS + s0 * D, F.lane); ld_bf16_row(yb, YS + s1 * D, F.lane);
#pragma unroll
            for (int i = 0; i < 16; ++i) y[i] = g0 * ya[i] + g1 * yb[i];
        } else ld_bf16_row(y, HB + (size_t)m * D, F.lane);
        const float ry = row_rstd(y);
        ld_f32_row(g, ffn_post_g + layer * D, F.lane); ld_f32_row(gt, mod_ptr(F, layer, b, 5), F.lane);
#pragma unroll
        for (int i = 0; i < 16; ++i) x[i] += gt[i] * (y[i] * ry * g[i]);
        if (layer == 0) st_bf16_row(x, (bf16*)(F.ws + WS_XB) + (size_t)m * D, F.lane); else st_f32_row(x, F.out + (size_t)m * D, F.lane);
        if (layer == 0) norm_mod_store(x, mix_pre_g + D, mod_ptr(F, 1, b, 1), mod_ptr(F, 1, b, 0), HB + (size_t)m * D, F.lane, h);
    }
}
__device__ __forceinline__ void phase_mixnorm(Frame& F, int layer) {
    REFRESH(F);
    const int rpw = M / (NWG * 8); bf16* MIXN = (bf16*)(F.ws + WS_HB);
    const bf16* OA = (const bf16*)(F.ws + WS_OA); const bf16* OC = (const bf16*)(F.ws + WS_OC); const bf16* OD = (const bf16*)(F.ws + WS_OD);
    const bf16* DIL = (const bf16*)(F.ws + WS_DIL); const float* LSE = (const float*)(F.ws + WS_LSE);
    const int lane = F.lane, hh = lane >> 4; ArgsP A = args_ptr(); const float* group_g = INP(A, I_GROUPG);
    for (int k = 0; k < rpw; ++k) { const size_t m = (size_t)(F.vcu * 8 + F.wave) * rpw + k;
        float v[4][4];
        { const u32x2 t = ((const u32x2*)(OA + m * 256))[lane]; v[0][0] = bflo(t.x); v[0][1] = bfhi(t.x); v[0][2] = bflo(t.y); v[0][3] = bfhi(t.y); }
        { const float l0 = LSE[m * 4 + hh], l1 = LSE[((size_t)M + m) * 4 + hh], l2 = LSE[((size_t)2 * M + m) * 4 + hh];
          const float mx = fmaxf(l0, fmaxf(l1, l2)); float w0 = fast_exp2(l0 - mx), w1 = fast_exp2(l1 - mx), w2 = fast_exp2(l2 - mx); const float inv = fast_rcp(w0 + w1 + w2); w0 *= inv; w1 *= inv; w2 *= inv;
          const u32x2 a = ((const u32x2*)(DIL + m * 256))[lane], bq = ((const u32x2*)(DIL + ((size_t)M + m) * 256))[lane], cq = ((const u32x2*)(DIL + ((size_t)2 * M + m) * 256))[lane];
          v[1][0] = w0 * bflo(a.x) + w1 * bflo(bq.x) + w2 * bflo(cq.x); v[1][1] = w0 * bfhi(a.x) + w1 * bfhi(bq.x) + w2 * bfhi(cq.x);
          v[1][2] = w0 * bflo(a.y) + w1 * bflo(bq.y) + w2 * bflo(cq.y); v[1][3] = w0 * bfhi(a.y) + w1 * bfhi(bq.y) + w2 * bfhi(cq.y); }
        { const u32x2 t = ((const u32x2*)(OC + m * 256))[lane]; v[2][0] = bflo(t.x); v[2][1] = bfhi(t.x); v[2][2] = bflo(t.y); v[2][3] = bfhi(t.y); }
        { const u32x2 t = ((const u32x2*)(OD + m * 256))[lane]; v[3][0] = bflo(t.x); v[3][1] = bfhi(t.x); v[3][2] = bflo(t.y); v[3][3] = bfhi(t.y); }
#pragma unroll
        for (int g = 0; g < 4; ++g) {
            const float ss = wave_sum(v[g][0] * v[g][0] + v[g][1] * v[g][1] + v[g][2] * v[g][2] + v[g][3] * v[g][3]);
            const float r = __builtin_amdgcn_rsqf(ss * (1.0f / 256.0f) + EPS);
            const f32x4 gg = *(const f32x4*)(group_g + (size_t)(layer * 4 + g) * 256 + 4 * lane);
            u32x2 t; t.x = cvtpk(v[g][0] * r * gg[0], v[g][1] * r * gg[1]); t.y = cvtpk(v[g][2] * r * gg[2], v[g][3] * r * gg[3]);
            ((u32x2*)(MIXN + m * D + 256 * g))[lane] = t; }
    }
}

__device__ __forceinline__ void gmlp_unit(Frame& F, int layer, int b, int ch) {
    const bf16* P = (const bf16*)(F.ws + WS_P); bf16* OC = (bf16*)(F.ws + WS_OC);
    const size_t R0 = (size_t)b * SEQ + 128 * ch;
    LAS bf16* VT = (LAS bf16*)F.lds;
    const int lane = F.lane, w = F.wave;
    for (int k = 0; k < 16; ++k) { const int s = 16 * w + k;
        const u32x2 t = ((const u32x2*)(P + (R0 + s) * PW + P_GV))[lane];
        float v0 = bflo(t.x), v1 = bfhi(t.x), v2 = bflo(t.y), v3 = bfhi(t.y);
        const float mean = wave_sum((v0 + v1) + (v2 + v3)) * (1.0f / 256.0f);
        v0 -= mean; v1 -= mean; v2 -= mean; v3 -= mean;
        const float rstd = __builtin_amdgcn_rsqf(wave_sum((v0 * v0 + v1 * v1) + (v2 * v2 + v3 * v3)) * (1.0f / 256.0f) + EPS);
        const unsigned p0 = cvtpk(v0 * rstd, v1 * rstd), p1 = cvtpk(v2 * rstd, v3 * rstd);
        VT[(4 * lane + 0) * 136 + s] = (bf16)(p0 & 0xffffu); VT[(4 * lane + 1) * 136 + s] = (bf16)(p0 >> 16);
        VT[(4 * lane + 2) * 136 + s] = (bf16)(p1 & 0xffffu); VT[(4 * lane + 3) * 136 + s] = (bf16)(p1 >> 16); }
    __syncthreads();
    const int g = w >> 1, cb = 64 * g + 32 * (w & 1), r = lane & 31, h = lane >> 5;
    ArgsP A = args_ptr();
    const float* W = INP(A, I_GMLPW) + (size_t)(layer * 4 + g) * 128 * 128;
    const float* bias = INP(A, I_GMLPB) + (size_t)(layer * 4 + g) * 128;
    for (int tt = 0; tt < 4; ++tt) {
        f32x16 acc;
#pragma unroll
        for (int i = 0; i < 16; ++i) acc[i] = 0.f;
        const int t = 32 * tt + r;
        for (int ks = 0; ks < 2 * (tt + 1); ++ks) {
            const int s0 = 16 * ks + 8 * h;
            const f32x4 a = *(const f32x4*)(W + (size_t)t * 128 + s0), c = *(const f32x4*)(W + (size_t)t * 128 + s0 + 4);
            float v[8] = {a[0], a[1], a[2], a[3], c[0], c[1], c[2], c[3]};
#pragma unroll
            for (int e = 0; e < 8; ++e) v[e] = (s0 + e <= t) ? v[e] : 0.f;
            u32x4 aw; aw.x = cvtpk(v[0], v[1]); aw.y = cvtpk(v[2], v[3]); aw.z = cvtpk(v[4], v[5]); aw.w = cvtpk(v[6], v[7]);
            const bf16x8 bfrag = *(const LAS bf16x8*)(VT + (cb + r) * 136 + s0);
            acc = MFMA32(__builtin_bit_cast(bf16x8, aw), bfrag, acc);
        }
#pragma unroll
        for (int i = 0; i < 16; ++i) { const int to = 32 * tt + crow(i, h); const float z = acc[i] + bias[to];
            const float u = bf2f(P[(R0 + to) * PW + P_GU + cb + r]);
            OC[(R0 + to) * 256 + cb + r] = (bf16)(cvtpk(u * z, 0.f) & 0xffffu); }
    }
    __syncthreads();
}
__device__ __forceinline__ void conv_unit(Frame& F, int layer, int b, int ch) {
    const bf16* P = (const bf16*)(F.ws + WS_P); bf16* OD = (bf16*)(F.ws + WS_OD);
    const int t0 = 64 * ch; const size_t Rb = (size_t)b * SEQ;
    LAS bf16* XT = (LAS bf16*)F.lds;
    LAS float* YT = (LAS float*)(F.lds + 48128);
    for (int id = F.tid; id < 94 * 32; id += 512) { const int row = id >> 5, piece = id & 31, t = t0 - 30 + row;
        u32x4 v = (u32x4){0u, 0u, 0u, 0u};
        if (t >= 0) v = *(const u32x4*)(P + (Rb + t) * PW + P_GLU + 8 * piece);
        *(LAS u32x4*)(XT + row * 256 + 8 * piece) = v; }
    __syncthreads();
    ArgsP A = args_ptr();
    { const int c = F.tid & 255, half = F.tid >> 8; const float* conv_w = INP(A, I_CONVW);
      float wk[31];
#pragma unroll
      for (int k = 0; k < 31; ++k) wk[k] = conv_w[(size_t)(layer * 31 + k) * 256 + c];
      const float cb = INP(A, I_CONVB)[layer * 256 + c];
      float xs[62];
#pragma unroll
      for (int i = 0; i < 62; ++i) xs[i] = bf2f(XT[(32 * half + i) * 256 + c]);
#pragma unroll
      for (int j = 0; j < 32; ++j) { float y = cb;
#pragma unroll
          for (int k = 0; k < 31; ++k) y += wk[k] * xs[j + k];
          YT[(32 * half + j) * 260 + c] = y; } }
    __syncthreads();
    { const int lane = F.lane;
      const f32x4 lg = *(const f32x4*)(INP(A, I_CONVLNG) + layer * 256 + 4 * lane), lb = *(const f32x4*)(INP(A, I_CONVLNB) + layer * 256 + 4 * lane);
      for (int k = 0; k < 8; ++k) { const int t = 8 * F.wave + k;
          f32x4 y = *(const LAS f32x4*)(YT + t * 260 + 4 * lane);
          const float mean = wave_sum((y[0] + y[1]) + (y[2] + y[3])) * (1.0f / 256.0f);
          y = y - mean;
          const float rstd = __builtin_amdgcn_rsqf(wave_sum((y[0] * y[0] + y[1] * y[1]) + (y[2] * y[2] + y[3] * y[3])) * (1.0f / 256.0f) + EPS);
          float o[4];
#pragma unroll
          for (int e = 0; e < 4; ++e) o[e] = siluf_(y[e] * rstd * lg[e] + lb[e]);
          u32x2 w; w.x = cvtpk(o[0], o[1]); w.y = cvtpk(o[2], o[3]);
          ((u32x2*)(OD + (Rb + t0 + t) * 256))[lane] = w; } }
    __syncthreads();
}
__device__ __forceinline__ void phase_mixers(Frame& F, int layer) {
    REFRESH(F);
    __syncthreads();
    const bf16* P = (const bf16*)(F.ws + WS_P);
    const float* kms = (const float*)(F.ctl + CW_KM) + (size_t)layer * 32768;
    for (int rq = (REPK == 16 ? 2 : 1); rq > 0; --rq)
    for (int u = F.vcu; u < 256; u += NWG) { const int bh = u >> 2, sq = u & 3; const attn_body::bf16* Pq = (const attn_body::bf16*)P;
        for (int k2 = 0; k2 < 2; ++k2)
            attn_body::attn_unit<8>(F.tid, bh >> 2, bh & 3, k2 ? 7 - sq : sq, Pq + P_QA, Pq + P_KA, Pq + P_VA, (attn_body::bf16*)(F.ws + WS_OA), kms, (char*)F.lds); }
    REFRESH(F);
    for (int rq = (REPK == 17 ? 2 : 1); rq > 0; --rq)
    for (int u = F.vcu; u < 256; u += NWG) gmlp_unit(F, layer, u >> 4, u & 15);
    REFRESH(F);
    for (int rq = (REPK == 18 ? 2 : 1); rq > 0; --rq)
    for (int u = F.vcu; u < 512; u += NWG) conv_unit(F, layer, u >> 5, u & 31);
    REFRESH(F);
    LAS char* vt = (LAS char*)(F.lds + F.wave * 4096);
    const int gw = F.vcu * 8 + F.wave, NGW = NWG * 8;
    for (int rq = (REPK == 19 ? 2 : 1); rq > 0; --rq)
    for (int it = gw; it < 3 * 4096; it += NGW) { const int cfg = it >> 12, rem = it & 4095, bh = rem >> 6, idx = rem & 63;
        dil_item(P, (bf16*)(F.ws + WS_DIL) + (size_t)cfg * M * 256, (float*)(F.ws + WS_LSE) + (size_t)cfg * M * 4, cfg, bh >> 2, bh & 3, idx, vt, F.lane); }
}

constexpr int PH_PROLOGUE = 0, PH_PRENORM = 1, PH_L0 = 2, PH_L1 = 10, PH_MOE_INDEX = 15, PH_MOE_CHUNK0 = 16, PH_POSTFFN1 = 26, N_PHASES = 27;
__global__ void __launch_bounds__(512, 2) fwd_kernel(Args args) {
    extern __shared__ __attribute__((aligned(16))) unsigned char lds_raw[];
    Frame F;
    F.lds = (LAS unsigned char*)lds_raw;
    F.ws0 = args.ws; F.ws = args.ws; F.ctl = (unsigned*)(args.ws + WS_CTL); F.out = args.out;
    F.wave0 = __builtin_amdgcn_readfirstlane((int)threadIdx.x >> 6); REFRESH(F);
    { const int bx = blockIdx.x; F.vcu = (bx % 8) * (NWG / 8) + bx / 8; }
    volatile LAS unsigned* MISC = (volatile LAS unsigned*)(F.lds + LDSX_OFF);
    if (F.tid < 16) MISC[F.tid] = 0u;
    __syncthreads();
    const int lo = args.ph_lo, hi = args.ph_hi;
    int nrep2 = 2; asm volatile("" : "+s"(nrep2));
    const bool multi = (hi - lo) > 1;
    XcdBarrier bar; bar.bar = F.ctl + CW_BAR; bar.x = 0; bar.st = nullptr;
    if (multi) bar = xcd_barrier_post(F.ctl + CW_BAR, MISC + 8, F.tid);
#ifndef KMASK
#define KMASK 0xFFFF
#endif
#define KON(b) (((KMASK) >> (b)) & 1)
#define NREP(b) (((REPK) == (b)) ? nrep2 : 1)
#define IN(k) (lo <= (k) && (k) < hi)
#define SEAM(k) do { if (IN(k) && IN((k) + 1)) xcd_barrier(bar, F.wave0 * 64 + lane_id()); } while (0)

    if (KON(0) && IN(PH_PROLOGUE)) for (int rp = NREP(0); rp > 0; --rp) phase_prologue(F);
    SEAM(PH_PROLOGUE);
    if (KON(1) && IN(PH_PRENORM)) for (int rp = NREP(1); rp > 0; --rp) phase_prenorm0(F);
    SEAM(PH_PRENORM);
    for (int layer = 0; layer < 2; ++layer) {
        const int pb = layer == 0 ? PH_L0 : PH_L1;
        if (KON(2) && IN(pb)) for (int rp = NREP(2); rp > 0; --rp) {
            REFRESH(F);
            pg8::SchedPlain S; S.init(M / 256, NIN / 256, NWG, (int)blockIdx.x); S.Bt = (const char*)(F.ws + WS_WIN) + (size_t)layer * NIN * 1024 * 2; S.tstep = (size_t)256 * 1024 * 2;
            EpiInProj E{(bf16*)(F.ws + WS_P), (const int*)args.in[I_POS], (float*)(F.ctl + CW_KM) + (size_t)layer * 32768};
            pg8::gemm_phase(F.lds, F.wave0, (const char*)(F.ws + WS_HB), 2 * 1024, S, E);
        }
        SEAM(pb);
        if (KON(3) && IN(pb + 1)) for (int rp = NREP(3); rp > 0; --rp) phase_mixers(F, layer);
        SEAM(pb + 1);
        if (KON(4) && IN(pb + 2)) for (int rp = NREP(4); rp > 0; --rp) phase_mixnorm(F, layer);
        SEAM(pb + 2);
        if (KON(5) && IN(pb + 3)) for (int rp = NREP(5); rp > 0; --rp) {
            REFRESH(F);
            pg8::SchedPlain S; S.init(M / 256, 4, NWG, (int)blockIdx.x); S.Bt = (const char*)(F.ws + WS_WOUT) + (size_t)layer * 1024 * 1024 * 2; S.tstep = (size_t)256 * 1024 * 2;
            EpiPlain E{(bf16*)(F.ws + WS_Y), 1024, 0};
            pg8::gemm_phase(F.lds, F.wave0, (const char*)(F.ws + WS_HB), 2 * 1024, S, E);
        }
        SEAM(pb + 3);
        if (KON(6) && IN(pb + 4)) for (int rp = (layer == 0 ? NREP(6) : 1); rp > 0; --rp) phase_postmix(F, layer, layer == 1);
        SEAM(pb + 4);
        if (layer == 0) {
            if (KON(7) && IN(pb + 5)) for (int rp = NREP(7); rp > 0; --rp) {
                REFRESH(F);
                pg8::SchedPlain S; S.init(M / 256, 2 * FFD / 256, NWG, (int)blockIdx.x); S.Bt = (const char*)(F.ws + WS_WFGU); S.tstep = (size_t)256 * 1024 * 2;
                EpiSwiGLU8 E{F.ws + WS_FH, FFD, MOE_HID_SC};
                pg8::gemm_phase(F.lds, F.wave0, (const char*)(F.ws + WS_HB), 2 * 1024, S, E);
            }
            SEAM(pb + 5);
            if (KON(8) && IN(pb + 6)) for (int rp = NREP(8); rp > 0; --rp) {
                REFRESH(F);
                pg8::SchedPlain S; S.init(M / 256, 4, NWG, (int)blockIdx.x); S.Bt = (const char*)(F.ws + WS_WFD); S.tstep = (size_t)256 * FFD;
                EpiPlain E{(bf16*)(F.ws + WS_HB), 1024, 0};
                pg8::gemm_phase<EpiPlain, pg8::SchedPlain, true>(F.lds, F.wave0, (const char*)(F.ws + WS_FH), FFD, S, E, E8_WD, E8_HID);
            }
            SEAM(pb + 6);
            if (KON(9) && IN(pb + 7)) phase_postffn(F, 0, false);
            SEAM(pb + 7);
        } else {
            if (KON(10) && IN(PH_MOE_INDEX)) for (int rp = NREP(10); rp > 0; --rp) phase_moe_index(F);
            SEAM(PH_MOE_INDEX);
            for (int rp14 = NREP(14); rp14 > 0; --rp14)
            for (int c = 0; c < NCHUNK; ++c) {
                const int pg = PH_MOE_CHUNK0 + 2 * c;
                if (IN(pg) || IN(pg + 1)) {
                    REFRESH(F);
                    int ts[9], cnt[8]; moe_tiles(F, ts, cnt);
                    const int tile0 = CHUNK_TILES * c; int nt = ts[8] - tile0; nt = nt > CHUNK_TILES ? CHUNK_TILES : nt;
                    if (KON(11) && IN(pg) && nt > 0) for (int rp = NREP(11); rp > 0; --rp) {
                        pg8::SchedMoe<true> S; S.init(nt, 2 * FFE / 256, NWG, (int)blockIdx.x); S.Bt = (const char*)(F.ws + WS_WMGU); S.tstep = (size_t)256 * 1024; S.estride = (size_t)2 * FFE * 1024;
                        S.tile0 = tile0; S.s2t = (const int*)(F.ws + WS_S2T);
#pragma unroll
                        for (int k = 0; k < 7; ++k) S.ts[k] = ts[k + 1];
                        { LAS int* tab = (LAS int*)(F.lds + LDSX_OFF + 1024); S.tab = tab;
                          pg8::StaticOrder so; so.init(nt, 2 * FFE / 256, NWG, (int)blockIdx.x); const int* s2t = (const int*)(F.ws + WS_S2T);
#pragma unroll 1
                          for (int i = 0; i < 8; ++i) { pg8::Unit u; const bool ok = so.next(i, u); if (ok && F.tid < 256) tab[i * 256 + F.tid] = s2t[(size_t)(tile0 + u.pm) * 256 + F.tid]; }
                          __syncthreads(); }
                        EpiSwiGLU8 E{F.ws + WS_HID + (size_t)(c & 1) * HID_BYTES, FFE, MOE_HID_SC};
                        pg8::gemm_phase<EpiSwiGLU8, pg8::SchedMoe<true>, true>(F.lds, F.wave0, (const char*)(F.ws + WS_HB), 1024, S, E, E8_WGU, E8_ONE);
                    }
                    SEAM(pg);
                    if (KON(12) && IN(pg + 1) && nt > 0) for (int rp = NREP(12); rp > 0; --rp) {
                        pg8::SchedMoe<false> S; S.init(nt, 4, NWG, (int)blockIdx.x); S.Bt = (const char*)(F.ws + WS_WMD); S.tstep = (size_t)256 * FFE; S.estride = (size_t)1024 * FFE;
                        S.tile0 = tile0; S.s2t = nullptr; S.tab = nullptr;
#pragma unroll
                        for (int k = 0; k < 7; ++k) S.ts[k] = ts[k + 1];
                        EpiPlain E{(bf16*)(F.ws + WS_YS), 1024, tile0 * 256};
                        pg8::gemm_phase<EpiPlain, pg8::SchedMoe<false>, true>(F.lds, F.wave0, (const char*)(F.ws + WS_HID + (size_t)(c & 1) * HID_BYTES), FFE, S, E, E8_WD, E8_HID);
                    }
                    if (c == NCHUNK - 1 || !(MK_ONE_LAUNCH)) SEAM(pg + 1);
                }
            }
            if (KON(13) && IN(PH_POSTFFN1)) phase_postffn(F, 1, true);
        }
    }
#undef IN
#undef SEAM
}

extern "C" void kernel_launch(void* const* d_in, const int* in_sizes, int n_in, void* d_out, int out_size, void* d_ws, size_t ws_size, hipStream_t stream) {
    static int grid = 0;
    if (grid == 0) {
        if (n_in != 26 || out_size != M * D || ws_size < WS_END) { fprintf(stderr, "kernel_launch: unexpected problem: n_in %d out %d ws %zu (need %zu)\n", n_in, out_size, ws_size, (size_t)WS_END); grid = -1; return; }
        int dev = 0, cus = 0, per_cu = 0;
        if (hipGetDevice(&dev) != hipSuccess || hipDeviceGetAttribute(&cus, hipDeviceAttributeMultiprocessorCount, dev) != hipSuccess) { grid = -1; return; }
        if (hipFuncSetAttribute((const void*)fwd_kernel, hipFuncAttributeMaxDynamicSharedMemorySize, LDS_BYTES) != hipSuccess) { fprintf(stderr, "kernel_launch: hipFuncSetAttribute failed\n"); grid = -1; return; }
        if (hipOccupancyMaxActiveBlocksPerMultiprocessor(&per_cu, (const void*)fwd_kernel, 512, LDS_BYTES) != hipSuccess || per_cu < 1) fprintf(stderr, "kernel_launch: occupancy query says %d\n", per_cu);
        (void)hipGetLastError();
        if (cus != NWG) { fprintf(stderr, "kernel_launch: built for a %d-CU device, found %d\n", NWG, cus); grid = -1; return; }
        grid = NWG;
        fprintf(stderr, "kernel_launch: grid %d, ws %zu\n", grid, ws_size);
    }
    if (grid < 0) return;
    (void)hipMemsetAsync((char*)d_ws + WS_CTL, 0, CTL_ZERO_BYTES, stream);
    Args a{};
    for (int i = 0; i < 26; ++i) a.in[i] = d_in[i];
    a.out = (float*)d_out; a.ws = (unsigned char*)d_ws;
#if MK_ONE_LAUNCH
    a.ph_lo = 0; a.ph_hi = N_PHASES;
    hipLaunchKernelGGL(fwd_kernel, dim3(grid), dim3(512), LDS_BYTES, stream, a);
#else
    for (int p = 0; p < N_PHASES; ++p) { a.ph_lo = p; a.ph_hi = p + 1; hipLaunchKernelGGL(fwd_kernel, dim3(grid), dim3(512), LDS_BYTES, stream, a); }
#endif
}
```

```cpp
#include <hip/hip_runtime.h>
#include <cstdio>
#include <cstdint>

#ifndef REPK
#define REPK -1
#endif
#ifndef TSA
#define TSA -1
#endif
#ifndef TSB
#define TSB -1
#endif
#ifndef MK_ONE_LAUNCH
#define MK_ONE_LAUNCH 1
#endif

#define GAS __attribute__((address_space(1)))
#define LAS __attribute__((address_space(3)))
typedef unsigned short bf16;
typedef short bf16x8 __attribute__((ext_vector_type(8)));
typedef float f32x4 __attribute__((ext_vector_type(4)));
typedef float f32x16 __attribute__((ext_vector_type(16)));
typedef unsigned u32x4 __attribute__((ext_vector_type(4)));
typedef unsigned u32x2 __attribute__((ext_vector_type(2)));
typedef float f32x2_t __attribute__((ext_vector_type(2)));
typedef __bf16 bf16x2_t __attribute__((ext_vector_type(2)));
typedef short v4i16_t __attribute__((ext_vector_type(4)));
typedef GAS unsigned gu32;

constexpr int BATCH = 16, SEQ = 2048, D = 1024, M = BATCH * SEQ;
constexpr int NIN = 2560, PW = 2304;
constexpr int FFD = 2816, FFE = 3584, NEXP = 8;
constexpr float EPS = 1e-6f;
constexpr int NWG = 256;
constexpr float C2 = 0.125f * 1.4426950408889634f;
constexpr int P_QA = 0, P_KA = 256, P_VA = 512, P_QB = 768, P_KB = 1024, P_VB = 1280, P_GU = 1536, P_GV = 1792, P_GLU = 2048;
constexpr int MOE_TILES_MAX = 264, CHUNK_TILES = 64, NCHUNK = 5;
constexpr float MOE_WGU_SC = 32.f, MOE_WD_SC = 64.f, MOE_HID_SC = 4.f;
constexpr int E8_WGU = 0x7a7a7a7a, E8_WD = 0x79797979, E8_HID = 0x7f7f7f7f, E8_ONE = 0x7f7f7f7f;

__device__ __forceinline__ unsigned cvtpk(float lo, float hi) { f32x2_t v = {lo, hi}; bf16x2_t b = __builtin_convertvector(v, bf16x2_t); return __builtin_bit_cast(unsigned, b); }
__device__ __forceinline__ unsigned pk4_fp8(float a, float b, float c, float d) {
    a = __builtin_amdgcn_fmed3f(a, -448.f, 448.f); b = __builtin_amdgcn_fmed3f(b, -448.f, 448.f); c = __builtin_amdgcn_fmed3f(c, -448.f, 448.f); d = __builtin_amdgcn_fmed3f(d, -448.f, 448.f);
    int p = __builtin_amdgcn_cvt_pk_fp8_f32(a, b, 0, false); p = __builtin_amdgcn_cvt_pk_fp8_f32(c, d, p, true); return (unsigned)p; }
__device__ __forceinline__ float bf2f(unsigned short b) { return __uint_as_float((unsigned)b << 16); }
__device__ __forceinline__ float bflo(unsigned w) { return __uint_as_float(w << 16); }
__device__ __forceinline__ float bfhi(unsigned w) { return __uint_as_float(w & 0xffff0000u); }
__device__ __forceinline__ float fast_exp2(float x) { return __builtin_amdgcn_exp2f(x); }
__device__ __forceinline__ float fast_rcp(float x) { return __builtin_amdgcn_rcpf(x); }
__device__ __forceinline__ float sigmoidf_(float x) { return fast_rcp(1.0f + fast_exp2(-1.4426950408889634f * x)); }
__device__ __forceinline__ float siluf_(float x) { return x * sigmoidf_(x); }
__device__ __forceinline__ float gelu_tanh(float x) { const float u = x + 0.044715f * x * x * x; return x * fast_rcp(1.0f + fast_exp2(-2.3022081982f * u)); }
__device__ __forceinline__ f32x2_t exp2_pk(f32x2_t t) { f32x2_t e; e.x = __builtin_amdgcn_exp2f(t.x); e.y = __builtin_amdgcn_exp2f(t.y); return e; }
__device__ __forceinline__ f32x2_t rcp_pk(f32x2_t d) { f32x2_t r; r.x = __builtin_amdgcn_rcpf(d.x); r.y = __builtin_amdgcn_rcpf(d.y); return r; }
__device__ __forceinline__ f32x2_t sigmoid_pk(f32x2_t x) { return rcp_pk(exp2_pk(x * -1.4426950408889634f) + 1.0f); }
__device__ __forceinline__ f32x2_t silu_mul_pk(f32x2_t g, f32x2_t u) { return (g * u) * sigmoid_pk(g); }
__device__ __forceinline__ f32x2_t gelu_tanh_pk(f32x2_t x) { const f32x2_t u = x * ((x * x) * 0.044715f + 1.0f); return x * rcp_pk(exp2_pk(u * -2.3022081982f) + 1.0f); }
__device__ __forceinline__ unsigned pk4_fp8_raw(f32x2_t a, f32x2_t b) {
    a.x = __builtin_amdgcn_fmed3f(a.x, -448.f, 448.f); a.y = __builtin_amdgcn_fmed3f(a.y, -448.f, 448.f); b.x = __builtin_amdgcn_fmed3f(b.x, -448.f, 448.f); b.y = __builtin_amdgcn_fmed3f(b.y, -448.f, 448.f);
    int p = __builtin_amdgcn_cvt_pk_fp8_f32(a.x, a.y, 0, false); p = __builtin_amdgcn_cvt_pk_fp8_f32(b.x, b.y, p, true); return (unsigned)p; }
__device__ __forceinline__ int lane_id() { int l; asm volatile("v_mbcnt_lo_u32_b32 %0, -1, 0\n\tv_mbcnt_hi_u32_b32 %0, -1, %0" : "=v"(l)); return l; }
template <int CTRL> __device__ __forceinline__ float dpp_f(float v) { return __builtin_bit_cast(float, __builtin_amdgcn_update_dpp(0, __builtin_bit_cast(int, v), CTRL, 0xf, 0xf, false)); }
__device__ __forceinline__ float sum16(float v) {
    v += dpp_f<0xB1>(v); v += dpp_f<0x4E>(v); v += dpp_f<0x141>(v); v += dpp_f<0x140>(v); return v; }
__device__ __forceinline__ float pair16_sum(float v) { const auto r = __builtin_amdgcn_permlane16_swap(__float_as_uint(v), __float_as_uint(v), false, false); return __uint_as_float(r[0]) + __uint_as_float(r[1]); }
__device__ __forceinline__ float pair32_sum(float v) { const auto r = __builtin_amdgcn_permlane32_swap(__float_as_uint(v), __float_as_uint(v), false, false); return __uint_as_float(r[0]) + __uint_as_float(r[1]); }
__device__ __forceinline__ float pair32_max(float v) { const auto r = __builtin_amdgcn_permlane32_swap(__float_as_uint(v), __float_as_uint(v), false, false); return fmaxf(__uint_as_float(r[0]), __uint_as_float(r[1])); }
__device__ __forceinline__ float pair32_other(float v, int h) { const auto r = __builtin_amdgcn_permlane32_swap(__float_as_uint(v), __float_as_uint(v), false, false); return __uint_as_float(h ? r[0] : r[1]); }
__device__ __forceinline__ float wave_sum(float v) { return pair32_sum(pair16_sum(sum16(v))); }

namespace pg8 {
constexpr int BM = 256, BK = 64, HALF = 128, HTB = HALF * BK * 2, STAGE_BYTES = 8 * HTB, NXCD = 8, WGM = 8;
__host__ __device__ __forceinline__ int lds_byte(int r, int c) { const int st = (r >> 4) * 2 + (c >> 5), rr = r & 15, cc = c & 31, ob = rr * 64 + cc * 2; return st * 1024 + (ob ^ (((ob >> 9) & 1) << 5)); }
__host__ __device__ __forceinline__ void stage_rc(int b, int& R, int& C) { const int st = b / 1024, sb = b % 1024, swz = sb ^ (((sb >> 9) & 1) << 5); R = (st >> 1) * 16 + swz / 64; C = (st & 1) * 32 + (swz % 64) / 2; }
__host__ __device__ __forceinline__ int perm32(int rho) { const int n = rho >> 4, i = rho & 15; return 8 * (i >> 2) + 4 * n + (i & 3); }

struct Unit { int pm, pn; };
struct StaticOrder {
    int nM, nN, nwg, G, c; bool dup;
    __device__ __forceinline__ void init(int nM_, int nN_, int G_, int c_) { nM = nM_; nN = nN_; nwg = nM * nN; G = G_; c = c_; dup = false; }
    __device__ __forceinline__ bool next(int i, Unit& u) const {
        if (dup) i >>= 1;
        const long L = (long)i * G + c; if (L >= nwg) return false;
        int wgid = (int)L; { const int q = nwg / NXCD, r = nwg % NXCD, xcd = wgid % NXCD, off = wgid / NXCD; wgid = (xcd < r ? xcd * (q + 1) : r * (q + 1) + (xcd - r) * q) + off; }
        const int nig = WGM * nN, gid = wgid / nig, fm = gid * WGM, gsz = (nM - fm) < WGM ? (nM - fm) : WGM;
        u.pm = fm + ((wgid % nig) % gsz); u.pn = (wgid % nig) / gsz; return true;
    }
};
struct SchedPlain : StaticOrder {
    static constexpr bool GATHER = false;
    const char* Bt; size_t tstep;
    __device__ __forceinline__ int arow(const Unit& u, int rr) const { return u.pm * BM + rr; }
    __device__ __forceinline__ const char* bptr(const Unit& u) const { return Bt + (size_t)u.pn * tstep; }
    __device__ __forceinline__ size_t koff(const Unit&) const { return 0; }
};
template <bool GATHER_> struct SchedMoe : StaticOrder {
    static constexpr bool GATHER = GATHER_;
    const char* Bt; size_t tstep, estride; int tile0; const int* s2t; int ts[7];
    __device__ __forceinline__ int expert(int pmg) const { int e = 0;
#pragma unroll
        for (int k = 0; k < 7; ++k) e += (pmg >= ts[k]) ? 1 : 0;
        return e; }
    __device__ __forceinline__ int arow(const Unit& u, int rr) const { return u.pm * BM + rr; }
    const LAS int* tab;
    __device__ __forceinline__ u32x4 arow4(int ui, int R0) const { if (dup) ui >>= 1; return *(const LAS u32x4*)(tab + ui * 256 + R0 * 4); }
    int ksb;
    __device__ __forceinline__ size_t koff(const Unit& u) const { return ksb ? (size_t)(u.pn >> 2) * ksb : 0; }
    __device__ __forceinline__ const char* bptr(const Unit& u) const { return Bt + (size_t)expert(tile0 + u.pm) * estride + (size_t)(ksb ? (u.pn & 3) : u.pn) * tstep + koff(u); }
};

typedef int v8i32 __attribute__((ext_vector_type(8)));
template <class Epi, class Sched, bool FP8 = false>
__device__ __forceinline__ void gemm_phase(LAS unsigned char* lds, const int wave0, const char* Abase, const int KB, const Sched& S, const Epi& E, const int sW = 0x7f7f7f7f, const int sX = 0x7f7f7f7f, const int ntiles = 0) {
    int tid = wave0 * 64 + lane_id(); asm volatile("" : "+v"(tid)); const int wid = __builtin_amdgcn_readfirstlane(tid >> 6), lane = tid & 63, wr = wid >> 2, wc = wid & 3, fr = lane & 15, fq = lane >> 4;
    const int nt = ntiles ? ntiles : KB / 128;
    int R0, C0; stage_rc(tid * 16, R0, C0);
    const unsigned voffA = (unsigned)(R0 * KB + C0 * 2), voffB = (unsigned)(((R0 & ~31) + perm32(R0 & 31)) * KB + C0 * 2);
    const size_t kstep = (size_t)(BK * 2);
    const size_t hstep = (size_t)HALF * KB;
    const unsigned rowb = (unsigned)KB, colb = (unsigned)C0 * 2u;
    const size_t q64 = (size_t)64 * KB;
    const unsigned ldsw = (unsigned)wid * 1024u;
    const int aoff = lds_byte(wr * 64 + fr, fq * 8), boff = lds_byte(wc * 32 + fr, fq * 8);
#define PG8_SA(b, h) (((b) * 2 + (h)) * HTB)
#define PG8_SB(b, h) ((4 + (b) * 2 + (h)) * HTB)
#define PG8_GLDS(gp, bufoff, i) __builtin_amdgcn_global_load_lds((const unsigned*)(gp), (LAS unsigned*)(lds + (bufoff) + ldsw + (i) * 8192), 16, 0, 0)
#define PG8_STAGE_B(bufoff, gbase) do { PG8_GLDS((const char*)(gbase) + voffB, bufoff, 0); PG8_GLDS((const char*)(gbase) + q64 + voffB, bufoff, 1); } while (0)
#define PG8_STAGE_A(bufoff, h, kb, NX) do { \
        if constexpr (Sched::GATHER) { const unsigned _o0 = (NX) ? ((h) ? n2 : n0) : ((h) ? va2 : va0), _o1 = (NX) ? ((h) ? n3 : n1) : ((h) ? va3 : va1); \
            PG8_GLDS(Abase + (kb) + _o0, bufoff, 0); PG8_GLDS(Abase + (kb) + _o1, bufoff, 1); } \
        else { const char* _b = ((NX) ? nA : cA) + (size_t)(h) * hstep + (kb); PG8_GLDS(_b + voffA, bufoff, 0); PG8_GLDS(_b + q64 + voffA, bufoff, 1); } } while (0)
#define PG8_LDA(dst, b, h) do { _Pragma("unroll") for (int m = 0; m < 4; ++m) _Pragma("unroll") for (int k = 0; k < 2; ++k) dst[m][k] = *(const LAS bf16x8*)(lds + PG8_SA(b, h) + aoff + m * 2048 + k * 1024); } while (0)
#define PG8_LDB(dst, b, h) do { _Pragma("unroll") for (int n = 0; n < 2; ++n) _Pragma("unroll") for (int k = 0; k < 2; ++k) dst[n][k] = *(const LAS bf16x8*)(lds + PG8_SB(b, h) + boff + n * 2048 + k * 1024); } while (0)
#define PG8_CAT(x, y) __builtin_shufflevector(__builtin_bit_cast(u32x4, x), __builtin_bit_cast(u32x4, y), 0, 1, 2, 3, 4, 5, 6, 7)
#define PG8_MMA(ai, bj, At, Bt) do { __builtin_amdgcn_s_setprio(1); \
        if constexpr (FP8) { _Pragma("unroll") for (int m = 0; m < 4; ++m) _Pragma("unroll") for (int n = 0; n < 2; ++n) { \
            const v8i32 b8_ = __builtin_bit_cast(v8i32, PG8_CAT(Bt[n][0], Bt[n][1])), a8_ = __builtin_bit_cast(v8i32, PG8_CAT(At[m][0], At[m][1])); \
            asm volatile("s_nop 1\n\tv_mfma_scale_f32_16x16x128_f8f6f4 %0, %1, %2, %0, %3, %4 op_sel_hi:[0,0,0]" : "+v"(acc[ai][bj][m][n]) : "v"(b8_), "v"(a8_), "v"(sW), "v"(sX)); } } \
        else { _Pragma("unroll") for (int m = 0; m < 4; ++m) _Pragma("unroll") for (int n = 0; n < 2; ++n) _Pragma("unroll") for (int k = 0; k < 2; ++k) \
            acc[ai][bj][m][n] = __builtin_amdgcn_mfma_f32_16x16x32_bf16(Bt[n][k], At[m][k], acc[ai][bj][m][n], 0, 0, 0); } \
        __builtin_amdgcn_s_setprio(0); } while (0)
#define PG8_WAIT_V(n) asm volatile("s_waitcnt vmcnt(" #n ")" ::: "memory")
#define PG8_WAIT_L(n) asm volatile("s_waitcnt lgkmcnt(" #n ")" ::: "memory")
#define PG8_BAR __builtin_amdgcn_s_barrier()
#define PG8_SCHED __builtin_amdgcn_sched_barrier(0)
    Unit cur, nxt; int ui = 0;
    if (!S.next(0, cur)) return;
#define PG8_PIN8(a, b) asm volatile("" : "+v"(acc[a][b][0][0]), "+v"(acc[a][b][0][1]), "+v"(acc[a][b][1][0]), "+v"(acc[a][b][1][1]), "+v"(acc[a][b][2][0]), "+v"(acc[a][b][2][1]), "+v"(acc[a][b][3][0]), "+v"(acc[a][b][3][1]))
#define PG8_PINACC() do { PG8_PIN8(0, 0); PG8_PIN8(0, 1); PG8_PIN8(1, 0); PG8_PIN8(1, 1); } while (0)
    f32x4 acc[2][2][4][2];
#pragma unroll
    for (int a = 0; a < 2; ++a)
#pragma unroll
        for (int b = 0; b < 2; ++b)
#pragma unroll
            for (int m = 0; m < 4; ++m)
#pragma unroll
                for (int n = 0; n < 2; ++n) acc[a][b][m][n] = (f32x4){0.f, 0.f, 0.f, 0.f};
    PG8_PINACC();
    bf16x8 At[4][2], B0[2][2], B1[2][2];
    unsigned va0 = 0, va1 = 0, va2 = 0, va3 = 0, na0 = 0, na1 = 0, na2 = 0, na3 = 0;
    const char* cA = Abase; const char* nA = Abase;
    if constexpr (Sched::GATHER) { const u32x4 ci = S.arow4(0, R0); va0 = ci.x * rowb + colb; va1 = ci.y * rowb + colb; va2 = ci.z * rowb + colb; va3 = ci.w * rowb + colb; }
    else cA = Abase + (size_t)S.arow(cur, 0) * rowb + S.koff(cur);
    const char* cB = S.bptr(cur);
    { const unsigned n0 = 0, n1 = 0, n2 = 0, n3 = 0; (void)n0; (void)n1; (void)n2; (void)n3;
    PG8_STAGE_B(PG8_SB(0, 0), cB); PG8_STAGE_B(PG8_SB(0, 1), cB + hstep); PG8_STAGE_A(PG8_SA(0, 0), 0, 0, false); PG8_STAGE_A(PG8_SA(0, 1), 1, 0, false);
    if (wr == 1) PG8_BAR;
    PG8_WAIT_V(2); PG8_BAR;
    PG8_STAGE_B(PG8_SB(1, 0), cB + kstep); PG8_STAGE_A(PG8_SA(1, 0), 0, kstep, false); PG8_STAGE_B(PG8_SB(1, 1), cB + hstep + kstep);
    PG8_WAIT_V(6); PG8_BAR; }
    for (;;) {
        const bool has_next = S.next(ui + 1, nxt);
        const char* nB = has_next ? S.bptr(nxt) : cB;
        if constexpr (Sched::GATHER) {
            { const u32x4 ni = S.arow4(has_next ? ui + 1 : ui, R0); na0 = ni.x * rowb + colb; na1 = ni.y * rowb + colb; na2 = ni.z * rowb + colb; na3 = ni.w * rowb + colb; }
        } else nA = has_next ? Abase + (size_t)S.arow(nxt, 0) * rowb + S.koff(nxt) : cA;
        for (int t = 0; t < nt; t += 2) {
            const bool last = (t == nt - 2);
            const size_t k1 = (size_t)(t + 1) * kstep, k2 = last ? 0 : (size_t)(t + 2) * kstep, k3 = k2 + kstep;
            const char* b2 = last ? nB : cB + (size_t)(t + 2) * kstep; const char* b3 = b2 + kstep;
            const unsigned n0 = last ? na0 : va0, n1 = last ? na1 : va1, n2 = last ? na2 : va2, n3 = last ? na3 : va3;
            PG8_LDB(B0, 0, 0); PG8_LDB(B1, 0, 1); PG8_SCHED; PG8_LDA(At, 0, 0); PG8_STAGE_A(PG8_SA(1, 1), 1, k1, false);
            PG8_WAIT_V(8); PG8_WAIT_L(0); PG8_BAR; PG8_MMA(0, 0, At, B0); PG8_MMA(0, 1, At, B1); PG8_BAR; PG8_SCHED;
            PG8_LDA(At, 0, 1); PG8_STAGE_B(PG8_SB(0, 0), b2); PG8_STAGE_B(PG8_SB(0, 1), b2 + hstep); PG8_STAGE_A(PG8_SA(0, 0), 0, k2, last);
            PG8_WAIT_V(8); PG8_WAIT_L(0); PG8_BAR; PG8_MMA(1, 0, At, B0); PG8_MMA(1, 1, At, B1); PG8_BAR; PG8_SCHED;
            PG8_LDB(B0, 1, 0); PG8_LDB(B1, 1, 1); PG8_SCHED; PG8_LDA(At, 1, 0); PG8_STAGE_A(PG8_SA(0, 1), 1, k2, last);
            PG8_WAIT_V(8); PG8_WAIT_L(0); PG8_BAR; PG8_MMA(0, 0, At, B0); PG8_MMA(0, 1, At, B1); PG8_BAR; PG8_SCHED;
            PG8_LDA(At, 1, 1); PG8_STAGE_B(PG8_SB(1, 0), b3); PG8_STAGE_B(PG8_SB(1, 1), b3 + hstep); PG8_STAGE_A(PG8_SA(1, 0), 0, k3, last);
            PG8_WAIT_V(8); PG8_WAIT_L(0); PG8_BAR; PG8_MMA(1, 0, At, B0); PG8_MMA(1, 1, At, B1); PG8_BAR; PG8_SCHED;
        }
        if (wr == 0) PG8_BAR;
        if constexpr (FP8) asm volatile("s_nop 15\n\ts_nop 15" ::: "memory");
        E(acc, cur, wr, wc, fr, fq);
        if (!has_next) break;
#pragma unroll
        for (int a = 0; a < 2; ++a)
#pragma unroll
            for (int b = 0; b < 2; ++b)
#pragma unroll
                for (int m = 0; m < 4; ++m)
#pragma unroll
                    for (int n = 0; n < 2; ++n) acc[a][b][m][n] = (f32x4){0.f, 0.f, 0.f, 0.f};
        PG8_PINACC();
        cur = nxt; cB = nB; cA = nA; ++ui;
        if constexpr (Sched::GATHER) { va0 = na0; va1 = na1; va2 = na2; va3 = na3; }
        if (wr == 1) PG8_BAR;
    }
    PG8_WAIT_V(0);
    PG8_BAR;
#undef PG8_SA
#undef PG8_SB
#undef PG8_GLDS
#undef PG8_STAGE_A
#undef PG8_STAGE_B
#undef PG8_LDA
#undef PG8_LDB
#undef PG8_MMA
#undef PG8_PIN8
#undef PG8_PINACC
#undef PG8_CAT
#undef PG8_WAIT_V
#undef PG8_WAIT_L
#undef PG8_BAR
#undef PG8_SCHED
}
}

#ifndef EPI_NT
#define EPI_NT 0
#endif
#if EPI_NT
#define EPI_STORE(ty, ptr, val) __builtin_nontemporal_store((val), (ty*)(ptr))
#else
#define EPI_STORE(ty, ptr, val) (*(ty*)(ptr) = (val))
#endif
struct EpiPlain {
    bf16* O; int ldc; int rowoff; size_t plane = 0;
    __device__ __forceinline__ void operator()(const f32x4 (&acc)[2][2][4][2], const pg8::Unit& u, int wr, int wc, int fr, int fq) const {
        const int pn = plane ? (u.pn & 3) : u.pn; bf16* Ob = O + (plane ? (size_t)(u.pn >> 2) * plane : 0);
        const int row0 = rowoff + u.pm * 256 + wr * 64 + fr, col0 = pn * 256 + wc * 32 + 8 * fq;
#pragma unroll
        for (int ai = 0; ai < 2; ++ai)
#pragma unroll
            for (int m = 0; m < 4; ++m) { bf16* rowp = Ob + (size_t)(row0 + ai * 128 + m * 16) * ldc + col0;
#pragma unroll
                for (int bj = 0; bj < 2; ++bj) { const f32x4 v0 = acc[ai][bj][m][0], v1 = acc[ai][bj][m][1];
                    u32x4 w; w.x = cvtpk(v0[0], v0[1]); w.y = cvtpk(v0[2], v0[3]); w.z = cvtpk(v1[0], v1[1]); w.w = cvtpk(v1[2], v1[3]);
                    EPI_STORE(u32x4, (rowp + bj * 128), w); } }
    }
};
struct EpiSwiGLU {
    bf16* O; int ldc;
    __device__ __forceinline__ void operator()(const f32x4 (&acc)[2][2][4][2], const pg8::Unit& u, int wr, int wc, int fr, int fq) const {
        const int row0 = u.pm * 256 + wr * 64 + fr, col0 = u.pn * 128 + wc * 32 + 8 * fq;
#pragma unroll
        for (int ai = 0; ai < 2; ++ai)
#pragma unroll
            for (int m = 0; m < 4; ++m) { bf16* rowp = O + (size_t)(row0 + ai * 128 + m * 16) * ldc + col0;
                const f32x4 g0 = acc[ai][0][m][0], g1 = acc[ai][0][m][1], u0 = acc[ai][1][m][0], u1 = acc[ai][1][m][1];
                const f32x2_t h0 = silu_mul_pk((f32x2_t){g0[0], g0[1]}, (f32x2_t){u0[0], u0[1]}), h1 = silu_mul_pk((f32x2_t){g0[2], g0[3]}, (f32x2_t){u0[2], u0[3]});
                const f32x2_t h2 = silu_mul_pk((f32x2_t){g1[0], g1[1]}, (f32x2_t){u1[0], u1[1]}), h3 = silu_mul_pk((f32x2_t){g1[2], g1[3]}, (f32x2_t){u1[2], u1[3]});
                u32x4 w; w.x = cvtpk(h0.x, h0.y); w.y = cvtpk(h1.x, h1.y); w.z = cvtpk(h2.x, h2.y); w.w = cvtpk(h3.x, h3.y);
                EPI_STORE(u32x4, rowp, w); }
    }
};
struct EpiSwiGLU8 {
    unsigned char* O; int ldc;
    __device__ __forceinline__ void operator()(const f32x4 (&acc)[2][2][4][2], const pg8::Unit& u, int wr, int wc, int fr, int fq) const {
        const int row0 = u.pm * 256 + wr * 64 + fr, col0 = u.pn * 128 + wc * 32 + 8 * fq;
#pragma unroll
        for (int ai = 0; ai < 2; ++ai)
#pragma unroll
            for (int m = 0; m < 4; ++m) { unsigned char* rowp = O + (size_t)(row0 + ai * 128 + m * 16) * ldc + col0;
                const f32x4 g0 = acc[ai][0][m][0], g1 = acc[ai][0][m][1], u0 = acc[ai][1][m][0], u1 = acc[ai][1][m][1];
                const f32x2_t h0 = silu_mul_pk((f32x2_t){g0[0], g0[1]}, (f32x2_t){u0[0], u0[1]}), h1 = silu_mul_pk((f32x2_t){g0[2], g0[3]}, (f32x2_t){u0[2], u0[3]});
                const f32x2_t h2 = silu_mul_pk((f32x2_t){g1[0], g1[1]}, (f32x2_t){u1[0], u1[1]}), h3 = silu_mul_pk((f32x2_t){g1[2], g1[3]}, (f32x2_t){u1[2], u1[3]});
                u32x2 w; w.x = pk4_fp8_raw(h0, h1); w.y = pk4_fp8_raw(h2, h3);
                EPI_STORE(u32x2, rowp, w); }
    }
};
struct EpiInProj {
    bf16* P; const int* pos; float* kmsum;
    __device__ __forceinline__ void operator()(const f32x4 (&acc)[2][2][4][2], const pg8::Unit& u, int wr, int wc, int fr, int fq) const {
        const int pn = u.pn, row0 = u.pm * 256 + wr * 64 + fr;
        if (pn == 0 || pn == 1 || pn == 3 || pn == 4) {
            const int g = wc & 1, i0 = 16 * g + 4 * fq;
            float invf[4];
#pragma unroll
            for (int e = 0; e < 4; ++e) invf[e] = fast_exp2(-(float)(i0 + e) * 0.4152410118609203f);
            const float sc = (pn == 0 || pn == 3) ? C2 : 1.0f;
            float ks[2][2][4];
#pragma unroll
            for (int a = 0; a < 2; ++a)
#pragma unroll
                for (int b = 0; b < 2; ++b)
#pragma unroll
                    for (int e = 0; e < 4; ++e) ks[a][b][e] = 0.f;
#pragma unroll
            for (int ai = 0; ai < 2; ++ai)
#pragma unroll
                for (int m = 0; m < 4; ++m) { const int row = row0 + ai * 128 + m * 16; const float p = (float)pos[row];
                    float cs[4], sn[4];
#pragma unroll
                    for (int e = 0; e < 4; ++e) { const float ang = p * invf[e]; const float k = rintf(ang * 0.15915494309189535f);
                        float r = fmaf(-k, 6.2831854820251465f, ang); r = fmaf(-k, -1.7484556000744883e-07f, r); const float rev = r * 0.15915494309189535f;
                        cs[e] = __builtin_amdgcn_cosf(rev); sn[e] = __builtin_amdgcn_sinf(rev); }
                    bf16* rowp = P + (size_t)row * PW + 256 * pn;
#pragma unroll
                    for (int bj = 0; bj < 2; ++bj) { const int hh = 2 * bj + (wc >> 1); const f32x4 v0 = acc[ai][bj][m][0], v1 = acc[ai][bj][m][1];
                        float o0[4], o1[4];
#pragma unroll
                        for (int e = 0; e < 4; ++e) { o0[e] = (v0[e] * cs[e] - v1[e] * sn[e]) * sc; o1[e] = (v1[e] * cs[e] + v0[e] * sn[e]) * sc; ks[bj][0][e] += o0[e]; ks[bj][1][e] += o1[e]; }
                        u32x4 w; w.x = cvtpk(o0[0], o0[1]); w.y = cvtpk(o0[2], o0[3]); w.z = cvtpk(o1[0], o1[1]); w.w = cvtpk(o1[2], o1[3]);
                        EPI_STORE(u32x4, (rowp + 64 * hh + 32 * g + 8 * fq), w); } }
            if (pn == 1) {
#pragma unroll
                for (int bj = 0; bj < 2; ++bj)
#pragma unroll
                    for (int n = 0; n < 2; ++n)
#pragma unroll
                        for (int e = 0; e < 4; ++e) { const float v = sum16(ks[bj][n][e]);
                            if (fr == 0) atomicAdd(kmsum + (size_t)(u.pm * 4 + 2 * bj + (wc >> 1)) * 64 + 32 * g + 8 * fq + 4 * n + e, v); }
            }
        } else if (pn >= 8) {
            const int col0 = P_GLU + 128 * (pn - 8) + wc * 32 + 8 * fq;
#pragma unroll
            for (int ai = 0; ai < 2; ++ai)
#pragma unroll
                for (int m = 0; m < 4; ++m) { bf16* rowp = P + (size_t)(row0 + ai * 128 + m * 16) * PW + col0;
                    const f32x4 a0 = acc[ai][0][m][0], a1 = acc[ai][0][m][1], g0 = acc[ai][1][m][0], g1 = acc[ai][1][m][1];
                    const f32x2_t o0 = (f32x2_t){a0[0], a0[1]} * sigmoid_pk((f32x2_t){g0[0], g0[1]}), o1 = (f32x2_t){a0[2], a0[3]} * sigmoid_pk((f32x2_t){g0[2], g0[3]});
                    const f32x2_t o2 = (f32x2_t){a1[0], a1[1]} * sigmoid_pk((f32x2_t){g1[0], g1[1]}), o3 = (f32x2_t){a1[2], a1[3]} * sigmoid_pk((f32x2_t){g1[2], g1[3]});
                    u32x4 w; w.x = cvtpk(o0.x, o0.y); w.y = cvtpk(o1.x, o1.y); w.z = cvtpk(o2.x, o2.y); w.w = cvtpk(o3.x, o3.y);
                    EPI_STORE(u32x4, rowp, w); }
        } else {
            const bool act = (pn >= 6);
            const int col0 = 256 * pn + wc * 32 + 8 * fq;
#pragma unroll
            for (int ai = 0; ai < 2; ++ai)
#pragma unroll
                for (int m = 0; m < 4; ++m) { bf16* rowp = P + (size_t)(row0 + ai * 128 + m * 16) * PW + col0;
#pragma unroll
                    for (int bj = 0; bj < 2; ++bj) { const f32x4 v0 = acc[ai][bj][m][0], v1 = acc[ai][bj][m][1];
                        f32x2_t o0 = {v0[0], v0[1]}, o1 = {v0[2], v0[3]}, o2 = {v1[0], v1[1]}, o3 = {v1[2], v1[3]};
                        if (act) { o0 = gelu_tanh_pk(o0); o1 = gelu_tanh_pk(o1); o2 = gelu_tanh_pk(o2); o3 = gelu_tanh_pk(o3); }
                        u32x4 w; w.x = cvtpk(o0.x, o0.y); w.y = cvtpk(o1.x, o1.y); w.z = cvtpk(o2.x, o2.y); w.w = cvtpk(o3.x, o3.y);
                        EPI_STORE(u32x4, (rowp + bj * 128), w); } }
        }
    }
};

#define MFMA32(a, b, c) __builtin_amdgcn_mfma_f32_32x32x16_bf16((a), (b), (c), 0, 0, 0)
__device__ __forceinline__ int crow(int i, int h) { return (i & 3) + 8 * (i >> 2) + 4 * h; }
__device__ __forceinline__ v4i16_t vtr(const LAS char* p) { return __builtin_amdgcn_ds_read_tr16_b64_v4i16((LAS v4i16_t*)p); }

struct AttnOperands { u32x4 kk[4]; u32x4 vv[4]; };
__device__ __forceinline__ void attn_load(AttnOperands& T, const bf16* kp, const bf16* vp, size_t v8) {
#pragma unroll
    for (int w = 0; w < 4; ++w) T.kk[w] = *(const u32x4*)(kp + (size_t)w * v8);
#pragma unroll
    for (int w = 0; w < 4; ++w) T.vv[w] = *(const u32x4*)(vp + (size_t)w * v8);
}
constexpr int ATT_KLDS = 4096, ATT_WAVE_LDS = 9216;
__device__ __forceinline__ void attn_kfrags(bf16x8 (&kf)[4], const AttnOperands& T, LAS char* vt, int lane) {
    { const int piece = lane & 7, key0 = lane >> 3;
#pragma unroll
      for (int w = 0; w < 4; ++w) *(LAS u32x4*)(vt + ATT_KLDS + (key0 + 8 * w) * 144 + piece * 16) = T.kk[w]; }
    const int r = lane & 31, h = lane >> 5;
#pragma unroll
    for (int s = 0; s < 4; ++s) kf[s] = *(const LAS bf16x8*)(vt + ATT_KLDS + r * 144 + (2 * s + h) * 16);
}
__device__ __forceinline__ void attn_compute(f32x16& o0, f32x16& o1, float& m, float& l, const bf16x8 (&qf)[4], const AttnOperands& T, LAS char* vt, int lane, unsigned vmask) {
    const int h = lane >> 5;
    f32x16 p; bf16x8 kf[4]; attn_kfrags(kf, T, vt, lane);
#pragma unroll
    for (int i = 0; i < 16; ++i) p[i] = 0.f;
#pragma unroll
    for (int s = 0; s < 4; ++s) p = MFMA32(kf[s], qf[s], p);
    { const int piece = lane & 7, key0 = lane >> 3;
#pragma unroll
      for (int w = 0; w < 4; ++w) *(LAS u32x4*)(vt + (2 * w + (piece >> 2)) * 512 + key0 * 64 + (piece & 3) * 16) = T.vv[w]; }
    float tm = -INFINITY;
#pragma unroll
    for (int i = 0; i < 16; ++i) { p[i] = ((vmask >> i) & 1u) ? p[i] : -INFINITY; tm = fmaxf(tm, p[i]); }
    tm = pair32_max(tm);
    const float mn = fmaxf(m, tm), alpha = fast_exp2(m - mn); m = mn;
    float rs = 0.f;
#pragma unroll
    for (int i = 0; i < 16; ++i) { p[i] = fast_exp2(p[i] - mn); rs += p[i]; }
    l = l * alpha + rs;
#pragma unroll
    for (int i = 0; i < 16; ++i) { o0[i] *= alpha; o1[i] *= alpha; }
    u32x4 w0, w1;
    w0.x = cvtpk(p[0], p[1]); w0.y = cvtpk(p[2], p[3]); w0.z = cvtpk(p[4], p[5]); w0.w = cvtpk(p[6], p[7]);
    w1.x = cvtpk(p[8], p[9]); w1.y = cvtpk(p[10], p[11]); w1.z = cvtpk(p[12], p[13]); w1.w = cvtpk(p[14], p[15]);
    const bf16x8 pf0 = __builtin_bit_cast(bf16x8, w0), pf1 = __builtin_bit_cast(bf16x8, w1);
    const LAS char* vb = vt + (4 * h + ((lane & 15) >> 2)) * 64 + ((lane >> 4) & 1) * 32 + (lane & 3) * 8;
#pragma unroll
    for (int s2 = 0; s2 < 2; ++s2) {
        const v4i16_t a0 = vtr(vb + (4 * s2 + 0) * 512), a1 = vtr(vb + (4 * s2 + 2) * 512);
        const v4i16_t b0 = vtr(vb + (4 * s2 + 1) * 512), b1 = vtr(vb + (4 * s2 + 3) * 512);
        const bf16x8 vf0 = (bf16x8){a0[0], a0[1], a0[2], a0[3], a1[0], a1[1], a1[2], a1[3]};
        const bf16x8 vf1 = (bf16x8){b0[0], b0[1], b0[2], b0[3], b1[0], b1[1], b1[2], b1[3]};
        o0 = MFMA32(vf0, s2 ? pf1 : pf0, o0);
        o1 = MFMA32(vf1, s2 ? pf1 : pf0, o1);
    }
}
__device__ __forceinline__ void attn_store(const f32x16& o0, const f32x16& o1, float inv, bf16* dst, int h) {
#pragma unroll
    for (int g = 0; g < 4; ++g) {
        u32x2 a, b; a.x = cvtpk(o0[4 * g] * inv, o0[4 * g + 1] * inv); a.y = cvtpk(o0[4 * g + 2] * inv, o0[4 * g + 3] * inv);
        b.x = cvtpk(o1[4 * g] * inv, o1[4 * g + 1] * inv); b.y = cvtpk(o1[4 * g + 2] * inv, o1[4 * g + 3] * inv);
        *(u32x2*)(dst + 8 * g + 4 * h) = a; *(u32x2*)(dst + 32 + 8 * g + 4 * h) = b; }
}
__device__ __forceinline__ void dil_item(const bf16* P, bf16* DO, float* LS, int cfg, int b, int hh, int idx, LAS char* vt, int lane) {
    const int r = lane & 31, h = lane >> 5, sh = 2 * cfg, dil = 1 << sh, tsh = 6 - sh;
    const int res = idx >> tsh, qt = idx & ((1 << tsh) - 1);
    const bf16* Pb = P + ((size_t)b * SEQ + res) * PW;
    const size_t rs = (size_t)dil * PW;
    const bf16* qp = Pb + (size_t)(32 * qt + r) * rs + P_QB + 64 * hh + 8 * h;
    bf16x8 qf[4];
#pragma unroll
    for (int s = 0; s < 4; ++s) qf[s] = *(const bf16x8*)(qp + 16 * s);
    f32x16 o0, o1;
#pragma unroll
    for (int i = 0; i < 16; ++i) { o0[i] = 0.f; o1[i] = 0.f; }
    float m = -1e30f, l = 0.f;
    const bf16* kbase = Pb + (size_t)(lane >> 3) * rs + P_KB + 64 * hh + 8 * (lane & 7);
    const bf16* vbase = Pb + (size_t)(lane >> 3) * rs + P_VB + 64 * hh + 8 * (lane & 7);
#define DIL_MASK(kt_) ({ unsigned vm_ = 0u; _Pragma("unroll") for (int i = 0; i < 16; ++i) { const int dl = 32 * (qt - (kt_)) + r - crow(i, h); vm_ |= (dl >= 0 && dl <= 128) ? (1u << i) : 0u; } vm_; })
    AttnOperands TA, TB;
    int kt = (qt > 4 ? qt - 4 : 0);
    attn_load(TA, kbase + (size_t)32 * kt * rs, vbase + (size_t)32 * kt * rs, 8 * rs);
    for (;;) {
        if (kt < qt) attn_load(TB, kbase + (size_t)32 * (kt + 1) * rs, vbase + (size_t)32 * (kt + 1) * rs, 8 * rs);
        attn_compute(o0, o1, m, l, qf, TA, vt, lane, DIL_MASK(kt));
        if (++kt > qt) break;
        if (kt < qt) attn_load(TA, kbase + (size_t)32 * (kt + 1) * rs, vbase + (size_t)32 * (kt + 1) * rs, 8 * rs);
        attn_compute(o0, o1, m, l, qf, TB, vt, lane, DIL_MASK(kt));
        if (++kt > qt) break;
    }
#undef DIL_MASK
    l = pair32_sum(l);
    const size_t row = (size_t)b * SEQ + (size_t)(32 * qt + r) * dil + res;
    attn_store(o0, o1, fast_rcp(l), DO + row * 256 + 64 * hh, h);
    if (h == 0) LS[row * 4 + hh] = m + __builtin_amdgcn_logf(l);
}

__device__ __forceinline__ void softmax_step(f32x16& p, unsigned vmask, bool full  , float& m, float& l, f32x16& o0, f32x16& o1, bf16x8& pf0, bf16x8& pf1) {
    float tm = -INFINITY;
    if (full) {
#pragma unroll
        for (int i = 0; i < 16; ++i) tm = fmaxf(tm, p[i]);
    } else {
#pragma unroll
        for (int i = 0; i < 16; ++i) { p[i] = ((vmask >> i) & 1u) ? p[i] : -INFINITY; tm = fmaxf(tm, p[i]); }
    }
    tm = pair32_max(tm);
    const float mn = fmaxf(m, tm), alpha = fast_exp2(m - mn); m = mn;
    float rs = 0.f;
#pragma unroll
    for (int i = 0; i < 16; ++i) { p[i] = fast_exp2(p[i] - mn); rs += p[i]; }
    l = l * alpha + rs;
    if (__any(alpha != 1.0f)) {
#pragma unroll
        for (int i = 0; i < 16; ++i) { o0[i] *= alpha; o1[i] *= alpha; }
    }
    u32x4 w0, w1;
    w0.x = cvtpk(p[0], p[1]); w0.y = cvtpk(p[2], p[3]); w0.z = cvtpk(p[4], p[5]); w0.w = cvtpk(p[6], p[7]);
    w1.x = cvtpk(p[8], p[9]); w1.y = cvtpk(p[10], p[11]); w1.z = cvtpk(p[12], p[13]); w1.w = cvtpk(p[14], p[15]);
    pf0 = __builtin_bit_cast(bf16x8, w0); pf1 = __builtin_bit_cast(bf16x8, w1);
}
struct AttnQ { f32x16 o0, o1; float m, l; bf16x8 qf[4]; };
__device__ __forceinline__ void attn_compute2(AttnQ& A, AttnQ& B, const AttnOperands& T, LAS char* vt, int lane, unsigned vmA, int modeA, unsigned vmB, int modeB) {
    const int h = lane >> 5;
    f32x16 pA, pB; bf16x8 kf[4]; attn_kfrags(kf, T, vt, lane);
#pragma unroll
    for (int i = 0; i < 16; ++i) { pA[i] = 0.f; pB[i] = 0.f; }
    if (modeA && modeB) {
#pragma unroll
        for (int s = 0; s < 4; ++s) { pA = MFMA32(kf[s], A.qf[s], pA); pB = MFMA32(kf[s], B.qf[s], pB); }
    } else if (modeA) {
#pragma unroll
        for (int s = 0; s < 4; ++s) pA = MFMA32(kf[s], A.qf[s], pA);
    } else {
#pragma unroll
        for (int s = 0; s < 4; ++s) pB = MFMA32(kf[s], B.qf[s], pB);
    }
    { const int piece = lane & 7, key0 = lane >> 3;
#pragma unroll
      for (int w = 0; w < 4; ++w) *(LAS u32x4*)(vt + (2 * w + (piece >> 2)) * 512 + key0 * 64 + (piece & 3) * 16) = T.vv[w]; }
    bf16x8 fA0 = {}, fA1 = {}, fB0 = {}, fB1 = {};
    if (modeA) softmax_step(pA, vmA, modeA == 1, A.m, A.l, A.o0, A.o1, fA0, fA1);
    if (modeB) softmax_step(pB, vmB, modeB == 1, B.m, B.l, B.o0, B.o1, fB0, fB1);
    const LAS char* vb = vt + (4 * h + ((lane & 15) >> 2)) * 64 + ((lane >> 4) & 1) * 32 + (lane & 3) * 8;
#pragma unroll
    for (int s2 = 0; s2 < 2; ++s2) {
        const v4i16_t a0 = vtr(vb + (4 * s2 + 0) * 512), a1 = vtr(vb + (4 * s2 + 2) * 512);
        const v4i16_t b0 = vtr(vb + (4 * s2 + 1) * 512), b1 = vtr(vb + (4 * s2 + 3) * 512);
        const bf16x8 vf0 = (bf16x8){a0[0], a0[1], a0[2], a0[3], a1[0], a1[1], a1[2], a1[3]};
        const bf16x8 vf1 = (bf16x8){b0[0], b0[1], b0[2], b0[3], b1[0], b1[1], b1[2], b1[3]};
        if (modeA) { A.o0 = MFMA32(vf0, s2 ? fA1 : fA0, A.o0); A.o1 = MFMA32(vf1, s2 ? fA1 : fA0, A.o1); }
        if (modeB) { B.o0 = MFMA32(vf0, s2 ? fB1 : fB0, B.o0); B.o1 = MFMA32(vf1, s2 ? fB1 : fB0, B.o1); }
    }
}
__device__ __forceinline__ void dil_pair_item(const bf16* P, bf16* DO, float* LS, int cfg, int b, int hh, int idx, LAS char* vt, int lane) {
    const int r = lane & 31, h = lane >> 5, sh = 2 * cfg, dil = 1 << sh, tsh = 5 - sh;
    const int res = idx >> tsh, qt = 2 * (idx & ((1 << tsh) - 1));
    const bf16* Pb = P + ((size_t)b * SEQ + res) * PW;
    const size_t rs = (size_t)dil * PW;
    AttnQ A, B;
    { const bf16* qp = Pb + (size_t)(32 * qt + r) * rs + P_QB + 64 * hh + 8 * h;
#pragma unroll
      for (int s = 0; s < 4; ++s) { A.qf[s] = *(const bf16x8*)(qp + 16 * s); B.qf[s] = *(const bf16x8*)(qp + 32 * rs + 16 * s); } }
#pragma unroll
    for (int i = 0; i < 16; ++i) { A.o0[i] = 0.f; A.o1[i] = 0.f; B.o0[i] = 0.f; B.o1[i] = 0.f; }
    A.m = -1e30f; A.l = 0.f; B.m = -1e30f; B.l = 0.f;
    const bf16* kbase = Pb + (size_t)(lane >> 3) * rs + P_KB + 64 * hh + 8 * (lane & 7);
    const bf16* vbase = Pb + (size_t)(lane >> 3) * rs + P_VB + 64 * hh + 8 * (lane & 7);
    unsigned dmask = 0u, lmask = 0u;
#pragma unroll
    for (int i = 0; i < 16; ++i) { dmask |= (crow(i, h) <= r) ? (1u << i) : 0u; lmask |= (crow(i, h) >= r) ? (1u << i) : 0u; }
    for (int kt = (qt > 4 ? qt - 4 : 0); kt <= qt + 1; ++kt) {
        AttnOperands T; attn_load(T, kbase + (size_t)32 * kt * rs, vbase + (size_t)32 * kt * rs, 8 * rs);
        const int dA = qt - kt, dB = dA + 1;
        const int modeA = (dA < 0 || dA > 4) ? 0 : (dA == 0 || dA == 4) ? 2 : 1, modeB = (dB < 0 || dB > 4) ? 0 : (dB == 0 || dB == 4) ? 2 : 1;
        attn_compute2(A, B, T, vt, lane, dA == 0 ? dmask : lmask, modeA, dB == 0 ? dmask : lmask, modeB);
    }
    A.l = pair32_sum(A.l); B.l = pair32_sum(B.l);
    const size_t rowA = (size_t)b * SEQ + (size_t)(32 * qt + r) * dil + res, rowB = rowA + (size_t)32 * dil;
    attn_store(A.o0, A.o1, fast_rcp(A.l), DO + rowA * 256 + 64 * hh, h);
    attn_store(B.o0, B.o1, fast_rcp(B.l), DO + rowB * 256 + 64 * hh, h);
    if (h == 0) { LS[rowA * 4 + hh] = A.m + __builtin_amdgcn_logf(A.l); LS[rowB * 4 + hh] = B.m + __builtin_amdgcn_logf(B.l); }
}

#include <hip/hip_bf16.h>
#include <cmath>
namespace attn_body {
using bf16=__hip_bfloat16;
using bf16x8=__attribute__((ext_vector_type(8)))short;
using s16x4=__attribute__((ext_vector_type(4)))short;
using f32x16=__attribute__((ext_vector_type(16)))float;
using f32x4=__attribute__((ext_vector_type(4)))float;
using u32x4=__attribute__((ext_vector_type(4)))unsigned;
constexpr int SEQ=2048,D=64,DM=2304,OP=256;
constexpr int NW=8,QBLK=32,QB=QBLK*NW,KVBLK=64,NQB=SEQ/QB;
__device__ __forceinline__ int crow(int r,int hi){return (r&3)+8*(r>>2)+4*hi;}
#define SBAR() __builtin_amdgcn_sched_barrier(0)
__device__ __forceinline__ void cmask(f32x16&p0,f32x16&p1,int jb,int qrel,int hi){
  const float NEG=-INFINITY; int kb=64*jb+4*hi;
  #pragma unroll
  for(int r=0;r<16;++r){int kv=kb+(r&3)+8*(r>>2); if(kv>qrel)p0[r]=NEG; if(kv+32>qrel)p1[r]=NEG;}
}

constexpr int NSLOT=3, SLOTB=8192;
constexpr int LDS_K=0, LDS_V=NSLOT*SLOTB, LDS_WS=2*NSLOT*SLOTB, LDS_OST=LDS_WS+NW*64*4, LDS_BYTES=LDS_OST+NW*4096;
constexpr float C2=0.125f*1.4426950408889634f;
__device__ __forceinline__ void glds16(const void*gsrc,unsigned lds_dst){unsigned keep;
  asm volatile("s_mov_b32 %0, m0\n\ts_mov_b32 m0, %2\n\ts_nop 0\n\tglobal_load_lds_dwordx4 %1, off\n\ts_mov_b32 m0, %0":"=&s"(keep):"v"(gsrc),"s"(lds_dst):"memory");}
__device__ __forceinline__ float max3f(float a,float b,float c){float r;asm("v_max3_f32 %0, %1, %2, %3":"=v"(r):"v"(a),"v"(b),"v"(c));return r;}
__device__ __forceinline__ float max2f(float a,float b){float r;asm("v_max_f32_e32 %0, %1, %2":"=v"(r):"v"(a),"v"(b));return r;}
__device__ __forceinline__ float fadd_s(float a,float b){float r;asm("v_add_f32_e32 %0, %1, %2":"=v"(r):"v"(a),"v"(b));return r;}
__device__ __forceinline__ float fsub_s(float a,float b){float r;asm("v_sub_f32_e32 %0, %1, %2":"=v"(r):"v"(a),"v"(b));return r;}
typedef float f32x2_t __attribute__((ext_vector_type(2))); typedef __bf16 bf16x2_t __attribute__((ext_vector_type(2)));
__device__ __forceinline__ unsigned cvtpk_s(float lo,float hi){f32x2_t v={lo,hi};bf16x2_t b=__builtin_convertvector(v,bf16x2_t);return __builtin_bit_cast(unsigned,b);}
#define WAIT_BAR(N) asm volatile("s_waitcnt vmcnt(" #N ") lgkmcnt(0)\n\ts_barrier":::"memory")

__device__ __forceinline__ void qkt(f32x16&p0,f32x16&p1,const char*Kslot,const bf16x8*qr,const f32x16&negm,int r32,int hi){
  const char*kb=Kslot+hi*1024+r32*16;
  #pragma unroll
  for(int d0=0;d0<4;++d0){
    const bf16x8 b0=*reinterpret_cast<const bf16x8*>(kb+d0*2048);
    const bf16x8 b1=*reinterpret_cast<const bf16x8*>(kb+d0*2048+512);
    if(d0==0){p0=__builtin_amdgcn_mfma_f32_32x32x16_bf16(b0,qr[0],negm,0,0,0);p1=__builtin_amdgcn_mfma_f32_32x32x16_bf16(b1,qr[0],negm,0,0,0);}
    else{p0=__builtin_amdgcn_mfma_f32_32x32x16_bf16(b0,qr[d0],p0,0,0,0);p1=__builtin_amdgcn_mfma_f32_32x32x16_bf16(b1,qr[d0],p1,0,0,0);}}
}
typedef __attribute__((address_space(3))) const char* lds_cptr;
typedef short v4i16_t __attribute__((ext_vector_type(4)));
__device__ __forceinline__ void kload8(bf16x8*kf,lds_cptr kp){
  kf[0]=*(const __attribute__((address_space(3))) bf16x8*)(kp);      kf[1]=*(const __attribute__((address_space(3))) bf16x8*)(kp+512);
  kf[2]=*(const __attribute__((address_space(3))) bf16x8*)(kp+2048); kf[3]=*(const __attribute__((address_space(3))) bf16x8*)(kp+2560);
  kf[4]=*(const __attribute__((address_space(3))) bf16x8*)(kp+4096); kf[5]=*(const __attribute__((address_space(3))) bf16x8*)(kp+4608);
  kf[6]=*(const __attribute__((address_space(3))) bf16x8*)(kp+6144); kf[7]=*(const __attribute__((address_space(3))) bf16x8*)(kp+6656);
}
__device__ __forceinline__ void kload2(bf16x8*kf,lds_cptr kp,int j){ kf[2*j]=*(const __attribute__((address_space(3))) bf16x8*)(kp+j*2048); kf[2*j+1]=*(const __attribute__((address_space(3))) bf16x8*)(kp+j*2048+512); }
__device__ __forceinline__ s16x4 vtr(lds_cptr p){ return __builtin_bit_cast(s16x4,__builtin_amdgcn_ds_read_tr16_b64_v4i16((__attribute__((address_space(3))) v4i16_t*)p)); }
__device__ __forceinline__ float rowmax(const f32x16&p0,const f32x16&p1){
  float a=max3f(p0[0],p0[1],p1[0]),b=max3f(p0[2],p0[3],p1[1]);a=max3f(a,p1[2],p1[3]);
  #pragma unroll
  for(int r=4;r<16;r+=4){a=max3f(a,p0[r],p0[r+1]);b=max3f(b,p0[r+2],p0[r+3]);a=max3f(a,p1[r],p1[r+1]);b=max3f(b,p1[r+2],p1[r+3]);}
  const float m=max2f(a,b);
  auto rr=__builtin_amdgcn_permlane32_swap(__float_as_uint(m),__float_as_uint(m),false,false);
  return max2f(__uint_as_float(rr[0]),__uint_as_float(rr[1]));
}
__device__ __forceinline__ void pv(f32x16*o,int vb,bf16x8 pa0,bf16x8 pa1,bf16x8 pa2,bf16x8 pa3){
  #pragma unroll
  for(int d0=0;d0<2;++d0){s16x4 lo[4],hi[4];
    #pragma unroll
    for(int ks=0;ks<4;++ks){
      asm volatile("ds_read_b64_tr_b16 %0,%1 offset:%c2":"=&v"(lo[ks]):"v"(vb),"i"(d0*4096+ks*1024):"memory");
      asm volatile("ds_read_b64_tr_b16 %0,%1 offset:%c2":"=&v"(hi[ks]):"v"(vb),"i"(d0*4096+ks*1024+512):"memory");}
    asm volatile("s_waitcnt lgkmcnt(0)":::"memory");SBAR();
    #define PK(k) (bf16x8){lo[k][0],lo[k][1],lo[k][2],lo[k][3],hi[k][0],hi[k][1],hi[k][2],hi[k][3]}
    o[d0]=__builtin_amdgcn_mfma_f32_32x32x16_bf16(pa0,PK(0),o[d0],0,0,0);
    o[d0]=__builtin_amdgcn_mfma_f32_32x32x16_bf16(pa1,PK(1),o[d0],0,0,0);
    o[d0]=__builtin_amdgcn_mfma_f32_32x32x16_bf16(pa2,PK(2),o[d0],0,0,0);
    o[d0]=__builtin_amdgcn_mfma_f32_32x32x16_bf16(pa3,PK(3),o[d0],0,0,0);
    #undef PK
  }
}

#ifndef ATTN_STORE16
#define ATTN_STORE16(p,v) (*(u32x4*)(p)=(v))
#endif
template<int THRL> __device__ __forceinline__ void attn_unit(int tid,int b,int h,int qb,const bf16*Q,const bf16*__restrict__ K,const bf16*__restrict__ V,bf16*O,const float*__restrict__ kms,char*shm){
  asm volatile("":"+v"(tid));
  const int lane=tid&63,r32=lane&31,hi=lane>>5; const int wid=__builtin_amdgcn_readfirstlane(tid>>6);
  const long rowbase=(long)b*SEQ; const int q0=qb*QB;
  const bf16*Qw=Q+(rowbase+q0+wid*QBLK)*DM+h*D;
  const bf16*Kh=K+rowbase*DM+h*D,*Vh=V+rowbase*DM+h*D;
  const unsigned lds0=(unsigned)(uintptr_t)shm;
  float*wsf=(float*)(shm+LDS_WS)+wid*64;
  const bf16*ksrc=Kh+(long)lane*DM+wid*8;
  const bf16*vsrc=Vh+(long)(16*(wid&3)+(lane>>2))*DM+(wid>>2)*32+(lane&3)*8;
  const unsigned kdst=lds0+LDS_K+wid*1024, vdst=lds0+LDS_V+wid*1024;
  #define DMA_K(t,slot) glds16(ksrc+(long)(t)*KVBLK*DM,(unsigned)__builtin_amdgcn_readfirstlane(kdst+(slot)))
  #define DMA_V(t,slot) glds16(vsrc+(long)(t)*KVBLK*DM,(unsigned)__builtin_amdgcn_readfirstlane(vdst+(slot)))
  const int vb0=(int)(lds0+LDS_V)+((lane>>4)&1)*32+(lane&3)*8+(4*hi+((lane&15)>>2))*64;
  const char*Kbase=shm+LDS_K; bf16x8 kf[8];
  const lds_cptr shm3=(lds_cptr)shm; const lds_cptr kp0=shm3+LDS_K+hi*1024+r32*16; const lds_cptr vp0=shm3+LDS_V+((lane>>4)&1)*32+(lane&3)*8+(4*hi+((lane&15)>>2))*64;
  const int NT=(q0+QB)/KVBLK;
  DMA_K(0,0);DMA_V(0,0);DMA_K(1,SLOTB);
  bf16x8 qr[4];
  #pragma unroll
  for(int d0=0;d0<4;++d0)qr[d0]=*reinterpret_cast<const bf16x8*>(&Qw[(long)r32*DM+d0*16+hi*8]);
  unsigned sel=(1u<<qb)-1u;
  if(qb>3){
    f32x16 g=f32x16{};
    const float*kmr=kms+(long)((b*8+(r32&7))*4+h)*64+8*hi;
    #pragma unroll
    for(int s=0;s<4;++s){
      f32x4 a=f32x4{0.f,0.f,0.f,0.f},c=a;
      if(r32<qb){a=*reinterpret_cast<const f32x4*>(kmr+16*s);c=*reinterpret_cast<const f32x4*>(kmr+16*s+4);}
      const float v[8]={a[0],a[1],a[2],a[3],c[0],c[1],c[2],c[3]}; unsigned hw[4],lw[4];
      #pragma unroll
      for(int e=0;e<4;++e){hw[e]=cvtpk_s(v[2*e],v[2*e+1]);lw[e]=cvtpk_s(v[2*e]-__uint_as_float(hw[e]<<16),v[2*e+1]-__uint_as_float(hw[e]&0xffff0000u));}
      const bf16x8 khi=__builtin_bit_cast(bf16x8,(u32x4){hw[0],hw[1],hw[2],hw[3]}),klo=__builtin_bit_cast(bf16x8,(u32x4){lw[0],lw[1],lw[2],lw[3]});
      g=__builtin_amdgcn_mfma_f32_32x32x16_bf16(khi,qr[s],g,0,0,0);g=__builtin_amdgcn_mfma_f32_32x32x16_bf16(klo,qr[s],g,0,0,0);
    }
    float gate[8];
    #pragma unroll
    for(int i=0;i<4;++i){auto rr=__builtin_amdgcn_permlane32_swap(__float_as_uint(g[i]),__float_as_uint(g[i]),false,false);const float oth=__uint_as_float(hi?rr[0]:rr[1]);gate[i]=hi?oth:g[i];gate[4+i]=hi?g[i]:oth;}
    sel=0u;
    #pragma unroll
    for(int k=0;k<3;++k){float best=-INFINITY;int bi=0;
      #pragma unroll
      for(int n=0;n<8;++n){const bool c=(n<qb)&&!((sel>>n)&1u)&&(gate[n]>best);best=c?gate[n]:best;bi=c?n:bi;}
      sel|=1u<<bi;}
  }
  float mhat=0.f,l_reg=0.f;f32x16 o[2];o[0]=f32x16{};o[1]=f32x16{};f32x16 negm=f32x16{};asm volatile("":"+v"(negm));
  const int qrel=wid*QBLK+r32;
  #define CMASK(P0,P1,t) do{int jb_=(t)-(NT-4); if(jb_>=0)cmask(P0,P1,jb_,qrel,hi);}while(0)
  bool resc=false;
  #define START(P0,P1) do{ const float rm=rowmax(P0,P1); resc=false; \
    { const float dl=fmaxf(rm,-128.f); mhat=fadd_s(mhat,dl); \
      _Pragma("unroll") for(int r=0;r<16;++r){P0[r]=fsub_s(P0[r],dl);P1[r]=fsub_s(P1[r],dl);} \
      _Pragma("unroll") for(int r=0;r<16;++r)negm[r]=-mhat; asm volatile("":"+v"(negm)); } \
    _Pragma("unroll") for(int r=0;r<16;++r)P0[r]=__builtin_amdgcn_exp2f(P0[r]); }while(0)
  #define RESC() do{ if(resc){ asm volatile("s_waitcnt lgkmcnt(0)":::"memory"); \
      _Pragma("unroll") for(int d_=0;d_<2;++d_) _Pragma("unroll") for(int r=0;r<16;++r)o[d_][r]*=wsf[crow(r,hi)]; } }while(0)
  f32x16 pA0,pA1,pB0,pB1;
  int sl_prev=0,sl_cur=0,sl_next=SLOTB;
  #define ROT() do{sl_prev=sl_cur;sl_cur=sl_next;sl_next=(sl_next==(NSLOT-1)*SLOTB)?0:sl_next+SLOTB;}while(0)
  DMA_K(2,2*SLOTB);
  WAIT_BAR(3);
  { const float nm_=((sel&1u)||NT==4)?0.f:-INFINITY; _Pragma("unroll") for(int r_=0;r_<16;++r_)negm[r_]=nm_; asm volatile("":"+v"(negm)); }
  qkt(pA0,pA1,Kbase,qr,negm,r32,hi);asm volatile("s_nop 15\n\ts_nop 7":"+v"(pA0),"+v"(pA1));CMASK(pA0,pA1,0);
  START(pA0,pA1);
  _Pragma("unroll") for(int r=0;r<16;++r)pA1[r]=__builtin_amdgcn_exp2f(pA1[r]);
  WAIT_BAR(0);
  DMA_K(3,0);DMA_V(1,SLOTB);
  ROT();
  kload8(kf,kp0+sl_cur);
  WAIT_BAR(2);
  s16x4 vlo[8],vhi[8]; u32x4 pw0,pw1,pw2,pw3;
  #define PKW(P,B) cvtpk_s(P[B],P[B+1])
  #define PAF(k) __builtin_bit_cast(bf16x8,pw##k)
  #define VFR(i) (bf16x8){vlo[i][0],vlo[i][1],vlo[i][2],vlo[i][3],vhi[i][0],vhi[i][1],vhi[i][2],vhi[i][3]}
  #define PIN(x) asm volatile("":"+v"(x))
  #define MX3(a,b,c) __builtin_fmaxf(__builtin_fmaxf((a),(b)),(c))
  #define GAPA(MF,A0,A1,A2,A3,W0,W1,PW) do{ MF; sacc+=A0; sacc+=A1; sacc+=A2; sacc+=A3; PIN(sacc); W0; W1; PIN(PW); SBAR(); }while(0)
  #define EX(v) __builtin_amdgcn_exp2f(v)
  #define GAPB(MF,X,B) do{ MF; X[B]=EX(X[B]); X[B+1]=EX(X[B+1]); X[B+2]=EX(X[B+2]); X[B+3]=EX(X[B+3]); PIN(X); SBAR(); }while(0)
  #define VRD(i) do{ vlo[i]=vtr(vp_+(((i)>>2)*4096+((i)&3)*1024)); vhi[i]=vtr(vp_+(((i)>>2)*4096+((i)&3)*1024+512)); }while(0)
  #define KRD(G,j) do{ if(G){ kload2(kf,kp0+sl_next,j); SBAR(); } }while(0)
  #define STEP(C0,C1,P0,P1,t,GK,GV,GL) do{ SBAR(); \
    { const float nm_=(((sel>>((t)>>2))&1u)||((t)>=NT-4))?-mhat:-INFINITY; _Pragma("unroll") for(int r_=0;r_<16;++r_)negm[r_]=nm_; asm volatile("":"+v"(negm)); } \
    const lds_cptr vp_=vp0+sl_prev; \
    VRD(0); SBAR(); float sacc=(P0[0]+P0[1]); \
    GAPA(C0=__builtin_amdgcn_mfma_f32_32x32x16_bf16(kf[0],qr[0],negm,0,0,0), P0[2],P0[3],P0[4],P0[5],     pw0[0]=PKW(P0,0), pw0[1]=PKW(P0,2), pw0); \
    VRD(4); SBAR(); GAPA(C1=__builtin_amdgcn_mfma_f32_32x32x16_bf16(kf[1],qr[0],negm,0,0,0), P0[6],P0[7],P0[8],P0[9],     pw0[2]=PKW(P0,4), pw0[3]=PKW(P0,6), pw0); \
    VRD(1); SBAR(); GAPA(C0=__builtin_amdgcn_mfma_f32_32x32x16_bf16(kf[2],qr[1],C0,0,0,0),   P0[10],P0[11],P0[12],P0[13], pw1[0]=PKW(P0,8), pw1[1]=PKW(P0,10), pw1); \
    VRD(5); SBAR(); GAPA(C1=__builtin_amdgcn_mfma_f32_32x32x16_bf16(kf[3],qr[1],C1,0,0,0),   P0[14],P0[15],P1[0],P1[1],   pw1[2]=PKW(P0,12),pw1[3]=PKW(P0,14), pw1); \
    VRD(2); SBAR(); GAPA(C0=__builtin_amdgcn_mfma_f32_32x32x16_bf16(kf[4],qr[2],C0,0,0,0),   P1[2],P1[3],P1[4],P1[5],     pw2[0]=PKW(P1,0), pw2[1]=PKW(P1,2), pw2); \
    VRD(6); SBAR(); GAPA(C1=__builtin_amdgcn_mfma_f32_32x32x16_bf16(kf[5],qr[2],C1,0,0,0),   P1[6],P1[7],P1[8],P1[9],     pw2[2]=PKW(P1,4), pw2[3]=PKW(P1,6), pw2); \
    VRD(3); SBAR(); GAPA(C0=__builtin_amdgcn_mfma_f32_32x32x16_bf16(kf[6],qr[3],C0,0,0,0),   P1[10],P1[11],P1[12],P1[13], pw3[0]=PKW(P1,8), pw3[1]=PKW(P1,10), pw3); \
    VRD(7); SBAR(); GAPA(C1=__builtin_amdgcn_mfma_f32_32x32x16_bf16(kf[7],qr[3],C1,0,0,0),   P1[14],P1[15],0.f,0.f,       pw3[2]=PKW(P1,12),pw3[3]=PKW(P1,14), pw3); \
    l_reg+=sacc; \
    if(GK){DMA_K((t)+3,sl_cur);} if(GV){DMA_V((t)+1,sl_next);} \
    CMASK(C0,C1,t); \
    { float a=MX3(C0[0],C0[1],C1[0]),b=MX3(C0[2],C0[3],C1[1]); a=MX3(a,C1[2],C1[3]); \
      _Pragma("unroll") for(int r=4;r<16;r+=4){a=MX3(a,C0[r],C0[r+1]);b=MX3(b,C0[r+2],C0[r+3]);a=MX3(a,C1[r],C1[r+1]);b=MX3(b,C1[r+2],C1[r+3]);} \
      float rm=__builtin_fmaxf(a,b); { auto rr=__builtin_amdgcn_permlane32_swap(__float_as_uint(rm),__float_as_uint(rm),false,false); rm=__builtin_fmaxf(__uint_as_float(rr[0]),__uint_as_float(rr[1])); } \
      resc=false; \
      if(__builtin_expect(__any(rm>(float)THRL),0)){ const float dl=__builtin_fmaxf(rm,0.f); mhat+=dl; \
        _Pragma("unroll") for(int r=0;r<16;++r){C0[r]-=dl;C1[r]-=dl;} \
        _Pragma("unroll") for(int r=0;r<16;++r)negm[r]=-mhat; asm volatile("":"+v"(negm)); \
        const float f=__builtin_amdgcn_exp2f(-dl); l_reg*=f; if(hi==0)wsf[r32]=f; resc=true; } } \
    SBAR(); \
    GAPB(o[0]=__builtin_amdgcn_mfma_f32_32x32x16_bf16(PAF(0),VFR(0),o[0],0,0,0), C0,0); \
    GAPB(o[1]=__builtin_amdgcn_mfma_f32_32x32x16_bf16(PAF(0),VFR(4),o[1],0,0,0), C0,4); \
    KRD(GL,0); GAPB(o[0]=__builtin_amdgcn_mfma_f32_32x32x16_bf16(PAF(1),VFR(1),o[0],0,0,0), C0,8); \
    KRD(GL,1); GAPB(o[1]=__builtin_amdgcn_mfma_f32_32x32x16_bf16(PAF(1),VFR(5),o[1],0,0,0), C0,12); \
    KRD(GL,2); GAPB(o[0]=__builtin_amdgcn_mfma_f32_32x32x16_bf16(PAF(2),VFR(2),o[0],0,0,0), C1,0); \
    KRD(GL,3); GAPB(o[1]=__builtin_amdgcn_mfma_f32_32x32x16_bf16(PAF(2),VFR(6),o[1],0,0,0), C1,4); \
    GAPB(o[0]=__builtin_amdgcn_mfma_f32_32x32x16_bf16(PAF(3),VFR(3),o[0],0,0,0), C1,8); \
    GAPB(o[1]=__builtin_amdgcn_mfma_f32_32x32x16_bf16(PAF(3),VFR(7),o[1],0,0,0), C1,12); \
    }while(0)
  int t=1;
  #undef CMASK
  #define CMASK(P0,P1,t) do{}while(0)
  for(;t+5<NT;t+=2){
    STEP(pB0,pB1,pA0,pA1,t,true,true,true);     WAIT_BAR(2); RESC(); ROT();
    STEP(pA0,pA1,pB0,pB1,t+1,true,true,true);   WAIT_BAR(2); RESC(); ROT();
  }
  #undef CMASK
  #define CMASK(P0,P1,t) do{int jb_=(t)-(NT-4); if(jb_>=0)cmask(P0,P1,jb_,qrel,hi);}while(0)
  #define ENDW(tt) do{ if((tt)+3<NT){WAIT_BAR(2);} else if((tt)+2<NT){WAIT_BAR(1);} else {WAIT_BAR(0);} }while(0)
  for(;t+1<NT;t+=2){
    STEP(pB0,pB1,pA0,pA1,t,(t+3<NT),(t+1<NT),(t+1<NT));       ENDW(t);   RESC(); ROT();
    STEP(pA0,pA1,pB0,pB1,t+1,(t+4<NT),(t+2<NT),(t+2<NT));     ENDW(t+1); RESC(); ROT();
  }
  STEP(pB0,pB1,pA0,pA1,NT-1,false,false,false); RESC();
  { float sacc=pB0[0]+pB0[1]; _Pragma("unroll") for(int r=2;r<16;++r)sacc+=pB0[r]; _Pragma("unroll") for(int r=0;r<16;++r)sacc+=pB1[r]; l_reg+=sacc;
    pw0=(u32x4){PKW(pB0,0),PKW(pB0,2),PKW(pB0,4),PKW(pB0,6)};pw1=(u32x4){PKW(pB0,8),PKW(pB0,10),PKW(pB0,12),PKW(pB0,14)};pw2=(u32x4){PKW(pB1,0),PKW(pB1,2),PKW(pB1,4),PKW(pB1,6)};pw3=(u32x4){PKW(pB1,8),PKW(pB1,10),PKW(pB1,12),PKW(pB1,14)};
    SBAR(); pv(o,vb0+sl_cur,PAF(0),PAF(1),PAF(2),PAF(3)); }
  #undef PKW
  #undef PAF
  #undef VFR
  #undef PIN
  #undef MX3
  #undef GAPA
  #undef GAPB
  #undef EX
  #undef VRD
  #undef KRD
  #undef STEP
  #undef ENDW
  {auto rr=__builtin_amdgcn_permlane32_swap(__float_as_uint(l_reg),__float_as_uint(l_reg),false,false);l_reg=__uint_as_float(rr[0])+__uint_as_float(rr[1]);}
  if(hi==0)wsf[32+r32]=l_reg;asm volatile("s_waitcnt lgkmcnt(0)":::"memory");
  float rli[16];
  #pragma unroll
  for(int r=0;r<16;++r)rli[r]=__builtin_amdgcn_rcpf(wsf[32+crow(r,hi)]);
  bf16*Ow=O+(rowbase+q0+wid*QBLK)*OP+h*D;
  { bf16*stg=(bf16*)(shm+LDS_OST)+wid*2048;
    #pragma unroll
    for(int r=0;r<16;++r){const int orow=crow(r,hi);
      #pragma unroll
      for(int d0=0;d0<2;++d0)stg[orow*64+d0*32+r32]=__float2bfloat16(o[d0][r]*rli[r]);}
    asm volatile("s_waitcnt lgkmcnt(0)":::"memory");
    #pragma unroll
    for(int i=0;i<4;++i){const int row=i*8+(lane>>3),ch=lane&7; const u32x4 v=*(const u32x4*)(stg+row*64+ch*8); ATTN_STORE16(Ow+(long)row*OP+ch*8,v);} }
  asm volatile("s_waitcnt lgkmcnt(0)\n\ts_barrier":::"memory");
  #undef DMA_K
  #undef DMA_V
  #undef CMASK
  #undef START
  #undef RESC
  #undef ROT
}
constexpr int ATTN_LDS_BYTES=LDS_BYTES;
#undef SBAR
#undef WAIT_BAR
}

constexpr size_t MiB = 1u << 20;
constexpr size_t WS_CTL = 0, CTL_ZERO_BYTES = 1 * MiB;
constexpr size_t WS_MOD = 1 * MiB;
constexpr size_t WS_RTE = 2 * MiB, WS_RTP = WS_RTE + 256 * 1024, WS_RTG = WS_RTP + 256 * 1024, WS_S2T = WS_RTG + 256 * 1024;
constexpr size_t WS_WIN = 4 * MiB, WS_WOUT = 14 * MiB, WS_WFGU = 18 * MiB, WS_WFD = 29 * MiB, WS_WMGU = 35 * MiB, WS_WMD = 91 * MiB;
constexpr size_t WS_XB = 119 * MiB;
constexpr size_t WS_HB = 203 * MiB;
constexpr size_t WS_R = 267 * MiB;
constexpr size_t WS_P = WS_R, WS_DIL = WS_R + 144 * MiB, WS_LSE = WS_R + 192 * MiB, WS_OA = WS_R + 194 * MiB, WS_OC = WS_R + 210 * MiB, WS_OD = WS_R + 226 * MiB;
constexpr size_t WS_Y = WS_R;
constexpr size_t WS_FH = WS_R;
constexpr size_t WS_HID = WS_R, HID_BYTES = 56 * MiB, WS_YS = WS_R + 112 * MiB;
constexpr size_t WS_END = WS_R + 244 * MiB;
constexpr int CW_BAR = 4096;
constexpr int CW_TS = 12288;
constexpr int CW_CNT = 8192;
constexpr int CW_KM = 16384;
static_assert((CW_KM + 2 * 32768 * 1) * 4 <= (int)CTL_ZERO_BYTES + 0 || true, "");
static_assert((size_t)(CW_KM + 2 * 32768) * 4 <= CTL_ZERO_BYTES, "CTL region");

constexpr int RING_BYTES = 131072, LDSX_OFF = RING_BYTES, LDS_BYTES = 147456;

#define XB_TMO      128
#define XB_XCNT(j)  (256  + 64 * (j))
#define XB_XSUB(j)  (1280 + 64 * (j))
#define XB_XGEN(j)  (2304 + 64 * (j))
#define XB_TOP      3328
#define XB_TOPGEN   3392
#define XCD_BAR_WORDS 3456
#define XB_SPIN_CAP (1u << 18)
__device__ __forceinline__ unsigned xb_ld(unsigned* p)              { return __hip_atomic_load(p, __ATOMIC_RELAXED, __HIP_MEMORY_SCOPE_AGENT); }
__device__ __forceinline__ unsigned xb_add(unsigned* p, unsigned v) { return __hip_atomic_fetch_add(p, v, __ATOMIC_RELAXED, __HIP_MEMORY_SCOPE_AGENT); }
__device__ __forceinline__ unsigned xb_xcc_id() { return (unsigned)__builtin_amdgcn_s_getreg((3 << 11) | 20) & 0xFu; }
#define XB_SPIN(cond, bar) do { unsigned _sp = 0; while (cond) { __builtin_amdgcn_s_sleep(1); \
    if ((++_sp & 255u) == 0u) { if (xb_ld(&(bar)[XB_TMO])) break; if (_sp > XB_SPIN_CAP) { atomicAdd(&(bar)[XB_TMO], 1u); break; } } } } while (0)
struct XcdBarrier { unsigned* bar; unsigned x; volatile LAS unsigned* st; };
__device__ __forceinline__ XcdBarrier xcd_barrier_post(unsigned* bar, volatile LAS unsigned* st, int tid) {
    XcdBarrier b; b.bar = bar; b.x = xb_xcc_id(); b.st = st;
    if (tid == 0) (void)xb_add(&bar[XB_XCNT(b.x)], 1u);
    return b;
}
__device__ __forceinline__ void xcd_barrier_complete(unsigned* bar, unsigned x, unsigned& nloc, unsigned& nx) {
    const unsigned G = gridDim.x * gridDim.y * gridDim.z;
    unsigned sum, cnt, mine, sp = 0u;
    for (;;) {
        sum = 0u; cnt = 0u; mine = 0u;
#pragma unroll
        for (unsigned j = 0; j < 16; ++j) { const unsigned c = xb_ld(&bar[XB_XCNT(j)]); sum += c; cnt += (c > 0u) ? 1u : 0u; mine = (j == x) ? c : mine; }
        if (sum == G) break;
        __builtin_amdgcn_s_sleep(1);
        if ((++sp & 255u) == 0u) { if (xb_ld(&bar[XB_TMO])) break; if (sp > XB_SPIN_CAP) { atomicAdd(&bar[XB_TMO], 1u); break; } }
    }
    nloc = mine > 0u ? mine : 1u; nx = cnt > 0u ? cnt : 1u;
}
__device__ __forceinline__ void xcd_barrier(const XcdBarrier& b, int tid) {
    asm volatile("s_waitcnt vmcnt(0)" ::: "memory");
    __syncthreads();
    if (tid == 0) {
        unsigned* bar = b.bar;
        __builtin_amdgcn_s_waitcnt(0);
        unsigned nloc = b.st[0], nx = b.st[1];
        if (nloc == 0u) { xcd_barrier_complete(bar, b.x, nloc, nx); b.st[0] = nloc; b.st[1] = nx; }
        const unsigned old = xb_add(&bar[XB_XSUB(b.x)], 1u);
        const unsigned gen = old / nloc;
        if (old + 1u == (gen + 1u) * nloc) {
            __builtin_amdgcn_fence(__ATOMIC_RELEASE, "agent");
            asm volatile("s_waitcnt vmcnt(0)" ::: "memory");
            const unsigned og = xb_add(&bar[XB_TOP], 1u);
            const unsigned tg = og / nx;
            if (og + 1u == (tg + 1u) * nx) xb_add(&bar[XB_TOPGEN], 1u);
            else XB_SPIN(xb_ld(&bar[XB_TOPGEN]) == tg, bar);
            __builtin_amdgcn_fence(__ATOMIC_ACQUIRE, "agent");
            xb_add(&bar[XB_XGEN(b.x)], 1u);
            asm volatile("s_waitcnt vmcnt(0)" ::: "memory");
        } else {
            XB_SPIN(xb_ld(&bar[XB_XGEN(b.x)]) == gen, bar);
            __builtin_amdgcn_fence(__ATOMIC_ACQUIRE, "agent");
            asm volatile("s_waitcnt vmcnt(0)" ::: "memory");
        }
    }
    __syncthreads();
}

struct Args { const void* in[26]; float* out; unsigned char* ws; int ph_lo, ph_hi; };
struct Frame {
    LAS unsigned char* lds;
    unsigned char* ws0; unsigned char* ws; unsigned* ctl; float* out;
    int tid, lane, wave, wave0, vcu;
};
typedef const __attribute__((address_space(4))) Args* ArgsP;
__device__ __forceinline__ ArgsP args_ptr() { auto p = __builtin_amdgcn_kernarg_segment_ptr(); asm volatile("" : "+s"(p)); return (ArgsP)p; }
__device__ __forceinline__ int otid(int wave0) { int t = wave0 * 64 + lane_id(); asm volatile("" : "+v"(t)); return t; }
#define REFRESH(F) do { (F).tid = otid((F).wave0); (F).lane = (F).tid & 63; (F).wave = __builtin_amdgcn_readfirstlane((F).tid >> 6); { long z_ = 0; asm volatile("" : "+s"(z_)); (F).ws = (F).ws0 + z_; } (F).ctl = (unsigned*)(F).ws; } while (0)
#define INP(A, k) ((const float*)(A)->in[k])
enum { I_X = 0, I_C, I_POS, I_ADAW, I_ADAB, I_MIXPRE, I_MIXPOST, I_FFNPRE, I_FFNPOST, I_WIN, I_WOUT, I_GROUPG, I_GMLPW, I_GMLPB, I_CONVW, I_CONVB, I_CONVLNG, I_CONVLNB,
       I_FFNWG, I_FFNWU, I_FFNWD, I_ROUTW, I_ROUTB, I_MOEWG, I_MOEWU, I_MOEWD };
#define LDS_WAIT() asm volatile("s_waitcnt lgkmcnt(0)" ::: "memory")

__device__ __forceinline__ void ld_f32_row(float (&v)[16], const float* p, int lane) {
#pragma unroll
    for (int j = 0; j < 4; ++j) { const f32x4 t = ((const f32x4*)p)[lane + 64 * j]; v[4 * j] = t[0]; v[4 * j + 1] = t[1]; v[4 * j + 2] = t[2]; v[4 * j + 3] = t[3]; }
}
__device__ __forceinline__ void ld_bf16_row(float (&v)[16], const bf16* p, int lane) {
#pragma unroll
    for (int j = 0; j < 4; ++j) { const u32x2 t = ((const u32x2*)p)[lane + 64 * j]; v[4 * j] = bflo(t.x); v[4 * j + 1] = bfhi(t.x); v[4 * j + 2] = bflo(t.y); v[4 * j + 3] = bfhi(t.y); }
}
__device__ __forceinline__ void st_f32_row(const float (&v)[16], float* p, int lane) {
#pragma unroll
    for (int j = 0; j < 4; ++j) ((f32x4*)p)[lane + 64 * j] = (f32x4){v[4 * j], v[4 * j + 1], v[4 * j + 2], v[4 * j + 3]};
}
__device__ __forceinline__ void st_bf16_row(const float (&v)[16], bf16* p, int lane) {
#pragma unroll
    for (int j = 0; j < 4; ++j) { u32x2 t; t.x = cvtpk(v[4 * j], v[4 * j + 1]); t.y = cvtpk(v[4 * j + 2], v[4 * j + 3]); ((u32x2*)p)[lane + 64 * j] = t; }
}
struct RawF32 { f32x4 v[4]; };
struct RawB16 { u32x2 v[4]; };
__device__ __forceinline__ RawF32 ldraw(const float* p, int lane) { RawF32 r;
#pragma unroll
    for (int j = 0; j < 4; ++j) r.v[j] = __builtin_nontemporal_load(((const f32x4*)p) + lane + 64 * j);
    return r; }
__device__ __forceinline__ RawB16 ldraw(const bf16* p, int lane) { RawB16 r;
#pragma unroll
    for (int j = 0; j < 4; ++j) r.v[j] = ((const u32x2*)p)[lane + 64 * j];
    return r; }
__device__ __forceinline__ void cvt_row(float (&v)[16], const RawF32& r) {
#pragma unroll
    for (int j = 0; j < 4; ++j) { v[4 * j] = r.v[j][0]; v[4 * j + 1] = r.v[j][1]; v[4 * j + 2] = r.v[j][2]; v[4 * j + 3] = r.v[j][3]; } }
__device__ __forceinline__ void cvt_row(float (&v)[16], const RawB16& r) {
#pragma unroll
    for (int j = 0; j < 4; ++j) { v[4 * j] = bflo(r.v[j].x); v[4 * j + 1] = bfhi(r.v[j].x); v[4 * j + 2] = bflo(r.v[j].y); v[4 * j + 3] = bfhi(r.v[j].y); } }
__device__ __forceinline__ float row_rstd(const float (&v)[16]) {
    float s = 0.f;
#pragma unroll
    for (int i = 0; i < 16; ++i) s += v[i] * v[i];
    return __builtin_amdgcn_rsqf(wave_sum(s) * (1.0f / D) + EPS);
}
__device__ __forceinline__ const float* mod_ptr(const Frame& F, int layer, int b, int part) { return (const float*)(F.ws + WS_MOD) + ((size_t)(layer * 16 + b) * 6 + part) * 1024; }

__device__ __forceinline__ int dst_row(int type, int n) {
    if (type == 0) return n;
    if (type == 1) return 256 * (n >> 7) + (n & 127);
    if (type == 2) return 256 * (n >> 7) + 128 + (n & 127);
    const int sl = n >> 8, cc = n & 255;
    if (sl == 0 || sl == 1 || sl == 3 || sl == 4) { const int hh = cc >> 6, d = cc & 63; return 256 * sl + 64 * hh + 32 * ((d >> 4) & 1) + 8 * ((d >> 2) & 3) + 4 * (d >> 5) + (d & 3); }
    if (sl < 8) return n;
    return 256 * (8 + ((cc >> 7) & 1)) + (sl == 9 ? 128 : 0) + (cc & 127);
}
template <bool FP8>
__device__ __forceinline__ void transpose_item_t(const float* W, int K, int N, void* WTv, int type, float wsc, LAS float* scr, int item, int lane) {
    const int nblk = N / 32, kb = item / nblk, nb = item % nblk, k0 = 64 * kb, n0 = 32 * nb;
    const int kk8 = lane >> 3, nq = lane & 7;
    f32x4 v[8];
#pragma unroll
    for (int i = 0; i < 8; ++i) v[i] = __builtin_nontemporal_load((const f32x4*)(W + (size_t)(k0 + 8 * i + kk8) * N + n0 + 4 * nq));
#pragma unroll
    for (int i = 0; i < 8; ++i)
#pragma unroll
        for (int e = 0; e < 4; ++e) scr[(4 * nq + e) * 68 + 8 * i + kk8] = v[i][e];
    LDS_WAIT(); asm volatile("" ::: "memory");
    const int c = lane & 7;
#pragma unroll
    for (int j = 0; j < 4; ++j) { const int n = (lane >> 3) + 8 * j;
        const f32x4 a = *(const LAS f32x4*)(scr + n * 68 + 8 * c), b = *(const LAS f32x4*)(scr + n * 68 + 8 * c + 4);
        const size_t off = (size_t)dst_row(type, n0 + n) * K + k0 + 8 * c;
        if constexpr (FP8) { u32x2 o; o.x = pk4_fp8(a[0] * wsc, a[1] * wsc, a[2] * wsc, a[3] * wsc); o.y = pk4_fp8(b[0] * wsc, b[1] * wsc, b[2] * wsc, b[3] * wsc); *(u32x2*)((unsigned char*)WTv + off) = o; }
        else { u32x4 o; o.x = cvtpk(a[0], a[1]); o.y = cvtpk(a[2], a[3]); o.z = cvtpk(b[0], b[1]); o.w = cvtpk(b[2], b[3]); *(u32x4*)((bf16*)WTv + off) = o; } }
    LDS_WAIT(); asm volatile("" ::: "memory");
}
__device__ __forceinline__ void transpose_item(const float* W, int K, int N, bf16* WT, int type, LAS float* scr, int item, int lane) { transpose_item_t<false>(W, K, N, WT, type, 1.f, scr, item, lane); }
__device__ __forceinline__ void transpose_item8(const float* W, int K, int N, unsigned char* WT, int type, float wsc, LAS float* scr, int item, int lane) { transpose_item_t<true>(W, K, N, WT, type, wsc, scr, item, lane); }
__device__ __forceinline__ void ada_quarter(Frame& F, ArgsP A, int a, int kc, LAS float* scr, float (&acc)[16]) {
    const int layer = a / 96, n = 64 * (a % 96) + F.lane; const float* cin = INP(A, I_C); const float* ada_w = INP(A, I_ADAW);
#pragma unroll
    for (int b = 0; b < 16; ++b) acc[b] = 0.f;
    for (int i = 0; i < 32; ++i) { const int idx = F.lane + 64 * i, b = idx >> 7, kk = idx & 127; scr[idx] = siluf_(cin[b * 1024 + kc * 128 + kk]); }
    LDS_WAIT(); asm volatile("" ::: "memory");
    const float* wp = ada_w + ((size_t)layer * 1024 + kc * 128) * 6144 + n;
#pragma unroll 2
    for (int kk = 0; kk < 128; kk += 4) { const float w0 = wp[(size_t)kk * 6144], w1 = wp[(size_t)(kk + 1) * 6144], w2 = wp[(size_t)(kk + 2) * 6144], w3 = wp[(size_t)(kk + 3) * 6144];
#pragma unroll
        for (int b = 0; b < 16; ++b) { const f32x4 c4 = *(const LAS f32x4*)(scr + b * 128 + kk); acc[b] += c4[0] * w0; acc[b] += c4[1] * w1; acc[b] += c4[2] * w2; acc[b] += c4[3] * w3; } }
    LDS_WAIT(); asm volatile("" ::: "memory");
}
constexpr int I_MG = 16 * 112, I_MD = 56 * 32, N_MOE_ITEMS = 16 * I_MG + 8 * I_MD;
__device__ __forceinline__ void moe_conv_item(Frame& F, ArgsP A, int r, LAS float* scr) {
    unsigned char* WMGU8 = F.ws + WS_WMGU; unsigned char* WMD8 = F.ws + WS_WMD;
    if (r < 8 * I_MG) { const int e = r / I_MG; transpose_item8(INP(A, I_MOEWG) + (size_t)e * 1024 * FFE, 1024, FFE, WMGU8 + (size_t)e * 2 * FFE * 1024, 1, MOE_WGU_SC, scr, r % I_MG, F.lane); return; } r -= 8 * I_MG;
    if (r < 8 * I_MG) { const int e = r / I_MG; transpose_item8(INP(A, I_MOEWU) + (size_t)e * 1024 * FFE, 1024, FFE, WMGU8 + (size_t)e * 2 * FFE * 1024, 2, MOE_WGU_SC, scr, r % I_MG, F.lane); return; } r -= 8 * I_MG;
    { const int e = r / I_MD; transpose_item8(INP(A, I_MOEWD) + (size_t)e * FFE * 1024, FFE, 1024, WMD8 + (size_t)e * 1024 * FFE, 0, MOE_WD_SC, scr, r % I_MD, F.lane); }
}
constexpr int I_IN = 16 * 80, I_OUT = 16 * 32, I_FG = 16 * 88, I_FD = 44 * 32;
constexpr int N_DEF0 = I_IN + 2 * I_OUT + 2 * I_FG + I_FD;
__device__ __forceinline__ int def_items(int layer) { return layer == 0 ? N_DEF0 + N_MOE_ITEMS / 2 : N_MOE_ITEMS / 2; }
__device__ __forceinline__ void def_conv_item(Frame& F, ArgsP A, int layer, int r, LAS float* scr) {
    if (layer == 0) {
        bf16* WIN = (bf16*)(F.ws + WS_WIN); bf16* WOUT = (bf16*)(F.ws + WS_WOUT); bf16* WFGU = (bf16*)(F.ws + WS_WFGU); bf16* WFD = (bf16*)(F.ws + WS_WFD);
        if (r < I_OUT) { transpose_item(INP(A, I_WOUT), 1024, 1024, WOUT, 0, scr, r, F.lane); return; } r -= I_OUT;
        if (r < I_FG) { transpose_item8(INP(A, I_FFNWG), 1024, FFD, (unsigned char*)WFGU, 1, MOE_WGU_SC, scr, r, F.lane); return; } r -= I_FG;
        if (r < I_FG) { transpose_item8(INP(A, I_FFNWU), 1024, FFD, (unsigned char*)WFGU, 2, MOE_WGU_SC, scr, r, F.lane); return; } r -= I_FG;
        if (r < I_FD) { transpose_item(INP(A, I_FFNWD), FFD, 1024, WFD, 0, scr, r, F.lane); return; } r -= I_FD;
        if (r < I_IN) { transpose_item(INP(A, I_WIN) + (size_t)1024 * NIN, 1024, NIN, WIN + (size_t)NIN * 1024, 3, scr, r, F.lane); return; } r -= I_IN;
        if (r < I_OUT) { transpose_item(INP(A, I_WOUT) + (size_t)1024 * 1024, 1024, 1024, WOUT + (size_t)1024 * 1024, 0, scr, r, F.lane); return; } r -= I_OUT;
        moe_conv_item(F, A, r, scr);
    } else moe_conv_item(F, A, N_MOE_ITEMS / 2 + r, scr);
}
__device__ __forceinline__ void phase_prologue(Frame& F) {
    REFRESH(F);
    LAS float* scr = (LAS float*)(F.lds + F.wave * 16384);
    ArgsP A = args_ptr();
    const bool ada_wave = (F.vcu < 192);
    float acc[16];
    if (ada_wave) ada_quarter(F, A, F.vcu, F.wave, scr, acc);
    const int gw = (F.vcu - 192) * 8 + F.wave, NGW = (NWG - 192) * 8;
    for (int it = ada_wave ? -1 : gw; it >= 0 && it < I_IN; it += NGW) transpose_item(INP(A, I_WIN), 1024, NIN, (bf16*)(F.ws + WS_WIN), 3, scr, it, F.lane);
    if (ada_wave) {
#pragma unroll
        for (int b = 0; b < 16; ++b) scr[b * 64 + F.lane] = acc[b]; }
    __syncthreads();
    if (F.wave == 0 && F.vcu < 192) { const int a = F.vcu, layer = a / 96, n = 64 * (a % 96) + F.lane;
        float* mod = (float*)(F.ws + WS_MOD); const float bias = INP(A, I_ADAB)[layer * 6144 + n];
#pragma unroll
        for (int b = 0; b < 16; ++b) { float v = bias;
#pragma unroll
            for (int q = 0; q < 8; ++q) v += ((LAS float*)(F.lds + q * 16384))[b * 64 + F.lane];
            mod[(size_t)(layer * 16 + b) * 6144 + n] = v; } }
}

__device__ __forceinline__ void norm_mod_store(const float (&x)[16], const float* g, const float* sc, const float* sh, bf16* dst, int lane, float (&h)[16]) {
    const float r = row_rstd(x);
    float gv[16], scv[16], shv[16]; ld_f32_row(gv, g, lane); ld_f32_row(scv, sc, lane); ld_f32_row(shv, sh, lane);
#pragma unroll
    for (int i = 0; i < 16; ++i) h[i] = x[i] * r * gv[i] * (1.0f + scv[i]) + shv[i];
    if (dst) st_bf16_row(h, dst, lane);
}
__device__ __forceinline__ void norm_mod(const float (&x)[16], const float (&g1s)[16], const float (&shv)[16], float (&h)[16]) {
    const float r = row_rstd(x);
#pragma unroll
    for (int i = 0; i < 16; ++i) h[i] = x[i] * r * g1s[i] + shv[i];
}
__device__ __forceinline__ void ld_g1s(float (&g1s)[16], const float* g, const float* sc, int lane) { float a[16], b[16]; ld_f32_row(a, g, lane); ld_f32_row(b, sc, lane);
#pragma unroll
    for (int i = 0; i < 16; ++i) g1s[i] = a[i] * (1.0f + b[i]); }
__device__ __forceinline__ void phase_prenorm0(Frame& F) {
    REFRESH(F);
    const int rpw = M / (NWG * 8); bf16* HB = (bf16*)(F.ws + WS_HB); ArgsP A = args_ptr(); const float* x_in = INP(A, I_X); const float* mix_pre_g = INP(A, I_MIXPRE);
    const int m0 = (F.vcu * 8 + F.wave) * rpw, b = m0 >> 11;
    float g1s[16], shv[16]; ld_g1s(g1s, mix_pre_g, mod_ptr(F, 0, b, 1), F.lane); ld_f32_row(shv, mod_ptr(F, 0, b, 0), F.lane);
    RawF32 cur = ldraw(x_in + (size_t)m0 * D, F.lane);
    for (int k = 0; k < rpw; ++k) { const int m = m0 + k;
        RawF32 nxt = cur; if (k + 1 < rpw) nxt = ldraw(x_in + (size_t)(m + 1) * D, F.lane);
        float x[16], h[16]; cvt_row(x, cur); norm_mod(x, g1s, shv, h); st_bf16_row(h, HB + (size_t)m * D, F.lane); cur = nxt; }
}
__device__ __forceinline__ void phase_postmix(Frame& F, int layer, bool moe) {
    REFRESH(F);
    const int rpw = M / (NWG * 8); bf16* HB = (bf16*)(F.ws + WS_HB); const bf16* Y = (const bf16*)(F.ws + WS_Y);
    ArgsP A = args_ptr(); const float* xsrc = INP(A, I_X); bf16* XB = (bf16*)(F.ws + WS_XB);
    const float* mix_post_g = INP(A, I_MIXPOST); const float* ffn_pre_g = INP(A, I_FFNPRE); const float* router_w = INP(A, I_ROUTW); const float* router_b = INP(A, I_ROUTB);
    LAS int* lcnt = (LAS int*)(F.lds + LDSX_OFF + 256);
    LAS int* lbase = lcnt + 8; LAS int* rinfo = lcnt + 16;
    if (moe) { if (F.tid < 16) lcnt[F.tid] = 0; __syncthreads(); }
    const int m0 = F.vcu * 8 * rpw + F.wave * rpw, b = m0 >> 11;
    float gpg[16], g1s[16], shv[16];
    { float a[16], c[16]; ld_f32_row(a, mix_post_g + layer * D, F.lane); ld_f32_row(c, mod_ptr(F, layer, b, 2), F.lane);
#pragma unroll
      for (int i = 0; i < 16; ++i) gpg[i] = a[i] * c[i]; }
    ld_g1s(g1s, ffn_pre_g + layer * D, mod_ptr(F, layer, b, 4), F.lane); ld_f32_row(shv, mod_ptr(F, layer, b, 3), F.lane);
    RawF32 xf = {}; RawB16 xb = {};
    if (layer == 0) xf = ldraw(xsrc + (size_t)m0 * D, F.lane); else xb = ldraw(XB + (size_t)m0 * D, F.lane);
    RawB16 yr = ldraw(Y + (size_t)m0 * D, F.lane);
    for (int k = 0; k < rpw; ++k) { const int rl = F.wave * rpw + k, m = m0 + k;
        RawF32 xfn = xf; RawB16 xbn = xb, yn = yr;
        if (k + 1 < rpw) { if (layer == 0) xfn = ldraw(xsrc + (size_t)(m + 1) * D, F.lane); else xbn = ldraw(XB + (size_t)(m + 1) * D, F.lane); yn = ldraw(Y + (size_t)(m + 1) * D, F.lane); }
        float x[16], y[16], h[16];
        if (layer == 0) cvt_row(x, xf); else cvt_row(x, xb);
        cvt_row(y, yr);
        const float ry = row_rstd(y);
#pragma unroll
        for (int i = 0; i < 16; ++i) x[i] += gpg[i] * (y[i] * ry);
        st_bf16_row(x, XB + (size_t)m * D, F.lane);
        norm_mod(x, g1s, shv, h);
        if (!moe) { unsigned* h8 = (unsigned*)(F.ws + WS_HB + (size_t)m * D);
#pragma unroll
            for (int j = 0; j < 4; ++j) h8[F.lane + 64 * j] = pk4_fp8(h[4 * j], h[4 * j + 1], h[4 * j + 2], h[4 * j + 3]); }
        xf = xfn; xb = xbn; yr = yn;
        if (moe) {
            { unsigned* h8 = (unsigned*)(F.ws + WS_HB + (size_t)m * D);
#pragma unroll
              for (int j = 0; j < 4; ++j) h8[F.lane + 64 * j] = pk4_fp8(h[4 * j], h[4 * j + 1], h[4 * j + 2], h[4 * j + 3]); }
            float lg[8];
#pragma unroll
            for (int e = 0; e < 8; ++e) lg[e] = 0.f;
#pragma unroll
            for (int j = 0; j < 4; ++j)
#pragma unroll
                for (int e4 = 0; e4 < 4; ++e4) { const float* rw = router_w + (size_t)(256 * j + 4 * F.lane + e4) * 8; const f32x4 w0 = *(const f32x4*)rw, w1 = *(const f32x4*)(rw + 4); const float hv = h[4 * j + e4];
                    lg[0] += hv * w0[0]; lg[1] += hv * w0[1]; lg[2] += hv * w0[2]; lg[3] += hv * w0[3]; lg[4] += hv * w1[0]; lg[5] += hv * w1[1]; lg[6] += hv * w1[2]; lg[7] += hv * w1[3]; }
#pragma unroll
            for (int e = 0; e < 8; ++e) lg[e] = wave_sum(lg[e]) + router_b[e];
            int e0 = 0; float l0 = lg[0];
#pragma unroll
            for (int e = 1; e < 8; ++e) if (lg[e] > l0) { l0 = lg[e]; e0 = e; }
            int e1 = -1; float l1 = -INFINITY;
#pragma unroll
            for (int e = 0; e < 8; ++e) if (e != e0 && lg[e] > l1) { l1 = lg[e]; e1 = e; }
            if (F.lane == 0) {
                const float g0 = fast_rcp(1.0f + __expf(l1 - l0));
                const int p0 = atomicAdd((int*)(lcnt + e0), 1), p1 = atomicAdd((int*)(lcnt + e1), 1);
                rinfo[rl * 4 + 0] = e0; rinfo[rl * 4 + 1] = e1; rinfo[rl * 4 + 2] = p0; rinfo[rl * 4 + 3] = p1;
                float* RTG = (float*)(F.ws + WS_RTG); RTG[2 * m] = g0; RTG[2 * m + 1] = 1.0f - g0;
            }
        }
    }
    if (moe) {
        __syncthreads();
        if (F.tid < 8) lbase[F.tid] = (int)__hip_atomic_fetch_add(F.ctl + CW_CNT + F.tid, (unsigned)lcnt[F.tid], __ATOMIC_RELAXED, __HIP_MEMORY_SCOPE_AGENT);
        __syncthreads();
        const int nrows = 8 * rpw;
        int* RTE = (int*)(F.ws + WS_RTE); int* RTP = (int*)(F.ws + WS_RTP);
        for (int rl = F.tid; rl < nrows; rl += 512) { const int m = F.vcu * nrows + rl; const int e0 = rinfo[rl * 4], e1 = rinfo[rl * 4 + 1];
            RTE[2 * m] = e0; RTE[2 * m + 1] = e1; RTP[2 * m] = lbase[e0] + rinfo[rl * 4 + 2]; RTP[2 * m + 1] = lbase[e1] + rinfo[rl * 4 + 3]; }
    }
}
__device__ __forceinline__ void moe_tiles(const Frame& F, int (&ts)[9], int (&cnt)[8]) {
    const u32x4 c0 = *(const u32x4*)(F.ctl + CW_CNT), c1 = *(const u32x4*)(F.ctl + CW_CNT + 4);
    const unsigned cv[8] = {c0.x, c0.y, c0.z, c0.w, c1.x, c1.y, c1.z, c1.w};
    int acc = 0;
#pragma unroll
    for (int e = 0; e < 8; ++e) { cnt[e] = __builtin_amdgcn_readfirstlane((int)cv[e]); ts[e] = acc; acc += (cnt[e] + 255) >> 8; }
    ts[8] = acc;
}
__device__ __forceinline__ void phase_moe_index(Frame& F) {
    REFRESH(F);
    int ts[9], cnt[8]; moe_tiles(F, ts, cnt);
    int* S2T = (int*)(F.ws + WS_S2T); const int* RTE = (const int*)(F.ws + WS_RTE); const int* RTP = (const int*)(F.ws + WS_RTP);
    const int gt = F.vcu * 512 + F.tid, NT = NWG * 512;
    for (int s = gt; s < ts[8] * 256; s += NT) { const int tile = s >> 8; int e = 0;
#pragma unroll
        for (int k = 1; k < 8; ++k) e += (tile >= ts[k]) ? 1 : 0;
        int c = 0, t0 = 0;
#pragma unroll
        for (int k = 0; k < 8; ++k) { c = (k == e) ? cnt[k] : c; t0 = (k == e) ? ts[k] : t0; }
        if (s - 256 * t0 >= c) S2T[((s >> 8) * 64 + (s & 63)) * 4 + ((s >> 6) & 3)] = 0; }
    for (int a = gt; a < 2 * M; a += NT) { const int e = RTE[a]; int t0 = 0;
#pragma unroll
        for (int k = 0; k < 8; ++k) t0 = (k == e) ? ts[k] : t0;
        { const int sl = 256 * t0 + RTP[a]; S2T[((sl >> 8) * 64 + (sl & 63)) * 4 + ((sl >> 6) & 3)] = a >> 1; } }
}
__device__ __forceinline__ void phase_postffn(Frame& F, int layer, bool moe) {
    REFRESH(F);
    const int rpw = M / (NWG * 8); bf16* HB = (bf16*)(F.ws + WS_HB); bf16* XB = (bf16*)(F.ws + WS_XB);
    int ts[9], cnt[8]; if (moe) moe_tiles(F, ts, cnt);
    ArgsP A = args_ptr(); const float* ffn_post_g = INP(A, I_FFNPOST); const float* mix_pre_g = INP(A, I_MIXPRE);
    const int* RTE = (const int*)(F.ws + WS_RTE); const int* RTP = (const int*)(F.ws + WS_RTP); const float* RTG = (const float*)(F.ws + WS_RTG); const bf16* YS = (const bf16*)(F.ws + WS_YS);
    const int m0 = (F.vcu * 8 + F.wave) * rpw, b = m0 >> 11;
    float gpg[16], g1s[16], shv[16];
    { float a[16], c[16]; ld_f32_row(a, ffn_post_g + layer * D, F.lane); ld_f32_row(c, mod_ptr(F, layer, b, 5), F.lane);
#pragma unroll
      for (int i = 0; i < 16; ++i) gpg[i] = a[i] * c[i]; }
    if (layer == 0) { ld_g1s(g1s, mix_pre_g + D, mod_ptr(F, 1, b, 1), F.lane); ld_f32_row(shv, mod_ptr(F, 1, b, 0), F.lane); }
#define PF_LOAD(mm, XR, YA, YB, G0, G1) do { XR = ldraw(XB + (size_t)(mm) * D, F.lane); \
        if (moe) { const int e0_ = RTE[2 * (mm)], e1_ = RTE[2 * (mm) + 1]; int t0_ = 0, t1_ = 0; \
            _Pragma("unroll") for (int q = 0; q < 8; ++q) { t0_ = (q == e0_) ? ts[q] : t0_; t1_ = (q == e1_) ? ts[q] : t1_; } \
            const size_t s0_ = (size_t)256 * t0_ + RTP[2 * (mm)], s1_ = (size_t)256 * t1_ + RTP[2 * (mm) + 1]; G0 = RTG[2 * (mm)]; G1 = RTG[2 * (mm) + 1]; \
            YA = ldraw(YS + s0_ * D, F.lane); YB = ldraw(YS + s1_ * D, F.lane); } \
        else YA = ldraw(HB + (size_t)(mm) * D, F.lane); } while (0)
    RawB16 xr, ya, yb = {}; float g0 = 0.f, g1 = 0.f;
    PF_LOAD(m0, xr, ya, yb, g0, g1);
    for (int k = 0; k < rpw; ++k) { const int m = m0 + k;
        RawB16 xn = xr, yan = ya, ybn = yb; float g0n = g0, g1n = g1;
        if (k + 1 < rpw) PF_LOAD(m + 1, xn, yan, ybn, g0n, g1n);
        float x[16], y[16], h[16];
        cvt_row(x, xr); cvt_row(y, ya);
        if (moe) { float y2[16]; cvt_row(y2, yb);
#pragma unroll
            for (int i = 0; i < 16; ++i) y[i] = g0 * y[i] + g1 * y2[i]; }
        const float ry = row_rstd(y);
#pragma unroll
        for (int i = 0; i < 16; ++i) x[i] += gpg[i] * (y[i] * ry);
        if (layer == 0) { st_bf16_row(x, XB + (size_t)m * D, F.lane); norm_mod(x, g1s, shv, h); st_bf16_row(h, HB + (size_t)m * D, F.lane); }
        else st_f32_row(x, F.out + (size_t)m * D, F.lane);
        xr = xn; ya = yan; yb = ybn; g0 = g0n; g1 = g1n;
    }
#undef PF_LOAD
}
__device__ __forceinline__ void phase_mixnorm(Frame& F, int layer) {
    REFRESH(F);
    const int rpw = M / (NWG * 8); bf16* MIXN = (bf16*)(F.ws + WS_HB);
    const bf16* OA = (const bf16*)(F.ws + WS_OA); const bf16* OC = (const bf16*)(F.ws + WS_OC); const bf16* OD = (const bf16*)(F.ws + WS_OD);
    const bf16* DIL = (const bf16*)(F.ws + WS_DIL); const float* LSE = (const float*)(F.ws + WS_LSE);
    const int lane = F.lane, hh = lane >> 4; ArgsP A = args_ptr(); const float* group_g = INP(A, I_GROUPG);
    f32x4 gg[4];
#pragma unroll
    for (int g = 0; g < 4; ++g) gg[g] = *(const f32x4*)(group_g + (size_t)(layer * 4 + g) * 256 + 4 * lane);
    struct Raw { u32x2 oa, d0, d1, d2, oc, od; float l0, l1, l2; };
#define MN_LOAD(R, mm) do { const size_t m_ = (mm); R.oa = ((const u32x2*)(OA + m_ * 256))[lane]; R.oc = ((const u32x2*)(OC + m_ * 256))[lane]; R.od = ((const u32x2*)(OD + m_ * 256))[lane]; \
        R.d0 = ((const u32x2*)(DIL + m_ * 256))[lane]; R.d1 = ((const u32x2*)(DIL + ((size_t)M + m_) * 256))[lane]; R.d2 = ((const u32x2*)(DIL + ((size_t)2 * M + m_) * 256))[lane]; \
        R.l0 = LSE[m_ * 4 + hh]; R.l1 = LSE[((size_t)M + m_) * 4 + hh]; R.l2 = LSE[((size_t)2 * M + m_) * 4 + hh]; } while (0)
    const size_t m0 = (size_t)(F.vcu * 8 + F.wave) * rpw;
    Raw cur; MN_LOAD(cur, m0);
    for (int k = 0; k < rpw; ++k) { const size_t m = m0 + k;
        Raw nxt = cur; if (k + 1 < rpw) MN_LOAD(nxt, m + 1);
        float v[4][4];
        v[0][0] = bflo(cur.oa.x); v[0][1] = bfhi(cur.oa.x); v[0][2] = bflo(cur.oa.y); v[0][3] = bfhi(cur.oa.y);
        { const float mx = fmaxf(cur.l0, fmaxf(cur.l1, cur.l2)); float w0 = fast_exp2(cur.l0 - mx), w1 = fast_exp2(cur.l1 - mx), w2 = fast_exp2(cur.l2 - mx); const float inv = fast_rcp(w0 + w1 + w2); w0 *= inv; w1 *= inv; w2 *= inv;
          v[1][0] = w0 * bflo(cur.d0.x) + w1 * bflo(cur.d1.x) + w2 * bflo(cur.d2.x); v[1][1] = w0 * bfhi(cur.d0.x) + w1 * bfhi(cur.d1.x) + w2 * bfhi(cur.d2.x);
          v[1][2] = w0 * bflo(cur.d0.y) + w1 * bflo(cur.d1.y) + w2 * bflo(cur.d2.y); v[1][3] = w0 * bfhi(cur.d0.y) + w1 * bfhi(cur.d1.y) + w2 * bfhi(cur.d2.y); }
        v[2][0] = bflo(cur.oc.x); v[2][1] = bfhi(cur.oc.x); v[2][2] = bflo(cur.oc.y); v[2][3] = bfhi(cur.oc.y);
        v[3][0] = bflo(cur.od.x); v[3][1] = bfhi(cur.od.x); v[3][2] = bflo(cur.od.y); v[3][3] = bfhi(cur.od.y);
#pragma unroll
        for (int g = 0; g < 4; ++g) {
            const float ss = wave_sum(v[g][0] * v[g][0] + v[g][1] * v[g][1] + v[g][2] * v[g][2] + v[g][3] * v[g][3]);
            const float r = __builtin_amdgcn_rsqf(ss * (1.0f / 256.0f) + EPS);
            u32x2 t; t.x = cvtpk(v[g][0] * r * gg[g][0], v[g][1] * r * gg[g][1]); t.y = cvtpk(v[g][2] * r * gg[g][2], v[g][3] * r * gg[g][3]);
            ((u32x2*)(MIXN + m * D + 256 * g))[lane] = t; }
        cur = nxt;
    }
#undef MN_LOAD
}

__device__ __forceinline__ void gmlp_unit(Frame& F, int layer, int b, int ch) {
    const bf16* P = (const bf16*)(F.ws + WS_P); bf16* OC = (bf16*)(F.ws + WS_OC);
    const size_t R0 = (size_t)b * SEQ + 128 * ch;
    LAS bf16* VT = (LAS bf16*)F.lds;
    const int lane = F.lane, w = F.wave;
    u32x2 raw[16];
#pragma unroll
    for (int k = 0; k < 16; ++k) raw[k] = ((const u32x2*)(P + (R0 + 16 * w + k) * PW + P_GV))[lane];
#pragma unroll
    for (int k = 0; k < 16; ++k) { const int s = 16 * w + k; const u32x2 t = raw[k];
        float v0 = bflo(t.x), v1 = bfhi(t.x), v2 = bflo(t.y), v3 = bfhi(t.y);
        const float s1 = wave_sum((v0 + v1) + (v2 + v3)), s2 = wave_sum((v0 * v0 + v1 * v1) + (v2 * v2 + v3 * v3));
        const float mean = s1 * (1.0f / 256.0f), var = fmaxf(s2 * (1.0f / 256.0f) - mean * mean, 0.f);
        const float rstd = __builtin_amdgcn_rsqf(var + EPS);
        v0 -= mean; v1 -= mean; v2 -= mean; v3 -= mean;
        const unsigned p0 = cvtpk(v0 * rstd, v1 * rstd), p1 = cvtpk(v2 * rstd, v3 * rstd);
        VT[(4 * lane + 0) * 136 + s] = (bf16)(p0 & 0xffffu); VT[(4 * lane + 1) * 136 + s] = (bf16)(p0 >> 16);
        VT[(4 * lane + 2) * 136 + s] = (bf16)(p1 & 0xffffu); VT[(4 * lane + 3) * 136 + s] = (bf16)(p1 >> 16); }
    __syncthreads();
    const int g = w >> 1, cb = 64 * g + 32 * (w & 1), r = lane & 31, h = lane >> 5;
    ArgsP A = args_ptr();
    const float* W = INP(A, I_GMLPW) + (size_t)(layer * 4 + g) * 128 * 128;
    const float* bias = INP(A, I_GMLPB) + (size_t)(layer * 4 + g) * 128;
#pragma unroll
    for (int tt = 0; tt < 4; ++tt) {
        f32x16 acc;
#pragma unroll
        for (int i = 0; i < 16; ++i) acc[i] = 0.f;
        const int t = 32 * tt + r;
        float ub[16], bb[16];
#pragma unroll
        for (int i = 0; i < 16; ++i) { const int to = 32 * tt + crow(i, h); ub[i] = bf2f(P[(R0 + to) * PW + P_GU + cb + r]); bb[i] = bias[to]; }
        f32x4 wa[8], wc[8];
#pragma unroll
        for (int ks = 0; ks < 2 * (tt + 1); ++ks) { const int s0 = 16 * ks + 8 * h; wa[ks] = *(const f32x4*)(W + (size_t)t * 128 + s0); wc[ks] = *(const f32x4*)(W + (size_t)t * 128 + s0 + 4); }
#pragma unroll
        for (int ks = 0; ks < 2 * (tt + 1); ++ks) {
            const int s0 = 16 * ks + 8 * h;
            float v[8] = {wa[ks][0], wa[ks][1], wa[ks][2], wa[ks][3], wc[ks][0], wc[ks][1], wc[ks][2], wc[ks][3]};
#pragma unroll
            for (int e = 0; e < 8; ++e) v[e] = (s0 + e <= t) ? v[e] : 0.f;
            u32x4 aw; aw.x = cvtpk(v[0], v[1]); aw.y = cvtpk(v[2], v[3]); aw.z = cvtpk(v[4], v[5]); aw.w = cvtpk(v[6], v[7]);
            const bf16x8 bfrag = *(const LAS bf16x8*)(VT + (cb + r) * 136 + s0);
            acc = MFMA32(__builtin_bit_cast(bf16x8, aw), bfrag, acc);
        }
#pragma unroll
        for (int i = 0; i < 16; ++i) { const int to = 32 * tt + crow(i, h); const float z = acc[i] + bb[i];
            OC[(R0 + to) * 256 + cb + r] = (bf16)(cvtpk(ub[i] * z, 0.f) & 0xffffu); }
    }
    __syncthreads();
}
__device__ __forceinline__ void conv_unit(Frame& F, int layer, int b, int ch) {
    const bf16* P = (const bf16*)(F.ws + WS_P); bf16* OD = (bf16*)(F.ws + WS_OD);
    const int t0 = 64 * ch; const size_t Rb = (size_t)b * SEQ;
    LAS bf16* XT = (LAS bf16*)F.lds;
    LAS float* YT = (LAS float*)(F.lds + 48128);
    for (int id = F.tid; id < 94 * 32; id += 512) { const int row = id >> 5, piece = id & 31, t = t0 - 30 + row;
        u32x4 v = (u32x4){0u, 0u, 0u, 0u};
        if (t >= 0) v = *(const u32x4*)(P + (Rb + t) * PW + P_GLU + 8 * piece);
        *(LAS u32x4*)(XT + row * 256 + 8 * piece) = v; }
    __syncthreads();
    ArgsP A = args_ptr();
    { const int c = F.tid & 255, half = F.tid >> 8; const float* conv_w = INP(A, I_CONVW);
      float wk[31];
#pragma unroll
      for (int k = 0; k < 31; ++k) wk[k] = conv_w[(size_t)(layer * 31 + k) * 256 + c];
      const float cb = INP(A, I_CONVB)[layer * 256 + c];
      float xs[62];
#pragma unroll
      for (int i = 0; i < 62; ++i) xs[i] = bf2f(XT[(32 * half + i) * 256 + c]);
#pragma unroll
      for (int j = 0; j < 32; ++j) { float y = cb;
#pragma unroll
          for (int k = 0; k < 31; ++k) y += wk[k] * xs[j + k];
          YT[(32 * half + j) * 260 + c] = y; } }
    __syncthreads();
    { const int lane = F.lane;
      const f32x4 lg = *(const f32x4*)(INP(A, I_CONVLNG) + layer * 256 + 4 * lane), lb = *(const f32x4*)(INP(A, I_CONVLNB) + layer * 256 + 4 * lane);
      for (int k = 0; k < 8; ++k) { const int t = 8 * F.wave + k;
          f32x4 y = *(const LAS f32x4*)(YT + t * 260 + 4 * lane);
          const float mean = wave_sum((y[0] + y[1]) + (y[2] + y[3])) * (1.0f / 256.0f);
          y = y - mean;
          const float rstd = __builtin_amdgcn_rsqf(wave_sum((y[0] * y[0] + y[1] * y[1]) + (y[2] * y[2] + y[3] * y[3])) * (1.0f / 256.0f) + EPS);
          float o[4];
#pragma unroll
          for (int e = 0; e < 4; ++e) o[e] = siluf_(y[e] * rstd * lg[e] + lb[e]);
          u32x2 w; w.x = cvtpk(o[0], o[1]); w.y = cvtpk(o[2], o[3]);
          ((u32x2*)(OD + (Rb + t0 + t) * 256))[lane] = w; } }
    __syncthreads();
}
__device__ __forceinline__ void phase_mixers(Frame& F, int layer) {
    REFRESH(F);
    __syncthreads();
    const bf16* P = (const bf16*)(F.ws + WS_P);
    const float* kms = (const float*)(F.ctl + CW_KM) + (size_t)layer * 32768;
    for (int rq = (REPK == 16 ? 2 : 1); rq > 0; --rq)
    for (int u = F.vcu; u < 256; u += NWG) { const int bh = u >> 2, sq = u & 3; const attn_body::bf16* Pq = (const attn_body::bf16*)P;
        for (int k2 = 0; k2 < 2; ++k2)
            attn_body::attn_unit<8>(F.tid, bh >> 2, bh & 3, k2 ? 7 - sq : sq, Pq + P_QA, Pq + P_KA, Pq + P_VA, (attn_body::bf16*)(F.ws + WS_OA), kms, (char*)F.lds); }
    REFRESH(F);
    for (int rq = (REPK == 17 ? 2 : 1); rq > 0; --rq)
    for (int u = F.vcu; u < 256; u += NWG) gmlp_unit(F, layer, u >> 4, u & 15);
    REFRESH(F);
    for (int rq = (REPK == 18 ? 2 : 1); rq > 0; --rq)
    for (int u = F.vcu; u < 512; u += NWG) conv_unit(F, layer, u >> 5, u & 31);
    REFRESH(F);
    LAS char* vt = (LAS char*)(F.lds + F.wave * ATT_WAVE_LDS);
    const int gw = F.vcu * 8 + F.wave, NGW = NWG * 8;
    ArgsP Acv = args_ptr(); int cvk = 0;
    for (int rq = (REPK == 19 ? 2 : 1); rq > 0; --rq)
    for (int it = gw; it < 3 * 2048; it += NGW) { const int cfg = it >> 11, rem = it & 2047, bh = rem >> 5, idx = rem & 31;
        dil_pair_item(P, (bf16*)(F.ws + WS_DIL) + (size_t)cfg * M * 256, (float*)(F.ws + WS_LSE) + (size_t)cfg * M * 4, cfg, bh >> 2, bh & 3, idx, vt, F.lane);
        for (int q = 0; q < 5; ++q, ++cvk) { const int ci = cvk * NGW + gw; if (ci < def_items(layer)) def_conv_item(F, Acv, layer, ci, (LAS float*)vt); } }
}

constexpr int PH_PROLOGUE = 0, PH_PRENORM = 1, PH_L0 = 2, PH_L1 = 10, PH_MOE_INDEX = 15, PH_MOE_CHUNK0 = 16, PH_MOE_COMBINE = 26, PH_POSTFFN1 = 27, N_PHASES = 28;
constexpr int KSPLIT = 7, KS_BYTES = FFE / KSPLIT;
#ifndef KMASK
#define KMASK 0xFFFF
#endif
#define KON(b) (((KMASK) >> (b)) & 1)
#define NREP(b) (((REPK) == (b)) ? nrep2 : 1)
#if MK_ONE_LAUNCH
#define IN(k) true
#else
#define IN(k) (lo <= (k) && (k) < hi)
#endif
#define SEAM(k) do { if (IN(k) && IN((k) + 1)) { xcd_barrier(bar, F.wave0 * 64 + lane_id()); if (REPK == 20) xcd_barrier(bar, F.wave0 * 64 + lane_id()); \
    if (TSA >= 0) { if (blockIdx.x == 0 && F.wave0 == 0 && lane_id() == 0) __hip_atomic_store((unsigned long long*)(F.ctl + CW_TS) + (k) + 1, (unsigned long long)__builtin_amdgcn_s_memrealtime(), __ATOMIC_RELAXED, __HIP_MEMORY_SCOPE_AGENT); } } } while (0)

template <int LAYER>
__device__ __forceinline__ void run_layer(Frame& F, const XcdBarrier& bar, const int* posp, const int lo, const int hi, const int nrep2) {
        constexpr int layer = LAYER; constexpr int pb = LAYER == 0 ? PH_L0 : PH_L1;
        if (KON(2) && IN(pb)) for (int rp = NREP(2); rp > 0; --rp) {
            REFRESH(F);
            pg8::SchedPlain S; S.init(M / 256, NIN / 256, NWG, (int)blockIdx.x); S.dup = (REPK == 25); S.Bt = (const char*)(F.ws + WS_WIN) + (size_t)layer * NIN * 1024 * 2; S.tstep = (size_t)256 * 1024 * 2;
            EpiInProj E{(bf16*)(F.ws + WS_P), posp, (float*)(F.ctl + CW_KM) + (size_t)layer * 32768};
            pg8::gemm_phase(F.lds, F.wave0, (const char*)(F.ws + WS_HB), 2 * 1024, S, E);
        }
        SEAM(pb);
        if (KON(3) && IN(pb + 1)) for (int rp = NREP(3); rp > 0; --rp) phase_mixers(F, layer);
        SEAM(pb + 1);
        if (KON(4) && IN(pb + 2)) for (int rp = NREP(4); rp > 0; --rp) phase_mixnorm(F, layer);
        SEAM(pb + 2);
        if (KON(5) && IN(pb + 3)) for (int rp = NREP(5); rp > 0; --rp) {
            REFRESH(F);
            pg8::SchedPlain S; S.init(M / 256, 4, NWG, (int)blockIdx.x); S.Bt = (const char*)(F.ws + WS_WOUT) + (size_t)layer * 1024 * 1024 * 2; S.tstep = (size_t)256 * 1024 * 2;
            EpiPlain E{(bf16*)(F.ws + WS_Y), 1024, 0};
            pg8::gemm_phase(F.lds, F.wave0, (const char*)(F.ws + WS_HB), 2 * 1024, S, E);
        }
        SEAM(pb + 3);
        if (KON(6) && IN(pb + 4)) for (int rp = (layer == 0 ? NREP(6) : 1); rp > 0; --rp) phase_postmix(F, layer, layer == 1);
        SEAM(pb + 4);
        if constexpr (LAYER == 0) {
            if (KON(7) && IN(pb + 5)) for (int rp = NREP(7); rp > 0; --rp) {
                REFRESH(F);
                pg8::SchedPlain S; S.init(M / 256, 2 * FFD / 256, NWG, (int)blockIdx.x); S.dup = (REPK == 24); S.Bt = (const char*)(F.ws + WS_WFGU); S.tstep = (size_t)256 * 1024;
                EpiSwiGLU E{(bf16*)(F.ws + WS_FH), FFD};
                pg8::gemm_phase<EpiSwiGLU, pg8::SchedPlain, true>(F.lds, F.wave0, (const char*)(F.ws + WS_HB), 1024, S, E, E8_WGU, E8_ONE);
            }
            SEAM(pb + 5);
            if (KON(8) && IN(pb + 6)) for (int rp = NREP(8); rp > 0; --rp) {
                REFRESH(F);
                pg8::SchedPlain S; S.init(M / 256, 4, NWG, (int)blockIdx.x); S.Bt = (const char*)(F.ws + WS_WFD); S.tstep = (size_t)256 * FFD * 2;
                EpiPlain E{(bf16*)(F.ws + WS_HB), 1024, 0};
                pg8::gemm_phase(F.lds, F.wave0, (const char*)(F.ws + WS_FH), 2 * FFD, S, E);
            }
            SEAM(pb + 6);
            if (KON(9) && IN(pb + 7)) phase_postffn(F, 0, false);
            SEAM(pb + 7);
        } else {
            if (KON(10) && IN(PH_MOE_INDEX)) for (int rp = NREP(10); rp > 0; --rp) phase_moe_index(F);
            SEAM(PH_MOE_INDEX);
            for (int rp14 = NREP(14); rp14 > 0; --rp14)
            for (int c = 0; c < NCHUNK; ++c) {
                const int pg = PH_MOE_CHUNK0 + 2 * c;
                if (IN(pg) || IN(pg + 1)) {
                    REFRESH(F);
                    int ts[9], cnt[8]; moe_tiles(F, ts, cnt);
                    const int tile0 = CHUNK_TILES * c; int nt = ts[8] - tile0; nt = nt > CHUNK_TILES ? CHUNK_TILES : nt;
                    if (KON(11) && IN(pg) && nt > 0) for (int rp = NREP(11); rp > 0; --rp) {
                        pg8::SchedMoe<true> S; S.init(nt, 2 * FFE / 256, NWG, (int)blockIdx.x); S.Bt = (const char*)(F.ws + WS_WMGU); S.tstep = (size_t)256 * 1024; S.estride = (size_t)2 * FFE * 1024;
                        S.tile0 = tile0; S.s2t = (const int*)(F.ws + WS_S2T); S.dup = (REPK == 22); S.ksb = 0;
#pragma unroll
                        for (int k = 0; k < 7; ++k) S.ts[k] = ts[k + 1];
                        { LAS int* tab = (LAS int*)(F.lds + LDSX_OFF + 1024); S.tab = tab;
                          pg8::StaticOrder so; so.init(nt, 2 * FFE / 256, NWG, (int)blockIdx.x); const int* s2t = (const int*)(F.ws + WS_S2T);
                          int tv[8];
#pragma unroll
                          for (int i = 0; i < 8; ++i) { pg8::Unit u; const bool ok = so.next(i, u); tv[i] = (ok && F.tid < 256) ? s2t[(size_t)(tile0 + u.pm) * 256 + F.tid] : 0; }
#pragma unroll
                          for (int i = 0; i < 8; ++i) if (F.tid < 256) tab[i * 256 + F.tid] = tv[i];
                          __syncthreads(); }
                        EpiSwiGLU8 E{F.ws + WS_HID + (size_t)(c & 1) * HID_BYTES, FFE};
                        pg8::gemm_phase<EpiSwiGLU8, pg8::SchedMoe<true>, true>(F.lds, F.wave0, (const char*)(F.ws + WS_HB), 1024, S, E, E8_WGU, E8_ONE);
                    }
                    SEAM(pg);
                    if (KON(12) && IN(pg + 1) && nt > 0) for (int rp = NREP(12); rp > 0; --rp) {
                        const bool ksp = (c == NCHUNK - 1);
                        pg8::SchedMoe<false> S; S.init(nt, ksp ? 4 * KSPLIT : 4, NWG, (int)blockIdx.x); S.Bt = (const char*)(F.ws + WS_WMD); S.tstep = (size_t)256 * FFE; S.estride = (size_t)1024 * FFE;
                        S.tile0 = tile0; S.s2t = nullptr; S.tab = nullptr; S.dup = (REPK == 23); S.ksb = ksp ? KS_BYTES : 0;
#pragma unroll
                        for (int k = 0; k < 7; ++k) S.ts[k] = ts[k + 1];
                        EpiPlain E{ksp ? (bf16*)(F.ws + WS_HID + (size_t)((c & 1) ^ 1) * HID_BYTES) : (bf16*)(F.ws + WS_YS), 1024, ksp ? 0 : tile0 * 256, ksp ? (size_t)8 * 256 * 1024 : 0};
                        pg8::gemm_phase<EpiPlain, pg8::SchedMoe<false>, true>(F.lds, F.wave0, (const char*)(F.ws + WS_HID + (size_t)(c & 1) * HID_BYTES), FFE, S, E, E8_WD, E8_HID, ksp ? KS_BYTES / 128 : 0);
                    }
                    if (c == NCHUNK - 1 || !(MK_ONE_LAUNCH)) SEAM(pg + 1);
                }
            }
            if (IN(PH_MOE_COMBINE)) {
                REFRESH(F);
                int ts[9], cnt[8]; moe_tiles(F, ts, cnt);
                const int tile0 = CHUNK_TILES * (NCHUNK - 1), nrow = (ts[8] - tile0) * 256;
                const bf16* YP = (const bf16*)(F.ws + WS_HID + (size_t)(((NCHUNK - 1) & 1) ^ 1) * HID_BYTES); bf16* YS = (bf16*)(F.ws + WS_YS);
                for (int row = F.vcu * 8 + F.wave; row < nrow; row += NWG * 8) {
                    float a[16];
#pragma unroll
                    for (int i = 0; i < 16; ++i) a[i] = 0.f;
#pragma unroll
                    for (int p = 0; p < KSPLIT; ++p) { float v[16]; ld_bf16_row(v, YP + ((size_t)p * 8 * 256 + row) * 1024, F.lane);
#pragma unroll
                        for (int i = 0; i < 16; ++i) a[i] += v[i]; }
                    st_bf16_row(a, YS + ((size_t)tile0 * 256 + row) * 1024, F.lane);
                }
            }
            SEAM(PH_MOE_COMBINE);
            if (KON(13) && IN(PH_POSTFFN1)) phase_postffn(F, 1, true);
        }
}
__global__ void __launch_bounds__(512, 2) fwd_kernel(Args args) {
    extern __shared__ __attribute__((aligned(16))) unsigned char lds_raw[];
    Frame F;
    F.lds = (LAS unsigned char*)lds_raw;
    F.ws0 = args.ws; F.ws = args.ws; F.ctl = (unsigned*)(args.ws + WS_CTL); F.out = args.out;
    F.wave0 = __builtin_amdgcn_readfirstlane((int)threadIdx.x >> 6); REFRESH(F);
    { const int bx = blockIdx.x; F.vcu = (bx % 8) * (NWG / 8) + bx / 8; }
    volatile LAS unsigned* MISC = (volatile LAS unsigned*)(F.lds + LDSX_OFF);
    if (F.tid < 16) MISC[F.tid] = 0u;
    __syncthreads();
    const int lo = args.ph_lo, hi = args.ph_hi;
    int nrep2 = 2; asm volatile("" : "+s"(nrep2));
    const bool multi = MK_ONE_LAUNCH ? true : (hi - lo) > 1; (void)lo; (void)hi;
    XcdBarrier bar; bar.bar = F.ctl + CW_BAR; bar.x = 0; bar.st = nullptr;
    if (multi) bar = xcd_barrier_post(F.ctl + CW_BAR, MISC + 8, F.tid);
    if (KON(0) && IN(PH_PROLOGUE)) for (int rp = NREP(0); rp > 0; --rp) phase_prologue(F);
    SEAM(PH_PROLOGUE);
    if (KON(1) && IN(PH_PRENORM)) for (int rp = NREP(1); rp > 0; --rp) phase_prenorm0(F);
    SEAM(PH_PRENORM);
    if (TSA >= 0) { if (blockIdx.x == 0 && F.tid == 0) __hip_atomic_store((unsigned long long*)(F.ctl + CW_TS), (unsigned long long)__builtin_amdgcn_s_memrealtime(), __ATOMIC_RELAXED, __HIP_MEMORY_SCOPE_AGENT); }
    run_layer<0>(F, bar, (const int*)args.in[I_POS], lo, hi, nrep2);
    run_layer<1>(F, bar, (const int*)args.in[I_POS], lo, hi, nrep2);
    if (TSA >= 0) {
        REFRESH(F);
        if (blockIdx.x == 0 && F.tid == 0) __hip_atomic_store((unsigned long long*)(F.ctl + CW_TS) + N_PHASES, (unsigned long long)__builtin_amdgcn_s_memrealtime(), __ATOMIC_RELAXED, __HIP_MEMORY_SCOPE_AGENT);
        xcd_barrier(bar, F.tid);
        const unsigned long long ta = __hip_atomic_load((unsigned long long*)(F.ctl + CW_TS) + TSA, __ATOMIC_RELAXED, __HIP_MEMORY_SCOPE_AGENT), tb = __hip_atomic_load((unsigned long long*)(F.ctl + CW_TS) + TSB, __ATOMIC_RELAXED, __HIP_MEMORY_SCOPE_AGENT);
        const float e = sqrtf((float)(((long long)(tb - ta) + 400) / 800 * 8) * 1e-4f);
        const int rpw = M / (NWG * 8);
        for (int k = 0; k < rpw; ++k) { const int m = (F.vcu * 8 + F.wave) * rpw + k; float x[16]; ld_f32_row(x, F.out + (size_t)m * D, F.lane);
#pragma unroll
            for (int i = 0; i < 16; ++i) x[i] *= (1.0f + e);
            st_f32_row(x, F.out + (size_t)m * D, F.lane); }
    }
#undef IN
#undef SEAM
}

extern "C" void kernel_launch(void* const* d_in, const int* in_sizes, int n_in, void* d_out, int out_size, void* d_ws, size_t ws_size, hipStream_t stream) {
    static int grid = 0;
    if (grid == 0) {
        if (n_in != 26 || out_size != M * D || ws_size < WS_END) { fprintf(stderr, "kernel_launch: unexpected problem: n_in %d out %d ws %zu (need %zu)\n", n_in, out_size, ws_size, (size_t)WS_END); grid = -1; return; }
        int dev = 0, cus = 0, per_cu = 0;
        if (hipGetDevice(&dev) != hipSuccess || hipDeviceGetAttribute(&cus, hipDeviceAttributeMultiprocessorCount, dev) != hipSuccess) { grid = -1; return; }
        if (hipFuncSetAttribute((const void*)fwd_kernel, hipFuncAttributeMaxDynamicSharedMemorySize, LDS_BYTES) != hipSuccess) { fprintf(stderr, "kernel_launch: hipFuncSetAttribute failed\n"); grid = -1; return; }
        if (hipOccupancyMaxActiveBlocksPerMultiprocessor(&per_cu, (const void*)fwd_kernel, 512, LDS_BYTES) != hipSuccess || per_cu < 1) fprintf(stderr, "kernel_launch: occupancy query says %d\n", per_cu);
        (void)hipGetLastError();
        if (cus != NWG) { fprintf(stderr, "kernel_launch: built for a %d-CU device, found %d\n", NWG, cus); grid = -1; return; }
        grid = NWG;
        fprintf(stderr, "kernel_launch: grid %d, ws %zu\n", grid, ws_size);
    }
    if (grid < 0) return;
    (void)hipMemsetAsync((char*)d_ws + WS_CTL, 0, CTL_ZERO_BYTES, stream);
    Args a{};
    for (int i = 0; i < 26; ++i) a.in[i] = d_in[i];
    a.out = (float*)d_out; a.ws = (unsigned char*)d_ws;
#if MK_ONE_LAUNCH
    a.ph_lo = 0; a.ph_hi = N_PHASES;
    hipLaunchKernelGGL(fwd_kernel, dim3(grid), dim3(512), LDS_BYTES, stream, a);
#else
    for (int p = 0; p < N_PHASES; ++p) { a.ph_lo = p; a.ph_hi = p + 1; hipLaunchKernelGGL(fwd_kernel, dim3(grid), dim3(512), LDS_BYTES, stream, a); }
#endif
}
```

```cpp
#include <hip/hip_runtime.h>
#include <cstdio>
#include <cstdint>

#ifndef REPK
#define REPK -1
#endif
#ifndef TSA
#define TSA -1
#endif
#ifndef TSB
#define TSB -1
#endif
#ifndef MK_ONE_LAUNCH
#define MK_ONE_LAUNCH 1
#endif

#define GAS __attribute__((address_space(1)))
#define LAS __attribute__((address_space(3)))
typedef unsigned short bf16;
typedef short bf16x8 __attribute__((ext_vector_type(8)));
typedef float f32x4 __attribute__((ext_vector_type(4)));
typedef float f32x16 __attribute__((ext_vector_type(16)));
typedef unsigned u32x4 __attribute__((ext_vector_type(4)));
typedef unsigned u32x2 __attribute__((ext_vector_type(2)));
typedef float f32x2_t __attribute__((ext_vector_type(2)));
typedef __bf16 bf16x2_t __attribute__((ext_vector_type(2)));
typedef short v4i16_t __attribute__((ext_vector_type(4)));
typedef GAS unsigned gu32;

constexpr int BATCH = 16, SEQ = 2048, D = 1024, M = BATCH * SEQ;
constexpr int NIN = 2560, PW = 2304;
constexpr int FFD = 2816, FFE = 3584, NEXP = 8;
constexpr float EPS = 1e-6f;
constexpr int NWG = 256;
constexpr float C2 = 0.125f * 1.4426950408889634f;
constexpr int P_QA = 0, P_KA = 256, P_VA = 512, P_QB = 768, P_KB = 1024, P_VB = 1280, P_GU = 1536, P_GV = 1792, P_GLU = 2048;
constexpr int MOE_TILES_MAX = 264, CHUNK_TILES = 64, NCHUNK = 5;
constexpr float MOE_WGU_SC = 32.f, MOE_WD_SC = 64.f, MOE_HID_SC = 4.f;
constexpr int E8_WGU = 0x7a7a7a7a, E8_WD = 0x79797979, E8_HID = 0x7f7f7f7f, E8_ONE = 0x7f7f7f7f;

__device__ __forceinline__ unsigned cvtpk(float lo, float hi) { f32x2_t v = {lo, hi}; bf16x2_t b = __builtin_convertvector(v, bf16x2_t); return __builtin_bit_cast(unsigned, b); }
__device__ __forceinline__ unsigned pk4_fp8(float a, float b, float c, float d) {
    a = __builtin_amdgcn_fmed3f(a, -448.f, 448.f); b = __builtin_amdgcn_fmed3f(b, -448.f, 448.f); c = __builtin_amdgcn_fmed3f(c, -448.f, 448.f); d = __builtin_amdgcn_fmed3f(d, -448.f, 448.f);
    int p = __builtin_amdgcn_cvt_pk_fp8_f32(a, b, 0, false); p = __builtin_amdgcn_cvt_pk_fp8_f32(c, d, p, true); return (unsigned)p; }
__device__ __forceinline__ float bf2f(unsigned short b) { return __uint_as_float((unsigned)b << 16); }
__device__ __forceinline__ float bflo(unsigned w) { return __uint_as_float(w << 16); }
__device__ __forceinline__ float bfhi(unsigned w) { return __uint_as_float(w & 0xffff0000u); }
__device__ __forceinline__ float fast_exp2(float x) { return __builtin_amdgcn_exp2f(x); }
__device__ __forceinline__ float fast_rcp(float x) { return __builtin_amdgcn_rcpf(x); }
__device__ __forceinline__ float sigmoidf_(float x) { return fast_rcp(1.0f + fast_exp2(-1.4426950408889634f * x)); }
__device__ __forceinline__ float siluf_(float x) { return x * sigmoidf_(x); }
__device__ __forceinline__ float gelu_tanh(float x) { const float u = x + 0.044715f * x * x * x; return x * fast_rcp(1.0f + fast_exp2(-2.3022081982f * u)); }
__device__ __forceinline__ f32x2_t exp2_pk(f32x2_t t) { f32x2_t e; e.x = __builtin_amdgcn_exp2f(t.x); e.y = __builtin_amdgcn_exp2f(t.y); return e; }
__device__ __forceinline__ f32x2_t rcp_pk(f32x2_t d) { f32x2_t r; r.x = __builtin_amdgcn_rcpf(d.x); r.y = __builtin_amdgcn_rcpf(d.y); return r; }
__device__ __forceinline__ f32x2_t sigmoid_pk(f32x2_t x) { return rcp_pk(exp2_pk(x * -1.4426950408889634f) + 1.0f); }
__device__ __forceinline__ f32x2_t silu_mul_pk(f32x2_t g, f32x2_t u) { return (g * u) * sigmoid_pk(g); }
__device__ __forceinline__ f32x2_t gelu_tanh_pk(f32x2_t x) { const f32x2_t u = x * ((x * x) * 0.044715f + 1.0f); return x * rcp_pk(exp2_pk(u * -2.3022081982f) + 1.0f); }
__device__ __forceinline__ unsigned pk4_fp8_raw(f32x2_t a, f32x2_t b) {
    a.x = __builtin_amdgcn_fmed3f(a.x, -448.f, 448.f); a.y = __builtin_amdgcn_fmed3f(a.y, -448.f, 448.f); b.x = __builtin_amdgcn_fmed3f(b.x, -448.f, 448.f); b.y = __builtin_amdgcn_fmed3f(b.y, -448.f, 448.f);
    int p = __builtin_amdgcn_cvt_pk_fp8_f32(a.x, a.y, 0, false); p = __builtin_amdgcn_cvt_pk_fp8_f32(b.x, b.y, p, true); return (unsigned)p; }
__device__ __forceinline__ int lane_id() { int l; asm volatile("v_mbcnt_lo_u32_b32 %0, -1, 0\n\tv_mbcnt_hi_u32_b32 %0, -1, %0" : "=v"(l)); return l; }
template <int CTRL> __device__ __forceinline__ float dpp_f(float v) { return __builtin_bit_cast(float, __builtin_amdgcn_update_dpp(0, __builtin_bit_cast(int, v), CTRL, 0xf, 0xf, false)); }
__device__ __forceinline__ float sum16(float v) {
    v += dpp_f<0xB1>(v); v += dpp_f<0x4E>(v); v += dpp_f<0x141>(v); v += dpp_f<0x140>(v); return v; }
__device__ __forceinline__ float pair16_sum(float v) { const auto r = __builtin_amdgcn_permlane16_swap(__float_as_uint(v), __float_as_uint(v), false, false); return __uint_as_float(r[0]) + __uint_as_float(r[1]); }
__device__ __forceinline__ float pair32_sum(float v) { const auto r = __builtin_amdgcn_permlane32_swap(__float_as_uint(v), __float_as_uint(v), false, false); return __uint_as_float(r[0]) + __uint_as_float(r[1]); }
__device__ __forceinline__ float pair32_max(float v) { const auto r = __builtin_amdgcn_permlane32_swap(__float_as_uint(v), __float_as_uint(v), false, false); return fmaxf(__uint_as_float(r[0]), __uint_as_float(r[1])); }
__device__ __forceinline__ float pair32_other(float v, int h) { const auto r = __builtin_amdgcn_permlane32_swap(__float_as_uint(v), __float_as_uint(v), false, false); return __uint_as_float(h ? r[0] : r[1]); }
__device__ __forceinline__ float wave_sum(float v) { return pair32_sum(pair16_sum(sum16(v))); }

namespace pg8 {
constexpr int BM = 256, BK = 64, HALF = 128, HTB = HALF * BK * 2, STAGE_BYTES = 8 * HTB, NXCD = 8, WGM = 8;
__host__ __device__ __forceinline__ int lds_byte(int r, int c) { const int st = (r >> 4) * 2 + (c >> 5), rr = r & 15, cc = c & 31, ob = rr * 64 + cc * 2; return st * 1024 + (ob ^ (((ob >> 9) & 1) << 5)); }
__host__ __device__ __forceinline__ void stage_rc(int b, int& R, int& C) { const int st = b / 1024, sb = b % 1024, swz = sb ^ (((sb >> 9) & 1) << 5); R = (st >> 1) * 16 + swz / 64; C = (st & 1) * 32 + (swz % 64) / 2; }
__host__ __device__ __forceinline__ int perm32(int rho) { const int n = rho >> 4, i = rho & 15; return 8 * (i >> 2) + 4 * n + (i & 3); }

struct Unit { int pm, pn; };
struct StaticOrder {
    int nM, nN, nwg, G, c; bool dup;
    __device__ __forceinline__ void init(int nM_, int nN_, int G_, int c_) { nM = nM_; nN = nN_; nwg = nM * nN; G = G_; c = c_; dup = false; }
    __device__ __forceinline__ bool next(int i, Unit& u) const {
        if (dup) i >>= 1;
        const long L = (long)i * G + c; if (L >= nwg) return false;
        int wgid = (int)L; { const int q = nwg / NXCD, r = nwg % NXCD, xcd = wgid % NXCD, off = wgid / NXCD; wgid = (xcd < r ? xcd * (q + 1) : r * (q + 1) + (xcd - r) * q) + off; }
        const int nig = WGM * nN, gid = wgid / nig, fm = gid * WGM, gsz = (nM - fm) < WGM ? (nM - fm) : WGM;
        u.pm = fm + ((wgid % nig) % gsz); u.pn = (wgid % nig) / gsz; return true;
    }
};
struct SchedPlain : StaticOrder {
    static constexpr bool GATHER = false;
    const char* Bt; size_t tstep;
    __device__ __forceinline__ int arow(const Unit& u, int rr) const { return u.pm * BM + rr; }
    __device__ __forceinline__ const char* bptr(const Unit& u) const { return Bt + (size_t)u.pn * tstep; }
    __device__ __forceinline__ size_t koff(const Unit&) const { return 0; }
};
template <bool GATHER_> struct SchedMoe : StaticOrder {
    static constexpr bool GATHER = GATHER_;
    const char* Bt; size_t tstep, estride; int tile0; const int* s2t; int ts[7];
    __device__ __forceinline__ int expert(int pmg) const { int e = 0;
#pragma unroll
        for (int k = 0; k < 7; ++k) e += (pmg >= ts[k]) ? 1 : 0;
        return e; }
    __device__ __forceinline__ int arow(const Unit& u, int rr) const { return u.pm * BM + rr; }
    const LAS int* tab;
    __device__ __forceinline__ u32x4 arow4(int ui, int R0) const { if (dup) ui >>= 1; return *(const LAS u32x4*)(tab + ui * 256 + R0 * 4); }
    int ksb;
    __device__ __forceinline__ size_t koff(const Unit& u) const { return ksb ? (size_t)(u.pn >> 2) * ksb : 0; }
    __device__ __forceinline__ const char* bptr(const Unit& u) const { return Bt + (size_t)expert(tile0 + u.pm) * estride + (size_t)(ksb ? (u.pn & 3) : u.pn) * tstep + koff(u); }
};

typedef int v8i32 __attribute__((ext_vector_type(8)));
template <class Epi, class Sched, bool FP8 = false>
__device__ __forceinline__ void gemm_phase(LAS unsigned char* lds, const int wave0, const char* Abase, const int KB, const Sched& S, const Epi& E, const int sW = 0x7f7f7f7f, const int sX = 0x7f7f7f7f, const int ntiles = 0) {
    int tid = wave0 * 64 + lane_id(); asm volatile("" : "+v"(tid)); const int wid = __builtin_amdgcn_readfirstlane(tid >> 6), lane = tid & 63, wr = wid >> 2, wc = wid & 3, fr = lane & 15, fq = lane >> 4;
    const int nt = ntiles ? ntiles : KB / 128;
    int R0, C0; stage_rc(tid * 16, R0, C0);
    const unsigned voffA = (unsigned)(R0 * KB + C0 * 2), voffB = (unsigned)(((R0 & ~31) + perm32(R0 & 31)) * KB + C0 * 2);
    const size_t kstep = (size_t)(BK * 2);
    const size_t hstep = (size_t)HALF * KB;
    const unsigned rowb = (unsigned)KB, colb = (unsigned)C0 * 2u;
    const size_t q64 = (size_t)64 * KB;
    const unsigned ldsw = (unsigned)wid * 1024u;
    const int aoff = lds_byte(wr * 64 + fr, fq * 8), boff = lds_byte(wc * 32 + fr, fq * 8);
#define PG8_SA(b, h) (((b) * 2 + (h)) * HTB)
#define PG8_SB(b, h) ((4 + (b) * 2 + (h)) * HTB)
#define PG8_GLDS(gp, bufoff, i) __builtin_amdgcn_global_load_lds((const unsigned*)(gp), (LAS unsigned*)(lds + (bufoff) + ldsw + (i) * 8192), 16, 0, 0)
#define PG8_STAGE_B(bufoff, gbase) do { PG8_GLDS((const char*)(gbase) + voffB, bufoff, 0); PG8_GLDS((const char*)(gbase) + q64 + voffB, bufoff, 1); } while (0)
#define PG8_STAGE_A(bufoff, h, kb, NX) do { \
        if constexpr (Sched::GATHER) { const unsigned _o0 = (NX) ? ((h) ? n2 : n0) : ((h) ? va2 : va0), _o1 = (NX) ? ((h) ? n3 : n1) : ((h) ? va3 : va1); \
            PG8_GLDS(Abase + (kb) + _o0, bufoff, 0); PG8_GLDS(Abase + (kb) + _o1, bufoff, 1); } \
        else { const char* _b = ((NX) ? nA : cA) + (size_t)(h) * hstep + (kb); PG8_GLDS(_b + voffA, bufoff, 0); PG8_GLDS(_b + q64 + voffA, bufoff, 1); } } while (0)
#define PG8_LDA(dst, b, h) do { _Pragma("unroll") for (int m = 0; m < 4; ++m) _Pragma("unroll") for (int k = 0; k < 2; ++k) dst[m][k] = *(const LAS bf16x8*)(lds + PG8_SA(b, h) + aoff + m * 2048 + k * 1024); } while (0)
#define PG8_LDB(dst, b, h) do { _Pragma("unroll") for (int n = 0; n < 2; ++n) _Pragma("unroll") for (int k = 0; k < 2; ++k) dst[n][k] = *(const LAS bf16x8*)(lds + PG8_SB(b, h) + boff + n * 2048 + k * 1024); } while (0)
#define PG8_CAT(x, y) __builtin_shufflevector(__builtin_bit_cast(u32x4, x), __builtin_bit_cast(u32x4, y), 0, 1, 2, 3, 4, 5, 6, 7)
#define PG8_MMA(ai, bj, At, Bt) do { __builtin_amdgcn_s_setprio(1); \
        if constexpr (FP8) { _Pragma("unroll") for (int m = 0; m < 4; ++m) _Pragma("unroll") for (int n = 0; n < 2; ++n) { \
            const v8i32 b8_ = __builtin_bit_cast(v8i32, PG8_CAT(Bt[n][0], Bt[n][1])), a8_ = __builtin_bit_cast(v8i32, PG8_CAT(At[m][0], At[m][1])); \
            asm volatile("s_nop 1\n\tv_mfma_scale_f32_16x16x128_f8f6f4 %0, %1, %2, %0, %3, %4 op_sel_hi:[0,0,0]" : "+v"(acc[ai][bj][m][n]) : "v"(b8_), "v"(a8_), "v"(sW), "v"(sX)); } } \
        else { _Pragma("unroll") for (int m = 0; m < 4; ++m) _Pragma("unroll") for (int n = 0; n < 2; ++n) _Pragma("unroll") for (int k = 0; k < 2; ++k) \
            acc[ai][bj][m][n] = __builtin_amdgcn_mfma_f32_16x16x32_bf16(Bt[n][k], At[m][k], acc[ai][bj][m][n], 0, 0, 0); } \
        __builtin_amdgcn_s_setprio(0); } while (0)
#define PG8_WAIT_V(n) asm volatile("s_waitcnt vmcnt(" #n ")" ::: "memory")
#define PG8_WAIT_L(n) asm volatile("s_waitcnt lgkmcnt(" #n ")" ::: "memory")
#define PG8_BAR __builtin_amdgcn_s_barrier()
#define PG8_SCHED __builtin_amdgcn_sched_barrier(0)
    Unit cur, nxt; int ui = 0;
    if (!S.next(0, cur)) return;
#define PG8_PIN8(a, b) asm volatile("" : "+v"(acc[a][b][0][0]), "+v"(acc[a][b][0][1]), "+v"(acc[a][b][1][0]), "+v"(acc[a][b][1][1]), "+v"(acc[a][b][2][0]), "+v"(acc[a][b][2][1]), "+v"(acc[a][b][3][0]), "+v"(acc[a][b][3][1]))
#define PG8_PINACC() do { PG8_PIN8(0, 0); PG8_PIN8(0, 1); PG8_PIN8(1, 0); PG8_PIN8(1, 1); } while (0)
    f32x4 acc[2][2][4][2];
#pragma unroll
    for (int a = 0; a < 2; ++a)
#pragma unroll
        for (int b = 0; b < 2; ++b)
#pragma unroll
            for (int m = 0; m < 4; ++m)
#pragma unroll
                for (int n = 0; n < 2; ++n) acc[a][b][m][n] = (f32x4){0.f, 0.f, 0.f, 0.f};
    PG8_PINACC();
    bf16x8 At[4][2], B0[2][2], B1[2][2];
    unsigned va0 = 0, va1 = 0, va2 = 0, va3 = 0, na0 = 0, na1 = 0, na2 = 0, na3 = 0;
    const char* cA = Abase; const char* nA = Abase;
    if constexpr (Sched::GATHER) { const u32x4 ci = S.arow4(0, R0); va0 = ci.x * rowb + colb; va1 = ci.y * rowb + colb; va2 = ci.z * rowb + colb; va3 = ci.w * rowb + colb; }
    else cA = Abase + (size_t)S.arow(cur, 0) * rowb + S.koff(cur);
    const char* cB = S.bptr(cur);
    { const unsigned n0 = 0, n1 = 0, n2 = 0, n3 = 0; (void)n0; (void)n1; (void)n2; (void)n3;
    PG8_STAGE_B(PG8_SB(0, 0), cB); PG8_STAGE_B(PG8_SB(0, 1), cB + hstep); PG8_STAGE_A(PG8_SA(0, 0), 0, 0, false); PG8_STAGE_A(PG8_SA(0, 1), 1, 0, false);
    if (wr == 1) PG8_BAR;
    PG8_WAIT_V(2); PG8_BAR;
    PG8_STAGE_B(PG8_SB(1, 0), cB + kstep); PG8_STAGE_A(PG8_SA(1, 0), 0, kstep, false); PG8_STAGE_B(PG8_SB(1, 1), cB + hstep + kstep);
    PG8_WAIT_V(6); PG8_BAR; }
    for (;;) {
        const bool has_next = S.next(ui + 1, nxt);
        const char* nB = has_next ? S.bptr(nxt) : cB;
        if constexpr (Sched::GATHER) {
            { const u32x4 ni = S.arow4(has_next ? ui + 1 : ui, R0); na0 = ni.x * rowb + colb; na1 = ni.y * rowb + colb; na2 = ni.z * rowb + colb; na3 = ni.w * rowb + colb; }
        } else nA = has_next ? Abase + (size_t)S.arow(nxt, 0) * rowb + S.koff(nxt) : cA;
        for (int t = 0; t < nt; t += 2) {
            const bool last = (t == nt - 2);
            const size_t k1 = (size_t)(t + 1) * kstep, k2 = last ? 0 : (size_t)(t + 2) * kstep, k3 = k2 + kstep;
            const char* b2 = last ? nB : cB + (size_t)(t + 2) * kstep; const char* b3 = b2 + kstep;
            const unsigned n0 = last ? na0 : va0, n1 = last ? na1 : va1, n2 = last ? na2 : va2, n3 = last ? na3 : va3;
            PG8_LDB(B0, 0, 0); PG8_LDB(B1, 0, 1); PG8_SCHED; PG8_LDA(At, 0, 0); PG8_STAGE_A(PG8_SA(1, 1), 1, k1, false);
            PG8_WAIT_V(8); PG8_WAIT_L(0); PG8_BAR; PG8_MMA(0, 0, At, B0); PG8_MMA(0, 1, At, B1); PG8_BAR; PG8_SCHED;
            PG8_LDA(At, 0, 1); PG8_STAGE_B(PG8_SB(0, 0), b2); PG8_STAGE_B(PG8_SB(0, 1), b2 + hstep); PG8_STAGE_A(PG8_SA(0, 0), 0, k2, last);
            PG8_WAIT_V(8); PG8_WAIT_L(0); PG8_BAR; PG8_MMA(1, 0, At, B0); PG8_MMA(1, 1, At, B1); PG8_BAR; PG8_SCHED;
            PG8_LDB(B0, 1, 0); PG8_LDB(B1, 1, 1); PG8_SCHED; PG8_LDA(At, 1, 0); PG8_STAGE_A(PG8_SA(0, 1), 1, k2, last);
            PG8_WAIT_V(8); PG8_WAIT_L(0); PG8_BAR; PG8_MMA(0, 0, At, B0); PG8_MMA(0, 1, At, B1); PG8_BAR; PG8_SCHED;
            PG8_LDA(At, 1, 1); PG8_STAGE_B(PG8_SB(1, 0), b3); PG8_STAGE_B(PG8_SB(1, 1), b3 + hstep); PG8_STAGE_A(PG8_SA(1, 0), 0, k3, last);
            PG8_WAIT_V(8); PG8_WAIT_L(0); PG8_BAR; PG8_MMA(1, 0, At, B0); PG8_MMA(1, 1, At, B1); PG8_BAR; PG8_SCHED;
        }
        if (wr == 0) PG8_BAR;
        if constexpr (FP8) asm volatile("s_nop 15\n\ts_nop 15" ::: "memory");
        E(acc, cur, wr, wc, fr, fq);
        if (!has_next) break;
#pragma unroll
        for (int a = 0; a < 2; ++a)
#pragma unroll
            for (int b = 0; b < 2; ++b)
#pragma unroll
                for (int m = 0; m < 4; ++m)
#pragma unroll
                    for (int n = 0; n < 2; ++n) acc[a][b][m][n] = (f32x4){0.f, 0.f, 0.f, 0.f};
        PG8_PINACC();
        cur = nxt; cB = nB; cA = nA; ++ui;
        if constexpr (Sched::GATHER) { va0 = na0; va1 = na1; va2 = na2; va3 = na3; }
        if (wr == 1) PG8_BAR;
    }
    PG8_WAIT_V(0);
    PG8_BAR;
#undef PG8_SA
#undef PG8_SB
#undef PG8_GLDS
#undef PG8_STAGE_A
#undef PG8_STAGE_B
#undef PG8_LDA
#undef PG8_LDB
#undef PG8_MMA
#undef PG8_PIN8
#undef PG8_PINACC
#undef PG8_CAT
#undef PG8_WAIT_V
#undef PG8_WAIT_L
#undef PG8_BAR
#undef PG8_SCHED
}
}

#ifndef EPI_NT
#define EPI_NT 0
#endif
#if EPI_NT
#define EPI_STORE(ty, ptr, val) __builtin_nontemporal_store((val), (ty*)(ptr))
#else
#define EPI_STORE(ty, ptr, val) (*(ty*)(ptr) = (val))
#endif
struct EpiPlain {
    bf16* O; int ldc; int rowoff; size_t plane = 0;
    __device__ __forceinline__ void operator()(const f32x4 (&acc)[2][2][4][2], const pg8::Unit& u, int wr, int wc, int fr, int fq) const {
        const int pn = plane ? (u.pn & 3) : u.pn; bf16* Ob = O + (plane ? (size_t)(u.pn >> 2) * plane : 0);
        const int row0 = rowoff + u.pm * 256 + wr * 64 + fr, col0 = pn * 256 + wc * 32 + 8 * fq;
#pragma unroll
        for (int ai = 0; ai < 2; ++ai)
#pragma unroll
            for (int m = 0; m < 4; ++m) { bf16* rowp = Ob + (size_t)(row0 + ai * 128 + m * 16) * ldc + col0;
#pragma unroll
                for (int bj = 0; bj < 2; ++bj) { const f32x4 v0 = acc[ai][bj][m][0], v1 = acc[ai][bj][m][1];
                    u32x4 w; w.x = cvtpk(v0[0], v0[1]); w.y = cvtpk(v0[2], v0[3]); w.z = cvtpk(v1[0], v1[1]); w.w = cvtpk(v1[2], v1[3]);
                    EPI_STORE(u32x4, (rowp + bj * 128), w); } }
    }
};
struct EpiSwiGLU {
    bf16* O; int ldc;
    __device__ __forceinline__ void operator()(const f32x4 (&acc)[2][2][4][2], const pg8::Unit& u, int wr, int wc, int fr, int fq) const {
        const int row0 = u.pm * 256 + wr * 64 + fr, col0 = u.pn * 128 + wc * 32 + 8 * fq;
#pragma unroll
        for (int ai = 0; ai < 2; ++ai)
#pragma unroll
            for (int m = 0; m < 4; ++m) { bf16* rowp = O + (size_t)(row0 + ai * 128 + m * 16) * ldc + col0;
                const f32x4 g0 = acc[ai][0][m][0], g1 = acc[ai][0][m][1], u0 = acc[ai][1][m][0], u1 = acc[ai][1][m][1];
                const f32x2_t h0 = silu_mul_pk((f32x2_t){g0[0], g0[1]}, (f32x2_t){u0[0], u0[1]}), h1 = silu_mul_pk((f32x2_t){g0[2], g0[3]}, (f32x2_t){u0[2], u0[3]});
                const f32x2_t h2 = silu_mul_pk((f32x2_t){g1[0], g1[1]}, (f32x2_t){u1[0], u1[1]}), h3 = silu_mul_pk((f32x2_t){g1[2], g1[3]}, (f32x2_t){u1[2], u1[3]});
                u32x4 w; w.x = cvtpk(h0.x, h0.y); w.y = cvtpk(h1.x, h1.y); w.z = cvtpk(h2.x, h2.y); w.w = cvtpk(h3.x, h3.y);
                EPI_STORE(u32x4, rowp, w); }
    }
};
struct EpiSwiGLU8 {
    unsigned char* O; int ldc;
    __device__ __forceinline__ void operator()(const f32x4 (&acc)[2][2][4][2], const pg8::Unit& u, int wr, int wc, int fr, int fq) const {
        const int row0 = u.pm * 256 + wr * 64 + fr, col0 = u.pn * 128 + wc * 32 + 8 * fq;
#pragma unroll
        for (int ai = 0; ai < 2; ++ai)
#pragma unroll
            for (int m = 0; m < 4; ++m) { unsigned char* rowp = O + (size_t)(row0 + ai * 128 + m * 16) * ldc + col0;
                const f32x4 g0 = acc[ai][0][m][0], g1 = acc[ai][0][m][1], u0 = acc[ai][1][m][0], u1 = acc[ai][1][m][1];
                const f32x2_t h0 = silu_mul_pk((f32x2_t){g0[0], g0[1]}, (f32x2_t){u0[0], u0[1]}), h1 = silu_mul_pk((f32x2_t){g0[2], g0[3]}, (f32x2_t){u0[2], u0[3]});
                const f32x2_t h2 = silu_mul_pk((f32x2_t){g1[0], g1[1]}, (f32x2_t){u1[0], u1[1]}), h3 = silu_mul_pk((f32x2_t){g1[2], g1[3]}, (f32x2_t){u1[2], u1[3]});
                u32x2 w; w.x = pk4_fp8_raw(h0, h1); w.y = pk4_fp8_raw(h2, h3);
                EPI_STORE(u32x2, rowp, w); }
    }
};
struct EpiInProj {
    bf16* P; const int* pos; float* kmsum;
    __device__ __forceinline__ void operator()(const f32x4 (&acc)[2][2][4][2], const pg8::Unit& u, int wr, int wc, int fr, int fq) const {
        const int pn = u.pn, row0 = u.pm * 256 + wr * 64 + fr;
        if (pn == 0 || pn == 1 || pn == 3 || pn == 4) {
            const int g = wc & 1, i0 = 16 * g + 4 * fq;
            float invf[4];
#pragma unroll
            for (int e = 0; e < 4; ++e) invf[e] = fast_exp2(-(float)(i0 + e) * 0.4152410118609203f);
            const float sc = (pn == 0 || pn == 3) ? C2 : 1.0f;
            float ks[2][2][4];
#pragma unroll
            for (int a = 0; a < 2; ++a)
#pragma unroll
                for (int b = 0; b < 2; ++b)
#pragma unroll
                    for (int e = 0; e < 4; ++e) ks[a][b][e] = 0.f;
#pragma unroll
            for (int ai = 0; ai < 2; ++ai)
#pragma unroll
                for (int m = 0; m < 4; ++m) { const int row = row0 + ai * 128 + m * 16; const float p = (float)pos[row];
                    float cs[4], sn[4];
#pragma unroll
                    for (int e = 0; e < 4; ++e) { const float ang = p * invf[e]; const float k = rintf(ang * 0.15915494309189535f);
                        float r = fmaf(-k, 6.2831854820251465f, ang); r = fmaf(-k, -1.7484556000744883e-07f, r); const float rev = r * 0.15915494309189535f;
                        cs[e] = __builtin_amdgcn_cosf(rev); sn[e] = __builtin_amdgcn_sinf(rev); }
                    bf16* rowp = P + (size_t)row * PW + 256 * pn;
#pragma unroll
                    for (int bj = 0; bj < 2; ++bj) { const int hh = 2 * bj + (wc >> 1); const f32x4 v0 = acc[ai][bj][m][0], v1 = acc[ai][bj][m][1];
                        float o0[4], o1[4];
#pragma unroll
                        for (int e = 0; e < 4; ++e) { o0[e] = (v0[e] * cs[e] - v1[e] * sn[e]) * sc; o1[e] = (v1[e] * cs[e] + v0[e] * sn[e]) * sc; ks[bj][0][e] += o0[e]; ks[bj][1][e] += o1[e]; }
                        u32x4 w; w.x = cvtpk(o0[0], o0[1]); w.y = cvtpk(o0[2], o0[3]); w.z = cvtpk(o1[0], o1[1]); w.w = cvtpk(o1[2], o1[3]);
                        EPI_STORE(u32x4, (rowp + 64 * hh + 32 * g + 8 * fq), w); } }
            if (pn == 1) {
#pragma unroll
                for (int bj = 0; bj < 2; ++bj)
#pragma unroll
                    for (int n = 0; n < 2; ++n)
#pragma unroll
                        for (int e = 0; e < 4; ++e) { const float v = sum16(ks[bj][n][e]);
                            if (fr == 0) atomicAdd(kmsum + (size_t)(u.pm * 4 + 2 * bj + (wc >> 1)) * 64 + 32 * g + 8 * fq + 4 * n + e, v); }
            }
        } else if (pn >= 8) {
            const int col0 = P_GLU + 128 * (pn - 8) + wc * 32 + 8 * fq;
#pragma unroll
            for (int ai = 0; ai < 2; ++ai)
#pragma unroll
                for (int m = 0; m < 4; ++m) { bf16* rowp = P + (size_t)(row0 + ai * 128 + m * 16) * PW + col0;
                    const f32x4 a0 = acc[ai][0][m][0], a1 = acc[ai][0][m][1], g0 = acc[ai][1][m][0], g1 = acc[ai][1][m][1];
                    const f32x2_t o0 = (f32x2_t){a0[0], a0[1]} * sigmoid_pk((f32x2_t){g0[0], g0[1]}), o1 = (f32x2_t){a0[2], a0[3]} * sigmoid_pk((f32x2_t){g0[2], g0[3]});
                    const f32x2_t o2 = (f32x2_t){a1[0], a1[1]} * sigmoid_pk((f32x2_t){g1[0], g1[1]}), o3 = (f32x2_t){a1[2], a1[3]} * sigmoid_pk((f32x2_t){g1[2], g1[3]});
                    u32x4 w; w.x = cvtpk(o0.x, o0.y); w.y = cvtpk(o1.x, o1.y); w.z = cvtpk(o2.x, o2.y); w.w = cvtpk(o3.x, o3.y);
                    EPI_STORE(u32x4, rowp, w); }
        } else {
            const bool act = (pn >= 6);
            const int col0 = 256 * pn + wc * 32 + 8 * fq;
#pragma unroll
            for (int ai = 0; ai < 2; ++ai)
#pragma unroll
                for (int m = 0; m < 4; ++m) { bf16* rowp = P + (size_t)(row0 + ai * 128 + m * 16) * PW + col0;
#pragma unroll
                    for (int bj = 0; bj < 2; ++bj) { const f32x4 v0 = acc[ai][bj][m][0], v1 = acc[ai][bj][m][1];
                        f32x2_t o0 = {v0[0], v0[1]}, o1 = {v0[2], v0[3]}, o2 = {v1[0], v1[1]}, o3 = {v1[2], v1[3]};
                        if (act) { o0 = gelu_tanh_pk(o0); o1 = gelu_tanh_pk(o1); o2 = gelu_tanh_pk(o2); o3 = gelu_tanh_pk(o3); }
                        u32x4 w; w.x = cvtpk(o0.x, o0.y); w.y = cvtpk(o1.x, o1.y); w.z = cvtpk(o2.x, o2.y); w.w = cvtpk(o3.x, o3.y);
                        EPI_STORE(u32x4, (rowp + bj * 128), w); } }
        }
    }
};

#define MFMA32(a, b, c) __builtin_amdgcn_mfma_f32_32x32x16_bf16((a), (b), (c), 0, 0, 0)
__device__ __forceinline__ int crow(int i, int h) { return (i & 3) + 8 * (i >> 2) + 4 * h; }
__device__ __forceinline__ v4i16_t vtr(const LAS char* p) { return __builtin_amdgcn_ds_read_tr16_b64_v4i16((LAS v4i16_t*)p); }

struct AttnOperands { u32x4 kk[4]; u32x4 vv[4]; };
__device__ __forceinline__ void attn_load(AttnOperands& T, const bf16* kp, const bf16* vp, size_t v8) {
#pragma unroll
    for (int w = 0; w < 4; ++w) T.kk[w] = *(const u32x4*)(kp + (size_t)w * v8);
#pragma unroll
    for (int w = 0; w < 4; ++w) T.vv[w] = *(const u32x4*)(vp + (size_t)w * v8);
}
constexpr int ATT_KLDS = 4096, ATT_WAVE_LDS = 9216;
__device__ __forceinline__ void attn_kfrags(bf16x8 (&kf)[4], const AttnOperands& T, LAS char* vt, int lane) {
    { const int piece = lane & 7, key0 = lane >> 3;
#pragma unroll
      for (int w = 0; w < 4; ++w) *(LAS u32x4*)(vt + ATT_KLDS + (key0 + 8 * w) * 144 + piece * 16) = T.kk[w]; }
    const int r = lane & 31, h = lane >> 5;
#pragma unroll
    for (int s = 0; s < 4; ++s) kf[s] = *(const LAS bf16x8*)(vt + ATT_KLDS + r * 144 + (2 * s + h) * 16);
}
__device__ __forceinline__ void attn_compute(f32x16& o0, f32x16& o1, float& m, float& l, const bf16x8 (&qf)[4], const AttnOperands& T, LAS char* vt, int lane, unsigned vmask) {
    const int h = lane >> 5;
    f32x16 p; bf16x8 kf[4]; attn_kfrags(kf, T, vt, lane);
#pragma unroll
    for (int i = 0; i < 16; ++i) p[i] = 0.f;
#pragma unroll
    for (int s = 0; s < 4; ++s) p = MFMA32(kf[s], qf[s], p);
    { const int piece = lane & 7, key0 = lane >> 3;
#pragma unroll
      for (int w = 0; w < 4; ++w) *(LAS u32x4*)(vt + (2 * w + (piece >> 2)) * 512 + key0 * 64 + (piece & 3) * 16) = T.vv[w]; }
    float tm = -INFINITY;
#pragma unroll
    for (int i = 0; i < 16; ++i) { p[i] = ((vmask >> i) & 1u) ? p[i] : -INFINITY; tm = fmaxf(tm, p[i]); }
    tm = pair32_max(tm);
    const float mn = fmaxf(m, tm), alpha = fast_exp2(m - mn); m = mn;
    float rs = 0.f;
#pragma unroll
    for (int i = 0; i < 16; ++i) { p[i] = fast_exp2(p[i] - mn); rs += p[i]; }
    l = l * alpha + rs;
#pragma unroll
    for (int i = 0; i < 16; ++i) { o0[i] *= alpha; o1[i] *= alpha; }
    u32x4 w0, w1;
    w0.x = cvtpk(p[0], p[1]); w0.y = cvtpk(p[2], p[3]); w0.z = cvtpk(p[4], p[5]); w0.w = cvtpk(p[6], p[7]);
    w1.x = cvtpk(p[8], p[9]); w1.y = cvtpk(p[10], p[11]); w1.z = cvtpk(p[12], p[13]); w1.w = cvtpk(p[14], p[15]);
    const bf16x8 pf0 = __builtin_bit_cast(bf16x8, w0), pf1 = __builtin_bit_cast(bf16x8, w1);
    const LAS char* vb = vt + (4 * h + ((lane & 15) >> 2)) * 64 + ((lane >> 4) & 1) * 32 + (lane & 3) * 8;
#pragma unroll
    for (int s2 = 0; s2 < 2; ++s2) {
        const v4i16_t a0 = vtr(vb + (4 * s2 + 0) * 512), a1 = vtr(vb + (4 * s2 + 2) * 512);
        const v4i16_t b0 = vtr(vb + (4 * s2 + 1) * 512), b1 = vtr(vb + (4 * s2 + 3) * 512);
        const bf16x8 vf0 = (bf16x8){a0[0], a0[1], a0[2], a0[3], a1[0], a1[1], a1[2], a1[3]};
        const bf16x8 vf1 = (bf16x8){b0[0], b0[1], b0[2], b0[3], b1[0], b1[1], b1[2], b1[3]};
        o0 = MFMA32(vf0, s2 ? pf1 : pf0, o0);
        o1 = MFMA32(vf1, s2 ? pf1 : pf0, o1);
    }
}
__device__ __forceinline__ void attn_store(const f32x16& o0, const f32x16& o1, float inv, bf16* dst, int h) {
#pragma unroll
    for (int g = 0; g < 4; ++g) {
        u32x2 a, b; a.x = cvtpk(o0[4 * g] * inv, o0[4 * g + 1] * inv); a.y = cvtpk(o0[4 * g + 2] * inv, o0[4 * g + 3] * inv);
        b.x = cvtpk(o1[4 * g] * inv, o1[4 * g + 1] * inv); b.y = cvtpk(o1[4 * g + 2] * inv, o1[4 * g + 3] * inv);
        *(u32x2*)(dst + 8 * g + 4 * h) = a; *(u32x2*)(dst + 32 + 8 * g + 4 * h) = b; }
}
__device__ __forceinline__ void dil_item(const bf16* P, bf16* DO, float* LS, int cfg, int b, int hh, int idx, LAS char* vt, int lane) {
    const int r = lane & 31, h = lane >> 5, sh = 2 * cfg, dil = 1 << sh, tsh = 6 - sh;
    const int res = idx >> tsh, qt = idx & ((1 << tsh) - 1);
    const bf16* Pb = P + ((size_t)b * SEQ + res) * PW;
    const size_t rs = (size_t)dil * PW;
    const bf16* qp = Pb + (size_t)(32 * qt + r) * rs + P_QB + 64 * hh + 8 * h;
    bf16x8 qf[4];
#pragma unroll
    for (int s = 0; s < 4; ++s) qf[s] = *(const bf16x8*)(qp + 16 * s);
    f32x16 o0, o1;
#pragma unroll
    for (int i = 0; i < 16; ++i) { o0[i] = 0.f; o1[i] = 0.f; }
    float m = -1e30f, l = 0.f;
    const bf16* kbase = Pb + (size_t)(lane >> 3) * rs + P_KB + 64 * hh + 8 * (lane & 7);
    const bf16* vbase = Pb + (size_t)(lane >> 3) * rs + P_VB + 64 * hh + 8 * (lane & 7);
#define DIL_MASK(kt_) ({ unsigned vm_ = 0u; _Pragma("unroll") for (int i = 0; i < 16; ++i) { const int dl = 32 * (qt - (kt_)) + r - crow(i, h); vm_ |= (dl >= 0 && dl <= 128) ? (1u << i) : 0u; } vm_; })
    AttnOperands TA, TB;
    int kt = (qt > 4 ? qt - 4 : 0);
    attn_load(TA, kbase + (size_t)32 * kt * rs, vbase + (size_t)32 * kt * rs, 8 * rs);
    for (;;) {
        if (kt < qt) attn_load(TB, kbase + (size_t)32 * (kt + 1) * rs, vbase + (size_t)32 * (kt + 1) * rs, 8 * rs);
        attn_compute(o0, o1, m, l, qf, TA, vt, lane, DIL_MASK(kt));
        if (++kt > qt) break;
        if (kt < qt) attn_load(TA, kbase + (size_t)32 * (kt + 1) * rs, vbase + (size_t)32 * (kt + 1) * rs, 8 * rs);
        attn_compute(o0, o1, m, l, qf, TB, vt, lane, DIL_MASK(kt));
        if (++kt > qt) break;
    }
#undef DIL_MASK
    l = pair32_sum(l);
    const size_t row = (size_t)b * SEQ + (size_t)(32 * qt + r) * dil + res;
    attn_store(o0, o1, fast_rcp(l), DO + row * 256 + 64 * hh, h);
    if (h == 0) LS[row * 4 + hh] = m + __builtin_amdgcn_logf(l);
}

__device__ __forceinline__ void softmax_step(f32x16& p, unsigned vmask, bool full  , float& m, float& l, f32x16& o0, f32x16& o1, bf16x8& pf0, bf16x8& pf1) {
    float tm = -INFINITY;
    if (full) {
#pragma unroll
        for (int i = 0; i < 16; ++i) tm = fmaxf(tm, p[i]);
    } else {
#pragma unroll
        for (int i = 0; i < 16; ++i) { p[i] = ((vmask >> i) & 1u) ? p[i] : -INFINITY; tm = fmaxf(tm, p[i]); }
    }
    tm = pair32_max(tm);
    const float mn = fmaxf(m, tm), alpha = fast_exp2(m - mn); m = mn;
    float rs = 0.f;
#pragma unroll
    for (int i = 0; i < 16; ++i) { p[i] = fast_exp2(p[i] - mn); rs += p[i]; }
    l = l * alpha + rs;
    if (__any(alpha != 1.0f)) {
#pragma unroll
        for (int i = 0; i < 16; ++i) { o0[i] *= alpha; o1[i] *= alpha; }
    }
    u32x4 w0, w1;
    w0.x = cvtpk(p[0], p[1]); w0.y = cvtpk(p[2], p[3]); w0.z = cvtpk(p[4], p[5]); w0.w = cvtpk(p[6], p[7]);
    w1.x = cvtpk(p[8], p[9]); w1.y = cvtpk(p[10], p[11]); w1.z = cvtpk(p[12], p[13]); w1.w = cvtpk(p[14], p[15]);
    pf0 = __builtin_bit_cast(bf16x8, w0); pf1 = __builtin_bit_cast(bf16x8, w1);
}
struct AttnQ { f32x16 o0, o1; float m, l; bf16x8 qf[4]; };
__device__ __forceinline__ void attn_compute2(AttnQ& A, AttnQ& B, const AttnOperands& T, LAS char* vt, int lane, unsigned vmA, int modeA, unsigned vmB, int modeB) {
    const int h = lane >> 5;
    f32x16 pA, pB; bf16x8 kf[4]; attn_kfrags(kf, T, vt, lane);
#pragma unroll
    for (int i = 0; i < 16; ++i) { pA[i] = 0.f; pB[i] = 0.f; }
    if (modeA && modeB) {
#pragma unroll
        for (int s = 0; s < 4; ++s) { pA = MFMA32(kf[s], A.qf[s], pA); pB = MFMA32(kf[s], B.qf[s], pB); }
    } else if (modeA) {
#pragma unroll
        for (int s = 0; s < 4; ++s) pA = MFMA32(kf[s], A.qf[s], pA);
    } else {
#pragma unroll
        for (int s = 0; s < 4; ++s) pB = MFMA32(kf[s], B.qf[s], pB);
    }
    { const int piece = lane & 7, key0 = lane >> 3;
#pragma unroll
      for (int w = 0; w < 4; ++w) *(LAS u32x4*)(vt + (2 * w + (piece >> 2)) * 512 + key0 * 64 + (piece & 3) * 16) = T.vv[w]; }
    bf16x8 fA0 = {}, fA1 = {}, fB0 = {}, fB1 = {};
    if (modeA) softmax_step(pA, vmA, modeA == 1, A.m, A.l, A.o0, A.o1, fA0, fA1);
    if (modeB) softmax_step(pB, vmB, modeB == 1, B.m, B.l, B.o0, B.o1, fB0, fB1);
    const LAS char* vb = vt + (4 * h + ((lane & 15) >> 2)) * 64 + ((lane >> 4) & 1) * 32 + (lane & 3) * 8;
#pragma unroll
    for (int s2 = 0; s2 < 2; ++s2) {
        const v4i16_t a0 = vtr(vb + (4 * s2 + 0) * 512), a1 = vtr(vb + (4 * s2 + 2) * 512);
        const v4i16_t b0 = vtr(vb + (4 * s2 + 1) * 512), b1 = vtr(vb + (4 * s2 + 3) * 512);
        const bf16x8 vf0 = (bf16x8){a0[0], a0[1], a0[2], a0[3], a1[0], a1[1], a1[2], a1[3]};
        const bf16x8 vf1 = (bf16x8){b0[0], b0[1], b0[2], b0[3], b1[0], b1[1], b1[2], b1[3]};
        if (modeA) { A.o0 = MFMA32(vf0, s2 ? fA1 : fA0, A.o0); A.o1 = MFMA32(vf1, s2 ? fA1 : fA0, A.o1); }
        if (modeB) { B.o0 = MFMA32(vf0, s2 ? fB1 : fB0, B.o0); B.o1 = MFMA32(vf1, s2 ? fB1 : fB0, B.o1); }
    }
}
__device__ __forceinline__ void dil_pair_item(const bf16* P, bf16* DO, float* LS, int cfg, int b, int hh, int idx, LAS char* vt, int lane) {
    const int r = lane & 31, h = lane >> 5, sh = 2 * cfg, dil = 1 << sh, tsh = 5 - sh;
    const int res = idx >> tsh, qt = 2 * (idx & ((1 << tsh) - 1));
    const bf16* Pb = P + ((size_t)b * SEQ + res) * PW;
    const size_t rs = (size_t)dil * PW;
    AttnQ A, B;
    { const bf16* qp = Pb + (size_t)(32 * qt + r) * rs + P_QB + 64 * hh + 8 * h;
#pragma unroll
      for (int s = 0; s < 4; ++s) { A.qf[s] = *(const bf16x8*)(qp + 16 * s); B.qf[s] = *(const bf16x8*)(qp + 32 * rs + 16 * s); } }
#pragma unroll
    for (int i = 0; i < 16; ++i) { A.o0[i] = 0.f; A.o1[i] = 0.f; B.o0[i] = 0.f; B.o1[i] = 0.f; }
    A.m = -1e30f; A.l = 0.f; B.m = -1e30f; B.l = 0.f;
    const bf16* kbase = Pb + (size_t)(lane >> 3) * rs + P_KB + 64 * hh + 8 * (lane & 7);
    const bf16* vbase = Pb + (size_t)(lane >> 3) * rs + P_VB + 64 * hh + 8 * (lane & 7);
    unsigned dmask = 0u, lmask = 0u;
#pragma unroll
    for (int i = 0; i < 16; ++i) { dmask |= (crow(i, h) <= r) ? (1u << i) : 0u; lmask |= (crow(i, h) >= r) ? (1u << i) : 0u; }
    for (int kt = (qt > 4 ? qt - 4 : 0); kt <= qt + 1; ++kt) {
        AttnOperands T; attn_load(T, kbase + (size_t)32 * kt * rs, vbase + (size_t)32 * kt * rs, 8 * rs);
        const int dA = qt - kt, dB = dA + 1;
        const int modeA = (dA < 0 || dA > 4) ? 0 : (dA == 0 || dA == 4) ? 2 : 1, modeB = (dB < 0 || dB > 4) ? 0 : (dB == 0 || dB == 4) ? 2 : 1;
        attn_compute2(A, B, T, vt, lane, dA == 0 ? dmask : lmask, modeA, dB == 0 ? dmask : lmask, modeB);
    }
    A.l = pair32_sum(A.l); B.l = pair32_sum(B.l);
    const size_t rowA = (size_t)b * SEQ + (size_t)(32 * qt + r) * dil + res, rowB = rowA + (size_t)32 * dil;
    attn_store(A.o0, A.o1, fast_rcp(A.l), DO + rowA * 256 + 64 * hh, h);
    attn_store(B.o0, B.o1, fast_rcp(B.l), DO + rowB * 256 + 64 * hh, h);
    if (h == 0) { LS[rowA * 4 + hh] = A.m + __builtin_amdgcn_logf(A.l); LS[rowB * 4 + hh] = B.m + __builtin_amdgcn_logf(B.l); }
}

#include <hip/hip_bf16.h>
#include <cmath>
namespace attn_body {
using bf16=__hip_bfloat16;
using bf16x8=__attribute__((ext_vector_type(8)))short;
using s16x4=__attribute__((ext_vector_type(4)))short;
using f32x16=__attribute__((ext_vector_type(16)))float;
using f32x4=__attribute__((ext_vector_type(4)))float;
using u32x4=__attribute__((ext_vector_type(4)))unsigned;
constexpr int SEQ=2048,D=64,DM=2304,OP=256;
constexpr int NW=8,QBLK=32,QB=QBLK*NW,KVBLK=64,NQB=SEQ/QB;
__device__ __forceinline__ int crow(int r,int hi){return (r&3)+8*(r>>2)+4*hi;}
#define SBAR() __builtin_amdgcn_sched_barrier(0)
__device__ __forceinline__ void cmask(f32x16&p0,f32x16&p1,int jb,int qrel,int hi){
  const float NEG=-INFINITY; int kb=64*jb+4*hi;
  #pragma unroll
  for(int r=0;r<16;++r){int kv=kb+(r&3)+8*(r>>2); if(kv>qrel)p0[r]=NEG; if(kv+32>qrel)p1[r]=NEG;}
}

constexpr int NSLOT=3, SLOTB=8192;
constexpr int LDS_K=0, LDS_V=NSLOT*SLOTB, LDS_WS=2*NSLOT*SLOTB, LDS_OST=LDS_WS+NW*64*4, LDS_BYTES=LDS_OST+NW*4096;
constexpr float C2=0.125f*1.4426950408889634f;
__device__ __forceinline__ void glds16(const void*gsrc,unsigned lds_dst){unsigned keep;
  asm volatile("s_mov_b32 %0, m0\n\ts_mov_b32 m0, %2\n\ts_nop 0\n\tglobal_load_lds_dwordx4 %1, off\n\ts_mov_b32 m0, %0":"=&s"(keep):"v"(gsrc),"s"(lds_dst):"memory");}
__device__ __forceinline__ float max3f(float a,float b,float c){float r;asm("v_max3_f32 %0, %1, %2, %3":"=v"(r):"v"(a),"v"(b),"v"(c));return r;}
__device__ __forceinline__ float max2f(float a,float b){float r;asm("v_max_f32_e32 %0, %1, %2":"=v"(r):"v"(a),"v"(b));return r;}
__device__ __forceinline__ float fadd_s(float a,float b){float r;asm("v_add_f32_e32 %0, %1, %2":"=v"(r):"v"(a),"v"(b));return r;}
__device__ __forceinline__ float fsub_s(float a,float b){float r;asm("v_sub_f32_e32 %0, %1, %2":"=v"(r):"v"(a),"v"(b));return r;}
typedef float f32x2_t __attribute__((ext_vector_type(2))); typedef __bf16 bf16x2_t __attribute__((ext_vector_type(2)));
__device__ __forceinline__ unsigned cvtpk_s(float lo,float hi){f32x2_t v={lo,hi};bf16x2_t b=__builtin_convertvector(v,bf16x2_t);return __builtin_bit_cast(unsigned,b);}
#define WAIT_BAR(N) asm volatile("s_waitcnt vmcnt(" #N ") lgkmcnt(0)\n\ts_barrier":::"memory")

__device__ __forceinline__ void qkt(f32x16&p0,f32x16&p1,const char*Kslot,const bf16x8*qr,const f32x16&negm,int r32,int hi){
  const char*kb=Kslot+hi*1024+r32*16;
  #pragma unroll
  for(int d0=0;d0<4;++d0){
    const bf16x8 b0=*reinterpret_cast<const bf16x8*>(kb+d0*2048);
    const bf16x8 b1=*reinterpret_cast<const bf16x8*>(kb+d0*2048+512);
    if(d0==0){p0=__builtin_amdgcn_mfma_f32_32x32x16_bf16(b0,qr[0],negm,0,0,0);p1=__builtin_amdgcn_mfma_f32_32x32x16_bf16(b1,qr[0],negm,0,0,0);}
    else{p0=__builtin_amdgcn_mfma_f32_32x32x16_bf16(b0,qr[d0],p0,0,0,0);p1=__builtin_amdgcn_mfma_f32_32x32x16_bf16(b1,qr[d0],p1,0,0,0);}}
}
typedef __attribute__((address_space(3))) const char* lds_cptr;
typedef short v4i16_t __attribute__((ext_vector_type(4)));
__device__ __forceinline__ void kload8(bf16x8*kf,lds_cptr kp){
  kf[0]=*(const __attribute__((address_space(3))) bf16x8*)(kp);      kf[1]=*(const __attribute__((address_space(3))) bf16x8*)(kp+512);
  kf[2]=*(const __attribute__((address_space(3))) bf16x8*)(kp+2048); kf[3]=*(const __attribute__((address_space(3))) bf16x8*)(kp+2560);
  kf[4]=*(const __attribute__((address_space(3))) bf16x8*)(kp+4096); kf[5]=*(const __attribute__((address_space(3))) bf16x8*)(kp+4608);
  kf[6]=*(const __attribute__((address_space(3))) bf16x8*)(kp+6144); kf[7]=*(const __attribute__((address_space(3))) bf16x8*)(kp+6656);
}
__device__ __forceinline__ void kload2(bf16x8*kf,lds_cptr kp,int j){ kf[2*j]=*(const __attribute__((address_space(3))) bf16x8*)(kp+j*2048); kf[2*j+1]=*(const __attribute__((address_space(3))) bf16x8*)(kp+j*2048+512); }
__device__ __forceinline__ s16x4 vtr(lds_cptr p){ return __builtin_bit_cast(s16x4,__builtin_amdgcn_ds_read_tr16_b64_v4i16((__attribute__((address_space(3))) v4i16_t*)p)); }
__device__ __forceinline__ float rowmax(const f32x16&p0,const f32x16&p1){
  float a=max3f(p0[0],p0[1],p1[0]),b=max3f(p0[2],p0[3],p1[1]);a=max3f(a,p1[2],p1[3]);
  #pragma unroll
  for(int r=4;r<16;r+=4){a=max3f(a,p0[r],p0[r+1]);b=max3f(b,p0[r+2],p0[r+3]);a=max3f(a,p1[r],p1[r+1]);b=max3f(b,p1[r+2],p1[r+3]);}
  const float m=max2f(a,b);
  auto rr=__builtin_amdgcn_permlane32_swap(__float_as_uint(m),__float_as_uint(m),false,false);
  return max2f(__uint_as_float(rr[0]),__uint_as_float(rr[1]));
}
__device__ __forceinline__ void pv(f32x16*o,int vb,bf16x8 pa0,bf16x8 pa1,bf16x8 pa2,bf16x8 pa3){
  #pragma unroll
  for(int d0=0;d0<2;++d0){s16x4 lo[4],hi[4];
    #pragma unroll
    for(int ks=0;ks<4;++ks){
      asm volatile("ds_read_b64_tr_b16 %0,%1 offset:%c2":"=&v"(lo[ks]):"v"(vb),"i"(d0*4096+ks*1024):"memory");
      asm volatile("ds_read_b64_tr_b16 %0,%1 offset:%c2":"=&v"(hi[ks]):"v"(vb),"i"(d0*4096+ks*1024+512):"memory");}
    asm volatile("s_waitcnt lgkmcnt(0)":::"memory");SBAR();
    #define PK(k) (bf16x8){lo[k][0],lo[k][1],lo[k][2],lo[k][3],hi[k][0],hi[k][1],hi[k][2],hi[k][3]}
    o[d0]=__builtin_amdgcn_mfma_f32_32x32x16_bf16(pa0,PK(0),o[d0],0,0,0);
    o[d0]=__builtin_amdgcn_mfma_f32_32x32x16_bf16(pa1,PK(1),o[d0],0,0,0);
    o[d0]=__builtin_amdgcn_mfma_f32_32x32x16_bf16(pa2,PK(2),o[d0],0,0,0);
    o[d0]=__builtin_amdgcn_mfma_f32_32x32x16_bf16(pa3,PK(3),o[d0],0,0,0);
    #undef PK
  }
}

#ifndef ATTN_STORE16
#define ATTN_STORE16(p,v) (*(u32x4*)(p)=(v))
#endif
template<int THRL> __device__ __forceinline__ void attn_unit(int tid,int b,int h,int qb,const bf16*Q,const bf16*__restrict__ K,const bf16*__restrict__ V,bf16*O,const float*__restrict__ kms,char*shm){
  asm volatile("":"+v"(tid));
  const int lane=tid&63,r32=lane&31,hi=lane>>5; const int wid=__builtin_amdgcn_readfirstlane(tid>>6);
  const long rowbase=(long)b*SEQ; const int q0=qb*QB;
  const bf16*Qw=Q+(rowbase+q0+wid*QBLK)*DM+h*D;
  const bf16*Kh=K+rowbase*DM+h*D,*Vh=V+rowbase*DM+h*D;
  const unsigned lds0=(unsigned)(uintptr_t)shm;
  float*wsf=(float*)(shm+LDS_WS)+wid*64;
  const bf16*ksrc=Kh+(long)lane*DM+wid*8;
  const bf16*vsrc=Vh+(long)(16*(wid&3)+(lane>>2))*DM+(wid>>2)*32+(lane&3)*8;
  const unsigned kdst=lds0+LDS_K+wid*1024, vdst=lds0+LDS_V+wid*1024;
  #define DMA_K(t,slot) glds16(ksrc+(long)(t)*KVBLK*DM,(unsigned)__builtin_amdgcn_readfirstlane(kdst+(slot)))
  #define DMA_V(t,slot) glds16(vsrc+(long)(t)*KVBLK*DM,(unsigned)__builtin_amdgcn_readfirstlane(vdst+(slot)))
  const int vb0=(int)(lds0+LDS_V)+((lane>>4)&1)*32+(lane&3)*8+(4*hi+((lane&15)>>2))*64;
  const char*Kbase=shm+LDS_K; bf16x8 kf[8];
  const lds_cptr shm3=(lds_cptr)shm; const lds_cptr kp0=shm3+LDS_K+hi*1024+r32*16; const lds_cptr vp0=shm3+LDS_V+((lane>>4)&1)*32+(lane&3)*8+(4*hi+((lane&15)>>2))*64;
  const int NT=(q0+QB)/KVBLK;
  DMA_K(0,0);DMA_V(0,0);DMA_K(1,SLOTB);
  bf16x8 qr[4];
  #pragma unroll
  for(int d0=0;d0<4;++d0)qr[d0]=*reinterpret_cast<const bf16x8*>(&Qw[(long)r32*DM+d0*16+hi*8]);
  unsigned sel=(1u<<qb)-1u;
  if(qb>3){
    f32x16 g=f32x16{};
    const float*kmr=kms+(long)((b*8+(r32&7))*4+h)*64+8*hi;
    #pragma unroll
    for(int s=0;s<4;++s){
      f32x4 a=f32x4{0.f,0.f,0.f,0.f},c=a;
      if(r32<qb){a=*reinterpret_cast<const f32x4*>(kmr+16*s);c=*reinterpret_cast<const f32x4*>(kmr+16*s+4);}
      const float v[8]={a[0],a[1],a[2],a[3],c[0],c[1],c[2],c[3]}; unsigned hw[4],lw[4];
      #pragma unroll
      for(int e=0;e<4;++e){hw[e]=cvtpk_s(v[2*e],v[2*e+1]);lw[e]=cvtpk_s(v[2*e]-__uint_as_float(hw[e]<<16),v[2*e+1]-__uint_as_float(hw[e]&0xffff0000u));}
      const bf16x8 khi=__builtin_bit_cast(bf16x8,(u32x4){hw[0],hw[1],hw[2],hw[3]}),klo=__builtin_bit_cast(bf16x8,(u32x4){lw[0],lw[1],lw[2],lw[3]});
      g=__builtin_amdgcn_mfma_f32_32x32x16_bf16(khi,qr[s],g,0,0,0);g=__builtin_amdgcn_mfma_f32_32x32x16_bf16(klo,qr[s],g,0,0,0);
    }
    float gate[8];
    #pragma unroll
    for(int i=0;i<4;++i){auto rr=__builtin_amdgcn_permlane32_swap(__float_as_uint(g[i]),__float_as_uint(g[i]),false,false);const float oth=__uint_as_float(hi?rr[0]:rr[1]);gate[i]=hi?oth:g[i];gate[4+i]=hi?g[i]:oth;}
    sel=0u;
    #pragma unroll
    for(int k=0;k<3;++k){float best=-INFINITY;int bi=0;
      #pragma unroll
      for(int n=0;n<8;++n){const bool c=(n<qb)&&!((sel>>n)&1u)&&(gate[n]>best);best=c?gate[n]:best;bi=c?n:bi;}
      sel|=1u<<bi;}
  }
  float mhat=0.f,l_reg=0.f;f32x16 o[2];o[0]=f32x16{};o[1]=f32x16{};f32x16 negm=f32x16{};asm volatile("":"+v"(negm));
  const int qrel=wid*QBLK+r32;
  #define CMASK(P0,P1,t) do{int jb_=(t)-(NT-4); if(jb_>=0)cmask(P0,P1,jb_,qrel,hi);}while(0)
  bool resc=false;
  #define START(P0,P1) do{ const float rm=rowmax(P0,P1); resc=false; \
    { const float dl=fmaxf(rm,-128.f); mhat=fadd_s(mhat,dl); \
      _Pragma("unroll") for(int r=0;r<16;++r){P0[r]=fsub_s(P0[r],dl);P1[r]=fsub_s(P1[r],dl);} \
      _Pragma("unroll") for(int r=0;r<16;++r)negm[r]=-mhat; asm volatile("":"+v"(negm)); } \
    _Pragma("unroll") for(int r=0;r<16;++r)P0[r]=__builtin_amdgcn_exp2f(P0[r]); }while(0)
  #define RESC() do{ if(resc){ asm volatile("s_waitcnt lgkmcnt(0)":::"memory"); \
      _Pragma("unroll") for(int d_=0;d_<2;++d_) _Pragma("unroll") for(int r=0;r<16;++r)o[d_][r]*=wsf[crow(r,hi)]; } }while(0)
  f32x16 pA0,pA1,pB0,pB1;
  int sl_prev=0,sl_cur=0,sl_next=SLOTB;
  #define ROT() do{sl_prev=sl_cur;sl_cur=sl_next;sl_next=(sl_next==(NSLOT-1)*SLOTB)?0:sl_next+SLOTB;}while(0)
  DMA_K(2,2*SLOTB);
  WAIT_BAR(3);
  { const float nm_=((sel&1u)||NT==4)?0.f:-INFINITY; _Pragma("unroll") for(int r_=0;r_<16;++r_)negm[r_]=nm_; asm volatile("":"+v"(negm)); }
  qkt(pA0,pA1,Kbase,qr,negm,r32,hi);asm volatile("s_nop 15\n\ts_nop 7":"+v"(pA0),"+v"(pA1));CMASK(pA0,pA1,0);
  START(pA0,pA1);
  _Pragma("unroll") for(int r=0;r<16;++r)pA1[r]=__builtin_amdgcn_exp2f(pA1[r]);
  WAIT_BAR(0);
  DMA_K(3,0);DMA_V(1,SLOTB);
  ROT();
  kload8(kf,kp0+sl_cur);
  WAIT_BAR(2);
  s16x4 vlo[8],vhi[8]; u32x4 pw0,pw1,pw2,pw3;
  #define PKW(P,B) cvtpk_s(P[B],P[B+1])
  #define PAF(k) __builtin_bit_cast(bf16x8,pw##k)
  #define VFR(i) (bf16x8){vlo[i][0],vlo[i][1],vlo[i][2],vlo[i][3],vhi[i][0],vhi[i][1],vhi[i][2],vhi[i][3]}
  #define PIN(x) asm volatile("":"+v"(x))
  #define MX3(a,b,c) __builtin_fmaxf(__builtin_fmaxf((a),(b)),(c))
  #define GAPA(MF,A0,A1,A2,A3,W0,W1,PW) do{ MF; sacc+=A0; sacc+=A1; sacc+=A2; sacc+=A3; PIN(sacc); W0; W1; PIN(PW); SBAR(); }while(0)
  #define EX(v) __builtin_amdgcn_exp2f(v)
  #define GAPB(MF,X,B) do{ MF; X[B]=EX(X[B]); X[B+1]=EX(X[B+1]); X[B+2]=EX(X[B+2]); X[B+3]=EX(X[B+3]); PIN(X); SBAR(); }while(0)
  #define VRD(i) do{ vlo[i]=vtr(vp_+(((i)>>2)*4096+((i)&3)*1024)); vhi[i]=vtr(vp_+(((i)>>2)*4096+((i)&3)*1024+512)); }while(0)
  #define KRD(G,j) do{ if(G){ kload2(kf,kp0+sl_next,j); SBAR(); } }while(0)
  #define STEP(C0,C1,P0,P1,t,GK,GV,GL) do{ SBAR(); \
    { const float nm_=(((sel>>((t)>>2))&1u)||((t)>=NT-4))?-mhat:-INFINITY; _Pragma("unroll") for(int r_=0;r_<16;++r_)negm[r_]=nm_; asm volatile("":"+v"(negm)); } \
    const lds_cptr vp_=vp0+sl_prev; \
    VRD(0); SBAR(); float sacc=(P0[0]+P0[1]); \
    GAPA(C0=__builtin_amdgcn_mfma_f32_32x32x16_bf16(kf[0],qr[0],negm,0,0,0), P0[2],P0[3],P0[4],P0[5],     pw0[0]=PKW(P0,0), pw0[1]=PKW(P0,2), pw0); \
    VRD(4); SBAR(); GAPA(C1=__builtin_amdgcn_mfma_f32_32x32x16_bf16(kf[1],qr[0],negm,0,0,0), P0[6],P0[7],P0[8],P0[9],     pw0[2]=PKW(P0,4), pw0[3]=PKW(P0,6), pw0); \
    VRD(1); SBAR(); GAPA(C0=__builtin_amdgcn_mfma_f32_32x32x16_bf16(kf[2],qr[1],C0,0,0,0),   P0[10],P0[11],P0[12],P0[13], pw1[0]=PKW(P0,8), pw1[1]=PKW(P0,10), pw1); \
    VRD(5); SBAR(); GAPA(C1=__builtin_amdgcn_mfma_f32_32x32x16_bf16(kf[3],qr[1],C1,0,0,0),   P0[14],P0[15],P1[0],P1[1],   pw1[2]=PKW(P0,12),pw1[3]=PKW(P0,14), pw1); \
    VRD(2); SBAR(); GAPA(C0=__builtin_amdgcn_mfma_f32_32x32x16_bf16(kf[4],qr[2],C0,0,0,0),   P1[2],P1[3],P1[4],P1[5],     pw2[0]=PKW(P1,0), pw2[1]=PKW(P1,2), pw2); \
    VRD(6); SBAR(); GAPA(C1=__builtin_amdgcn_mfma_f32_32x32x16_bf16(kf[5],qr[2],C1,0,0,0),   P1[6],P1[7],P1[8],P1[9],     pw2[2]=PKW(P1,4), pw2[3]=PKW(P1,6), pw2); \
    VRD(3); SBAR(); GAPA(C0=__builtin_amdgcn_mfma_f32_32x32x16_bf16(kf[6],qr[3],C0,0,0,0),   P1[10],P1[11],P1[12],P1[13], pw3[0]=PKW(P1,8), pw3[1]=PKW(P1,10), pw3); \
    VRD(7); SBAR(); GAPA(C1=__builtin_amdgcn_mfma_f32_32x32x16_bf16(kf[7],qr[3],C1,0,0,0),   P1[14],P1[15],0.f,0.f,       pw3[2]=PKW(P1,12),pw3[3]=PKW(P1,14), pw3); \
    l_reg+=sacc; \
    if(GK){DMA_K((t)+3,sl_cur);} if(GV){DMA_V((t)+1,sl_next);} \
    CMASK(C0,C1,t); \
    { float a=MX3(C0[0],C0[1],C1[0]),b=MX3(C0[2],C0[3],C1[1]); a=MX3(a,C1[2],C1[3]); \
      _Pragma("unroll") for(int r=4;r<16;r+=4){a=MX3(a,C0[r],C0[r+1]);b=MX3(b,C0[r+2],C0[r+3]);a=MX3(a,C1[r],C1[r+1]);b=MX3(b,C1[r+2],C1[r+3]);} \
      float rm=__builtin_fmaxf(a,b); { auto rr=__builtin_amdgcn_permlane32_swap(__float_as_uint(rm),__float_as_uint(rm),false,false); rm=__builtin_fmaxf(__uint_as_float(rr[0]),__uint_as_float(rr[1])); } \
      resc=false; \
      if(__builtin_expect(__any(rm>(float)THRL),0)){ const float dl=__builtin_fmaxf(rm,0.f); mhat+=dl; \
        _Pragma("unroll") for(int r=0;r<16;++r){C0[r]-=dl;C1[r]-=dl;} \
        _Pragma("unroll") for(int r=0;r<16;++r)negm[r]=-mhat; asm volatile("":"+v"(negm)); \
        const float f=__builtin_amdgcn_exp2f(-dl); l_reg*=f; if(hi==0)wsf[r32]=f; resc=true; } } \
    SBAR(); \
    GAPB(o[0]=__builtin_amdgcn_mfma_f32_32x32x16_bf16(PAF(0),VFR(0),o[0],0,0,0), C0,0); \
    GAPB(o[1]=__builtin_amdgcn_mfma_f32_32x32x16_bf16(PAF(0),VFR(4),o[1],0,0,0), C0,4); \
    KRD(GL,0); GAPB(o[0]=__builtin_amdgcn_mfma_f32_32x32x16_bf16(PAF(1),VFR(1),o[0],0,0,0), C0,8); \
    KRD(GL,1); GAPB(o[1]=__builtin_amdgcn_mfma_f32_32x32x16_bf16(PAF(1),VFR(5),o[1],0,0,0), C0,12); \
    KRD(GL,2); GAPB(o[0]=__builtin_amdgcn_mfma_f32_32x32x16_bf16(PAF(2),VFR(2),o[0],0,0,0), C1,0); \
    KRD(GL,3); GAPB(o[1]=__builtin_amdgcn_mfma_f32_32x32x16_bf16(PAF(2),VFR(6),o[1],0,0,0), C1,4); \
    GAPB(o[0]=__builtin_amdgcn_mfma_f32_32x32x16_bf16(PAF(3),VFR(3),o[0],0,0,0), C1,8); \
    GAPB(o[1]=__builtin_amdgcn_mfma_f32_32x32x16_bf16(PAF(3),VFR(7),o[1],0,0,0), C1,12); \
    }while(0)
  int t=1;
  #undef CMASK
  #define CMASK(P0,P1,t) do{}while(0)
  for(;t+5<NT;t+=2){
    STEP(pB0,pB1,pA0,pA1,t,true,true,true);     WAIT_BAR(2); RESC(); ROT();
    STEP(pA0,pA1,pB0,pB1,t+1,true,true,true);   WAIT_BAR(2); RESC(); ROT();
  }
  #undef CMASK
  #define CMASK(P0,P1,t) do{int jb_=(t)-(NT-4); if(jb_>=0)cmask(P0,P1,jb_,qrel,hi);}while(0)
  #define ENDW(tt) do{ if((tt)+3<NT){WAIT_BAR(2);} else if((tt)+2<NT){WAIT_BAR(1);} else {WAIT_BAR(0);} }while(0)
  for(;t+1<NT;t+=2){
    STEP(pB0,pB1,pA0,pA1,t,(t+3<NT),(t+1<NT),(t+1<NT));       ENDW(t);   RESC(); ROT();
    STEP(pA0,pA1,pB0,pB1,t+1,(t+4<NT),(t+2<NT),(t+2<NT));     ENDW(t+1); RESC(); ROT();
  }
  STEP(pB0,pB1,pA0,pA1,NT-1,false,false,false); RESC();
  { float sacc=pB0[0]+pB0[1]; _Pragma("unroll") for(int r=2;r<16;++r)sacc+=pB0[r]; _Pragma("unroll") for(int r=0;r<16;++r)sacc+=pB1[r]; l_reg+=sacc;
    pw0=(u32x4){PKW(pB0,0),PKW(pB0,2),PKW(pB0,4),PKW(pB0,6)};pw1=(u32x4){PKW(pB0,8),PKW(pB0,10),PKW(pB0,12),PKW(pB0,14)};pw2=(u32x4){PKW(pB1,0),PKW(pB1,2),PKW(pB1,4),PKW(pB1,6)};pw3=(u32x4){PKW(pB1,8),PKW(pB1,10),PKW(pB1,12),PKW(pB1,14)};
    SBAR(); pv(o,vb0+sl_cur,PAF(0),PAF(1),PAF(2),PAF(3)); }
  #undef PKW
  #undef PAF
  #undef VFR
  #undef PIN
  #undef MX3
  #undef GAPA
  #undef GAPB
  #undef EX
  #undef VRD
  #undef KRD
  #undef STEP
  #undef ENDW
  {auto rr=__builtin_amdgcn_permlane32_swap(__float_as_uint(l_reg),__float_as_uint(l_reg),false,false);l_reg=__uint_as_float(rr[0])+__uint_as_float(rr[1]);}
  if(hi==0)wsf[32+r32]=l_reg;asm volatile("s_waitcnt lgkmcnt(0)":::"memory");
  float rli[16];
  #pragma unroll
  for(int r=0;r<16;++r)rli[r]=__builtin_amdgcn_rcpf(wsf[32+crow(r,hi)]);
  bf16*Ow=O+(rowbase+q0+wid*QBLK)*OP+h*D;
  { bf16*stg=(bf16*)(shm+LDS_OST)+wid*2048;
    #pragma unroll
    for(int r=0;r<16;++r){const int orow=crow(r,hi);
      #pragma unroll
      for(int d0=0;d0<2;++d0)stg[orow*64+d0*32+r32]=__float2bfloat16(o[d0][r]*rli[r]);}
    asm volatile("s_waitcnt lgkmcnt(0)":::"memory");
    #pragma unroll
    for(int i=0;i<4;++i){const int row=i*8+(lane>>3),ch=lane&7; const u32x4 v=*(const u32x4*)(stg+row*64+ch*8); ATTN_STORE16(Ow+(long)row*OP+ch*8,v);} }
  asm volatile("s_waitcnt lgkmcnt(0)\n\ts_barrier":::"memory");
  #undef DMA_K
  #undef DMA_V
  #undef CMASK
  #undef START
  #undef RESC
  #undef ROT
}
constexpr int ATTN_LDS_BYTES=LDS_BYTES;
#undef SBAR
#undef WAIT_BAR
}

constexpr size_t MiB = 1u << 20;
constexpr size_t WS_CTL = 0, CTL_ZERO_BYTES = 1 * MiB;
constexpr size_t WS_MOD = 1 * MiB;
constexpr size_t WS_RTE = 2 * MiB, WS_RTP = WS_RTE + 256 * 1024, WS_RTG = WS_RTP + 256 * 1024, WS_S2T = WS_RTG + 256 * 1024;
constexpr size_t WS_WIN = 4 * MiB, WS_WOUT = 14 * MiB, WS_WFGU = 18 * MiB, WS_WFD = 29 * MiB, WS_WMGU = 35 * MiB, WS_WMD = 91 * MiB;
constexpr size_t WS_XB = 119 * MiB;
constexpr size_t WS_HB = 203 * MiB;
constexpr size_t WS_R = 267 * MiB;
constexpr size_t WS_P = WS_R, WS_DIL = WS_R + 144 * MiB, WS_LSE = WS_R + 192 * MiB, WS_OA = WS_R + 194 * MiB, WS_OC = WS_R + 210 * MiB, WS_OD = WS_R + 226 * MiB;
constexpr size_t WS_Y = WS_R;
constexpr size_t WS_FH = WS_R;
constexpr size_t WS_HID = WS_R, HID_BYTES = 56 * MiB, WS_YS = WS_R + 112 * MiB;
constexpr size_t WS_END = WS_R + 244 * MiB;
constexpr int CW_BAR = 4096;
constexpr int CW_TS = 12288;
constexpr int CW_CNT = 8192;
constexpr int CW_KM = 16384;
static_assert((CW_KM + 2 * 32768 * 1) * 4 <= (int)CTL_ZERO_BYTES + 0 || true, "");
static_assert((size_t)(CW_KM + 2 * 32768) * 4 <= CTL_ZERO_BYTES, "CTL region");
constexpr int CW_DQ = 131072;
static_assert((size_t)(CW_DQ + 2048) * 4 <= CTL_ZERO_BYTES, "CTL region");

constexpr int RING_BYTES = 131072, LDSX_OFF = RING_BYTES, LDS_BYTES = 147456;

#define XB_TMO      128
#define XB_XCNT(j)  (256  + 64 * (j))
#define XB_XSUB(j)  (1280 + 64 * (j))
#define XB_XGEN(j)  (2304 + 64 * (j))
#define XB_TOP      3328
#define XB_TOPGEN   3392
#define XCD_BAR_WORDS 3456
#define XB_SPIN_CAP (1u << 18)
__device__ __forceinline__ unsigned xb_ld(unsigned* p)              { return __hip_atomic_load(p, __ATOMIC_RELAXED, __HIP_MEMORY_SCOPE_AGENT); }
__device__ __forceinline__ unsigned xb_add(unsigned* p, unsigned v) { return __hip_atomic_fetch_add(p, v, __ATOMIC_RELAXED, __HIP_MEMORY_SCOPE_AGENT); }
__device__ __forceinline__ unsigned xb_xcc_id() { return (unsigned)__builtin_amdgcn_s_getreg((3 << 11) | 20) & 0xFu; }
#define XB_SPIN(cond, bar) do { unsigned _sp = 0; while (cond) { __builtin_amdgcn_s_sleep(1); \
    if ((++_sp & 255u) == 0u) { if (xb_ld(&(bar)[XB_TMO])) break; if (_sp > XB_SPIN_CAP) { atomicAdd(&(bar)[XB_TMO], 1u); break; } } } } while (0)
struct XcdBarrier { unsigned* bar; unsigned x; volatile LAS unsigned* st; };
__device__ __forceinline__ XcdBarrier xcd_barrier_post(unsigned* bar, volatile LAS unsigned* st, int tid) {
    XcdBarrier b; b.bar = bar; b.x = xb_xcc_id(); b.st = st;
    if (tid == 0) (void)xb_add(&bar[XB_XCNT(b.x)], 1u);
    return b;
}
__device__ __forceinline__ void xcd_barrier_complete(unsigned* bar, unsigned x, unsigned& nloc, unsigned& nx) {
    const unsigned G = gridDim.x * gridDim.y * gridDim.z;
    unsigned sum, cnt, mine, sp = 0u;
    for (;;) {
        sum = 0u; cnt = 0u; mine = 0u;
#pragma unroll
        for (unsigned j = 0; j < 16; ++j) { const unsigned c = xb_ld(&bar[XB_XCNT(j)]); sum += c; cnt += (c > 0u) ? 1u : 0u; mine = (j == x) ? c : mine; }
        if (sum == G) break;
        __builtin_amdgcn_s_sleep(1);
        if ((++sp & 255u) == 0u) { if (xb_ld(&bar[XB_TMO])) break; if (sp > XB_SPIN_CAP) { atomicAdd(&bar[XB_TMO], 1u); break; } }
    }
    nloc = mine > 0u ? mine : 1u; nx = cnt > 0u ? cnt : 1u;
}
__device__ __forceinline__ void xcd_barrier(const XcdBarrier& b, int tid) {
    asm volatile("s_waitcnt vmcnt(0)" ::: "memory");
    __syncthreads();
    if (tid == 0) {
        unsigned* bar = b.bar;
        __builtin_amdgcn_s_waitcnt(0);
        unsigned nloc = b.st[0], nx = b.st[1];
        if (nloc == 0u) { xcd_barrier_complete(bar, b.x, nloc, nx); b.st[0] = nloc; b.st[1] = nx; }
        const unsigned old = xb_add(&bar[XB_XSUB(b.x)], 1u);
        const unsigned gen = old / nloc;
        if (old + 1u == (gen + 1u) * nloc) {
            __builtin_amdgcn_fence(__ATOMIC_RELEASE, "agent");
            asm volatile("s_waitcnt vmcnt(0)" ::: "memory");
            const unsigned og = xb_add(&bar[XB_TOP], 1u);
            const unsigned tg = og / nx;
            if (og + 1u == (tg + 1u) * nx) xb_add(&bar[XB_TOPGEN], 1u);
            else XB_SPIN(xb_ld(&bar[XB_TOPGEN]) == tg, bar);
            __builtin_amdgcn_fence(__ATOMIC_ACQUIRE, "agent");
            xb_add(&bar[XB_XGEN(b.x)], 1u);
            asm volatile("s_waitcnt vmcnt(0)" ::: "memory");
        } else {
            XB_SPIN(xb_ld(&bar[XB_XGEN(b.x)]) == gen, bar);
            __builtin_amdgcn_fence(__ATOMIC_ACQUIRE, "agent");
            asm volatile("s_waitcnt vmcnt(0)" ::: "memory");
        }
    }
    __syncthreads();
}

struct Args { const void* in[26]; float* out; unsigned char* ws; int ph_lo, ph_hi; };
struct Frame {
    LAS unsigned char* lds;
    unsigned char* ws0; unsigned char* ws; unsigned* ctl; float* out;
    int tid, lane, wave, wave0, vcu;
};
typedef const __attribute__((address_space(4))) Args* ArgsP;
__device__ __forceinline__ ArgsP args_ptr() { auto p = __builtin_amdgcn_kernarg_segment_ptr(); asm volatile("" : "+s"(p)); return (ArgsP)p; }
__device__ __forceinline__ int otid(int wave0) { int t = wave0 * 64 + lane_id(); asm volatile("" : "+v"(t)); return t; }
#define REFRESH(F) do { (F).tid = otid((F).wave0); (F).lane = (F).tid & 63; (F).wave = __builtin_amdgcn_readfirstlane((F).tid >> 6); { long z_ = 0; asm volatile("" : "+s"(z_)); (F).ws = (F).ws0 + z_; } (F).ctl = (unsigned*)(F).ws; } while (0)
#define INP(A, k) ((const float*)(A)->in[k])
enum { I_X = 0, I_C, I_POS, I_ADAW, I_ADAB, I_MIXPRE, I_MIXPOST, I_FFNPRE, I_FFNPOST, I_WIN, I_WOUT, I_GROUPG, I_GMLPW, I_GMLPB, I_CONVW, I_CONVB, I_CONVLNG, I_CONVLNB,
       I_FFNWG, I_FFNWU, I_FFNWD, I_ROUTW, I_ROUTB, I_MOEWG, I_MOEWU, I_MOEWD };
#define LDS_WAIT() asm volatile("s_waitcnt lgkmcnt(0)" ::: "memory")

__device__ __forceinline__ void ld_f32_row(float (&v)[16], const float* p, int lane) {
#pragma unroll
    for (int j = 0; j < 4; ++j) { const f32x4 t = ((const f32x4*)p)[lane + 64 * j]; v[4 * j] = t[0]; v[4 * j + 1] = t[1]; v[4 * j + 2] = t[2]; v[4 * j + 3] = t[3]; }
}
__device__ __forceinline__ void ld_bf16_row(float (&v)[16], const bf16* p, int lane) {
#pragma unroll
    for (int j = 0; j < 4; ++j) { const u32x2 t = ((const u32x2*)p)[lane + 64 * j]; v[4 * j] = bflo(t.x); v[4 * j + 1] = bfhi(t.x); v[4 * j + 2] = bflo(t.y); v[4 * j + 3] = bfhi(t.y); }
}
__device__ __forceinline__ void st_f32_row(const float (&v)[16], float* p, int lane) {
#pragma unroll
    for (int j = 0; j < 4; ++j) ((f32x4*)p)[lane + 64 * j] = (f32x4){v[4 * j], v[4 * j + 1], v[4 * j + 2], v[4 * j + 3]};
}
__device__ __forceinline__ void st_bf16_row(const float (&v)[16], bf16* p, int lane) {
#pragma unroll
    for (int j = 0; j < 4; ++j) { u32x2 t; t.x = cvtpk(v[4 * j], v[4 * j + 1]); t.y = cvtpk(v[4 * j + 2], v[4 * j + 3]); ((u32x2*)p)[lane + 64 * j] = t; }
}
struct RawF32 { f32x4 v[4]; };
struct RawB16 { u32x2 v[4]; };
__device__ __forceinline__ RawF32 ldraw(const float* p, int lane) { RawF32 r;
#pragma unroll
    for (int j = 0; j < 4; ++j) r.v[j] = __builtin_nontemporal_load(((const f32x4*)p) + lane + 64 * j);
    return r; }
__device__ __forceinline__ RawB16 ldraw(const bf16* p, int lane) { RawB16 r;
#pragma unroll
    for (int j = 0; j < 4; ++j) r.v[j] = ((const u32x2*)p)[lane + 64 * j];
    return r; }
__device__ __forceinline__ void cvt_row(float (&v)[16], const RawF32& r) {
#pragma unroll
    for (int j = 0; j < 4; ++j) { v[4 * j] = r.v[j][0]; v[4 * j + 1] = r.v[j][1]; v[4 * j + 2] = r.v[j][2]; v[4 * j + 3] = r.v[j][3]; } }
__device__ __forceinline__ void cvt_row(float (&v)[16], const RawB16& r) {
#pragma unroll
    for (int j = 0; j < 4; ++j) { v[4 * j] = bflo(r.v[j].x); v[4 * j + 1] = bfhi(r.v[j].x); v[4 * j + 2] = bflo(r.v[j].y); v[4 * j + 3] = bfhi(r.v[j].y); } }
__device__ __forceinline__ float row_rstd(const float (&v)[16]) {
    float s = 0.f;
#pragma unroll
    for (int i = 0; i < 16; ++i) s += v[i] * v[i];
    return __builtin_amdgcn_rsqf(wave_sum(s) * (1.0f / D) + EPS);
}
__device__ __forceinline__ const float* mod_ptr(const Frame& F, int layer, int b, int part) { return (const float*)(F.ws + WS_MOD) + ((size_t)(layer * 16 + b) * 6 + part) * 1024; }

__device__ __forceinline__ int dst_row(int type, int n) {
    if (type == 0) return n;
    if (type == 1) return 256 * (n >> 7) + (n & 127);
    if (type == 2) return 256 * (n >> 7) + 128 + (n & 127);
    const int sl = n >> 8, cc = n & 255;
    if (sl == 0 || sl == 1 || sl == 3 || sl == 4) { const int hh = cc >> 6, d = cc & 63; return 256 * sl + 64 * hh + 32 * ((d >> 4) & 1) + 8 * ((d >> 2) & 3) + 4 * (d >> 5) + (d & 3); }
    if (sl < 8) return n;
    return 256 * (8 + ((cc >> 7) & 1)) + (sl == 9 ? 128 : 0) + (cc & 127);
}
template <bool FP8>
__device__ __forceinline__ void transpose_item_t(const float* W, int K, int N, void* WTv, int type, float wsc, LAS float* scr, int item, int lane) {
    const int nblk = N / 32, kb = item / nblk, nb = item % nblk, k0 = 64 * kb, n0 = 32 * nb;
    const int kk8 = lane >> 3, nq = lane & 7;
    f32x4 v[8];
#pragma unroll
    for (int i = 0; i < 8; ++i) v[i] = __builtin_nontemporal_load((const f32x4*)(W + (size_t)(k0 + 8 * i + kk8) * N + n0 + 4 * nq));
#pragma unroll
    for (int i = 0; i < 8; ++i)
#pragma unroll
        for (int e = 0; e < 4; ++e) scr[(4 * nq + e) * 68 + 8 * i + kk8] = v[i][e];
    LDS_WAIT(); asm volatile("" ::: "memory");
    const int c = lane & 7;
#pragma unroll
    for (int j = 0; j < 4; ++j) { const int n = (lane >> 3) + 8 * j;
        const f32x4 a = *(const LAS f32x4*)(scr + n * 68 + 8 * c), b = *(const LAS f32x4*)(scr + n * 68 + 8 * c + 4);
        const size_t off = (size_t)dst_row(type, n0 + n) * K + k0 + 8 * c;
        if constexpr (FP8) { u32x2 o; o.x = pk4_fp8(a[0] * wsc, a[1] * wsc, a[2] * wsc, a[3] * wsc); o.y = pk4_fp8(b[0] * wsc, b[1] * wsc, b[2] * wsc, b[3] * wsc); *(u32x2*)((unsigned char*)WTv + off) = o; }
        else { u32x4 o; o.x = cvtpk(a[0], a[1]); o.y = cvtpk(a[2], a[3]); o.z = cvtpk(b[0], b[1]); o.w = cvtpk(b[2], b[3]); *(u32x4*)((bf16*)WTv + off) = o; } }
    LDS_WAIT(); asm volatile("" ::: "memory");
}
__device__ __forceinline__ void transpose_item(const float* W, int K, int N, bf16* WT, int type, LAS float* scr, int item, int lane) { transpose_item_t<false>(W, K, N, WT, type, 1.f, scr, item, lane); }
__device__ __forceinline__ void transpose_item8(const float* W, int K, int N, unsigned char* WT, int type, float wsc, LAS float* scr, int item, int lane) { transpose_item_t<true>(W, K, N, WT, type, wsc, scr, item, lane); }
__device__ __forceinline__ void ada_quarter(Frame& F, ArgsP A, int a, int kc, LAS float* scr, float (&acc)[16]) {
    const int layer = a / 96, n = 64 * (a % 96) + F.lane; const float* cin = INP(A, I_C); const float* ada_w = INP(A, I_ADAW);
#pragma unroll
    for (int b = 0; b < 16; ++b) acc[b] = 0.f;
    for (int i = 0; i < 32; ++i) { const int idx = F.lane + 64 * i, b = idx >> 7, kk = idx & 127; scr[idx] = siluf_(cin[b * 1024 + kc * 128 + kk]); }
    LDS_WAIT(); asm volatile("" ::: "memory");
    const float* wp = ada_w + ((size_t)layer * 1024 + kc * 128) * 6144 + n;
#pragma unroll 2
    for (int kk = 0; kk < 128; kk += 4) { const float w0 = wp[(size_t)kk * 6144], w1 = wp[(size_t)(kk + 1) * 6144], w2 = wp[(size_t)(kk + 2) * 6144], w3 = wp[(size_t)(kk + 3) * 6144];
#pragma unroll
        for (int b = 0; b < 16; ++b) { const f32x4 c4 = *(const LAS f32x4*)(scr + b * 128 + kk); acc[b] += c4[0] * w0; acc[b] += c4[1] * w1; acc[b] += c4[2] * w2; acc[b] += c4[3] * w3; } }
    LDS_WAIT(); asm volatile("" ::: "memory");
}
constexpr int I_MG = 16 * 112, I_MD = 56 * 32, N_MOE_ITEMS = 16 * I_MG + 8 * I_MD;
__device__ __forceinline__ void moe_conv_item(Frame& F, ArgsP A, int r, LAS float* scr) {
    unsigned char* WMGU8 = F.ws + WS_WMGU; unsigned char* WMD8 = F.ws + WS_WMD;
    if (r < 8 * I_MG) { const int e = r / I_MG; transpose_item8(INP(A, I_MOEWG) + (size_t)e * 1024 * FFE, 1024, FFE, WMGU8 + (size_t)e * 2 * FFE * 1024, 1, MOE_WGU_SC, scr, r % I_MG, F.lane); return; } r -= 8 * I_MG;
    if (r < 8 * I_MG) { const int e = r / I_MG; transpose_item8(INP(A, I_MOEWU) + (size_t)e * 1024 * FFE, 1024, FFE, WMGU8 + (size_t)e * 2 * FFE * 1024, 2, MOE_WGU_SC, scr, r % I_MG, F.lane); return; } r -= 8 * I_MG;
    { const int e = r / I_MD; transpose_item8(INP(A, I_MOEWD) + (size_t)e * FFE * 1024, FFE, 1024, WMD8 + (size_t)e * 1024 * FFE, 0, MOE_WD_SC, scr, r % I_MD, F.lane); }
}
constexpr int I_IN = 16 * 80, I_OUT = 16 * 32, I_FG = 16 * 88, I_FD = 44 * 32;
constexpr int N_DEF0 = I_IN + 2 * I_OUT + 2 * I_FG + I_FD;
__device__ __forceinline__ int def_items(int layer) { return layer == 0 ? N_DEF0 + N_MOE_ITEMS / 2 : N_MOE_ITEMS / 2; }
__device__ __forceinline__ void def_conv_item(Frame& F, ArgsP A, int layer, int r, LAS float* scr) {
    if (layer == 0) {
        bf16* WIN = (bf16*)(F.ws + WS_WIN); bf16* WOUT = (bf16*)(F.ws + WS_WOUT); bf16* WFGU = (bf16*)(F.ws + WS_WFGU); bf16* WFD = (bf16*)(F.ws + WS_WFD);
        if (r < I_OUT) { transpose_item(INP(A, I_WOUT), 1024, 1024, WOUT, 0, scr, r, F.lane); return; } r -= I_OUT;
        if (r < I_FG) { transpose_item8(INP(A, I_FFNWG), 1024, FFD, (unsigned char*)WFGU, 1, MOE_WGU_SC, scr, r, F.lane); return; } r -= I_FG;
        if (r < I_FG) { transpose_item8(INP(A, I_FFNWU), 1024, FFD, (unsigned char*)WFGU, 2, MOE_WGU_SC, scr, r, F.lane); return; } r -= I_FG;
        if (r < I_FD) { transpose_item(INP(A, I_FFNWD), FFD, 1024, WFD, 0, scr, r, F.lane); return; } r -= I_FD;
        if (r < I_IN) { transpose_item(INP(A, I_WIN) + (size_t)1024 * NIN, 1024, NIN, WIN + (size_t)NIN * 1024, 3, scr, r, F.lane); return; } r -= I_IN;
        if (r < I_OUT) { transpose_item(INP(A, I_WOUT) + (size_t)1024 * 1024, 1024, 1024, WOUT + (size_t)1024 * 1024, 0, scr, r, F.lane); return; } r -= I_OUT;
        moe_conv_item(F, A, r, scr);
    } else moe_conv_item(F, A, N_MOE_ITEMS / 2 + r, scr);
}
__device__ __forceinline__ void phase_prologue(Frame& F) {
    REFRESH(F);
    LAS float* scr = (LAS float*)(F.lds + F.wave * 16384);
    ArgsP A = args_ptr();
    const bool ada_wave = (F.vcu < 192);
    float acc[16];
    if (ada_wave) ada_quarter(F, A, F.vcu, F.wave, scr, acc);
    const int gw = (F.vcu - 192) * 8 + F.wave, NGW = (NWG - 192) * 8;
    for (int it = ada_wave ? -1 : gw; it >= 0 && it < I_IN; it += NGW) transpose_item(INP(A, I_WIN), 1024, NIN, (bf16*)(F.ws + WS_WIN), 3, scr, it, F.lane);
    if (ada_wave) {
#pragma unroll
        for (int b = 0; b < 16; ++b) scr[b * 64 + F.lane] = acc[b]; }
    __syncthreads();
    if (F.wave == 0 && F.vcu < 192) { const int a = F.vcu, layer = a / 96, n = 64 * (a % 96) + F.lane;
        float* mod = (float*)(F.ws + WS_MOD); const float bias = INP(A, I_ADAB)[layer * 6144 + n];
#pragma unroll
        for (int b = 0; b < 16; ++b) { float v = bias;
#pragma unroll
            for (int q = 0; q < 8; ++q) v += ((LAS float*)(F.lds + q * 16384))[b * 64 + F.lane];
            mod[(size_t)(layer * 16 + b) * 6144 + n] = v; } }
}

__device__ __forceinline__ void norm_mod_store(const float (&x)[16], const float* g, const float* sc, const float* sh, bf16* dst, int lane, float (&h)[16]) {
    const float r = row_rstd(x);
    float gv[16], scv[16], shv[16]; ld_f32_row(gv, g, lane); ld_f32_row(scv, sc, lane); ld_f32_row(shv, sh, lane);
#pragma unroll
    for (int i = 0; i < 16; ++i) h[i] = x[i] * r * gv[i] * (1.0f + scv[i]) + shv[i];
    if (dst) st_bf16_row(h, dst, lane);
}
__device__ __forceinline__ void norm_mod(const float (&x)[16], const float (&g1s)[16], const float (&shv)[16], float (&h)[16]) {
    const float r = row_rstd(x);
#pragma unroll
    for (int i = 0; i < 16; ++i) h[i] = x[i] * r * g1s[i] + shv[i];
}
__device__ __forceinline__ void ld_g1s(float (&g1s)[16], const float* g, const float* sc, int lane) { float a[16], b[16]; ld_f32_row(a, g, lane); ld_f32_row(b, sc, lane);
#pragma unroll
    for (int i = 0; i < 16; ++i) g1s[i] = a[i] * (1.0f + b[i]); }
__device__ __forceinline__ void phase_prenorm0(Frame& F) {
    REFRESH(F);
    const int rpw = M / (NWG * 8); bf16* HB = (bf16*)(F.ws + WS_HB); ArgsP A = args_ptr(); const float* x_in = INP(A, I_X); const float* mix_pre_g = INP(A, I_MIXPRE);
    const int m0 = (F.vcu * 8 + F.wave) * rpw, b = m0 >> 11;
    float g1s[16], shv[16]; ld_g1s(g1s, mix_pre_g, mod_ptr(F, 0, b, 1), F.lane); ld_f32_row(shv, mod_ptr(F, 0, b, 0), F.lane);
    RawF32 cur = ldraw(x_in + (size_t)m0 * D, F.lane);
    for (int k = 0; k < rpw; ++k) { const int m = m0 + k;
        RawF32 nxt = cur; if (k + 1 < rpw) nxt = ldraw(x_in + (size_t)(m + 1) * D, F.lane);
        float x[16], h[16]; cvt_row(x, cur); norm_mod(x, g1s, shv, h); st_bf16_row(h, HB + (size_t)m * D, F.lane); cur = nxt; }
}
__device__ __forceinline__ void phase_postmix(Frame& F, int layer, bool moe) {
    REFRESH(F);
    const int rpw = M / (NWG * 8); bf16* HB = (bf16*)(F.ws + WS_HB); const bf16* Y = (const bf16*)(F.ws + WS_Y);
    ArgsP A = args_ptr(); const float* xsrc = INP(A, I_X); bf16* XB = (bf16*)(F.ws + WS_XB);
    const float* mix_post_g = INP(A, I_MIXPOST); const float* ffn_pre_g = INP(A, I_FFNPRE); const float* router_w = INP(A, I_ROUTW); const float* router_b = INP(A, I_ROUTB);
    LAS int* lcnt = (LAS int*)(F.lds + LDSX_OFF + 256);
    LAS int* lbase = lcnt + 8; LAS int* rinfo = lcnt + 16;
    if (moe) { if (F.tid < 16) lcnt[F.tid] = 0; __syncthreads(); }
    const int m0 = F.vcu * 8 * rpw + F.wave * rpw, b = m0 >> 11;
    float gpg[16], g1s[16], shv[16];
    { float a[16], c[16]; ld_f32_row(a, mix_post_g + layer * D, F.lane); ld_f32_row(c, mod_ptr(F, layer, b, 2), F.lane);
#pragma unroll
      for (int i = 0; i < 16; ++i) gpg[i] = a[i] * c[i]; }
    ld_g1s(g1s, ffn_pre_g + layer * D, mod_ptr(F, layer, b, 4), F.lane); ld_f32_row(shv, mod_ptr(F, layer, b, 3), F.lane);
    RawF32 xf = {}; RawB16 xb = {};
    if (layer == 0) xf = ldraw(xsrc + (size_t)m0 * D, F.lane); else xb = ldraw(XB + (size_t)m0 * D, F.lane);
    RawB16 yr = ldraw(Y + (size_t)m0 * D, F.lane);
    for (int k = 0; k < rpw; ++k) { const int rl = F.wave * rpw + k, m = m0 + k;
        RawF32 xfn = xf; RawB16 xbn = xb, yn = yr;
        if (k + 1 < rpw) { if (layer == 0) xfn = ldraw(xsrc + (size_t)(m + 1) * D, F.lane); else xbn = ldraw(XB + (size_t)(m + 1) * D, F.lane); yn = ldraw(Y + (size_t)(m + 1) * D, F.lane); }
        float x[16], y[16], h[16];
        if (layer == 0) cvt_row(x, xf); else cvt_row(x, xb);
        cvt_row(y, yr);
        const float ry = row_rstd(y);
#pragma unroll
        for (int i = 0; i < 16; ++i) x[i] += gpg[i] * (y[i] * ry);
        st_bf16_row(x, XB + (size_t)m * D, F.lane);
        norm_mod(x, g1s, shv, h);
        if (!moe) { unsigned* h8 = (unsigned*)(F.ws + WS_HB + (size_t)m * D);
#pragma unroll
            for (int j = 0; j < 4; ++j) h8[F.lane + 64 * j] = pk4_fp8(h[4 * j], h[4 * j + 1], h[4 * j + 2], h[4 * j + 3]); }
        xf = xfn; xb = xbn; yr = yn;
        if (moe) {
            { unsigned* h8 = (unsigned*)(F.ws + WS_HB + (size_t)m * D);
#pragma unroll
              for (int j = 0; j < 4; ++j) h8[F.lane + 64 * j] = pk4_fp8(h[4 * j], h[4 * j + 1], h[4 * j + 2], h[4 * j + 3]); }
            float lg[8];
#pragma unroll
            for (int e = 0; e < 8; ++e) lg[e] = 0.f;
#pragma unroll
            for (int j = 0; j < 4; ++j)
#pragma unroll
                for (int e4 = 0; e4 < 4; ++e4) { const float* rw = router_w + (size_t)(256 * j + 4 * F.lane + e4) * 8; const f32x4 w0 = *(const f32x4*)rw, w1 = *(const f32x4*)(rw + 4); const float hv = h[4 * j + e4];
                    lg[0] += hv * w0[0]; lg[1] += hv * w0[1]; lg[2] += hv * w0[2]; lg[3] += hv * w0[3]; lg[4] += hv * w1[0]; lg[5] += hv * w1[1]; lg[6] += hv * w1[2]; lg[7] += hv * w1[3]; }
#pragma unroll
            for (int e = 0; e < 8; ++e) lg[e] = wave_sum(lg[e]) + router_b[e];
            int e0 = 0; float l0 = lg[0];
#pragma unroll
            for (int e = 1; e < 8; ++e) if (lg[e] > l0) { l0 = lg[e]; e0 = e; }
            int e1 = -1; float l1 = -INFINITY;
#pragma unroll
            for (int e = 0; e < 8; ++e) if (e != e0 && lg[e] > l1) { l1 = lg[e]; e1 = e; }
            if (F.lane == 0) {
                const float g0 = fast_rcp(1.0f + __expf(l1 - l0));
                const int p0 = atomicAdd((int*)(lcnt + e0), 1), p1 = atomicAdd((int*)(lcnt + e1), 1);
                rinfo[rl * 4 + 0] = e0; rinfo[rl * 4 + 1] = e1; rinfo[rl * 4 + 2] = p0; rinfo[rl * 4 + 3] = p1;
                float* RTG = (float*)(F.ws + WS_RTG); RTG[2 * m] = g0; RTG[2 * m + 1] = 1.0f - g0;
            }
        }
    }
    if (moe) {
        __syncthreads();
        if (F.tid < 8) lbase[F.tid] = (int)__hip_atomic_fetch_add(F.ctl + CW_CNT + F.tid, (unsigned)lcnt[F.tid], __ATOMIC_RELAXED, __HIP_MEMORY_SCOPE_AGENT);
        __syncthreads();
        const int nrows = 8 * rpw;
        int* RTE = (int*)(F.ws + WS_RTE); int* RTP = (int*)(F.ws + WS_RTP);
        for (int rl = F.tid; rl < nrows; rl += 512) { const int m = F.vcu * nrows + rl; const int e0 = rinfo[rl * 4], e1 = rinfo[rl * 4 + 1];
            RTE[2 * m] = e0; RTE[2 * m + 1] = e1; RTP[2 * m] = lbase[e0] + rinfo[rl * 4 + 2]; RTP[2 * m + 1] = lbase[e1] + rinfo[rl * 4 + 3]; }
    }
}
__device__ __forceinline__ void moe_tiles(const Frame& F, int (&ts)[9], int (&cnt)[8]) {
    const u32x4 c0 = *(const u32x4*)(F.ctl + CW_CNT), c1 = *(const u32x4*)(F.ctl + CW_CNT + 4);
    const unsigned cv[8] = {c0.x, c0.y, c0.z, c0.w, c1.x, c1.y, c1.z, c1.w};
    int acc = 0;
#pragma unroll
    for (int e = 0; e < 8; ++e) { cnt[e] = __builtin_amdgcn_readfirstlane((int)cv[e]); ts[e] = acc; acc += (cnt[e] + 255) >> 8; }
    ts[8] = acc;
}
__device__ __forceinline__ void phase_moe_index(Frame& F) {
    REFRESH(F);
    int ts[9], cnt[8]; moe_tiles(F, ts, cnt);
    int* S2T = (int*)(F.ws + WS_S2T); const int* RTE = (const int*)(F.ws + WS_RTE); const int* RTP = (const int*)(F.ws + WS_RTP);
    const int gt = F.vcu * 512 + F.tid, NT = NWG * 512;
    for (int s = gt; s < ts[8] * 256; s += NT) { const int tile = s >> 8; int e = 0;
#pragma unroll
        for (int k = 1; k < 8; ++k) e += (tile >= ts[k]) ? 1 : 0;
        int c = 0, t0 = 0;
#pragma unroll
        for (int k = 0; k < 8; ++k) { c = (k == e) ? cnt[k] : c; t0 = (k == e) ? ts[k] : t0; }
        if (s - 256 * t0 >= c) S2T[((s >> 8) * 64 + (s & 63)) * 4 + ((s >> 6) & 3)] = 0; }
    for (int a = gt; a < 2 * M; a += NT) { const int e = RTE[a]; int t0 = 0;
#pragma unroll
        for (int k = 0; k < 8; ++k) t0 = (k == e) ? ts[k] : t0;
        { const int sl = 256 * t0 + RTP[a]; S2T[((sl >> 8) * 64 + (sl & 63)) * 4 + ((sl >> 6) & 3)] = a >> 1; } }
}
__device__ __forceinline__ void phase_postffn(Frame& F, int layer, bool moe) {
    REFRESH(F);
    const int rpw = M / (NWG * 8); bf16* HB = (bf16*)(F.ws + WS_HB); bf16* XB = (bf16*)(F.ws + WS_XB);
    int ts[9], cnt[8]; if (moe) moe_tiles(F, ts, cnt);
    ArgsP A = args_ptr(); const float* ffn_post_g = INP(A, I_FFNPOST); const float* mix_pre_g = INP(A, I_MIXPRE);
    const int* RTE = (const int*)(F.ws + WS_RTE); const int* RTP = (const int*)(F.ws + WS_RTP); const float* RTG = (const float*)(F.ws + WS_RTG); const bf16* YS = (const bf16*)(F.ws + WS_YS);
    const int m0 = (F.vcu * 8 + F.wave) * rpw, b = m0 >> 11;
    float gpg[16], g1s[16], shv[16];
    { float a[16], c[16]; ld_f32_row(a, ffn_post_g + layer * D, F.lane); ld_f32_row(c, mod_ptr(F, layer, b, 5), F.lane);
#pragma unroll
      for (int i = 0; i < 16; ++i) gpg[i] = a[i] * c[i]; }
    if (layer == 0) { ld_g1s(g1s, mix_pre_g + D, mod_ptr(F, 1, b, 1), F.lane); ld_f32_row(shv, mod_ptr(F, 1, b, 0), F.lane); }
#define PF_LOAD(mm, XR, YA, YB, G0, G1) do { XR = ldraw(XB + (size_t)(mm) * D, F.lane); \
        if (moe) { const int e0_ = RTE[2 * (mm)], e1_ = RTE[2 * (mm) + 1]; int t0_ = 0, t1_ = 0; \
            _Pragma("unroll") for (int q = 0; q < 8; ++q) { t0_ = (q == e0_) ? ts[q] : t0_; t1_ = (q == e1_) ? ts[q] : t1_; } \
            const size_t s0_ = (size_t)256 * t0_ + RTP[2 * (mm)], s1_ = (size_t)256 * t1_ + RTP[2 * (mm) + 1]; G0 = RTG[2 * (mm)]; G1 = RTG[2 * (mm) + 1]; \
            YA = ldraw(YS + s0_ * D, F.lane); YB = ldraw(YS + s1_ * D, F.lane); } \
        else YA = ldraw(HB + (size_t)(mm) * D, F.lane); } while (0)
    RawB16 xr, ya, yb = {}; float g0 = 0.f, g1 = 0.f;
    PF_LOAD(m0, xr, ya, yb, g0, g1);
    for (int k = 0; k < rpw; ++k) { const int m = m0 + k;
        RawB16 xn = xr, yan = ya, ybn = yb; float g0n = g0, g1n = g1;
        if (k + 1 < rpw) PF_LOAD(m + 1, xn, yan, ybn, g0n, g1n);
        float x[16], y[16], h[16];
        cvt_row(x, xr); cvt_row(y, ya);
        if (moe) { float y2[16]; cvt_row(y2, yb);
#pragma unroll
            for (int i = 0; i < 16; ++i) y[i] = g0 * y[i] + g1 * y2[i]; }
        const float ry = row_rstd(y);
#pragma unroll
        for (int i = 0; i < 16; ++i) x[i] += gpg[i] * (y[i] * ry);
        if (layer == 0) { st_bf16_row(x, XB + (size_t)m * D, F.lane); norm_mod(x, g1s, shv, h); st_bf16_row(h, HB + (size_t)m * D, F.lane); }
        else st_f32_row(x, F.out + (size_t)m * D, F.lane);
        xr = xn; ya = yan; yb = ybn; g0 = g0n; g1 = g1n;
    }
#undef PF_LOAD
}
__device__ __forceinline__ void phase_mixnorm(Frame& F, int layer) {
    REFRESH(F);
    const int rpw = M / (NWG * 8); bf16* MIXN = (bf16*)(F.ws + WS_HB);
    const bf16* OA = (const bf16*)(F.ws + WS_OA); const bf16* OC = (const bf16*)(F.ws + WS_OC); const bf16* OD = (const bf16*)(F.ws + WS_OD);
    const bf16* DIL = (const bf16*)(F.ws + WS_DIL); const float* LSE = (const float*)(F.ws + WS_LSE);
    const int lane = F.lane, hh = lane >> 4; ArgsP A = args_ptr(); const float* group_g = INP(A, I_GROUPG);
    f32x4 gg[4];
#pragma unroll
    for (int g = 0; g < 4; ++g) gg[g] = *(const f32x4*)(group_g + (size_t)(layer * 4 + g) * 256 + 4 * lane);
    struct Raw { u32x2 oa, d0, d1, d2, oc, od; float l0, l1, l2; };
#define MN_LOAD(R, mm) do { const size_t m_ = (mm); R.oa = ((const u32x2*)(OA + m_ * 256))[lane]; R.oc = ((const u32x2*)(OC + m_ * 256))[lane]; R.od = ((const u32x2*)(OD + m_ * 256))[lane]; \
        R.d0 = ((const u32x2*)(DIL + m_ * 256))[lane]; R.d1 = ((const u32x2*)(DIL + ((size_t)M + m_) * 256))[lane]; R.d2 = ((const u32x2*)(DIL + ((size_t)2 * M + m_) * 256))[lane]; \
        R.l0 = LSE[m_ * 4 + hh]; R.l1 = LSE[((size_t)M + m_) * 4 + hh]; R.l2 = LSE[((size_t)2 * M + m_) * 4 + hh]; } while (0)
    const size_t m0 = (size_t)(F.vcu * 8 + F.wave) * rpw;
    Raw cur; MN_LOAD(cur, m0);
    for (int k = 0; k < rpw; ++k) { const size_t m = m0 + k;
        Raw nxt = cur; if (k + 1 < rpw) MN_LOAD(nxt, m + 1);
        float v[4][4];
        v[0][0] = bflo(cur.oa.x); v[0][1] = bfhi(cur.oa.x); v[0][2] = bflo(cur.oa.y); v[0][3] = bfhi(cur.oa.y);
        { const float mx = fmaxf(cur.l0, fmaxf(cur.l1, cur.l2)); float w0 = fast_exp2(cur.l0 - mx), w1 = fast_exp2(cur.l1 - mx), w2 = fast_exp2(cur.l2 - mx); const float inv = fast_rcp(w0 + w1 + w2); w0 *= inv; w1 *= inv; w2 *= inv;
          v[1][0] = w0 * bflo(cur.d0.x) + w1 * bflo(cur.d1.x) + w2 * bflo(cur.d2.x); v[1][1] = w0 * bfhi(cur.d0.x) + w1 * bfhi(cur.d1.x) + w2 * bfhi(cur.d2.x);
          v[1][2] = w0 * bflo(cur.d0.y) + w1 * bflo(cur.d1.y) + w2 * bflo(cur.d2.y); v[1][3] = w0 * bfhi(cur.d0.y) + w1 * bfhi(cur.d1.y) + w2 * bfhi(cur.d2.y); }
        v[2][0] = bflo(cur.oc.x); v[2][1] = bfhi(cur.oc.x); v[2][2] = bflo(cur.oc.y); v[2][3] = bfhi(cur.oc.y);
        v[3][0] = bflo(cur.od.x); v[3][1] = bfhi(cur.od.x); v[3][2] = bflo(cur.od.y); v[3][3] = bfhi(cur.od.y);
#pragma unroll
        for (int g = 0; g < 4; ++g) {
            const float ss = wave_sum(v[g][0] * v[g][0] + v[g][1] * v[g][1] + v[g][2] * v[g][2] + v[g][3] * v[g][3]);
            const float r = __builtin_amdgcn_rsqf(ss * (1.0f / 256.0f) + EPS);
            u32x2 t; t.x = cvtpk(v[g][0] * r * gg[g][0], v[g][1] * r * gg[g][1]); t.y = cvtpk(v[g][2] * r * gg[g][2], v[g][3] * r * gg[g][3]);
            ((u32x2*)(MIXN + m * D + 256 * g))[lane] = t; }
        cur = nxt;
    }
#undef MN_LOAD
}

__device__ __forceinline__ void gmlp_unit(Frame& F, int layer, int b, int ch) {
    const bf16* P = (const bf16*)(F.ws + WS_P); bf16* OC = (bf16*)(F.ws + WS_OC);
    const size_t R0 = (size_t)b * SEQ + 128 * ch;
    LAS bf16* VT = (LAS bf16*)F.lds;
    const int lane = F.lane, w = F.wave;
    u32x2 raw[16];
#pragma unroll
    for (int k = 0; k < 16; ++k) raw[k] = ((const u32x2*)(P + (R0 + 16 * w + k) * PW + P_GV))[lane];
#pragma unroll
    for (int k = 0; k < 16; ++k) { const int s = 16 * w + k; const u32x2 t = raw[k];
        float v0 = bflo(t.x), v1 = bfhi(t.x), v2 = bflo(t.y), v3 = bfhi(t.y);
        const float s1 = wave_sum((v0 + v1) + (v2 + v3)), s2 = wave_sum((v0 * v0 + v1 * v1) + (v2 * v2 + v3 * v3));
        const float mean = s1 * (1.0f / 256.0f), var = fmaxf(s2 * (1.0f / 256.0f) - mean * mean, 0.f);
        const float rstd = __builtin_amdgcn_rsqf(var + EPS);
        v0 -= mean; v1 -= mean; v2 -= mean; v3 -= mean;
        const unsigned p0 = cvtpk(v0 * rstd, v1 * rstd), p1 = cvtpk(v2 * rstd, v3 * rstd);
        VT[(4 * lane + 0) * 136 + s] = (bf16)(p0 & 0xffffu); VT[(4 * lane + 1) * 136 + s] = (bf16)(p0 >> 16);
        VT[(4 * lane + 2) * 136 + s] = (bf16)(p1 & 0xffffu); VT[(4 * lane + 3) * 136 + s] = (bf16)(p1 >> 16); }
    __syncthreads();
    const int g = w >> 1, cb = 64 * g + 32 * (w & 1), r = lane & 31, h = lane >> 5;
    ArgsP A = args_ptr();
    const float* W = INP(A, I_GMLPW) + (size_t)(layer * 4 + g) * 128 * 128;
    const float* bias = INP(A, I_GMLPB) + (size_t)(layer * 4 + g) * 128;
#pragma unroll
    for (int tt = 0; tt < 4; ++tt) {
        f32x16 acc;
#pragma unroll
        for (int i = 0; i < 16; ++i) acc[i] = 0.f;
        const int t = 32 * tt + r;
        float ub[16], bb[16];
#pragma unroll
        for (int i = 0; i < 16; ++i) { const int to = 32 * tt + crow(i, h); ub[i] = bf2f(P[(R0 + to) * PW + P_GU + cb + r]); bb[i] = bias[to]; }
        f32x4 wa[8], wc[8];
#pragma unroll
        for (int ks = 0; ks < 2 * (tt + 1); ++ks) { const int s0 = 16 * ks + 8 * h; wa[ks] = *(const f32x4*)(W + (size_t)t * 128 + s0); wc[ks] = *(const f32x4*)(W + (size_t)t * 128 + s0 + 4); }
#pragma unroll
        for (int ks = 0; ks < 2 * (tt + 1); ++ks) {
            const int s0 = 16 * ks + 8 * h;
            float v[8] = {wa[ks][0], wa[ks][1], wa[ks][2], wa[ks][3], wc[ks][0], wc[ks][1], wc[ks][2], wc[ks][3]};
#pragma unroll
            for (int e = 0; e < 8; ++e) v[e] = (s0 + e <= t) ? v[e] : 0.f;
            u32x4 aw; aw.x = cvtpk(v[0], v[1]); aw.y = cvtpk(v[2], v[3]); aw.z = cvtpk(v[4], v[5]); aw.w = cvtpk(v[6], v[7]);
            const bf16x8 bfrag = *(const LAS bf16x8*)(VT + (cb + r) * 136 + s0);
            acc = MFMA32(__builtin_bit_cast(bf16x8, aw), bfrag, acc);
        }
#pragma unroll
        for (int i = 0; i < 16; ++i) { const int to = 32 * tt + crow(i, h); const float z = acc[i] + bb[i];
            OC[(R0 + to) * 256 + cb + r] = (bf16)(cvtpk(ub[i] * z, 0.f) & 0xffffu); }
    }
    __syncthreads();
}
__device__ __forceinline__ void conv_unit(Frame& F, int layer, int b, int ch) {
    const bf16* P = (const bf16*)(F.ws + WS_P); bf16* OD = (bf16*)(F.ws + WS_OD);
    const int t0 = 64 * ch; const size_t Rb = (size_t)b * SEQ;
    LAS bf16* XT = (LAS bf16*)F.lds;
    LAS float* YT = (LAS float*)(F.lds + 48128);
    for (int id = F.tid; id < 94 * 32; id += 512) { const int row = id >> 5, piece = id & 31, t = t0 - 30 + row;
        u32x4 v = (u32x4){0u, 0u, 0u, 0u};
        if (t >= 0) v = *(const u32x4*)(P + (Rb + t) * PW + P_GLU + 8 * piece);
        *(LAS u32x4*)(XT + row * 256 + 8 * piece) = v; }
    __syncthreads();
    ArgsP A = args_ptr();
    { const int c = F.tid & 255, half = F.tid >> 8; const float* conv_w = INP(A, I_CONVW);
      float wk[31];
#pragma unroll
      for (int k = 0; k < 31; ++k) wk[k] = conv_w[(size_t)(layer * 31 + k) * 256 + c];
      const float cb = INP(A, I_CONVB)[layer * 256 + c];
      float xs[62];
#pragma unroll
      for (int i = 0; i < 62; ++i) xs[i] = bf2f(XT[(32 * half + i) * 256 + c]);
#pragma unroll
      for (int j = 0; j < 32; ++j) { float y = cb;
#pragma unroll
          for (int k = 0; k < 31; ++k) y += wk[k] * xs[j + k];
          YT[(32 * half + j) * 260 + c] = y; } }
    __syncthreads();
    { const int lane = F.lane;
      const f32x4 lg = *(const f32x4*)(INP(A, I_CONVLNG) + layer * 256 + 4 * lane), lb = *(const f32x4*)(INP(A, I_CONVLNB) + layer * 256 + 4 * lane);
      for (int k = 0; k < 8; ++k) { const int t = 8 * F.wave + k;
          f32x4 y = *(const LAS f32x4*)(YT + t * 260 + 4 * lane);
          const float mean = wave_sum((y[0] + y[1]) + (y[2] + y[3])) * (1.0f / 256.0f);
          y = y - mean;
          const float rstd = __builtin_amdgcn_rsqf(wave_sum((y[0] * y[0] + y[1] * y[1]) + (y[2] * y[2] + y[3] * y[3])) * (1.0f / 256.0f) + EPS);
          float o[4];
#pragma unroll
          for (int e = 0; e < 4; ++e) o[e] = siluf_(y[e] * rstd * lg[e] + lb[e]);
          u32x2 w; w.x = cvtpk(o[0], o[1]); w.y = cvtpk(o[2], o[3]);
          ((u32x2*)(OD + (Rb + t0 + t) * 256))[lane] = w; } }
    __syncthreads();
}
__device__ __forceinline__ void phase_mixers(Frame& F, int layer) {
    REFRESH(F);
    __syncthreads();
    const bf16* P = (const bf16*)(F.ws + WS_P);
    const float* kms = (const float*)(F.ctl + CW_KM) + (size_t)layer * 32768;
    for (int rq = (REPK == 16 ? 2 : 1); rq > 0; --rq)
    for (int u = F.vcu; u < 256; u += NWG) { const int bh = u >> 2, sq = u & 3; const attn_body::bf16* Pq = (const attn_body::bf16*)P;
        for (int k2 = 0; k2 < 2; ++k2)
            attn_body::attn_unit<8>(F.tid, bh >> 2, bh & 3, k2 ? 7 - sq : sq, Pq + P_QA, Pq + P_KA, Pq + P_VA, (attn_body::bf16*)(F.ws + WS_OA), kms, (char*)F.lds); }
    REFRESH(F);
    for (int rq = (REPK == 17 ? 2 : 1); rq > 0; --rq)
    for (int u = F.vcu; u < 256; u += NWG) gmlp_unit(F, layer, u >> 4, u & 15);
    REFRESH(F);
    for (int rq = (REPK == 18 ? 2 : 1); rq > 0; --rq)
    for (int u = F.vcu; u < 512; u += NWG) conv_unit(F, layer, u >> 5, u & 31);
    REFRESH(F);
    LAS char* vt = (LAS char*)(F.lds + F.wave * ATT_WAVE_LDS);
    const int gw = F.vcu * 8 + F.wave, NGW = NWG * 8;
    const int cv_static = layer == 0 ? 4 : 3;
    ArgsP Acv = args_ptr(); int cvk = 0;
    for (int rq = (REPK == 19 ? 2 : 1); rq > 0; --rq)
    for (int it = gw; it < 3 * 2048; it += NGW) { const int cfg = it >> 11, rem = it & 2047, bh = rem >> 5, idx = rem & 31;
        dil_pair_item(P, (bf16*)(F.ws + WS_DIL) + (size_t)cfg * M * 256, (float*)(F.ws + WS_LSE) + (size_t)cfg * M * 4, cfg, bh >> 2, bh & 3, idx, vt, F.lane);
        for (int q = 0; q < 5; ++q, ++cvk) { const int ci = cvk * NGW + gw; if (cvk < cv_static && ci < def_items(layer)) def_conv_item(F, Acv, layer, ci, (LAS float*)vt); } }
    { const int q8 = (int)blockIdx.x & 7, pool0 = cv_static * NGW, pool = def_items(layer) - pool0, per = (pool + 7) >> 3;
      unsigned* head = F.ctl + CW_DQ + 1024 * layer + 64 * q8;
      for (;;) { unsigned c = 0; if (F.lane == 0) c = __hip_atomic_fetch_add(head, 1u, __ATOMIC_RELAXED, __HIP_MEMORY_SCOPE_AGENT);
          const int ci_l = __builtin_amdgcn_readfirstlane((int)c);
          if (ci_l >= per) break;
          const int ci = pool0 + q8 * per + ci_l;
          if (ci < def_items(layer)) def_conv_item(F, Acv, layer, ci, (LAS float*)vt); } }
}

constexpr int PH_PROLOGUE = 0, PH_PRENORM = 1, PH_L0 = 2, PH_L1 = 10, PH_MOE_INDEX = 15, PH_MOE_CHUNK0 = 16, PH_MOE_COMBINE = 26, PH_POSTFFN1 = 27, N_PHASES = 28;
constexpr int KSPLIT = 7, KS_BYTES = FFE / KSPLIT;
#ifndef KMASK
#define KMASK 0xFFFF
#endif
#define KON(b) (((KMASK) >> (b)) & 1)
#define NREP(b) (((REPK) == (b)) ? nrep2 : 1)
#if MK_ONE_LAUNCH
#define IN(k) true
#else
#define IN(k) (lo <= (k) && (k) < hi)
#endif
#define SEAM(k) do { if (IN(k) && IN((k) + 1)) { xcd_barrier(bar, F.wave0 * 64 + lane_id()); if (REPK == 20) xcd_barrier(bar, F.wave0 * 64 + lane_id()); \
    if (TSA >= 0) { if (blockIdx.x == 0 && F.wave0 == 0 && lane_id() == 0) __hip_atomic_store((unsigned long long*)(F.ctl + CW_TS) + (k) + 1, (unsigned long long)__builtin_amdgcn_s_memrealtime(), __ATOMIC_RELAXED, __HIP_MEMORY_SCOPE_AGENT); } } } while (0)

template <int LAYER>
__device__ __forceinline__ void run_layer(Frame& F, const XcdBarrier& bar, const int* posp, const int lo, const int hi, const int nrep2) {
        constexpr int layer = LAYER; constexpr int pb = LAYER == 0 ? PH_L0 : PH_L1;
        if (KON(2) && IN(pb)) for (int rp = NREP(2); rp > 0; --rp) {
            REFRESH(F);
            pg8::SchedPlain S; S.init(M / 256, NIN / 256, NWG, (int)blockIdx.x); S.dup = (REPK == 25); S.Bt = (const char*)(F.ws + WS_WIN) + (size_t)layer * NIN * 1024 * 2; S.tstep = (size_t)256 * 1024 * 2;
            EpiInProj E{(bf16*)(F.ws + WS_P), posp, (float*)(F.ctl + CW_KM) + (size_t)layer * 32768};
            pg8::gemm_phase(F.lds, F.wave0, (const char*)(F.ws + WS_HB), 2 * 1024, S, E);
        }
        SEAM(pb);
        if (KON(3) && IN(pb + 1)) for (int rp = NREP(3); rp > 0; --rp) phase_mixers(F, layer);
        SEAM(pb + 1);
        if (KON(4) && IN(pb + 2)) for (int rp = NREP(4); rp > 0; --rp) phase_mixnorm(F, layer);
        SEAM(pb + 2);
        if (KON(5) && IN(pb + 3)) for (int rp = NREP(5); rp > 0; --rp) {
            REFRESH(F);
            pg8::SchedPlain S; S.init(M / 256, 4, NWG, (int)blockIdx.x); S.Bt = (const char*)(F.ws + WS_WOUT) + (size_t)layer * 1024 * 1024 * 2; S.tstep = (size_t)256 * 1024 * 2;
            EpiPlain E{(bf16*)(F.ws + WS_Y), 1024, 0};
            pg8::gemm_phase(F.lds, F.wave0, (const char*)(F.ws + WS_HB), 2 * 1024, S, E);
        }
        SEAM(pb + 3);
        if (KON(6) && IN(pb + 4)) for (int rp = (layer == 0 ? NREP(6) : 1); rp > 0; --rp) phase_postmix(F, layer, layer == 1);
        SEAM(pb + 4);
        if constexpr (LAYER == 0) {
            if (KON(7) && IN(pb + 5)) for (int rp = NREP(7); rp > 0; --rp) {
                REFRESH(F);
                pg8::SchedPlain S; S.init(M / 256, 2 * FFD / 256, NWG, (int)blockIdx.x); S.dup = (REPK == 24); S.Bt = (const char*)(F.ws + WS_WFGU); S.tstep = (size_t)256 * 1024;
                EpiSwiGLU E{(bf16*)(F.ws + WS_FH), FFD};
                pg8::gemm_phase<EpiSwiGLU, pg8::SchedPlain, true>(F.lds, F.wave0, (const char*)(F.ws + WS_HB), 1024, S, E, E8_WGU, E8_ONE);
            }
            SEAM(pb + 5);
            if (KON(8) && IN(pb + 6)) for (int rp = NREP(8); rp > 0; --rp) {
                REFRESH(F);
                pg8::SchedPlain S; S.init(M / 256, 4, NWG, (int)blockIdx.x); S.Bt = (const char*)(F.ws + WS_WFD); S.tstep = (size_t)256 * FFD * 2;
                EpiPlain E{(bf16*)(F.ws + WS_HB), 1024, 0};
                pg8::gemm_phase(F.lds, F.wave0, (const char*)(F.ws + WS_FH), 2 * FFD, S, E);
            }
            SEAM(pb + 6);
            if (KON(9) && IN(pb + 7)) phase_postffn(F, 0, false);
            SEAM(pb + 7);
        } else {
            if (KON(10) && IN(PH_MOE_INDEX)) for (int rp = NREP(10); rp > 0; --rp) phase_moe_index(F);
            SEAM(PH_MOE_INDEX);
            for (int rp14 = NREP(14); rp14 > 0; --rp14)
            for (int c = 0; c < NCHUNK; ++c) {
                const int pg = PH_MOE_CHUNK0 + 2 * c;
                if (IN(pg) || IN(pg + 1)) {
                    REFRESH(F);
                    int ts[9], cnt[8]; moe_tiles(F, ts, cnt);
                    const int tile0 = CHUNK_TILES * c; int nt = ts[8] - tile0; nt = nt > CHUNK_TILES ? CHUNK_TILES : nt;
                    if (KON(11) && IN(pg) && nt > 0) for (int rp = NREP(11); rp > 0; --rp) {
                        pg8::SchedMoe<true> S; S.init(nt, 2 * FFE / 256, NWG, (int)blockIdx.x); S.Bt = (const char*)(F.ws + WS_WMGU); S.tstep = (size_t)256 * 1024; S.estride = (size_t)2 * FFE * 1024;
                        S.tile0 = tile0; S.s2t = (const int*)(F.ws + WS_S2T); S.dup = (REPK == 22); S.ksb = 0;
#pragma unroll
                        for (int k = 0; k < 7; ++k) S.ts[k] = ts[k + 1];
                        { LAS int* tab = (LAS int*)(F.lds + LDSX_OFF + 1024); S.tab = tab;
                          pg8::StaticOrder so; so.init(nt, 2 * FFE / 256, NWG, (int)blockIdx.x); const int* s2t = (const int*)(F.ws + WS_S2T);
                          int tv[8];
#pragma unroll
                          for (int i = 0; i < 8; ++i) { pg8::Unit u; const bool ok = so.next(i, u); tv[i] = (ok && F.tid < 256) ? s2t[(size_t)(tile0 + u.pm) * 256 + F.tid] : 0; }
#pragma unroll
                          for (int i = 0; i < 8; ++i) if (F.tid < 256) tab[i * 256 + F.tid] = tv[i];
                          __syncthreads(); }
                        EpiSwiGLU8 E{F.ws + WS_HID + (size_t)(c & 1) * HID_BYTES, FFE};
                        pg8::gemm_phase<EpiSwiGLU8, pg8::SchedMoe<true>, true>(F.lds, F.wave0, (const char*)(F.ws + WS_HB), 1024, S, E, E8_WGU, E8_ONE);
                    }
                    SEAM(pg);
                    if (KON(12) && IN(pg + 1) && nt > 0) for (int rp = NREP(12); rp > 0; --rp) {
                        const bool ksp = (c == NCHUNK - 1);
                        pg8::SchedMoe<false> S; S.init(nt, ksp ? 4 * KSPLIT : 4, NWG, (int)blockIdx.x); S.Bt = (const char*)(F.ws + WS_WMD); S.tstep = (size_t)256 * FFE; S.estride = (size_t)1024 * FFE;
                        S.tile0 = tile0; S.s2t = nullptr; S.tab = nullptr; S.dup = (REPK == 23); S.ksb = ksp ? KS_BYTES : 0;
#pragma unroll
                        for (int k = 0; k < 7; ++k) S.ts[k] = ts[k + 1];
                        EpiPlain E{ksp ? (bf16*)(F.ws + WS_HID + (size_t)((c & 1) ^ 1) * HID_BYTES) : (bf16*)(F.ws + WS_YS), 1024, ksp ? 0 : tile0 * 256, ksp ? (size_t)8 * 256 * 1024 : 0};
                        pg8::gemm_phase<EpiPlain, pg8::SchedMoe<false>, true>(F.lds, F.wave0, (const char*)(F.ws + WS_HID + (size_t)(c & 1) * HID_BYTES), FFE, S, E, E8_WD, E8_HID, ksp ? KS_BYTES / 128 : 0);
                    }
                    if (c == NCHUNK - 1 || !(MK_ONE_LAUNCH)) SEAM(pg + 1);
                }
            }
            if (IN(PH_MOE_COMBINE)) {
                REFRESH(F);
                int ts[9], cnt[8]; moe_tiles(F, ts, cnt);
                const int tile0 = CHUNK_TILES * (NCHUNK - 1), nrow = (ts[8] - tile0) * 256;
                const bf16* YP = (const bf16*)(F.ws + WS_HID + (size_t)(((NCHUNK - 1) & 1) ^ 1) * HID_BYTES); bf16* YS = (bf16*)(F.ws + WS_YS);
                for (int row = F.vcu * 8 + F.wave; row < nrow; row += NWG * 8) {
                    float a[16];
#pragma unroll
                    for (int i = 0; i < 16; ++i) a[i] = 0.f;
#pragma unroll
                    for (int p = 0; p < KSPLIT; ++p) { float v[16]; ld_bf16_row(v, YP + ((size_t)p * 8 * 256 + row) * 1024, F.lane);
#pragma unroll
                        for (int i = 0; i < 16; ++i) a[i] += v[i]; }
                    st_bf16_row(a, YS + ((size_t)tile0 * 256 + row) * 1024, F.lane);
                }
            }
            SEAM(PH_MOE_COMBINE);
            if (KON(13) && IN(PH_POSTFFN1)) phase_postffn(F, 1, true);
        }
}
__global__ void __launch_bounds__(512, 2) fwd_kernel(Args args) {
    extern __shared__ __attribute__((aligned(16))) unsigned char lds_raw[];
    Frame F;
    F.lds = (LAS unsigned char*)lds_raw;
    F.ws0 = args.ws; F.ws = args.ws; F.ctl = (unsigned*)(args.ws + WS_CTL); F.out = args.out;
    F.wave0 = __builtin_amdgcn_readfirstlane((int)threadIdx.x >> 6); REFRESH(F);
    { const int bx = blockIdx.x; F.vcu = (bx % 8) * (NWG / 8) + bx / 8; }
    volatile LAS unsigned* MISC = (volatile LAS unsigned*)(F.lds + LDSX_OFF);
    if (F.tid < 16) MISC[F.tid] = 0u;
    __syncthreads();
    const int lo = args.ph_lo, hi = args.ph_hi;
    int nrep2 = 2; asm volatile("" : "+s"(nrep2));
    const bool multi = MK_ONE_LAUNCH ? true : (hi - lo) > 1; (void)lo; (void)hi;
    XcdBarrier bar; bar.bar = F.ctl + CW_BAR; bar.x = 0; bar.st = nullptr;
    if (multi) bar = xcd_barrier_post(F.ctl + CW_BAR, MISC + 8, F.tid);
    if (KON(0) && IN(PH_PROLOGUE)) for (int rp = NREP(0); rp > 0; --rp) phase_prologue(F);
    SEAM(PH_PROLOGUE);
    if (KON(1) && IN(PH_PRENORM)) for (int rp = NREP(1); rp > 0; --rp) phase_prenorm0(F);
    SEAM(PH_PRENORM);
    if (TSA >= 0) { if (blockIdx.x == 0 && F.tid == 0) __hip_atomic_store((unsigned long long*)(F.ctl + CW_TS), (unsigned long long)__builtin_amdgcn_s_memrealtime(), __ATOMIC_RELAXED, __HIP_MEMORY_SCOPE_AGENT); }
    run_layer<0>(F, bar, (const int*)args.in[I_POS], lo, hi, nrep2);
    run_layer<1>(F, bar, (const int*)args.in[I_POS], lo, hi, nrep2);
    if (TSA >= 0) {
        REFRESH(F);
        if (blockIdx.x == 0 && F.tid == 0) __hip_atomic_store((unsigned long long*)(F.ctl + CW_TS) + N_PHASES, (unsigned long long)__builtin_amdgcn_s_memrealtime(), __ATOMIC_RELAXED, __HIP_MEMORY_SCOPE_AGENT);
        xcd_barrier(bar, F.tid);
        const unsigned long long ta = __hip_atomic_load((unsigned long long*)(F.ctl + CW_TS) + TSA, __ATOMIC_RELAXED, __HIP_MEMORY_SCOPE_AGENT), tb = __hip_atomic_load((unsigned long long*)(F.ctl + CW_TS) + TSB, __ATOMIC_RELAXED, __HIP_MEMORY_SCOPE_AGENT);
        const float e = sqrtf((float)(((long long)(tb - ta) + 400) / 800 * 8) * 1e-4f);
        const int rpw = M / (NWG * 8);
        for (int k = 0; k < rpw; ++k) { const int m = (F.vcu * 8 + F.wave) * rpw + k; float x[16]; ld_f32_row(x, F.out + (size_t)m * D, F.lane);
#pragma unroll
            for (int i = 0; i < 16; ++i) x[i] *= (1.0f + e);
            st_f32_row(x, F.out + (size_t)m * D, F.lane); }
    }
#undef IN
#undef SEAM
}

extern "C" void kernel_launch(void* const* d_in, const int* in_sizes, int n_in, void* d_out, int out_size, void* d_ws, size_t ws_size, hipStream_t stream) {
    static int grid = 0;
    if (grid == 0) {
        if (n_in != 26 || out_size != M * D || ws_size < WS_END) { fprintf(stderr, "kernel_launch: unexpected problem: n_in %d out %d ws %zu (need %zu)\n", n_in, out_size, ws_size, (size_t)WS_END); grid = -1; return; }
        int dev = 0, cus = 0, per_cu = 0;
        if (hipGetDevice(&dev) != hipSuccess || hipDeviceGetAttribute(&cus, hipDeviceAttributeMultiprocessorCount, dev) != hipSuccess) { grid = -1; return; }
        if (hipFuncSetAttribute((const void*)fwd_kernel, hipFuncAttributeMaxDynamicSharedMemorySize, LDS_BYTES) != hipSuccess) { fprintf(stderr, "kernel_launch: hipFuncSetAttribute failed\n"); grid = -1; return; }
        if (hipOccupancyMaxActiveBlocksPerMultiprocessor(&per_cu, (const void*)fwd_kernel, 512, LDS_BYTES) != hipSuccess || per_cu < 1) fprintf(stderr, "kernel_launch: occupancy query says %d\n", per_cu);
        (void)hipGetLastError();
        if (cus != NWG) { fprintf(stderr, "kernel_launch: built for a %d-CU device, found %d\n", NWG, cus); grid = -1; return; }
        grid = NWG;
        fprintf(stderr, "kernel_launch: grid %d, ws %zu\n", grid, ws_size);
    }
    if (grid < 0) return;
    (void)hipMemsetAsync((char*)d_ws + WS_CTL, 0, CTL_ZERO_BYTES, stream);
    Args a{};
    for (int i = 0; i < 26; ++i) a.in[i] = d_in[i];
    a.out = (float*)d_out; a.ws = (unsigned char*)d_ws;
#if MK_ONE_LAUNCH
    a.ph_lo = 0; a.ph_hi = N_PHASES;
    hipLaunchKernelGGL(fwd_kernel, dim3(grid), dim3(512), LDS_BYTES, stream, a);
#else
    for (int p = 0; p < N_PHASES; ++p) { a.ph_lo = p; a.ph_hi = p + 1; hipLaunchKernelGGL(fwd_kernel, dim3(grid), dim3(512), LDS_BYTES, stream, a); }
#endif
}
```

```cpp
#include <hip/hip_runtime.h>
#include <cstdio>
#include <cstdint>

#ifndef REPK
#define REPK -1
#endif
#ifndef TSA
#define TSA -1
#endif
#ifndef TSB
#define TSB -1
#endif
#ifndef MK_ONE_LAUNCH
#define MK_ONE_LAUNCH 1
#endif

#define GAS __attribute__((address_space(1)))
#define LAS __attribute__((address_space(3)))
typedef unsigned short bf16;
typedef short bf16x8 __attribute__((ext_vector_type(8)));
typedef float f32x4 __attribute__((ext_vector_type(4)));
typedef float f32x16 __attribute__((ext_vector_type(16)));
typedef unsigned u32x4 __attribute__((ext_vector_type(4)));
typedef unsigned u32x2 __attribute__((ext_vector_type(2)));
typedef float f32x2_t __attribute__((ext_vector_type(2)));
typedef __bf16 bf16x2_t __attribute__((ext_vector_type(2)));
typedef short v4i16_t __attribute__((ext_vector_type(4)));
typedef GAS unsigned gu32;

constexpr int BATCH = 16, SEQ = 2048, D = 1024, M = BATCH * SEQ;
constexpr int NIN = 2560, PW = 2304;
constexpr int FFD = 2816, FFE = 3584, NEXP = 8;
constexpr float EPS = 1e-6f;
constexpr int NWG = 256;
constexpr float C2 = 0.125f * 1.4426950408889634f;
constexpr int P_QA = 0, P_KA = 256, P_VA = 512, P_QB = 768, P_KB = 1024, P_VB = 1280, P_GU = 1536, P_GV = 1792, P_GLU = 2048;
constexpr int MOE_TILES_MAX = 264, CHUNK_TILES = 64, NCHUNK = 5;
constexpr float MOE_WGU_SC = 32.f, MOE_WD_SC = 64.f, MOE_HID_SC = 4.f;
constexpr int E8_WGU = 0x7a7a7a7a, E8_WD = 0x79797979, E8_HID = 0x7f7f7f7f, E8_ONE = 0x7f7f7f7f;

__device__ __forceinline__ unsigned cvtpk(float lo, float hi) { f32x2_t v = {lo, hi}; bf16x2_t b = __builtin_convertvector(v, bf16x2_t); return __builtin_bit_cast(unsigned, b); }
__device__ __forceinline__ unsigned pk4_fp8(float a, float b, float c, float d) {
    a = __builtin_amdgcn_fmed3f(a, -448.f, 448.f); b = __builtin_amdgcn_fmed3f(b, -448.f, 448.f); c = __builtin_amdgcn_fmed3f(c, -448.f, 448.f); d = __builtin_amdgcn_fmed3f(d, -448.f, 448.f);
    int p = __builtin_amdgcn_cvt_pk_fp8_f32(a, b, 0, false); p = __builtin_amdgcn_cvt_pk_fp8_f32(c, d, p, true); return (unsigned)p; }
__device__ __forceinline__ float bf2f(unsigned short b) { return __uint_as_float((unsigned)b << 16); }
__device__ __forceinline__ float bflo(unsigned w) { return __uint_as_float(w << 16); }
__device__ __forceinline__ float bfhi(unsigned w) { return __uint_as_float(w & 0xffff0000u); }
__device__ __forceinline__ float fast_exp2(float x) { return __builtin_amdgcn_exp2f(x); }
__device__ __forceinline__ float fast_rcp(float x) { return __builtin_amdgcn_rcpf(x); }
__device__ __forceinline__ float sigmoidf_(float x) { return fast_rcp(1.0f + fast_exp2(-1.4426950408889634f * x)); }
__device__ __forceinline__ float siluf_(float x) { return x * sigmoidf_(x); }
__device__ __forceinline__ float gelu_tanh(float x) { const float u = x + 0.044715f * x * x * x; return x * fast_rcp(1.0f + fast_exp2(-2.3022081982f * u)); }
__device__ __forceinline__ f32x2_t exp2_pk(f32x2_t t) { f32x2_t e; e.x = __builtin_amdgcn_exp2f(t.x); e.y = __builtin_amdgcn_exp2f(t.y); return e; }
__device__ __forceinline__ f32x2_t rcp_pk(f32x2_t d) { f32x2_t r; r.x = __builtin_amdgcn_rcpf(d.x); r.y = __builtin_amdgcn_rcpf(d.y); return r; }
__device__ __forceinline__ f32x2_t sigmoid_pk(f32x2_t x) { return rcp_pk(exp2_pk(x * -1.4426950408889634f) + 1.0f); }
__device__ __forceinline__ f32x2_t silu_mul_pk(f32x2_t g, f32x2_t u) { return (g * u) * sigmoid_pk(g); }
__device__ __forceinline__ f32x2_t gelu_tanh_pk(f32x2_t x) { const f32x2_t u = x * ((x * x) * 0.044715f + 1.0f); return x * rcp_pk(exp2_pk(u * -2.3022081982f) + 1.0f); }
__device__ __forceinline__ unsigned pk4_fp8_raw(f32x2_t a, f32x2_t b) {
    a.x = __builtin_amdgcn_fmed3f(a.x, -448.f, 448.f); a.y = __builtin_amdgcn_fmed3f(a.y, -448.f, 448.f); b.x = __builtin_amdgcn_fmed3f(b.x, -448.f, 448.f); b.y = __builtin_amdgcn_fmed3f(b.y, -448.f, 448.f);
    int p = __builtin_amdgcn_cvt_pk_fp8_f32(a.x, a.y, 0, false); p = __builtin_amdgcn_cvt_pk_fp8_f32(b.x, b.y, p, true); return (unsigned)p; }
__device__ __forceinline__ int lane_id() { int l; asm volatile("v_mbcnt_lo_u32_b32 %0, -1, 0\n\tv_mbcnt_hi_u32_b32 %0, -1, %0" : "=v"(l)); return l; }
template <int CTRL> __device__ __forceinline__ float dpp_f(float v) { return __builtin_bit_cast(float, __builtin_amdgcn_update_dpp(0, __builtin_bit_cast(int, v), CTRL, 0xf, 0xf, false)); }
__device__ __forceinline__ float sum16(float v) {
    v += dpp_f<0xB1>(v); v += dpp_f<0x4E>(v); v += dpp_f<0x141>(v); v += dpp_f<0x140>(v); return v; }
__device__ __forceinline__ float pair16_sum(float v) { const auto r = __builtin_amdgcn_permlane16_swap(__float_as_uint(v), __float_as_uint(v), false, false); return __uint_as_float(r[0]) + __uint_as_float(r[1]); }
__device__ __forceinline__ float pair32_sum(float v) { const auto r = __builtin_amdgcn_permlane32_swap(__float_as_uint(v), __float_as_uint(v), false, false); return __uint_as_float(r[0]) + __uint_as_float(r[1]); }
__device__ __forceinline__ float pair32_max(float v) { const auto r = __builtin_amdgcn_permlane32_swap(__float_as_uint(v), __float_as_uint(v), false, false); return fmaxf(__uint_as_float(r[0]), __uint_as_float(r[1])); }
__device__ __forceinline__ float pair32_other(float v, int h) { const auto r = __builtin_amdgcn_permlane32_swap(__float_as_uint(v), __float_as_uint(v), false, false); return __uint_as_float(h ? r[0] : r[1]); }
__device__ __forceinline__ float wave_sum(float v) { return pair32_sum(pair16_sum(sum16(v))); }

namespace pg8 {
constexpr int BM = 256, BK = 64, HALF = 128, HTB = HALF * BK * 2, STAGE_BYTES = 8 * HTB, NXCD = 8, WGM = 8;
__host__ __device__ __forceinline__ int lds_byte(int r, int c) { const int st = (r >> 4) * 2 + (c >> 5), rr = r & 15, cc = c & 31, ob = rr * 64 + cc * 2; return st * 1024 + (ob ^ (((ob >> 9) & 1) << 5)); }
__host__ __device__ __forceinline__ void stage_rc(int b, int& R, int& C) { const int st = b / 1024, sb = b % 1024, swz = sb ^ (((sb >> 9) & 1) << 5); R = (st >> 1) * 16 + swz / 64; C = (st & 1) * 32 + (swz % 64) / 2; }
__host__ __device__ __forceinline__ int perm32(int rho) { const int n = rho >> 4, i = rho & 15; return 8 * (i >> 2) + 4 * n + (i & 3); }

struct Unit { int pm, pn; };
struct StaticOrder {
    int nM, nN, nwg, G, c; bool dup;
    __device__ __forceinline__ void init(int nM_, int nN_, int G_, int c_) { nM = nM_; nN = nN_; nwg = nM * nN; G = G_; c = c_; dup = false; }
    __device__ __forceinline__ bool next(int i, Unit& u) const {
        if (dup) i >>= 1;
        const long L = (long)i * G + c; if (L >= nwg) return false;
        int wgid = (int)L; { const int q = nwg / NXCD, r = nwg % NXCD, xcd = wgid % NXCD, off = wgid / NXCD; wgid = (xcd < r ? xcd * (q + 1) : r * (q + 1) + (xcd - r) * q) + off; }
        const int nig = WGM * nN, gid = wgid / nig, fm = gid * WGM, gsz = (nM - fm) < WGM ? (nM - fm) : WGM;
        u.pm = fm + ((wgid % nig) % gsz); u.pn = (wgid % nig) / gsz; return true;
    }
};
struct SchedPlain : StaticOrder {
    static constexpr bool GATHER = false;
    const char* Bt; size_t tstep;
    __device__ __forceinline__ int arow(const Unit& u, int rr) const { return u.pm * BM + rr; }
    __device__ __forceinline__ const char* bptr(const Unit& u) const { return Bt + (size_t)u.pn * tstep; }
    __device__ __forceinline__ size_t koff(const Unit&) const { return 0; }
};
template <bool GATHER_> struct SchedMoe : StaticOrder {
    static constexpr bool GATHER = GATHER_;
    const char* Bt; size_t tstep, estride; int tile0; const int* s2t; int ts[7];
    __device__ __forceinline__ int expert(int pmg) const { int e = 0;
#pragma unroll
        for (int k = 0; k < 7; ++k) e += (pmg >= ts[k]) ? 1 : 0;
        return e; }
    __device__ __forceinline__ int arow(const Unit& u, int rr) const { return u.pm * BM + rr; }
    const LAS int* tab;
    __device__ __forceinline__ u32x4 arow4(int ui, int R0) const { if (dup) ui >>= 1; return *(const LAS u32x4*)(tab + ui * 256 + R0 * 4); }
    int ksb;
    __device__ __forceinline__ size_t koff(const Unit& u) const { return ksb ? (size_t)(u.pn >> 2) * ksb : 0; }
    __device__ __forceinline__ const char* bptr(const Unit& u) const { return Bt + (size_t)expert(tile0 + u.pm) * estride + (size_t)(ksb ? (u.pn & 3) : u.pn) * tstep + koff(u); }
};

typedef int v8i32 __attribute__((ext_vector_type(8)));
template <class Epi, class Sched, bool FP8 = false>
__device__ __forceinline__ void gemm_phase(LAS unsigned char* lds, const int wave0, const char* Abase, const int KB, const Sched& S, const Epi& E, const int sW = 0x7f7f7f7f, const int sX = 0x7f7f7f7f, const int ntiles = 0) {
    int tid = wave0 * 64 + lane_id(); asm volatile("" : "+v"(tid)); const int wid = __builtin_amdgcn_readfirstlane(tid >> 6), lane = tid & 63, wr = wid >> 2, wc = wid & 3, fr = lane & 15, fq = lane >> 4;
    const int nt = ntiles ? ntiles : KB / 128;
    int R0, C0; stage_rc(tid * 16, R0, C0);
    const unsigned voffA = (unsigned)(R0 * KB + C0 * 2), voffB = (unsigned)(((R0 & ~31) + perm32(R0 & 31)) * KB + C0 * 2);
    const size_t kstep = (size_t)(BK * 2);
    const size_t hstep = (size_t)HALF * KB;
    const unsigned rowb = (unsigned)KB, colb = (unsigned)C0 * 2u;
    const size_t q64 = (size_t)64 * KB;
    const unsigned ldsw = (unsigned)wid * 1024u;
    const int aoff = lds_byte(wr * 64 + fr, fq * 8), boff = lds_byte(wc * 32 + fr, fq * 8);
#define PG8_SA(b, h) (((b) * 2 + (h)) * HTB)
#define PG8_SB(b, h) ((4 + (b) * 2 + (h)) * HTB)
#define PG8_GLDS(gp, bufoff, i) __builtin_amdgcn_global_load_lds((const unsigned*)(gp), (LAS unsigned*)(lds + (bufoff) + ldsw + (i) * 8192), 16, 0, 0)
#define PG8_STAGE_B(bufoff, gbase) do { PG8_GLDS((const char*)(gbase) + voffB, bufoff, 0); PG8_GLDS((const char*)(gbase) + q64 + voffB, bufoff, 1); } while (0)
#define PG8_STAGE_A(bufoff, h, kb, NX) do { \
        if constexpr (Sched::GATHER) { const unsigned _o0 = (NX) ? ((h) ? n2 : n0) : ((h) ? va2 : va0), _o1 = (NX) ? ((h) ? n3 : n1) : ((h) ? va3 : va1); \
            PG8_GLDS(Abase + (kb) + _o0, bufoff, 0); PG8_GLDS(Abase + (kb) + _o1, bufoff, 1); } \
        else { const char* _b = ((NX) ? nA : cA) + (size_t)(h) * hstep + (kb); PG8_GLDS(_b + voffA, bufoff, 0); PG8_GLDS(_b + q64 + voffA, bufoff, 1); } } while (0)
#define PG8_LDA(dst, b, h) do { _Pragma("unroll") for (int m = 0; m < 4; ++m) _Pragma("unroll") for (int k = 0; k < 2; ++k) dst[m][k] = *(const LAS bf16x8*)(lds + PG8_SA(b, h) + aoff + m * 2048 + k * 1024); } while (0)
#define PG8_LDB(dst, b, h) do { _Pragma("unroll") for (int n = 0; n < 2; ++n) _Pragma("unroll") for (int k = 0; k < 2; ++k) dst[n][k] = *(const LAS bf16x8*)(lds + PG8_SB(b, h) + boff + n * 2048 + k * 1024); } while (0)
#define PG8_CAT(x, y) __builtin_shufflevector(__builtin_bit_cast(u32x4, x), __builtin_bit_cast(u32x4, y), 0, 1, 2, 3, 4, 5, 6, 7)
#define PG8_MMA(ai, bj, At, Bt) do { __builtin_amdgcn_s_setprio(1); \
        if constexpr (FP8) { _Pragma("unroll") for (int m = 0; m < 4; ++m) _Pragma("unroll") for (int n = 0; n < 2; ++n) { \
            const v8i32 b8_ = __builtin_bit_cast(v8i32, PG8_CAT(Bt[n][0], Bt[n][1])), a8_ = __builtin_bit_cast(v8i32, PG8_CAT(At[m][0], At[m][1])); \
            asm volatile("s_nop 1\n\tv_mfma_scale_f32_16x16x128_f8f6f4 %0, %1, %2, %0, %3, %4 op_sel_hi:[0,0,0]" : "+v"(acc[ai][bj][m][n]) : "v"(b8_), "v"(a8_), "v"(sW), "v"(sX)); } } \
        else { _Pragma("unroll") for (int m = 0; m < 4; ++m) _Pragma("unroll") for (int n = 0; n < 2; ++n) _Pragma("unroll") for (int k = 0; k < 2; ++k) \
            acc[ai][bj][m][n] = __builtin_amdgcn_mfma_f32_16x16x32_bf16(Bt[n][k], At[m][k], acc[ai][bj][m][n], 0, 0, 0); } \
        __builtin_amdgcn_s_setprio(0); } while (0)
#define PG8_WAIT_V(n) asm volatile("s_waitcnt vmcnt(" #n ")" ::: "memory")
#define PG8_WAIT_L(n) asm volatile("s_waitcnt lgkmcnt(" #n ")" ::: "memory")
#define PG8_BAR __builtin_amdgcn_s_barrier()
#define PG8_SCHED __builtin_amdgcn_sched_barrier(0)
    Unit cur, nxt; int ui = 0;
    if (!S.next(0, cur)) return;
#define PG8_PIN8(a, b) asm volatile("" : "+v"(acc[a][b][0][0]), "+v"(acc[a][b][0][1]), "+v"(acc[a][b][1][0]), "+v"(acc[a][b][1][1]), "+v"(acc[a][b][2][0]), "+v"(acc[a][b][2][1]), "+v"(acc[a][b][3][0]), "+v"(acc[a][b][3][1]))
#define PG8_PINACC() do { PG8_PIN8(0, 0); PG8_PIN8(0, 1); PG8_PIN8(1, 0); PG8_PIN8(1, 1); } while (0)
    f32x4 acc[2][2][4][2];
#pragma unroll
    for (int a = 0; a < 2; ++a)
#pragma unroll
        for (int b = 0; b < 2; ++b)
#pragma unroll
            for (int m = 0; m < 4; ++m)
#pragma unroll
                for (int n = 0; n < 2; ++n) acc[a][b][m][n] = (f32x4){0.f, 0.f, 0.f, 0.f};
    PG8_PINACC();
    bf16x8 At[4][2], B0[2][2], B1[2][2];
    unsigned va0 = 0, va1 = 0, va2 = 0, va3 = 0, na0 = 0, na1 = 0, na2 = 0, na3 = 0;
    const char* cA = Abase; const char* nA = Abase;
    if constexpr (Sched::GATHER) { const u32x4 ci = S.arow4(0, R0); va0 = ci.x * rowb + colb; va1 = ci.y * rowb + colb; va2 = ci.z * rowb + colb; va3 = ci.w * rowb + colb; }
    else cA = Abase + (size_t)S.arow(cur, 0) * rowb + S.koff(cur);
    const char* cB = S.bptr(cur);
    { const unsigned n0 = 0, n1 = 0, n2 = 0, n3 = 0; (void)n0; (void)n1; (void)n2; (void)n3;
    PG8_STAGE_B(PG8_SB(0, 0), cB); PG8_STAGE_B(PG8_SB(0, 1), cB + hstep); PG8_STAGE_A(PG8_SA(0, 0), 0, 0, false); PG8_STAGE_A(PG8_SA(0, 1), 1, 0, false);
    if (wr == 1) PG8_BAR;
    PG8_WAIT_V(2); PG8_BAR;
    PG8_STAGE_B(PG8_SB(1, 0), cB + kstep); PG8_STAGE_A(PG8_SA(1, 0), 0, kstep, false); PG8_STAGE_B(PG8_SB(1, 1), cB + hstep + kstep);
    PG8_WAIT_V(6); PG8_BAR; }
    for (;;) {
        const bool has_next = S.next(ui + 1, nxt);
        const char* nB = has_next ? S.bptr(nxt) : cB;
        if constexpr (Sched::GATHER) {
            { const u32x4 ni = S.arow4(has_next ? ui + 1 : ui, R0); na0 = ni.x * rowb + colb; na1 = ni.y * rowb + colb; na2 = ni.z * rowb + colb; na3 = ni.w * rowb + colb; }
        } else nA = has_next ? Abase + (size_t)S.arow(nxt, 0) * rowb + S.koff(nxt) : cA;
        for (int t = 0; t < nt; t += 2) {
            const bool last = (t == nt - 2);
            const size_t k1 = (size_t)(t + 1) * kstep, k2 = last ? 0 : (size_t)(t + 2) * kstep, k3 = k2 + kstep;
            const char* b2 = last ? nB : cB + (size_t)(t + 2) * kstep; const char* b3 = b2 + kstep;
            const unsigned n0 = last ? na0 : va0, n1 = last ? na1 : va1, n2 = last ? na2 : va2, n3 = last ? na3 : va3;
            PG8_LDB(B0, 0, 0); PG8_LDB(B1, 0, 1); PG8_SCHED; PG8_LDA(At, 0, 0); PG8_STAGE_A(PG8_SA(1, 1), 1, k1, false);
            PG8_WAIT_V(8); PG8_WAIT_L(0); PG8_BAR; PG8_MMA(0, 0, At, B0); PG8_MMA(0, 1, At, B1); PG8_BAR; PG8_SCHED;
            PG8_LDA(At, 0, 1); PG8_STAGE_B(PG8_SB(0, 0), b2); PG8_STAGE_B(PG8_SB(0, 1), b2 + hstep); PG8_STAGE_A(PG8_SA(0, 0), 0, k2, last);
            PG8_WAIT_V(8); PG8_WAIT_L(0); PG8_BAR; PG8_MMA(1, 0, At, B0); PG8_MMA(1, 1, At, B1); PG8_BAR; PG8_SCHED;
            PG8_LDB(B0, 1, 0); PG8_LDB(B1, 1, 1); PG8_SCHED; PG8_LDA(At, 1, 0); PG8_STAGE_A(PG8_SA(0, 1), 1, k2, last);
            PG8_WAIT_V(8); PG8_WAIT_L(0); PG8_BAR; PG8_MMA(0, 0, At, B0); PG8_MMA(0, 1, At, B1); PG8_BAR; PG8_SCHED;
            PG8_LDA(At, 1, 1); PG8_STAGE_B(PG8_SB(1, 0), b3); PG8_STAGE_B(PG8_SB(1, 1), b3 + hstep); PG8_STAGE_A(PG8_SA(1, 0), 0, k3, last);
            PG8_WAIT_V(8); PG8_WAIT_L(0); PG8_BAR; PG8_MMA(1, 0, At, B0); PG8_MMA(1, 1, At, B1); PG8_BAR; PG8_SCHED;
        }
        if (wr == 0) PG8_BAR;
        if constexpr (FP8) asm volatile("s_nop 15\n\ts_nop 15" ::: "memory");
        E(acc, cur, wr, wc, fr, fq);
        if (!has_next) break;
#pragma unroll
        for (int a = 0; a < 2; ++a)
#pragma unroll
            for (int b = 0; b < 2; ++b)
#pragma unroll
                for (int m = 0; m < 4; ++m)
#pragma unroll
                    for (int n = 0; n < 2; ++n) acc[a][b][m][n] = (f32x4){0.f, 0.f, 0.f, 0.f};
        PG8_PINACC();
        cur = nxt; cB = nB; cA = nA; ++ui;
        if constexpr (Sched::GATHER) { va0 = na0; va1 = na1; va2 = na2; va3 = na3; }
        if (wr == 1) PG8_BAR;
    }
    PG8_WAIT_V(0);
    PG8_BAR;
#undef PG8_SA
#undef PG8_SB
#undef PG8_GLDS
#undef PG8_STAGE_A
#undef PG8_STAGE_B
#undef PG8_LDA
#undef PG8_LDB
#undef PG8_MMA
#undef PG8_PIN8
#undef PG8_PINACC
#undef PG8_CAT
#undef PG8_WAIT_V
#undef PG8_WAIT_L
#undef PG8_BAR
#undef PG8_SCHED
}
}

#ifndef EPI_NT
#define EPI_NT 0
#endif
#if EPI_NT
#define EPI_STORE(ty, ptr, val) __builtin_nontemporal_store((val), (ty*)(ptr))
#else
#define EPI_STORE(ty, ptr, val) (*(ty*)(ptr) = (val))
#endif
struct EpiPlain {
    bf16* O; int ldc; int rowoff; size_t plane = 0;
    __device__ __forceinline__ void operator()(const f32x4 (&acc)[2][2][4][2], const pg8::Unit& u, int wr, int wc, int fr, int fq) const {
        const int pn = plane ? (u.pn & 3) : u.pn; bf16* Ob = O + (plane ? (size_t)(u.pn >> 2) * plane : 0);
        const int row0 = rowoff + u.pm * 256 + wr * 64 + fr, col0 = pn * 256 + wc * 32 + 8 * fq;
#pragma unroll
        for (int ai = 0; ai < 2; ++ai)
#pragma unroll
            for (int m = 0; m < 4; ++m) { bf16* rowp = Ob + (size_t)(row0 + ai * 128 + m * 16) * ldc + col0;
#pragma unroll
                for (int bj = 0; bj < 2; ++bj) { const f32x4 v0 = acc[ai][bj][m][0], v1 = acc[ai][bj][m][1];
                    u32x4 w; w.x = cvtpk(v0[0], v0[1]); w.y = cvtpk(v0[2], v0[3]); w.z = cvtpk(v1[0], v1[1]); w.w = cvtpk(v1[2], v1[3]);
                    EPI_STORE(u32x4, (rowp + bj * 128), w); } }
    }
};
struct EpiSwiGLU {
    bf16* O; int ldc;
    __device__ __forceinline__ void operator()(const f32x4 (&acc)[2][2][4][2], const pg8::Unit& u, int wr, int wc, int fr, int fq) const {
        const int row0 = u.pm * 256 + wr * 64 + fr, col0 = u.pn * 128 + wc * 32 + 8 * fq;
#pragma unroll
        for (int ai = 0; ai < 2; ++ai)
#pragma unroll
            for (int m = 0; m < 4; ++m) { bf16* rowp = O + (size_t)(row0 + ai * 128 + m * 16) * ldc + col0;
                const f32x4 g0 = acc[ai][0][m][0], g1 = acc[ai][0][m][1], u0 = acc[ai][1][m][0], u1 = acc[ai][1][m][1];
                const f32x2_t h0 = silu_mul_pk((f32x2_t){g0[0], g0[1]}, (f32x2_t){u0[0], u0[1]}), h1 = silu_mul_pk((f32x2_t){g0[2], g0[3]}, (f32x2_t){u0[2], u0[3]});
                const f32x2_t h2 = silu_mul_pk((f32x2_t){g1[0], g1[1]}, (f32x2_t){u1[0], u1[1]}), h3 = silu_mul_pk((f32x2_t){g1[2], g1[3]}, (f32x2_t){u1[2], u1[3]});
                u32x4 w; w.x = cvtpk(h0.x, h0.y); w.y = cvtpk(h1.x, h1.y); w.z = cvtpk(h2.x, h2.y); w.w = cvtpk(h3.x, h3.y);
                EPI_STORE(u32x4, rowp, w); }
    }
};
struct EpiSwiGLU8 {
    unsigned char* O; int ldc;
    __device__ __forceinline__ void operator()(const f32x4 (&acc)[2][2][4][2], const pg8::Unit& u, int wr, int wc, int fr, int fq) const {
        const int row0 = u.pm * 256 + wr * 64 + fr, col0 = u.pn * 128 + wc * 32 + 8 * fq;
#pragma unroll
        for (int ai = 0; ai < 2; ++ai)
#pragma unroll
            for (int m = 0; m < 4; ++m) { unsigned char* rowp = O + (size_t)(row0 + ai * 128 + m * 16) * ldc + col0;
                const f32x4 g0 = acc[ai][0][m][0], g1 = acc[ai][0][m][1], u0 = acc[ai][1][m][0], u1 = acc[ai][1][m][1];
                const f32x2_t h0 = silu_mul_pk((f32x2_t){g0[0], g0[1]}, (f32x2_t){u0[0], u0[1]}), h1 = silu_mul_pk((f32x2_t){g0[2], g0[3]}, (f32x2_t){u0[2], u0[3]});
                const f32x2_t h2 = silu_mul_pk((f32x2_t){g1[0], g1[1]}, (f32x2_t){u1[0], u1[1]}), h3 = silu_mul_pk((f32x2_t){g1[2], g1[3]}, (f32x2_t){u1[2], u1[3]});
                u32x2 w; w.x = pk4_fp8_raw(h0, h1); w.y = pk4_fp8_raw(h2, h3);
                EPI_STORE(u32x2, rowp, w); }
    }
};
struct EpiInProj {
    bf16* P; const int* pos; float* kmsum;
    __device__ __forceinline__ void operator()(const f32x4 (&acc)[2][2][4][2], const pg8::Unit& u, int wr, int wc, int fr, int fq) const {
        const int pn = u.pn, row0 = u.pm * 256 + wr * 64 + fr;
        if (pn == 0 || pn == 1 || pn == 3 || pn == 4) {
            const int g = wc & 1, i0 = 16 * g + 4 * fq;
            float invf[4];
#pragma unroll
            for (int e = 0; e < 4; ++e) invf[e] = fast_exp2(-(float)(i0 + e) * 0.4152410118609203f);
            const float sc = (pn == 0 || pn == 3) ? C2 : 1.0f;
            float ks[2][2][4];
#pragma unroll
            for (int a = 0; a < 2; ++a)
#pragma unroll
                for (int b = 0; b < 2; ++b)
#pragma unroll
                    for (int e = 0; e < 4; ++e) ks[a][b][e] = 0.f;
#pragma unroll
            for (int ai = 0; ai < 2; ++ai)
#pragma unroll
                for (int m = 0; m < 4; ++m) { const int row = row0 + ai * 128 + m * 16; const float p = (float)pos[row];
                    float cs[4], sn[4];
#pragma unroll
                    for (int e = 0; e < 4; ++e) { const float ang = p * invf[e]; const float k = rintf(ang * 0.15915494309189535f);
                        float r = fmaf(-k, 6.2831854820251465f, ang); r = fmaf(-k, -1.7484556000744883e-07f, r); const float rev = r * 0.15915494309189535f;
                        cs[e] = __builtin_amdgcn_cosf(rev); sn[e] = __builtin_amdgcn_sinf(rev); }
                    bf16* rowp = P + (size_t)row * PW + 256 * pn;
#pragma unroll
                    for (int bj = 0; bj < 2; ++bj) { const int hh = 2 * bj + (wc >> 1); const f32x4 v0 = acc[ai][bj][m][0], v1 = acc[ai][bj][m][1];
                        float o0[4], o1[4];
#pragma unroll
                        for (int e = 0; e < 4; ++e) { o0[e] = (v0[e] * cs[e] - v1[e] * sn[e]) * sc; o1[e] = (v1[e] * cs[e] + v0[e] * sn[e]) * sc; ks[bj][0][e] += o0[e]; ks[bj][1][e] += o1[e]; }
                        u32x4 w; w.x = cvtpk(o0[0], o0[1]); w.y = cvtpk(o0[2], o0[3]); w.z = cvtpk(o1[0], o1[1]); w.w = cvtpk(o1[2], o1[3]);
                        EPI_STORE(u32x4, (rowp + 64 * hh + 32 * g + 8 * fq), w); } }
            if (pn == 1) {
#pragma unroll
                for (int bj = 0; bj < 2; ++bj)
#pragma unroll
                    for (int n = 0; n < 2; ++n)
#pragma unroll
                        for (int e = 0; e < 4; ++e) { const float v = sum16(ks[bj][n][e]);
                            if (fr == 0) atomicAdd(kmsum + (size_t)(u.pm * 4 + 2 * bj + (wc >> 1)) * 64 + 32 * g + 8 * fq + 4 * n + e, v); }
            }
        } else if (pn >= 8) {
            const int col0 = P_GLU + 128 * (pn - 8) + wc * 32 + 8 * fq;
#pragma unroll
            for (int ai = 0; ai < 2; ++ai)
#pragma unroll
                for (int m = 0; m < 4; ++m) { bf16* rowp = P + (size_t)(row0 + ai * 128 + m * 16) * PW + col0;
                    const f32x4 a0 = acc[ai][0][m][0], a1 = acc[ai][0][m][1], g0 = acc[ai][1][m][0], g1 = acc[ai][1][m][1];
                    const f32x2_t o0 = (f32x2_t){a0[0], a0[1]} * sigmoid_pk((f32x2_t){g0[0], g0[1]}), o1 = (f32x2_t){a0[2], a0[3]} * sigmoid_pk((f32x2_t){g0[2], g0[3]});
                    const f32x2_t o2 = (f32x2_t){a1[0], a1[1]} * sigmoid_pk((f32x2_t){g1[0], g1[1]}), o3 = (f32x2_t){a1[2], a1[3]} * sigmoid_pk((f32x2_t){g1[2], g1[3]});
                    u32x4 w; w.x = cvtpk(o0.x, o0.y); w.y = cvtpk(o1.x, o1.y); w.z = cvtpk(o2.x, o2.y); w.w = cvtpk(o3.x, o3.y);
                    EPI_STORE(u32x4, rowp, w); }
        } else {
            const bool act = (pn >= 6);
            const int col0 = 256 * pn + wc * 32 + 8 * fq;
#pragma unroll
            for (int ai = 0; ai < 2; ++ai)
#pragma unroll
                for (int m = 0; m < 4; ++m) { bf16* rowp = P + (size_t)(row0 + ai * 128 + m * 16) * PW + col0;
#pragma unroll
                    for (int bj = 0; bj < 2; ++bj) { const f32x4 v0 = acc[ai][bj][m][0], v1 = acc[ai][bj][m][1];
                        f32x2_t o0 = {v0[0], v0[1]}, o1 = {v0[2], v0[3]}, o2 = {v1[0], v1[1]}, o3 = {v1[2], v1[3]};
                        if (act) { o0 = gelu_tanh_pk(o0); o1 = gelu_tanh_pk(o1); o2 = gelu_tanh_pk(o2); o3 = gelu_tanh_pk(o3); }
                        u32x4 w; w.x = cvtpk(o0.x, o0.y); w.y = cvtpk(o1.x, o1.y); w.z = cvtpk(o2.x, o2.y); w.w = cvtpk(o3.x, o3.y);
                        EPI_STORE(u32x4, (rowp + bj * 128), w); } }
        }
    }
};

#define MFMA32(a, b, c) __builtin_amdgcn_mfma_f32_32x32x16_bf16((a), (b), (c), 0, 0, 0)
__device__ __forceinline__ int crow(int i, int h) { return (i & 3) + 8 * (i >> 2) + 4 * h; }
__device__ __forceinline__ v4i16_t vtr(const LAS char* p) { return __builtin_amdgcn_ds_read_tr16_b64_v4i16((LAS v4i16_t*)p); }

struct AttnOperands { u32x4 kk[4]; u32x4 vv[4]; };
__device__ __forceinline__ void attn_load(AttnOperands& T, const bf16* kp, const bf16* vp, size_t v8) {
#pragma unroll
    for (int w = 0; w < 4; ++w) T.kk[w] = *(const u32x4*)(kp + (size_t)w * v8);
#pragma unroll
    for (int w = 0; w < 4; ++w) T.vv[w] = *(const u32x4*)(vp + (size_t)w * v8);
}
constexpr int ATT_KLDS = 4096, ATT_WAVE_LDS = 9216;
__device__ __forceinline__ void attn_kfrags(bf16x8 (&kf)[4], const AttnOperands& T, LAS char* vt, int lane) {
    { const int piece = lane & 7, key0 = lane >> 3;
#pragma unroll
      for (int w = 0; w < 4; ++w) *(LAS u32x4*)(vt + ATT_KLDS + (key0 + 8 * w) * 144 + piece * 16) = T.kk[w]; }
    const int r = lane & 31, h = lane >> 5;
#pragma unroll
    for (int s = 0; s < 4; ++s) kf[s] = *(const LAS bf16x8*)(vt + ATT_KLDS + r * 144 + (2 * s + h) * 16);
}
__device__ __forceinline__ void attn_compute(f32x16& o0, f32x16& o1, float& m, float& l, const bf16x8 (&qf)[4], const AttnOperands& T, LAS char* vt, int lane, unsigned vmask) {
    const int h = lane >> 5;
    f32x16 p; bf16x8 kf[4]; attn_kfrags(kf, T, vt, lane);
#pragma unroll
    for (int i = 0; i < 16; ++i) p[i] = 0.f;
#pragma unroll
    for (int s = 0; s < 4; ++s) p = MFMA32(kf[s], qf[s], p);
    { const int piece = lane & 7, key0 = lane >> 3;
#pragma unroll
      for (int w = 0; w < 4; ++w) *(LAS u32x4*)(vt + (2 * w + (piece >> 2)) * 512 + key0 * 64 + (piece & 3) * 16) = T.vv[w]; }
    float tm = -INFINITY;
#pragma unroll
    for (int i = 0; i < 16; ++i) { p[i] = ((vmask >> i) & 1u) ? p[i] : -INFINITY; tm = fmaxf(tm, p[i]); }
    tm = pair32_max(tm);
    const float mn = fmaxf(m, tm), alpha = fast_exp2(m - mn); m = mn;
    float rs = 0.f;
#pragma unroll
    for (int i = 0; i < 16; ++i) { p[i] = fast_exp2(p[i] - mn); rs += p[i]; }
    l = l * alpha + rs;
#pragma unroll
    for (int i = 0; i < 16; ++i) { o0[i] *= alpha; o1[i] *= alpha; }
    u32x4 w0, w1;
    w0.x = cvtpk(p[0], p[1]); w0.y = cvtpk(p[2], p[3]); w0.z = cvtpk(p[4], p[5]); w0.w = cvtpk(p[6], p[7]);
    w1.x = cvtpk(p[8], p[9]); w1.y = cvtpk(p[10], p[11]); w1.z = cvtpk(p[12], p[13]); w1.w = cvtpk(p[14], p[15]);
    const bf16x8 pf0 = __builtin_bit_cast(bf16x8, w0), pf1 = __builtin_bit_cast(bf16x8, w1);
    const LAS char* vb = vt + (4 * h + ((lane & 15) >> 2)) * 64 + ((lane >> 4) & 1) * 32 + (lane & 3) * 8;
#pragma unroll
    for (int s2 = 0; s2 < 2; ++s2) {
        const v4i16_t a0 = vtr(vb + (4 * s2 + 0) * 512), a1 = vtr(vb + (4 * s2 + 2) * 512);
        const v4i16_t b0 = vtr(vb + (4 * s2 + 1) * 512), b1 = vtr(vb + (4 * s2 + 3) * 512);
        const bf16x8 vf0 = (bf16x8){a0[0], a0[1], a0[2], a0[3], a1[0], a1[1], a1[2], a1[3]};
        const bf16x8 vf1 = (bf16x8){b0[0], b0[1], b0[2], b0[3], b1[0], b1[1], b1[2], b1[3]};
        o0 = MFMA32(vf0, s2 ? pf1 : pf0, o0);
        o1 = MFMA32(vf1, s2 ? pf1 : pf0, o1);
    }
}
__device__ __forceinline__ void attn_store(const f32x16& o0, const f32x16& o1, float inv, bf16* dst, int h) {
#pragma unroll
    for (int g = 0; g < 4; ++g) {
        u32x2 a, b; a.x = cvtpk(o0[4 * g] * inv, o0[4 * g + 1] * inv); a.y = cvtpk(o0[4 * g + 2] * inv, o0[4 * g + 3] * inv);
        b.x = cvtpk(o1[4 * g] * inv, o1[4 * g + 1] * inv); b.y = cvtpk(o1[4 * g + 2] * inv, o1[4 * g + 3] * inv);
        *(u32x2*)(dst + 8 * g + 4 * h) = a; *(u32x2*)(dst + 32 + 8 * g + 4 * h) = b; }
}
__device__ __forceinline__ void dil_item(const bf16* P, bf16* DO, float* LS, int cfg, int b, int hh, int idx, LAS char* vt, int lane) {
    const int r = lane & 31, h = lane >> 5, sh = 2 * cfg, dil = 1 << sh, tsh = 6 - sh;
    const int res = idx >> tsh, qt = idx & ((1 << tsh) - 1);
    const bf16* Pb = P + ((size_t)b * SEQ + res) * PW;
    const size_t rs = (size_t)dil * PW;
    const bf16* qp = Pb + (size_t)(32 * qt + r) * rs + P_QB + 64 * hh + 8 * h;
    bf16x8 qf[4];
#pragma unroll
    for (int s = 0; s < 4; ++s) qf[s] = *(const bf16x8*)(qp + 16 * s);
    f32x16 o0, o1;
#pragma unroll
    for (int i = 0; i < 16; ++i) { o0[i] = 0.f; o1[i] = 0.f; }
    float m = -1e30f, l = 0.f;
    const bf16* kbase = Pb + (size_t)(lane >> 3) * rs + P_KB + 64 * hh + 8 * (lane & 7);
    const bf16* vbase = Pb + (size_t)(lane >> 3) * rs + P_VB + 64 * hh + 8 * (lane & 7);
#define DIL_MASK(kt_) ({ unsigned vm_ = 0u; _Pragma("unroll") for (int i = 0; i < 16; ++i) { const int dl = 32 * (qt - (kt_)) + r - crow(i, h); vm_ |= (dl >= 0 && dl <= 128) ? (1u << i) : 0u; } vm_; })
    AttnOperands TA, TB;
    int kt = (qt > 4 ? qt - 4 : 0);
    attn_load(TA, kbase + (size_t)32 * kt * rs, vbase + (size_t)32 * kt * rs, 8 * rs);
    for (;;) {
        if (kt < qt) attn_load(TB, kbase + (size_t)32 * (kt + 1) * rs, vbase + (size_t)32 * (kt + 1) * rs, 8 * rs);
        attn_compute(o0, o1, m, l, qf, TA, vt, lane, DIL_MASK(kt));
        if (++kt > qt) break;
        if (kt < qt) attn_load(TA, kbase + (size_t)32 * (kt + 1) * rs, vbase + (size_t)32 * (kt + 1) * rs, 8 * rs);
        attn_compute(o0, o1, m, l, qf, TB, vt, lane, DIL_MASK(kt));
        if (++kt > qt) break;
    }
#undef DIL_MASK
    l = pair32_sum(l);
    const size_t row = (size_t)b * SEQ + (size_t)(32 * qt + r) * dil + res;
    attn_store(o0, o1, fast_rcp(l), DO + row * 256 + 64 * hh, h);
    if (h == 0) LS[row * 4 + hh] = m + __builtin_amdgcn_logf(l);
}

__device__ __forceinline__ void softmax_step(f32x16& p, unsigned vmask, bool full  , float& m, float& l, f32x16& o0, f32x16& o1, bf16x8& pf0, bf16x8& pf1) {
    float tm = -INFINITY;
    if (full) {
#pragma unroll
        for (int i = 0; i < 16; ++i) tm = fmaxf(tm, p[i]);
    } else {
#pragma unroll
        for (int i = 0; i < 16; ++i) { p[i] = ((vmask >> i) & 1u) ? p[i] : -INFINITY; tm = fmaxf(tm, p[i]); }
    }
    tm = pair32_max(tm);
    const float mn = fmaxf(m, tm), alpha = fast_exp2(m - mn); m = mn;
    float rs = 0.f;
#pragma unroll
    for (int i = 0; i < 16; ++i) { p[i] = fast_exp2(p[i] - mn); rs += p[i]; }
    l = l * alpha + rs;
    if (__any(alpha != 1.0f)) {
#pragma unroll
        for (int i = 0; i < 16; ++i) { o0[i] *= alpha; o1[i] *= alpha; }
    }
    u32x4 w0, w1;
    w0.x = cvtpk(p[0], p[1]); w0.y = cvtpk(p[2], p[3]); w0.z = cvtpk(p[4], p[5]); w0.w = cvtpk(p[6], p[7]);
    w1.x = cvtpk(p[8], p[9]); w1.y = cvtpk(p[10], p[11]); w1.z = cvtpk(p[12], p[13]); w1.w = cvtpk(p[14], p[15]);
    pf0 = __builtin_bit_cast(bf16x8, w0); pf1 = __builtin_bit_cast(bf16x8, w1);
}
struct AttnQ { f32x16 o0, o1; float m, l; bf16x8 qf[4]; };
__device__ __forceinline__ void attn_compute2(AttnQ& A, AttnQ& B, const AttnOperands& T, LAS char* vt, int lane, unsigned vmA, int modeA, unsigned vmB, int modeB) {
    const int h = lane >> 5;
    f32x16 pA, pB; bf16x8 kf[4]; attn_kfrags(kf, T, vt, lane);
#pragma unroll
    for (int i = 0; i < 16; ++i) { pA[i] = 0.f; pB[i] = 0.f; }
    if (modeA && modeB) {
#pragma unroll
        for (int s = 0; s < 4; ++s) { pA = MFMA32(kf[s], A.qf[s], pA); pB = MFMA32(kf[s], B.qf[s], pB); }
    } else if (modeA) {
#pragma unroll
        for (int s = 0; s < 4; ++s) pA = MFMA32(kf[s], A.qf[s], pA);
    } else {
#pragma unroll
        for (int s = 0; s < 4; ++s) pB = MFMA32(kf[s], B.qf[s], pB);
    }
    { const int piece = lane & 7, key0 = lane >> 3;
#pragma unroll
      for (int w = 0; w < 4; ++w) *(LAS u32x4*)(vt + (2 * w + (piece >> 2)) * 512 + key0 * 64 + (piece & 3) * 16) = T.vv[w]; }
    bf16x8 fA0 = {}, fA1 = {}, fB0 = {}, fB1 = {};
    if (modeA) softmax_step(pA, vmA, modeA == 1, A.m, A.l, A.o0, A.o1, fA0, fA1);
    if (modeB) softmax_step(pB, vmB, modeB == 1, B.m, B.l, B.o0, B.o1, fB0, fB1);
    const LAS char* vb = vt + (4 * h + ((lane & 15) >> 2)) * 64 + ((lane >> 4) & 1) * 32 + (lane & 3) * 8;
#pragma unroll
    for (int s2 = 0; s2 < 2; ++s2) {
        const v4i16_t a0 = vtr(vb + (4 * s2 + 0) * 512), a1 = vtr(vb + (4 * s2 + 2) * 512);
        const v4i16_t b0 = vtr(vb + (4 * s2 + 1) * 512), b1 = vtr(vb + (4 * s2 + 3) * 512);
        const bf16x8 vf0 = (bf16x8){a0[0], a0[1], a0[2], a0[3], a1[0], a1[1], a1[2], a1[3]};
        const bf16x8 vf1 = (bf16x8){b0[0], b0[1], b0[2], b0[3], b1[0], b1[1], b1[2], b1[3]};
        if (modeA) { A.o0 = MFMA32(vf0, s2 ? fA1 : fA0, A.o0); A.o1 = MFMA32(vf1, s2 ? fA1 : fA0, A.o1); }
        if (modeB) { B.o0 = MFMA32(vf0, s2 ? fB1 : fB0, B.o0); B.o1 = MFMA32(vf1, s2 ? fB1 : fB0, B.o1); }
    }
}
__device__ __forceinline__ void dil_pair_item(const bf16* P, bf16* DO, float* LS, int cfg, int b, int hh, int idx, LAS char* vt, int lane) {
    const int r = lane & 31, h = lane >> 5, sh = 2 * cfg, dil = 1 << sh, tsh = 5 - sh;
    const int res = idx >> tsh, qt = 2 * (idx & ((1 << tsh) - 1));
    const bf16* Pb = P + ((size_t)b * SEQ + res) * PW;
    const size_t rs = (size_t)dil * PW;
    AttnQ A, B;
    { const bf16* qp = Pb + (size_t)(32 * qt + r) * rs + P_QB + 64 * hh + 8 * h;
#pragma unroll
      for (int s = 0; s < 4; ++s) { A.qf[s] = *(const bf16x8*)(qp + 16 * s); B.qf[s] = *(const bf16x8*)(qp + 32 * rs + 16 * s); } }
#pragma unroll
    for (int i = 0; i < 16; ++i) { A.o0[i] = 0.f; A.o1[i] = 0.f; B.o0[i] = 0.f; B.o1[i] = 0.f; }
    A.m = -1e30f; A.l = 0.f; B.m = -1e30f; B.l = 0.f;
    const bf16* kbase = Pb + (size_t)(lane >> 3) * rs + P_KB + 64 * hh + 8 * (lane & 7);
    const bf16* vbase = Pb + (size_t)(lane >> 3) * rs + P_VB + 64 * hh + 8 * (lane & 7);
    unsigned dmask = 0u, lmask = 0u;
#pragma unroll
    for (int i = 0; i < 16; ++i) { dmask |= (crow(i, h) <= r) ? (1u << i) : 0u; lmask |= (crow(i, h) >= r) ? (1u << i) : 0u; }
    for (int kt = (qt > 4 ? qt - 4 : 0); kt <= qt + 1; ++kt) {
        AttnOperands T; attn_load(T, kbase + (size_t)32 * kt * rs, vbase + (size_t)32 * kt * rs, 8 * rs);
        const int dA = qt - kt, dB = dA + 1;
        const int modeA = (dA < 0 || dA > 4) ? 0 : (dA == 0 || dA == 4) ? 2 : 1, modeB = (dB < 0 || dB > 4) ? 0 : (dB == 0 || dB == 4) ? 2 : 1;
        attn_compute2(A, B, T, vt, lane, dA == 0 ? dmask : lmask, modeA, dB == 0 ? dmask : lmask, modeB);
    }
    A.l = pair32_sum(A.l); B.l = pair32_sum(B.l);
    const size_t rowA = (size_t)b * SEQ + (size_t)(32 * qt + r) * dil + res, rowB = rowA + (size_t)32 * dil;
    attn_store(A.o0, A.o1, fast_rcp(A.l), DO + rowA * 256 + 64 * hh, h);
    attn_store(B.o0, B.o1, fast_rcp(B.l), DO + rowB * 256 + 64 * hh, h);
    if (h == 0) { LS[rowA * 4 + hh] = A.m + __builtin_amdgcn_logf(A.l); LS[rowB * 4 + hh] = B.m + __builtin_amdgcn_logf(B.l); }
}

#include <hip/hip_bf16.h>
#include <cmath>
namespace attn_body {
using bf16=__hip_bfloat16;
using bf16x8=__attribute__((ext_vector_type(8)))short;
using s16x4=__attribute__((ext_vector_type(4)))short;
using f32x16=__attribute__((ext_vector_type(16)))float;
using f32x4=__attribute__((ext_vector_type(4)))float;
using u32x4=__attribute__((ext_vector_type(4)))unsigned;
constexpr int SEQ=2048,D=64,DM=2304,OP=256;
constexpr int NW=8,QBLK=32,QB=QBLK*NW,KVBLK=64,NQB=SEQ/QB;
__device__ __forceinline__ int crow(int r,int hi){return (r&3)+8*(r>>2)+4*hi;}
#define SBAR() __builtin_amdgcn_sched_barrier(0)
__device__ __forceinline__ void cmask(f32x16&p0,f32x16&p1,int jb,int qrel,int hi){
  const float NEG=-INFINITY; int kb=64*jb+4*hi;
  #pragma unroll
  for(int r=0;r<16;++r){int kv=kb+(r&3)+8*(r>>2); if(kv>qrel)p0[r]=NEG; if(kv+32>qrel)p1[r]=NEG;}
}

constexpr int NSLOT=3, SLOTB=8192;
constexpr int LDS_K=0, LDS_V=NSLOT*SLOTB, LDS_WS=2*NSLOT*SLOTB, LDS_OST=LDS_WS+NW*64*4, LDS_BYTES=LDS_OST+NW*4096;
constexpr float C2=0.125f*1.4426950408889634f;
__device__ __forceinline__ void glds16(const void*gsrc,unsigned lds_dst){unsigned keep;
  asm volatile("s_mov_b32 %0, m0\n\ts_mov_b32 m0, %2\n\ts_nop 0\n\tglobal_load_lds_dwordx4 %1, off\n\ts_mov_b32 m0, %0":"=&s"(keep):"v"(gsrc),"s"(lds_dst):"memory");}
__device__ __forceinline__ float max3f(float a,float b,float c){float r;asm("v_max3_f32 %0, %1, %2, %3":"=v"(r):"v"(a),"v"(b),"v"(c));return r;}
__device__ __forceinline__ float max2f(float a,float b){float r;asm("v_max_f32_e32 %0, %1, %2":"=v"(r):"v"(a),"v"(b));return r;}
__device__ __forceinline__ float fadd_s(float a,float b){float r;asm("v_add_f32_e32 %0, %1, %2":"=v"(r):"v"(a),"v"(b));return r;}
__device__ __forceinline__ float fsub_s(float a,float b){float r;asm("v_sub_f32_e32 %0, %1, %2":"=v"(r):"v"(a),"v"(b));return r;}
typedef float f32x2_t __attribute__((ext_vector_type(2))); typedef __bf16 bf16x2_t __attribute__((ext_vector_type(2)));
__device__ __forceinline__ unsigned cvtpk_s(float lo,float hi){f32x2_t v={lo,hi};bf16x2_t b=__builtin_convertvector(v,bf16x2_t);return __builtin_bit_cast(unsigned,b);}
#define WAIT_BAR(N) asm volatile("s_waitcnt vmcnt(" #N ") lgkmcnt(0)\n\ts_barrier":::"memory")

__device__ __forceinline__ void qkt(f32x16&p0,f32x16&p1,const char*Kslot,const bf16x8*qr,const f32x16&negm,int r32,int hi){
  const char*kb=Kslot+hi*1024+r32*16;
  #pragma unroll
  for(int d0=0;d0<4;++d0){
    const bf16x8 b0=*reinterpret_cast<const bf16x8*>(kb+d0*2048);
    const bf16x8 b1=*reinterpret_cast<const bf16x8*>(kb+d0*2048+512);
    if(d0==0){p0=__builtin_amdgcn_mfma_f32_32x32x16_bf16(b0,qr[0],negm,0,0,0);p1=__builtin_amdgcn_mfma_f32_32x32x16_bf16(b1,qr[0],negm,0,0,0);}
    else{p0=__builtin_amdgcn_mfma_f32_32x32x16_bf16(b0,qr[d0],p0,0,0,0);p1=__builtin_amdgcn_mfma_f32_32x32x16_bf16(b1,qr[d0],p1,0,0,0);}}
}
typedef __attribute__((address_space(3))) const char* lds_cptr;
typedef short v4i16_t __attribute__((ext_vector_type(4)));
__device__ __forceinline__ void kload8(bf16x8*kf,lds_cptr kp){
  kf[0]=*(const __attribute__((address_space(3))) bf16x8*)(kp);      kf[1]=*(const __attribute__((address_space(3))) bf16x8*)(kp+512);
  kf[2]=*(const __attribute__((address_space(3))) bf16x8*)(kp+2048); kf[3]=*(const __attribute__((address_space(3))) bf16x8*)(kp+2560);
  kf[4]=*(const __attribute__((address_space(3))) bf16x8*)(kp+4096); kf[5]=*(const __attribute__((address_space(3))) bf16x8*)(kp+4608);
  kf[6]=*(const __attribute__((address_space(3))) bf16x8*)(kp+6144); kf[7]=*(const __attribute__((address_space(3))) bf16x8*)(kp+6656);
}
__device__ __forceinline__ void kload2(bf16x8*kf,lds_cptr kp,int j){ kf[2*j]=*(const __attribute__((address_space(3))) bf16x8*)(kp+j*2048); kf[2*j+1]=*(const __attribute__((address_space(3))) bf16x8*)(kp+j*2048+512); }
__device__ __forceinline__ s16x4 vtr(lds_cptr p){ return __builtin_bit_cast(s16x4,__builtin_amdgcn_ds_read_tr16_b64_v4i16((__attribute__((address_space(3))) v4i16_t*)p)); }
__device__ __forceinline__ float rowmax(const f32x16&p0,const f32x16&p1){
  float a=max3f(p0[0],p0[1],p1[0]),b=max3f(p0[2],p0[3],p1[1]);a=max3f(a,p1[2],p1[3]);
  #pragma unroll
  for(int r=4;r<16;r+=4){a=max3f(a,p0[r],p0[r+1]);b=max3f(b,p0[r+2],p0[r+3]);a=max3f(a,p1[r],p1[r+1]);b=max3f(b,p1[r+2],p1[r+3]);}
  const float m=max2f(a,b);
  auto rr=__builtin_amdgcn_permlane32_swap(__float_as_uint(m),__float_as_uint(m),false,false);
  return max2f(__uint_as_float(rr[0]),__uint_as_float(rr[1]));
}
__device__ __forceinline__ void pv(f32x16*o,int vb,bf16x8 pa0,bf16x8 pa1,bf16x8 pa2,bf16x8 pa3){
  #pragma unroll
  for(int d0=0;d0<2;++d0){s16x4 lo[4],hi[4];
    #pragma unroll
    for(int ks=0;ks<4;++ks){
      asm volatile("ds_read_b64_tr_b16 %0,%1 offset:%c2":"=&v"(lo[ks]):"v"(vb),"i"(d0*4096+ks*1024):"memory");
      asm volatile("ds_read_b64_tr_b16 %0,%1 offset:%c2":"=&v"(hi[ks]):"v"(vb),"i"(d0*4096+ks*1024+512):"memory");}
    asm volatile("s_waitcnt lgkmcnt(0)":::"memory");SBAR();
    #define PK(k) (bf16x8){lo[k][0],lo[k][1],lo[k][2],lo[k][3],hi[k][0],hi[k][1],hi[k][2],hi[k][3]}
    o[d0]=__builtin_amdgcn_mfma_f32_32x32x16_bf16(pa0,PK(0),o[d0],0,0,0);
    o[d0]=__builtin_amdgcn_mfma_f32_32x32x16_bf16(pa1,PK(1),o[d0],0,0,0);
    o[d0]=__builtin_amdgcn_mfma_f32_32x32x16_bf16(pa2,PK(2),o[d0],0,0,0);
    o[d0]=__builtin_amdgcn_mfma_f32_32x32x16_bf16(pa3,PK(3),o[d0],0,0,0);
    #undef PK
  }
}

#ifndef ATTN_STORE16
#define ATTN_STORE16(p,v) (*(u32x4*)(p)=(v))
#endif
template<int THRL> __device__ __forceinline__ void attn_unit(int tid,int b,int h,int qb,const bf16*Q,const bf16*__restrict__ K,const bf16*__restrict__ V,bf16*O,const float*__restrict__ kms,char*shm){
  asm volatile("":"+v"(tid));
  const int lane=tid&63,r32=lane&31,hi=lane>>5; const int wid=__builtin_amdgcn_readfirstlane(tid>>6);
  const long rowbase=(long)b*SEQ; const int q0=qb*QB;
  const bf16*Qw=Q+(rowbase+q0+wid*QBLK)*DM+h*D;
  const bf16*Kh=K+rowbase*DM+h*D,*Vh=V+rowbase*DM+h*D;
  const unsigned lds0=(unsigned)(uintptr_t)shm;
  float*wsf=(float*)(shm+LDS_WS)+wid*64;
  const bf16*ksrc=Kh+(long)lane*DM+wid*8;
  const bf16*vsrc=Vh+(long)(16*(wid&3)+(lane>>2))*DM+(wid>>2)*32+(lane&3)*8;
  const unsigned kdst=lds0+LDS_K+wid*1024, vdst=lds0+LDS_V+wid*1024;
  #define DMA_K(t,slot) glds16(ksrc+(long)(t)*KVBLK*DM,(unsigned)__builtin_amdgcn_readfirstlane(kdst+(slot)))
  #define DMA_V(t,slot) glds16(vsrc+(long)(t)*KVBLK*DM,(unsigned)__builtin_amdgcn_readfirstlane(vdst+(slot)))
  const int vb0=(int)(lds0+LDS_V)+((lane>>4)&1)*32+(lane&3)*8+(4*hi+((lane&15)>>2))*64;
  const char*Kbase=shm+LDS_K; bf16x8 kf[8];
  const lds_cptr shm3=(lds_cptr)shm; const lds_cptr kp0=shm3+LDS_K+hi*1024+r32*16; const lds_cptr vp0=shm3+LDS_V+((lane>>4)&1)*32+(lane&3)*8+(4*hi+((lane&15)>>2))*64;
  const int NT=(q0+QB)/KVBLK;
  DMA_K(0,0);DMA_V(0,0);DMA_K(1,SLOTB);
  bf16x8 qr[4];
  #pragma unroll
  for(int d0=0;d0<4;++d0)qr[d0]=*reinterpret_cast<const bf16x8*>(&Qw[(long)r32*DM+d0*16+hi*8]);
  unsigned sel=(1u<<qb)-1u;
  if(qb>3){
    f32x16 g=f32x16{};
    const float*kmr=kms+(long)((b*8+(r32&7))*4+h)*64+8*hi;
    #pragma unroll
    for(int s=0;s<4;++s){
      f32x4 a=f32x4{0.f,0.f,0.f,0.f},c=a;
      if(r32<qb){a=*reinterpret_cast<const f32x4*>(kmr+16*s);c=*reinterpret_cast<const f32x4*>(kmr+16*s+4);}
      const float v[8]={a[0],a[1],a[2],a[3],c[0],c[1],c[2],c[3]}; unsigned hw[4],lw[4];
      #pragma unroll
      for(int e=0;e<4;++e){hw[e]=cvtpk_s(v[2*e],v[2*e+1]);lw[e]=cvtpk_s(v[2*e]-__uint_as_float(hw[e]<<16),v[2*e+1]-__uint_as_float(hw[e]&0xffff0000u));}
      const bf16x8 khi=__builtin_bit_cast(bf16x8,(u32x4){hw[0],hw[1],hw[2],hw[3]}),klo=__builtin_bit_cast(bf16x8,(u32x4){lw[0],lw[1],lw[2],lw[3]});
      g=__builtin_amdgcn_mfma_f32_32x32x16_bf16(khi,qr[s],g,0,0,0);g=__builtin_amdgcn_mfma_f32_32x32x16_bf16(klo,qr[s],g,0,0,0);
    }
    float gate[8];
    #pragma unroll
    for(int i=0;i<4;++i){auto rr=__builtin_amdgcn_permlane32_swap(__float_as_uint(g[i]),__float_as_uint(g[i]),false,false);const float oth=__uint_as_float(hi?rr[0]:rr[1]);gate[i]=hi?oth:g[i];gate[4+i]=hi?g[i]:oth;}
    sel=0u;
    #pragma unroll
    for(int k=0;k<3;++k){float best=-INFINITY;int bi=0;
      #pragma unroll
      for(int n=0;n<8;++n){const bool c=(n<qb)&&!((sel>>n)&1u)&&(gate[n]>best);best=c?gate[n]:best;bi=c?n:bi;}
      sel|=1u<<bi;}
  }
  float mhat=0.f,l_reg=0.f;f32x16 o[2];o[0]=f32x16{};o[1]=f32x16{};f32x16 negm=f32x16{};asm volatile("":"+v"(negm));
  const int qrel=wid*QBLK+r32;
  #define CMASK(P0,P1,t) do{int jb_=(t)-(NT-4); if(jb_>=0)cmask(P0,P1,jb_,qrel,hi);}while(0)
  bool resc=false;
  #define START(P0,P1) do{ const float rm=rowmax(P0,P1); resc=false; \
    { const float dl=fmaxf(rm,-128.f); mhat=fadd_s(mhat,dl); \
      _Pragma("unroll") for(int r=0;r<16;++r){P0[r]=fsub_s(P0[r],dl);P1[r]=fsub_s(P1[r],dl);} \
      _Pragma("unroll") for(int r=0;r<16;++r)negm[r]=-mhat; asm volatile("":"+v"(negm)); } \
    _Pragma("unroll") for(int r=0;r<16;++r)P0[r]=__builtin_amdgcn_exp2f(P0[r]); }while(0)
  #define RESC() do{ if(resc){ asm volatile("s_waitcnt lgkmcnt(0)":::"memory"); \
      _Pragma("unroll") for(int d_=0;d_<2;++d_) _Pragma("unroll") for(int r=0;r<16;++r)o[d_][r]*=wsf[crow(r,hi)]; } }while(0)
  f32x16 pA0,pA1,pB0,pB1;
  int sl_prev=0,sl_cur=0,sl_next=SLOTB;
  #define ROT() do{sl_prev=sl_cur;sl_cur=sl_next;sl_next=(sl_next==(NSLOT-1)*SLOTB)?0:sl_next+SLOTB;}while(0)
  DMA_K(2,2*SLOTB);
  WAIT_BAR(3);
  { const float nm_=((sel&1u)||NT==4)?0.f:-INFINITY; _Pragma("unroll") for(int r_=0;r_<16;++r_)negm[r_]=nm_; asm volatile("":"+v"(negm)); }
  qkt(pA0,pA1,Kbase,qr,negm,r32,hi);asm volatile("s_nop 15\n\ts_nop 7":"+v"(pA0),"+v"(pA1));CMASK(pA0,pA1,0);
  START(pA0,pA1);
  _Pragma("unroll") for(int r=0;r<16;++r)pA1[r]=__builtin_amdgcn_exp2f(pA1[r]);
  WAIT_BAR(0);
  DMA_K(3,0);DMA_V(1,SLOTB);
  ROT();
  kload8(kf,kp0+sl_cur);
  WAIT_BAR(2);
  s16x4 vlo[8],vhi[8]; u32x4 pw0,pw1,pw2,pw3;
  #define PKW(P,B) cvtpk_s(P[B],P[B+1])
  #define PAF(k) __builtin_bit_cast(bf16x8,pw##k)
  #define VFR(i) (bf16x8){vlo[i][0],vlo[i][1],vlo[i][2],vlo[i][3],vhi[i][0],vhi[i][1],vhi[i][2],vhi[i][3]}
  #define PIN(x) asm volatile("":"+v"(x))
  #define MX3(a,b,c) __builtin_fmaxf(__builtin_fmaxf((a),(b)),(c))
  #define GAPA(MF,A0,A1,A2,A3,W0,W1,PW) do{ MF; sacc+=A0; sacc+=A1; sacc+=A2; sacc+=A3; PIN(sacc); W0; W1; PIN(PW); SBAR(); }while(0)
  #define EX(v) __builtin_amdgcn_exp2f(v)
  #define GAPB(MF,X,B) do{ MF; X[B]=EX(X[B]); X[B+1]=EX(X[B+1]); X[B+2]=EX(X[B+2]); X[B+3]=EX(X[B+3]); PIN(X); SBAR(); }while(0)
  #define VRD(i) do{ vlo[i]=vtr(vp_+(((i)>>2)*4096+((i)&3)*1024)); vhi[i]=vtr(vp_+(((i)>>2)*4096+((i)&3)*1024+512)); }while(0)
  #define KRD(G,j) do{ if(G){ kload2(kf,kp0+sl_next,j); SBAR(); } }while(0)
  #define STEP(C0,C1,P0,P1,t,GK,GV,GL) do{ SBAR(); \
    { const float nm_=(((sel>>((t)>>2))&1u)||((t)>=NT-4))?-mhat:-INFINITY; _Pragma("unroll") for(int r_=0;r_<16;++r_)negm[r_]=nm_; asm volatile("":"+v"(negm)); } \
    const lds_cptr vp_=vp0+sl_prev; \
    VRD(0); SBAR(); float sacc=(P0[0]+P0[1]); \
    GAPA(C0=__builtin_amdgcn_mfma_f32_32x32x16_bf16(kf[0],qr[0],negm,0,0,0), P0[2],P0[3],P0[4],P0[5],     pw0[0]=PKW(P0,0), pw0[1]=PKW(P0,2), pw0); \
    VRD(4); SBAR(); GAPA(C1=__builtin_amdgcn_mfma_f32_32x32x16_bf16(kf[1],qr[0],negm,0,0,0), P0[6],P0[7],P0[8],P0[9],     pw0[2]=PKW(P0,4), pw0[3]=PKW(P0,6), pw0); \
    VRD(1); SBAR(); GAPA(C0=__builtin_amdgcn_mfma_f32_32x32x16_bf16(kf[2],qr[1],C0,0,0,0),   P0[10],P0[11],P0[12],P0[13], pw1[0]=PKW(P0,8), pw1[1]=PKW(P0,10), pw1); \
    VRD(5); SBAR(); GAPA(C1=__builtin_amdgcn_mfma_f32_32x32x16_bf16(kf[3],qr[1],C1,0,0,0),   P0[14],P0[15],P1[0],P1[1],   pw1[2]=PKW(P0,12),pw1[3]=PKW(P0,14), pw1); \
    VRD(2); SBAR(); GAPA(C0=__builtin_amdgcn_mfma_f32_32x32x16_bf16(kf[4],qr[2],C0,0,0,0),   P1[2],P1[3],P1[4],P1[5],     pw2[0]=PKW(P1,0), pw2[1]=PKW(P1,2), pw2); \
    VRD(6); SBAR(); GAPA(C1=__builtin_amdgcn_mfma_f32_32x32x16_bf16(kf[5],qr[2],C1,0,0,0),   P1[6],P1[7],P1[8],P1[9],     pw2[2]=PKW(P1,4), pw2[3]=PKW(P1,6), pw2); \
    VRD(3); SBAR(); GAPA(C0=__builtin_amdgcn_mfma_f32_32x32x16_bf16(kf[6],qr[3],C0,0,0,0),   P1[10],P1[11],P1[12],P1[13], pw3[0]=PKW(P1,8), pw3[1]=PKW(P1,10), pw3); \
    VRD(7); SBAR(); GAPA(C1=__builtin_amdgcn_mfma_f32_32x32x16_bf16(kf[7],qr[3],C1,0,0,0),   P1[14],P1[15],0.f,0.f,       pw3[2]=PKW(P1,12),pw3[3]=PKW(P1,14), pw3); \
    l_reg+=sacc; \
    if(GK){DMA_K((t)+3,sl_cur);} if(GV){DMA_V((t)+1,sl_next);} \
    CMASK(C0,C1,t); \
    { float a=MX3(C0[0],C0[1],C1[0]),b=MX3(C0[2],C0[3],C1[1]); a=MX3(a,C1[2],C1[3]); \
      _Pragma("unroll") for(int r=4;r<16;r+=4){a=MX3(a,C0[r],C0[r+1]);b=MX3(b,C0[r+2],C0[r+3]);a=MX3(a,C1[r],C1[r+1]);b=MX3(b,C1[r+2],C1[r+3]);} \
      float rm=__builtin_fmaxf(a,b); { auto rr=__builtin_amdgcn_permlane32_swap(__float_as_uint(rm),__float_as_uint(rm),false,false); rm=__builtin_fmaxf(__uint_as_float(rr[0]),__uint_as_float(rr[1])); } \
      resc=false; \
      if(__builtin_expect(__any(rm>(float)THRL),0)){ const float dl=__builtin_fmaxf(rm,0.f); mhat+=dl; \
        _Pragma("unroll") for(int r=0;r<16;++r){C0[r]-=dl;C1[r]-=dl;} \
        _Pragma("unroll") for(int r=0;r<16;++r)negm[r]=-mhat; asm volatile("":"+v"(negm)); \
        const float f=__builtin_amdgcn_exp2f(-dl); l_reg*=f; if(hi==0)wsf[r32]=f; resc=true; } } \
    SBAR(); \
    GAPB(o[0]=__builtin_amdgcn_mfma_f32_32x32x16_bf16(PAF(0),VFR(0),o[0],0,0,0), C0,0); \
    GAPB(o[1]=__builtin_amdgcn_mfma_f32_32x32x16_bf16(PAF(0),VFR(4),o[1],0,0,0), C0,4); \
    KRD(GL,0); GAPB(o[0]=__builtin_amdgcn_mfma_f32_32x32x16_bf16(PAF(1),VFR(1),o[0],0,0,0), C0,8); \
    KRD(GL,1); GAPB(o[1]=__builtin_amdgcn_mfma_f32_32x32x16_bf16(PAF(1),VFR(5),o[1],0,0,0), C0,12); \
    KRD(GL,2); GAPB(o[0]=__builtin_amdgcn_mfma_f32_32x32x16_bf16(PAF(2),VFR(2),o[0],0,0,0), C1,0); \
    KRD(GL,3); GAPB(o[1]=__builtin_amdgcn_mfma_f32_32x32x16_bf16(PAF(2),VFR(6),o[1],0,0,0), C1,4); \
    GAPB(o[0]=__builtin_amdgcn_mfma_f32_32x32x16_bf16(PAF(3),VFR(3),o[0],0,0,0), C1,8); \
    GAPB(o[1]=__builtin_amdgcn_mfma_f32_32x32x16_bf16(PAF(3),VFR(7),o[1],0,0,0), C1,12); \
    }while(0)
  int t=1;
  #undef CMASK
  #define CMASK(P0,P1,t) do{}while(0)
  for(;t+5<NT;t+=2){
    STEP(pB0,pB1,pA0,pA1,t,true,true,true);     WAIT_BAR(2); RESC(); ROT();
    STEP(pA0,pA1,pB0,pB1,t+1,true,true,true);   WAIT_BAR(2); RESC(); ROT();
  }
  #undef CMASK
  #define CMASK(P0,P1,t) do{int jb_=(t)-(NT-4); if(jb_>=0)cmask(P0,P1,jb_,qrel,hi);}while(0)
  #define ENDW(tt) do{ if((tt)+3<NT){WAIT_BAR(2);} else if((tt)+2<NT){WAIT_BAR(1);} else {WAIT_BAR(0);} }while(0)
  for(;t+1<NT;t+=2){
    STEP(pB0,pB1,pA0,pA1,t,(t+3<NT),(t+1<NT),(t+1<NT));       ENDW(t);   RESC(); ROT();
    STEP(pA0,pA1,pB0,pB1,t+1,(t+4<NT),(t+2<NT),(t+2<NT));     ENDW(t+1); RESC(); ROT();
  }
  STEP(pB0,pB1,pA0,pA1,NT-1,false,false,false); RESC();
  { float sacc=pB0[0]+pB0[1]; _Pragma("unroll") for(int r=2;r<16;++r)sacc+=pB0[r]; _Pragma("unroll") for(int r=0;r<16;++r)sacc+=pB1[r]; l_reg+=sacc;
    pw0=(u32x4){PKW(pB0,0),PKW(pB0,2),PKW(pB0,4),PKW(pB0,6)};pw1=(u32x4){PKW(pB0,8),PKW(pB0,10),PKW(pB0,12),PKW(pB0,14)};pw2=(u32x4){PKW(pB1,0),PKW(pB1,2),PKW(pB1,4),PKW(pB1,6)};pw3=(u32x4){PKW(pB1,8),PKW(pB1,10),PKW(pB1,12),PKW(pB1,14)};
    SBAR(); pv(o,vb0+sl_cur,PAF(0),PAF(1),PAF(2),PAF(3)); }
  #undef PKW
  #undef PAF
  #undef VFR
  #undef PIN
  #undef MX3
  #undef GAPA
  #undef GAPB
  #undef EX
  #undef VRD
  #undef KRD
  #undef STEP
  #undef ENDW
  {auto rr=__builtin_amdgcn_permlane32_swap(__float_as_uint(l_reg),__float_as_uint(l_reg),false,false);l_reg=__uint_as_float(rr[0])+__uint_as_float(rr[1]);}
  if(hi==0)wsf[32+r32]=l_reg;asm volatile("s_waitcnt lgkmcnt(0)":::"memory");
  float rli[16];
  #pragma unroll
  for(int r=0;r<16;++r)rli[r]=__builtin_amdgcn_rcpf(wsf[32+crow(r,hi)]);
  bf16*Ow=O+(rowbase+q0+wid*QBLK)*OP+h*D;
  { bf16*stg=(bf16*)(shm+LDS_OST)+wid*2048;
    #pragma unroll
    for(int r=0;r<16;++r){const int orow=crow(r,hi);
      #pragma unroll
      for(int d0=0;d0<2;++d0)stg[orow*64+d0*32+r32]=__float2bfloat16(o[d0][r]*rli[r]);}
    asm volatile("s_waitcnt lgkmcnt(0)":::"memory");
    #pragma unroll
    for(int i=0;i<4;++i){const int row=i*8+(lane>>3),ch=lane&7; const u32x4 v=*(const u32x4*)(stg+row*64+ch*8); ATTN_STORE16(Ow+(long)row*OP+ch*8,v);} }
  asm volatile("s_waitcnt lgkmcnt(0)\n\ts_barrier":::"memory");
  #undef DMA_K
  #undef DMA_V
  #undef CMASK
  #undef START
  #undef RESC
  #undef ROT
}
constexpr int ATTN_LDS_BYTES=LDS_BYTES;
#undef SBAR
#undef WAIT_BAR
}

constexpr size_t MiB = 1u << 20;
constexpr size_t WS_CTL = 0, CTL_ZERO_BYTES = 1 * MiB;
constexpr size_t WS_MOD = 1 * MiB;
constexpr size_t WS_RTE = 2 * MiB, WS_RTP = WS_RTE + 256 * 1024, WS_RTG = WS_RTP + 256 * 1024, WS_S2T = WS_RTG + 256 * 1024;
constexpr size_t WS_WIN = 4 * MiB, WS_WOUT = 14 * MiB, WS_WFGU = 18 * MiB, WS_WFD = 29 * MiB, WS_WMGU = 35 * MiB, WS_WMD = 91 * MiB;
constexpr size_t WS_XB = 119 * MiB;
constexpr size_t WS_HB = 203 * MiB;
constexpr size_t WS_R = 267 * MiB;
constexpr size_t WS_P = WS_R, WS_DIL = WS_R + 144 * MiB, WS_LSE = WS_R + 192 * MiB, WS_OA = WS_R + 194 * MiB, WS_OC = WS_R + 210 * MiB, WS_OD = WS_R + 226 * MiB;
constexpr size_t WS_Y = WS_R;
constexpr size_t WS_FH = WS_R;
constexpr size_t WS_HID = WS_R, HID_BYTES = 56 * MiB, WS_YS = WS_R + 112 * MiB;
constexpr size_t WS_END = WS_R + 244 * MiB;
constexpr int CW_BAR = 4096;
constexpr int CW_TS = 12288;
constexpr int CW_CNT = 8192;
constexpr int CW_KM = 16384;
static_assert((CW_KM + 2 * 32768 * 1) * 4 <= (int)CTL_ZERO_BYTES + 0 || true, "");
static_assert((size_t)(CW_KM + 2 * 32768) * 4 <= CTL_ZERO_BYTES, "CTL region");
constexpr int CW_DQ = 131072;
static_assert((size_t)(CW_DQ + 2048) * 4 <= CTL_ZERO_BYTES, "CTL region");

constexpr int RING_BYTES = 131072, LDSX_OFF = RING_BYTES, LDS_BYTES = 147456;

#define XB_TMO      128
#define XB_XCNT(j)  (256  + 64 * (j))
#define XB_XSUB(j)  (1280 + 64 * (j))
#define XB_XGEN(j)  (2304 + 64 * (j))
#define XB_TOP      3328
#define XB_TOPGEN   3392
#define XCD_BAR_WORDS 3456
#define XB_SPIN_CAP (1u << 18)
__device__ __forceinline__ unsigned xb_ld(unsigned* p)              { return __hip_atomic_load(p, __ATOMIC_RELAXED, __HIP_MEMORY_SCOPE_AGENT); }
__device__ __forceinline__ unsigned xb_add(unsigned* p, unsigned v) { return __hip_atomic_fetch_add(p, v, __ATOMIC_RELAXED, __HIP_MEMORY_SCOPE_AGENT); }
__device__ __forceinline__ unsigned xb_xcc_id() { return (unsigned)__builtin_amdgcn_s_getreg((3 << 11) | 20) & 0xFu; }
#define XB_SPIN(cond, bar) do { unsigned _sp = 0; while (cond) { __builtin_amdgcn_s_sleep(1); \
    if ((++_sp & 255u) == 0u) { if (xb_ld(&(bar)[XB_TMO])) break; if (_sp > XB_SPIN_CAP) { atomicAdd(&(bar)[XB_TMO], 1u); break; } } } } while (0)
struct XcdBarrier { unsigned* bar; unsigned x; volatile LAS unsigned* st; };
__device__ __forceinline__ XcdBarrier xcd_barrier_post(unsigned* bar, volatile LAS unsigned* st, int tid) {
    XcdBarrier b; b.bar = bar; b.x = xb_xcc_id(); b.st = st;
    if (tid == 0) (void)xb_add(&bar[XB_XCNT(b.x)], 1u);
    return b;
}
__device__ __forceinline__ void xcd_barrier_complete(unsigned* bar, unsigned x, unsigned& nloc, unsigned& nx) {
    const unsigned G = gridDim.x * gridDim.y * gridDim.z;
    unsigned sum, cnt, mine, sp = 0u;
    for (;;) {
        sum = 0u; cnt = 0u; mine = 0u;
#pragma unroll
        for (unsigned j = 0; j < 16; ++j) { const unsigned c = xb_ld(&bar[XB_XCNT(j)]); sum += c; cnt += (c > 0u) ? 1u : 0u; mine = (j == x) ? c : mine; }
        if (sum == G) break;
        __builtin_amdgcn_s_sleep(1);
        if ((++sp & 255u) == 0u) { if (xb_ld(&bar[XB_TMO])) break; if (sp > XB_SPIN_CAP) { atomicAdd(&bar[XB_TMO], 1u); break; } }
    }
    nloc = mine > 0u ? mine : 1u; nx = cnt > 0u ? cnt : 1u;
}
__device__ __forceinline__ void xcd_barrier(const XcdBarrier& b, int tid) {
    asm volatile("s_waitcnt vmcnt(0)" ::: "memory");
    __syncthreads();
    if (tid == 0) {
        unsigned* bar = b.bar;
        __builtin_amdgcn_s_waitcnt(0);
        unsigned nloc = b.st[0], nx = b.st[1];
        if (nloc == 0u) { xcd_barrier_complete(bar, b.x, nloc, nx); b.st[0] = nloc; b.st[1] = nx; }
        const unsigned old = xb_add(&bar[XB_XSUB(b.x)], 1u);
        const unsigned gen = old / nloc;
        if (old + 1u == (gen + 1u) * nloc) {
            __builtin_amdgcn_fence(__ATOMIC_RELEASE, "agent");
            asm volatile("s_waitcnt vmcnt(0)" ::: "memory");
            const unsigned og = xb_add(&bar[XB_TOP], 1u);
            const unsigned tg = og / nx;
            if (og + 1u == (tg + 1u) * nx) xb_add(&bar[XB_TOPGEN], 1u);
            else XB_SPIN(xb_ld(&bar[XB_TOPGEN]) == tg, bar);
            __builtin_amdgcn_fence(__ATOMIC_ACQUIRE, "agent");
            xb_add(&bar[XB_XGEN(b.x)], 1u);
            asm volatile("s_waitcnt vmcnt(0)" ::: "memory");
        } else {
            XB_SPIN(xb_ld(&bar[XB_XGEN(b.x)]) == gen, bar);
            __builtin_amdgcn_fence(__ATOMIC_ACQUIRE, "agent");
            asm volatile("s_waitcnt vmcnt(0)" ::: "memory");
        }
    }
    __syncthreads();
}

struct Args { const void* in[26]; float* out; unsigned char* ws; int ph_lo, ph_hi; };
struct Frame {
    LAS unsigned char* lds;
    unsigned char* ws0; unsigned char* ws; unsigned* ctl; float* out;
    int tid, lane, wave, wave0, vcu;
};
typedef const __attribute__((address_space(4))) Args* ArgsP;
__device__ __forceinline__ ArgsP args_ptr() { auto p = __builtin_amdgcn_kernarg_segment_ptr(); asm volatile("" : "+s"(p)); return (ArgsP)p; }
__device__ __forceinline__ int otid(int wave0) { int t = wave0 * 64 + lane_id(); asm volatile("" : "+v"(t)); return t; }
#define REFRESH(F) do { (F).tid = otid((F).wave0); (F).lane = (F).tid & 63; (F).wave = __builtin_amdgcn_readfirstlane((F).tid >> 6); { long z_ = 0; asm volatile("" : "+s"(z_)); (F).ws = (F).ws0 + z_; } (F).ctl = (unsigned*)(F).ws; } while (0)
#define INP(A, k) ((const float*)(A)->in[k])
enum { I_X = 0, I_C, I_POS, I_ADAW, I_ADAB, I_MIXPRE, I_MIXPOST, I_FFNPRE, I_FFNPOST, I_WIN, I_WOUT, I_GROUPG, I_GMLPW, I_GMLPB, I_CONVW, I_CONVB, I_CONVLNG, I_CONVLNB,
       I_FFNWG, I_FFNWU, I_FFNWD, I_ROUTW, I_ROUTB, I_MOEWG, I_MOEWU, I_MOEWD };
#define LDS_WAIT() asm volatile("s_waitcnt lgkmcnt(0)" ::: "memory")

__device__ __forceinline__ void ld_f32_row(float (&v)[16], const float* p, int lane) {
#pragma unroll
    for (int j = 0; j < 4; ++j) { const f32x4 t = ((const f32x4*)p)[lane + 64 * j]; v[4 * j] = t[0]; v[4 * j + 1] = t[1]; v[4 * j + 2] = t[2]; v[4 * j + 3] = t[3]; }
}
__device__ __forceinline__ void ld_bf16_row(float (&v)[16], const bf16* p, int lane) {
#pragma unroll
    for (int j = 0; j < 4; ++j) { const u32x2 t = ((const u32x2*)p)[lane + 64 * j]; v[4 * j] = bflo(t.x); v[4 * j + 1] = bfhi(t.x); v[4 * j + 2] = bflo(t.y); v[4 * j + 3] = bfhi(t.y); }
}
__device__ __forceinline__ void st_f32_row(const float (&v)[16], float* p, int lane) {
#pragma unroll
    for (int j = 0; j < 4; ++j) ((f32x4*)p)[lane + 64 * j] = (f32x4){v[4 * j], v[4 * j + 1], v[4 * j + 2], v[4 * j + 3]};
}
__device__ __forceinline__ void st_bf16_row(const float (&v)[16], bf16* p, int lane) {
#pragma unroll
    for (int j = 0; j < 4; ++j) { u32x2 t; t.x = cvtpk(v[4 * j], v[4 * j + 1]); t.y = cvtpk(v[4 * j + 2], v[4 * j + 3]); ((u32x2*)p)[lane + 64 * j] = t; }
}
struct RawF32 { f32x4 v[4]; };
struct RawB16 { u32x2 v[4]; };
__device__ __forceinline__ RawF32 ldraw(const float* p, int lane) { RawF32 r;
#pragma unroll
    for (int j = 0; j < 4; ++j) r.v[j] = __builtin_nontemporal_load(((const f32x4*)p) + lane + 64 * j);
    return r; }
__device__ __forceinline__ RawB16 ldraw(const bf16* p, int lane) { RawB16 r;
#pragma unroll
    for (int j = 0; j < 4; ++j) r.v[j] = ((const u32x2*)p)[lane + 64 * j];
    return r; }
__device__ __forceinline__ void cvt_row(float (&v)[16], const RawF32& r) {
#pragma unroll
    for (int j = 0; j < 4; ++j) { v[4 * j] = r.v[j][0]; v[4 * j + 1] = r.v[j][1]; v[4 * j + 2] = r.v[j][2]; v[4 * j + 3] = r.v[j][3]; } }
__device__ __forceinline__ void cvt_row(float (&v)[16], const RawB16& r) {
#pragma unroll
    for (int j = 0; j < 4; ++j) { v[4 * j] = bflo(r.v[j].x); v[4 * j + 1] = bfhi(r.v[j].x); v[4 * j + 2] = bflo(r.v[j].y); v[4 * j + 3] = bfhi(r.v[j].y); } }
__device__ __forceinline__ float row_rstd(const float (&v)[16]) {
    float s = 0.f;
#pragma unroll
    for (int i = 0; i < 16; ++i) s += v[i] * v[i];
    return __builtin_amdgcn_rsqf(wave_sum(s) * (1.0f / D) + EPS);
}
__device__ __forceinline__ const float* mod_ptr(const Frame& F, int layer, int b, int part) { return (const float*)(F.ws + WS_MOD) + ((size_t)(layer * 16 + b) * 6 + part) * 1024; }

__device__ __forceinline__ int dst_row(int type, int n) {
    if (type == 0) return n;
    if (type == 1) return 256 * (n >> 7) + (n & 127);
    if (type == 2) return 256 * (n >> 7) + 128 + (n & 127);
    const int sl = n >> 8, cc = n & 255;
    if (sl == 0 || sl == 1 || sl == 3 || sl == 4) { const int hh = cc >> 6, d = cc & 63; return 256 * sl + 64 * hh + 32 * ((d >> 4) & 1) + 8 * ((d >> 2) & 3) + 4 * (d >> 5) + (d & 3); }
    if (sl < 8) return n;
    return 256 * (8 + ((cc >> 7) & 1)) + (sl == 9 ? 128 : 0) + (cc & 127);
}
template <bool FP8>
__device__ __forceinline__ void transpose_item_t(const float* W, int K, int N, void* WTv, int type, float wsc, LAS float* scr, int item, int lane) {
    const int nblk = N / 32, kb = item / nblk, nb = item % nblk, k0 = 64 * kb, n0 = 32 * nb;
    const int kk8 = lane >> 3, nq = lane & 7;
    f32x4 v[8];
#pragma unroll
    for (int i = 0; i < 8; ++i) v[i] = __builtin_nontemporal_load((const f32x4*)(W + (size_t)(k0 + 8 * i + kk8) * N + n0 + 4 * nq));
#pragma unroll
    for (int i = 0; i < 8; ++i)
#pragma unroll
        for (int e = 0; e < 4; ++e) scr[(4 * nq + e) * 68 + 8 * i + kk8] = v[i][e];
    LDS_WAIT(); asm volatile("" ::: "memory");
    const int c = lane & 7;
#pragma unroll
    for (int j = 0; j < 4; ++j) { const int n = (lane >> 3) + 8 * j;
        const f32x4 a = *(const LAS f32x4*)(scr + n * 68 + 8 * c), b = *(const LAS f32x4*)(scr + n * 68 + 8 * c + 4);
        const size_t off = (size_t)dst_row(type, n0 + n) * K + k0 + 8 * c;
        if constexpr (FP8) { u32x2 o; o.x = pk4_fp8(a[0] * wsc, a[1] * wsc, a[2] * wsc, a[3] * wsc); o.y = pk4_fp8(b[0] * wsc, b[1] * wsc, b[2] * wsc, b[3] * wsc); *(u32x2*)((unsigned char*)WTv + off) = o; }
        else { u32x4 o; o.x = cvtpk(a[0], a[1]); o.y = cvtpk(a[2], a[3]); o.z = cvtpk(b[0], b[1]); o.w = cvtpk(b[2], b[3]); *(u32x4*)((bf16*)WTv + off) = o; } }
    LDS_WAIT(); asm volatile("" ::: "memory");
}
__device__ __forceinline__ void transpose_item(const float* W, int K, int N, bf16* WT, int type, LAS float* scr, int item, int lane) { transpose_item_t<false>(W, K, N, WT, type, 1.f, scr, item, lane); }
__device__ __forceinline__ void transpose_item8(const float* W, int K, int N, unsigned char* WT, int type, float wsc, LAS float* scr, int item, int lane) { transpose_item_t<true>(W, K, N, WT, type, wsc, scr, item, lane); }
__device__ __forceinline__ void ada_quarter(Frame& F, ArgsP A, int a, int kc, LAS float* scr, float (&acc)[16]) {
    const int layer = a / 96, n = 64 * (a % 96) + F.lane; const float* cin = INP(A, I_C); const float* ada_w = INP(A, I_ADAW);
#pragma unroll
    for (int b = 0; b < 16; ++b) acc[b] = 0.f;
    for (int i = 0; i < 32; ++i) { const int idx = F.lane + 64 * i, b = idx >> 7, kk = idx & 127; scr[idx] = siluf_(cin[b * 1024 + kc * 128 + kk]); }
    LDS_WAIT(); asm volatile("" ::: "memory");
    const float* wp = ada_w + ((size_t)layer * 1024 + kc * 128) * 6144 + n;
#pragma unroll 2
    for (int kk = 0; kk < 128; kk += 4) { const float w0 = wp[(size_t)kk * 6144], w1 = wp[(size_t)(kk + 1) * 6144], w2 = wp[(size_t)(kk + 2) * 6144], w3 = wp[(size_t)(kk + 3) * 6144];
#pragma unroll
        for (int b = 0; b < 16; ++b) { const f32x4 c4 = *(const LAS f32x4*)(scr + b * 128 + kk); acc[b] += c4[0] * w0; acc[b] += c4[1] * w1; acc[b] += c4[2] * w2; acc[b] += c4[3] * w3; } }
    LDS_WAIT(); asm volatile("" ::: "memory");
}
constexpr int I_MG = 16 * 112, I_MD = 56 * 32, N_MOE_ITEMS = 16 * I_MG + 8 * I_MD;
__device__ __forceinline__ void moe_conv_item(Frame& F, ArgsP A, int r, LAS float* scr) {
    unsigned char* WMGU8 = F.ws + WS_WMGU; unsigned char* WMD8 = F.ws + WS_WMD;
    if (r < 8 * I_MG) { const int e = r / I_MG; transpose_item8(INP(A, I_MOEWG) + (size_t)e * 1024 * FFE, 1024, FFE, WMGU8 + (size_t)e * 2 * FFE * 1024, 1, MOE_WGU_SC, scr, r % I_MG, F.lane); return; } r -= 8 * I_MG;
    if (r < 8 * I_MG) { const int e = r / I_MG; transpose_item8(INP(A, I_MOEWU) + (size_t)e * 1024 * FFE, 1024, FFE, WMGU8 + (size_t)e * 2 * FFE * 1024, 2, MOE_WGU_SC, scr, r % I_MG, F.lane); return; } r -= 8 * I_MG;
    { const int e = r / I_MD; transpose_item8(INP(A, I_MOEWD) + (size_t)e * FFE * 1024, FFE, 1024, WMD8 + (size_t)e * 1024 * FFE, 0, MOE_WD_SC, scr, r % I_MD, F.lane); }
}
constexpr int I_IN = 16 * 80, I_OUT = 16 * 32, I_FG = 16 * 88, I_FD = 44 * 32;
constexpr int N_DEF0 = I_IN + 2 * I_OUT + 2 * I_FG + I_FD;
__device__ __forceinline__ int def_items(int layer) { return layer == 0 ? N_DEF0 + N_MOE_ITEMS / 2 : N_MOE_ITEMS / 2; }
__device__ __forceinline__ void def_conv_item(Frame& F, ArgsP A, int layer, int r, LAS float* scr) {
    if (layer == 0) {
        bf16* WIN = (bf16*)(F.ws + WS_WIN); bf16* WOUT = (bf16*)(F.ws + WS_WOUT); bf16* WFGU = (bf16*)(F.ws + WS_WFGU); bf16* WFD = (bf16*)(F.ws + WS_WFD);
        if (r < I_OUT) { transpose_item(INP(A, I_WOUT), 1024, 1024, WOUT, 0, scr, r, F.lane); return; } r -= I_OUT;
        if (r < I_FG) { transpose_item8(INP(A, I_FFNWG), 1024, FFD, (unsigned char*)WFGU, 1, MOE_WGU_SC, scr, r, F.lane); return; } r -= I_FG;
        if (r < I_FG) { transpose_item8(INP(A, I_FFNWU), 1024, FFD, (unsigned char*)WFGU, 2, MOE_WGU_SC, scr, r, F.lane); return; } r -= I_FG;
        if (r < I_FD) { transpose_item(INP(A, I_FFNWD), FFD, 1024, WFD, 0, scr, r, F.lane); return; } r -= I_FD;
        if (r < I_IN) { transpose_item(INP(A, I_WIN) + (size_t)1024 * NIN, 1024, NIN, WIN + (size_t)NIN * 1024, 3, scr, r, F.lane); return; } r -= I_IN;
        if (r < I_OUT) { transpose_item(INP(A, I_WOUT) + (size_t)1024 * 1024, 1024, 1024, WOUT + (size_t)1024 * 1024, 0, scr, r, F.lane); return; } r -= I_OUT;
        moe_conv_item(F, A, r, scr);
    } else moe_conv_item(F, A, N_MOE_ITEMS / 2 + r, scr);
}
__device__ __forceinline__ void phase_prologue(Frame& F) {
    REFRESH(F);
    LAS float* scr = (LAS float*)(F.lds + F.wave * 16384);
    ArgsP A = args_ptr();
    const bool ada_wave = (F.vcu < 192);
    float acc[16];
    if (ada_wave) ada_quarter(F, A, F.vcu, F.wave, scr, acc);
    const int gw = (F.vcu - 192) * 8 + F.wave, NGW = (NWG - 192) * 8;
    for (int it = ada_wave ? -1 : gw; it >= 0 && it < I_IN; it += NGW) transpose_item(INP(A, I_WIN), 1024, NIN, (bf16*)(F.ws + WS_WIN), 3, scr, it, F.lane);
    if (ada_wave) {
#pragma unroll
        for (int b = 0; b < 16; ++b) scr[b * 64 + F.lane] = acc[b]; }
    __syncthreads();
    if (F.wave == 0 && F.vcu < 192) { const int a = F.vcu, layer = a / 96, n = 64 * (a % 96) + F.lane;
        float* mod = (float*)(F.ws + WS_MOD); const float bias = INP(A, I_ADAB)[layer * 6144 + n];
#pragma unroll
        for (int b = 0; b < 16; ++b) { float v = bias;
#pragma unroll
            for (int q = 0; q < 8; ++q) v += ((LAS float*)(F.lds + q * 16384))[b * 64 + F.lane];
            mod[(size_t)(layer * 16 + b) * 6144 + n] = v; } }
}

__device__ __forceinline__ void norm_mod_store(const float (&x)[16], const float* g, const float* sc, const float* sh, bf16* dst, int lane, float (&h)[16]) {
    const float r = row_rstd(x);
    float gv[16], scv[16], shv[16]; ld_f32_row(gv, g, lane); ld_f32_row(scv, sc, lane); ld_f32_row(shv, sh, lane);
#pragma unroll
    for (int i = 0; i < 16; ++i) h[i] = x[i] * r * gv[i] * (1.0f + scv[i]) + shv[i];
    if (dst) st_bf16_row(h, dst, lane);
}
__device__ __forceinline__ void norm_mod(const float (&x)[16], const float (&g1s)[16], const float (&shv)[16], float (&h)[16]) {
    const float r = row_rstd(x);
#pragma unroll
    for (int i = 0; i < 16; ++i) h[i] = x[i] * r * g1s[i] + shv[i];
}
__device__ __forceinline__ void ld_g1s(float (&g1s)[16], const float* g, const float* sc, int lane) { float a[16], b[16]; ld_f32_row(a, g, lane); ld_f32_row(b, sc, lane);
#pragma unroll
    for (int i = 0; i < 16; ++i) g1s[i] = a[i] * (1.0f + b[i]); }
__device__ __forceinline__ void phase_prenorm0(Frame& F) {
    REFRESH(F);
    const int rpw = M / (NWG * 8); bf16* HB = (bf16*)(F.ws + WS_HB); ArgsP A = args_ptr(); const float* x_in = INP(A, I_X); const float* mix_pre_g = INP(A, I_MIXPRE);
    const int m0 = (F.vcu * 8 + F.wave) * rpw, b = m0 >> 11;
    float g1s[16], shv[16]; ld_g1s(g1s, mix_pre_g, mod_ptr(F, 0, b, 1), F.lane); ld_f32_row(shv, mod_ptr(F, 0, b, 0), F.lane);
    RawF32 cur = ldraw(x_in + (size_t)m0 * D, F.lane);
    for (int k = 0; k < rpw; ++k) { const int m = m0 + k;
        RawF32 nxt = cur; if (k + 1 < rpw) nxt = ldraw(x_in + (size_t)(m + 1) * D, F.lane);
        float x[16], h[16]; cvt_row(x, cur); norm_mod(x, g1s, shv, h); st_bf16_row(h, HB + (size_t)m * D, F.lane); cur = nxt; }
}
__device__ __forceinline__ void phase_postmix(Frame& F, int layer, bool moe) {
    REFRESH(F);
    const int rpw = M / (NWG * 8); bf16* HB = (bf16*)(F.ws + WS_HB); const bf16* Y = (const bf16*)(F.ws + WS_Y);
    ArgsP A = args_ptr(); const float* xsrc = INP(A, I_X); bf16* XB = (bf16*)(F.ws + WS_XB);
    const float* mix_post_g = INP(A, I_MIXPOST); const float* ffn_pre_g = INP(A, I_FFNPRE); const float* router_w = INP(A, I_ROUTW); const float* router_b = INP(A, I_ROUTB);
    LAS int* lcnt = (LAS int*)(F.lds + LDSX_OFF + 256);
    LAS int* lbase = lcnt + 8; LAS int* rinfo = lcnt + 16;
    LAS f32x4* RWL = (LAS f32x4*)F.lds;
    if (moe) { if (F.tid < 16) lcnt[F.tid] = 0;
#pragma unroll
        for (int q = 0; q < 4; ++q) { const int id = F.tid + 512 * q, ln = id & 63, hf = (id >> 6) & 1, e4 = (id >> 7) & 3, j = id >> 9;
            RWL[id] = *(const f32x4*)(router_w + (size_t)(256 * j + 4 * ln + e4) * 8 + 4 * hf); }
        __syncthreads(); }
    const int m0 = F.vcu * 8 * rpw + F.wave * rpw, b = m0 >> 11;
    float gpg[16], g1s[16], shv[16];
    { float a[16], c[16]; ld_f32_row(a, mix_post_g + layer * D, F.lane); ld_f32_row(c, mod_ptr(F, layer, b, 2), F.lane);
#pragma unroll
      for (int i = 0; i < 16; ++i) gpg[i] = a[i] * c[i]; }
    ld_g1s(g1s, ffn_pre_g + layer * D, mod_ptr(F, layer, b, 4), F.lane); ld_f32_row(shv, mod_ptr(F, layer, b, 3), F.lane);
    RawF32 xf = {}; RawB16 xb = {};
    if (layer == 0) xf = ldraw(xsrc + (size_t)m0 * D, F.lane); else xb = ldraw(XB + (size_t)m0 * D, F.lane);
    RawB16 yr = ldraw(Y + (size_t)m0 * D, F.lane);
    for (int k = 0; k < rpw; ++k) { const int rl = F.wave * rpw + k, m = m0 + k;
        RawF32 xfn = xf; RawB16 xbn = xb, yn = yr;
        if (k + 1 < rpw) { if (layer == 0) xfn = ldraw(xsrc + (size_t)(m + 1) * D, F.lane); else xbn = ldraw(XB + (size_t)(m + 1) * D, F.lane); yn = ldraw(Y + (size_t)(m + 1) * D, F.lane); }
        float x[16], y[16], h[16];
        if (layer == 0) cvt_row(x, xf); else cvt_row(x, xb);
        cvt_row(y, yr);
        const float ry = row_rstd(y);
#pragma unroll
        for (int i = 0; i < 16; ++i) x[i] += gpg[i] * (y[i] * ry);
        st_bf16_row(x, XB + (size_t)m * D, F.lane);
        norm_mod(x, g1s, shv, h);
        if (!moe) { unsigned* h8 = (unsigned*)(F.ws + WS_HB + (size_t)m * D);
#pragma unroll
            for (int j = 0; j < 4; ++j) h8[F.lane + 64 * j] = pk4_fp8(h[4 * j], h[4 * j + 1], h[4 * j + 2], h[4 * j + 3]); }
        xf = xfn; xb = xbn; yr = yn;
        if (moe) {
            { unsigned* h8 = (unsigned*)(F.ws + WS_HB + (size_t)m * D);
#pragma unroll
              for (int j = 0; j < 4; ++j) h8[F.lane + 64 * j] = pk4_fp8(h[4 * j], h[4 * j + 1], h[4 * j + 2], h[4 * j + 3]); }
            float lg[8];
#pragma unroll
            for (int e = 0; e < 8; ++e) lg[e] = 0.f;
#pragma unroll
            for (int j = 0; j < 4; ++j)
#pragma unroll
                for (int e4 = 0; e4 < 4; ++e4) { const f32x4 w0 = RWL[((j * 4 + e4) * 2 + 0) * 64 + F.lane], w1 = RWL[((j * 4 + e4) * 2 + 1) * 64 + F.lane]; const float hv = h[4 * j + e4];
                    lg[0] += hv * w0[0]; lg[1] += hv * w0[1]; lg[2] += hv * w0[2]; lg[3] += hv * w0[3]; lg[4] += hv * w1[0]; lg[5] += hv * w1[1]; lg[6] += hv * w1[2]; lg[7] += hv * w1[3]; }
#pragma unroll
            for (int e = 0; e < 8; ++e) lg[e] = wave_sum(lg[e]) + router_b[e];
            int e0 = 0; float l0 = lg[0];
#pragma unroll
            for (int e = 1; e < 8; ++e) if (lg[e] > l0) { l0 = lg[e]; e0 = e; }
            int e1 = -1; float l1 = -INFINITY;
#pragma unroll
            for (int e = 0; e < 8; ++e) if (e != e0 && lg[e] > l1) { l1 = lg[e]; e1 = e; }
            if (F.lane == 0) {
                const float g0 = fast_rcp(1.0f + __expf(l1 - l0));
                const int p0 = atomicAdd((int*)(lcnt + e0), 1), p1 = atomicAdd((int*)(lcnt + e1), 1);
                rinfo[rl * 4 + 0] = e0; rinfo[rl * 4 + 1] = e1; rinfo[rl * 4 + 2] = p0; rinfo[rl * 4 + 3] = p1;
                float* RTG = (float*)(F.ws + WS_RTG); RTG[2 * m] = g0; RTG[2 * m + 1] = 1.0f - g0;
            }
        }
    }
    if (moe) {
        __syncthreads();
        if (F.tid < 8) lbase[F.tid] = (int)__hip_atomic_fetch_add(F.ctl + CW_CNT + F.tid, (unsigned)lcnt[F.tid], __ATOMIC_RELAXED, __HIP_MEMORY_SCOPE_AGENT);
        __syncthreads();
        const int nrows = 8 * rpw;
        int* RTE = (int*)(F.ws + WS_RTE); int* RTP = (int*)(F.ws + WS_RTP);
        for (int rl = F.tid; rl < nrows; rl += 512) { const int m = F.vcu * nrows + rl; const int e0 = rinfo[rl * 4], e1 = rinfo[rl * 4 + 1];
            RTE[2 * m] = e0; RTE[2 * m + 1] = e1; RTP[2 * m] = lbase[e0] + rinfo[rl * 4 + 2]; RTP[2 * m + 1] = lbase[e1] + rinfo[rl * 4 + 3]; }
    }
}
__device__ __forceinline__ void moe_tiles(const Frame& F, int (&ts)[9], int (&cnt)[8]) {
    const u32x4 c0 = *(const u32x4*)(F.ctl + CW_CNT), c1 = *(const u32x4*)(F.ctl + CW_CNT + 4);
    const unsigned cv[8] = {c0.x, c0.y, c0.z, c0.w, c1.x, c1.y, c1.z, c1.w};
    int acc = 0;
#pragma unroll
    for (int e = 0; e < 8; ++e) { cnt[e] = __builtin_amdgcn_readfirstlane((int)cv[e]); ts[e] = acc; acc += (cnt[e] + 255) >> 8; }
    ts[8] = acc;
}
__device__ __forceinline__ void phase_moe_index(Frame& F) {
    REFRESH(F);
    int ts[9], cnt[8]; moe_tiles(F, ts, cnt);
    int* S2T = (int*)(F.ws + WS_S2T); const int* RTE = (const int*)(F.ws + WS_RTE); const int* RTP = (const int*)(F.ws + WS_RTP);
    const int gt = F.vcu * 512 + F.tid, NT = NWG * 512;
    for (int s = gt; s < ts[8] * 256; s += NT) { const int tile = s >> 8; int e = 0;
#pragma unroll
        for (int k = 1; k < 8; ++k) e += (tile >= ts[k]) ? 1 : 0;
        int c = 0, t0 = 0;
#pragma unroll
        for (int k = 0; k < 8; ++k) { c = (k == e) ? cnt[k] : c; t0 = (k == e) ? ts[k] : t0; }
        if (s - 256 * t0 >= c) S2T[((s >> 8) * 64 + (s & 63)) * 4 + ((s >> 6) & 3)] = 0; }
    for (int a = gt; a < 2 * M; a += NT) { const int e = RTE[a]; int t0 = 0;
#pragma unroll
        for (int k = 0; k < 8; ++k) t0 = (k == e) ? ts[k] : t0;
        { const int sl = 256 * t0 + RTP[a]; S2T[((sl >> 8) * 64 + (sl & 63)) * 4 + ((sl >> 6) & 3)] = a >> 1; } }
}
__device__ __forceinline__ void phase_postffn(Frame& F, int layer, bool moe) {
    REFRESH(F);
    const int rpw = M / (NWG * 8); bf16* HB = (bf16*)(F.ws + WS_HB); bf16* XB = (bf16*)(F.ws + WS_XB);
    int ts[9], cnt[8]; if (moe) moe_tiles(F, ts, cnt);
    ArgsP A = args_ptr(); const float* ffn_post_g = INP(A, I_FFNPOST); const float* mix_pre_g = INP(A, I_MIXPRE);
    const int* RTE = (const int*)(F.ws + WS_RTE); const int* RTP = (const int*)(F.ws + WS_RTP); const float* RTG = (const float*)(F.ws + WS_RTG); const bf16* YS = (const bf16*)(F.ws + WS_YS);
    const int m0 = (F.vcu * 8 + F.wave) * rpw, b = m0 >> 11;
    float gpg[16], g1s[16], shv[16];
    { float a[16], c[16]; ld_f32_row(a, ffn_post_g + layer * D, F.lane); ld_f32_row(c, mod_ptr(F, layer, b, 5), F.lane);
#pragma unroll
      for (int i = 0; i < 16; ++i) gpg[i] = a[i] * c[i]; }
    if (layer == 0) { ld_g1s(g1s, mix_pre_g + D, mod_ptr(F, 1, b, 1), F.lane); ld_f32_row(shv, mod_ptr(F, 1, b, 0), F.lane); }
#define PF_LOAD(mm, XR, YA, YB, G0, G1) do { XR = ldraw(XB + (size_t)(mm) * D, F.lane); \
        if (moe) { const int e0_ = RTE[2 * (mm)], e1_ = RTE[2 * (mm) + 1]; int t0_ = 0, t1_ = 0; \
            _Pragma("unroll") for (int q = 0; q < 8; ++q) { t0_ = (q == e0_) ? ts[q] : t0_; t1_ = (q == e1_) ? ts[q] : t1_; } \
            const size_t s0_ = (size_t)256 * t0_ + RTP[2 * (mm)], s1_ = (size_t)256 * t1_ + RTP[2 * (mm) + 1]; G0 = RTG[2 * (mm)]; G1 = RTG[2 * (mm) + 1]; \
            YA = ldraw(YS + s0_ * D, F.lane); YB = ldraw(YS + s1_ * D, F.lane); } \
        else YA = ldraw(HB + (size_t)(mm) * D, F.lane); } while (0)
    RawB16 xr, ya, yb = {}; float g0 = 0.f, g1 = 0.f;
    PF_LOAD(m0, xr, ya, yb, g0, g1);
    for (int k = 0; k < rpw; ++k) { const int m = m0 + k;
        RawB16 xn = xr, yan = ya, ybn = yb; float g0n = g0, g1n = g1;
        if (k + 1 < rpw) PF_LOAD(m + 1, xn, yan, ybn, g0n, g1n);
        float x[16], y[16], h[16];
        cvt_row(x, xr); cvt_row(y, ya);
        if (moe) { float y2[16]; cvt_row(y2, yb);
#pragma unroll
            for (int i = 0; i < 16; ++i) y[i] = g0 * y[i] + g1 * y2[i]; }
        const float ry = row_rstd(y);
#pragma unroll
        for (int i = 0; i < 16; ++i) x[i] += gpg[i] * (y[i] * ry);
        if (layer == 0) { st_bf16_row(x, XB + (size_t)m * D, F.lane); norm_mod(x, g1s, shv, h); st_bf16_row(h, HB + (size_t)m * D, F.lane); }
        else st_f32_row(x, F.out + (size_t)m * D, F.lane);
        xr = xn; ya = yan; yb = ybn; g0 = g0n; g1 = g1n;
    }
#undef PF_LOAD
}
__device__ __forceinline__ void phase_mixnorm(Frame& F, int layer) {
    REFRESH(F);
    const int rpw = M / (NWG * 8); bf16* MIXN = (bf16*)(F.ws + WS_HB);
    const bf16* OA = (const bf16*)(F.ws + WS_OA); const bf16* OC = (const bf16*)(F.ws + WS_OC); const bf16* OD = (const bf16*)(F.ws + WS_OD);
    const bf16* DIL = (const bf16*)(F.ws + WS_DIL); const float* LSE = (const float*)(F.ws + WS_LSE);
    const int lane = F.lane, hh = lane >> 4; ArgsP A = args_ptr(); const float* group_g = INP(A, I_GROUPG);
    f32x4 gg[4];
#pragma unroll
    for (int g = 0; g < 4; ++g) gg[g] = *(const f32x4*)(group_g + (size_t)(layer * 4 + g) * 256 + 4 * lane);
    struct Raw { u32x2 oa, d0, d1, d2, oc, od; float l0, l1, l2; };
#define MN_LOAD(R, mm) do { const size_t m_ = (mm); R.oa = ((const u32x2*)(OA + m_ * 256))[lane]; R.oc = ((const u32x2*)(OC + m_ * 256))[lane]; R.od = ((const u32x2*)(OD + m_ * 256))[lane]; \
        R.d0 = ((const u32x2*)(DIL + m_ * 256))[lane]; R.d1 = ((const u32x2*)(DIL + ((size_t)M + m_) * 256))[lane]; R.d2 = ((const u32x2*)(DIL + ((size_t)2 * M + m_) * 256))[lane]; \
        R.l0 = LSE[m_ * 4 + hh]; R.l1 = LSE[((size_t)M + m_) * 4 + hh]; R.l2 = LSE[((size_t)2 * M + m_) * 4 + hh]; } while (0)
    const size_t m0 = (size_t)(F.vcu * 8 + F.wave) * rpw;
    Raw cur; MN_LOAD(cur, m0);
    for (int k = 0; k < rpw; ++k) { const size_t m = m0 + k;
        Raw nxt = cur; if (k + 1 < rpw) MN_LOAD(nxt, m + 1);
        float v[4][4];
        v[0][0] = bflo(cur.oa.x); v[0][1] = bfhi(cur.oa.x); v[0][2] = bflo(cur.oa.y); v[0][3] = bfhi(cur.oa.y);
        { const float mx = fmaxf(cur.l0, fmaxf(cur.l1, cur.l2)); float w0 = fast_exp2(cur.l0 - mx), w1 = fast_exp2(cur.l1 - mx), w2 = fast_exp2(cur.l2 - mx); const float inv = fast_rcp(w0 + w1 + w2); w0 *= inv; w1 *= inv; w2 *= inv;
          v[1][0] = w0 * bflo(cur.d0.x) + w1 * bflo(cur.d1.x) + w2 * bflo(cur.d2.x); v[1][1] = w0 * bfhi(cur.d0.x) + w1 * bfhi(cur.d1.x) + w2 * bfhi(cur.d2.x);
          v[1][2] = w0 * bflo(cur.d0.y) + w1 * bflo(cur.d1.y) + w2 * bflo(cur.d2.y); v[1][3] = w0 * bfhi(cur.d0.y) + w1 * bfhi(cur.d1.y) + w2 * bfhi(cur.d2.y); }
        v[2][0] = bflo(cur.oc.x); v[2][1] = bfhi(cur.oc.x); v[2][2] = bflo(cur.oc.y); v[2][3] = bfhi(cur.oc.y);
        v[3][0] = bflo(cur.od.x); v[3][1] = bfhi(cur.od.x); v[3][2] = bflo(cur.od.y); v[3][3] = bfhi(cur.od.y);
#pragma unroll
        for (int g = 0; g < 4; ++g) {
            const float ss = wave_sum(v[g][0] * v[g][0] + v[g][1] * v[g][1] + v[g][2] * v[g][2] + v[g][3] * v[g][3]);
            const float r = __builtin_amdgcn_rsqf(ss * (1.0f / 256.0f) + EPS);
            u32x2 t; t.x = cvtpk(v[g][0] * r * gg[g][0], v[g][1] * r * gg[g][1]); t.y = cvtpk(v[g][2] * r * gg[g][2], v[g][3] * r * gg[g][3]);
            ((u32x2*)(MIXN + m * D + 256 * g))[lane] = t; }
        cur = nxt;
    }
#undef MN_LOAD
}

__device__ __forceinline__ void gmlp_unit(Frame& F, int layer, int b, int ch) {
    const bf16* P = (const bf16*)(F.ws + WS_P); bf16* OC = (bf16*)(F.ws + WS_OC);
    const size_t R0 = (size_t)b * SEQ + 128 * ch;
    LAS bf16* VT = (LAS bf16*)F.lds;
    const int lane = F.lane, w = F.wave;
    u32x2 raw[16];
#pragma unroll
    for (int k = 0; k < 16; ++k) raw[k] = ((const u32x2*)(P + (R0 + 16 * w + k) * PW + P_GV))[lane];
#pragma unroll
    for (int k = 0; k < 16; ++k) { const int s = 16 * w + k; const u32x2 t = raw[k];
        float v0 = bflo(t.x), v1 = bfhi(t.x), v2 = bflo(t.y), v3 = bfhi(t.y);
        const float s1 = wave_sum((v0 + v1) + (v2 + v3)), s2 = wave_sum((v0 * v0 + v1 * v1) + (v2 * v2 + v3 * v3));
        const float mean = s1 * (1.0f / 256.0f), var = fmaxf(s2 * (1.0f / 256.0f) - mean * mean, 0.f);
        const float rstd = __builtin_amdgcn_rsqf(var + EPS);
        v0 -= mean; v1 -= mean; v2 -= mean; v3 -= mean;
        const unsigned p0 = cvtpk(v0 * rstd, v1 * rstd), p1 = cvtpk(v2 * rstd, v3 * rstd);
        VT[(4 * lane + 0) * 136 + s] = (bf16)(p0 & 0xffffu); VT[(4 * lane + 1) * 136 + s] = (bf16)(p0 >> 16);
        VT[(4 * lane + 2) * 136 + s] = (bf16)(p1 & 0xffffu); VT[(4 * lane + 3) * 136 + s] = (bf16)(p1 >> 16); }
    __syncthreads();
    const int g = w >> 1, cb = 64 * g + 32 * (w & 1), r = lane & 31, h = lane >> 5;
    ArgsP A = args_ptr();
    const float* W = INP(A, I_GMLPW) + (size_t)(layer * 4 + g) * 128 * 128;
    const float* bias = INP(A, I_GMLPB) + (size_t)(layer * 4 + g) * 128;
#pragma unroll
    for (int tt = 0; tt < 4; ++tt) {
        f32x16 acc;
#pragma unroll
        for (int i = 0; i < 16; ++i) acc[i] = 0.f;
        const int t = 32 * tt + r;
        float ub[16], bb[16];
#pragma unroll
        for (int i = 0; i < 16; ++i) { const int to = 32 * tt + crow(i, h); ub[i] = bf2f(P[(R0 + to) * PW + P_GU + cb + r]); bb[i] = bias[to]; }
        f32x4 wa[8], wc[8];
#pragma unroll
        for (int ks = 0; ks < 2 * (tt + 1); ++ks) { const int s0 = 16 * ks + 8 * h; wa[ks] = *(const f32x4*)(W + (size_t)t * 128 + s0); wc[ks] = *(const f32x4*)(W + (size_t)t * 128 + s0 + 4); }
#pragma unroll
        for (int ks = 0; ks < 2 * (tt + 1); ++ks) {
            const int s0 = 16 * ks + 8 * h;
            float v[8] = {wa[ks][0], wa[ks][1], wa[ks][2], wa[ks][3], wc[ks][0], wc[ks][1], wc[ks][2], wc[ks][3]};
#pragma unroll
            for (int e = 0; e < 8; ++e) v[e] = (s0 + e <= t) ? v[e] : 0.f;
            u32x4 aw; aw.x = cvtpk(v[0], v[1]); aw.y = cvtpk(v[2], v[3]); aw.z = cvtpk(v[4], v[5]); aw.w = cvtpk(v[6], v[7]);
            const bf16x8 bfrag = *(const LAS bf16x8*)(VT + (cb + r) * 136 + s0);
            acc = MFMA32(__builtin_bit_cast(bf16x8, aw), bfrag, acc);
        }
#pragma unroll
        for (int i = 0; i < 16; ++i) { const int to = 32 * tt + crow(i, h); const float z = acc[i] + bb[i];
            OC[(R0 + to) * 256 + cb + r] = (bf16)(cvtpk(ub[i] * z, 0.f) & 0xffffu); }
    }
    __syncthreads();
}
__device__ __forceinline__ void conv_unit(Frame& F, int layer, int b, int ch) {
    const bf16* P = (const bf16*)(F.ws + WS_P); bf16* OD = (bf16*)(F.ws + WS_OD);
    const int t0 = 64 * ch; const size_t Rb = (size_t)b * SEQ;
    LAS bf16* XT = (LAS bf16*)F.lds;
    LAS float* YT = (LAS float*)(F.lds + 48128);
    for (int id = F.tid; id < 94 * 32; id += 512) { const int row = id >> 5, piece = id & 31, t = t0 - 30 + row;
        u32x4 v = (u32x4){0u, 0u, 0u, 0u};
        if (t >= 0) v = *(const u32x4*)(P + (Rb + t) * PW + P_GLU + 8 * piece);
        *(LAS u32x4*)(XT + row * 256 + 8 * piece) = v; }
    __syncthreads();
    ArgsP A = args_ptr();
    { const int c = F.tid & 255, half = F.tid >> 8; const float* conv_w = INP(A, I_CONVW);
      float wk[31];
#pragma unroll
      for (int k = 0; k < 31; ++k) wk[k] = conv_w[(size_t)(layer * 31 + k) * 256 + c];
      const float cb = INP(A, I_CONVB)[layer * 256 + c];
      float xs[62];
#pragma unroll
      for (int i = 0; i < 62; ++i) xs[i] = bf2f(XT[(32 * half + i) * 256 + c]);
#pragma unroll
      for (int j = 0; j < 32; ++j) { float y = cb;
#pragma unroll
          for (int k = 0; k < 31; ++k) y += wk[k] * xs[j + k];
          YT[(32 * half + j) * 260 + c] = y; } }
    __syncthreads();
    { const int lane = F.lane;
      const f32x4 lg = *(const f32x4*)(INP(A, I_CONVLNG) + layer * 256 + 4 * lane), lb = *(const f32x4*)(INP(A, I_CONVLNB) + layer * 256 + 4 * lane);
      for (int k = 0; k < 8; ++k) { const int t = 8 * F.wave + k;
          f32x4 y = *(const LAS f32x4*)(YT + t * 260 + 4 * lane);
          const float mean = wave_sum((y[0] + y[1]) + (y[2] + y[3])) * (1.0f / 256.0f);
          y = y - mean;
          const float rstd = __builtin_amdgcn_rsqf(wave_sum((y[0] * y[0] + y[1] * y[1]) + (y[2] * y[2] + y[3] * y[3])) * (1.0f / 256.0f) + EPS);
          float o[4];
#pragma unroll
          for (int e = 0; e < 4; ++e) o[e] = siluf_(y[e] * rstd * lg[e] + lb[e]);
          u32x2 w; w.x = cvtpk(o[0], o[1]); w.y = cvtpk(o[2], o[3]);
          ((u32x2*)(OD + (Rb + t0 + t) * 256))[lane] = w; } }
    __syncthreads();
}
__device__ __forceinline__ void phase_mixers(Frame& F, int layer) {
    REFRESH(F);
    __syncthreads();
    const bf16* P = (const bf16*)(F.ws + WS_P);
    const float* kms = (const float*)(F.ctl + CW_KM) + (size_t)layer * 32768;
    for (int rq = (REPK == 16 ? 2 : 1); rq > 0; --rq)
    for (int u = F.vcu; u < 256; u += NWG) { const int bh = u >> 2, sq = u & 3; const attn_body::bf16* Pq = (const attn_body::bf16*)P;
        for (int k2 = 0; k2 < 2; ++k2)
            attn_body::attn_unit<8>(F.tid, bh >> 2, bh & 3, k2 ? 7 - sq : sq, Pq + P_QA, Pq + P_KA, Pq + P_VA, (attn_body::bf16*)(F.ws + WS_OA), kms, (char*)F.lds); }
    REFRESH(F);
    for (int rq = (REPK == 17 ? 2 : 1); rq > 0; --rq)
    for (int u = F.vcu; u < 256; u += NWG) gmlp_unit(F, layer, u >> 4, u & 15);
    REFRESH(F);
    for (int rq = (REPK == 18 ? 2 : 1); rq > 0; --rq)
    for (int u = F.vcu; u < 512; u += NWG) conv_unit(F, layer, u >> 5, u & 31);
    REFRESH(F);
    LAS char* vt = (LAS char*)(F.lds + F.wave * ATT_WAVE_LDS);
    const int gw = F.vcu * 8 + F.wave, NGW = NWG * 8;
    const int cv_static = layer == 0 ? 4 : 3;
    ArgsP Acv = args_ptr(); int cvk = 0;
    for (int rq = (REPK == 19 ? 2 : 1); rq > 0; --rq)
    for (int it = gw; it < 3 * 2048; it += NGW) { const int cfg = it >> 11, rem = it & 2047, bh = rem >> 5, idx = rem & 31;
        dil_pair_item(P, (bf16*)(F.ws + WS_DIL) + (size_t)cfg * M * 256, (float*)(F.ws + WS_LSE) + (size_t)cfg * M * 4, cfg, bh >> 2, bh & 3, idx, vt, F.lane);
        for (int q = 0; q < 5; ++q, ++cvk) { const int ci = cvk * NGW + gw; if (cvk < cv_static && ci < def_items(layer)) def_conv_item(F, Acv, layer, ci, (LAS float*)vt); } }
    { const int q8 = (int)blockIdx.x & 7, pool0 = cv_static * NGW, pool = def_items(layer) - pool0, per = (pool + 7) >> 3;
      unsigned* head = F.ctl + CW_DQ + 1024 * layer + 64 * q8;
      for (;;) { unsigned c = 0; if (F.lane == 0) c = __hip_atomic_fetch_add(head, 1u, __ATOMIC_RELAXED, __HIP_MEMORY_SCOPE_AGENT);
          const int ci_l = __builtin_amdgcn_readfirstlane((int)c);
          if (ci_l >= per) break;
          const int ci = pool0 + q8 * per + ci_l;
          if (ci < def_items(layer)) def_conv_item(F, Acv, layer, ci, (LAS float*)vt); } }
}

constexpr int PH_PROLOGUE = 0, PH_PRENORM = 1, PH_L0 = 2, PH_L1 = 10, PH_MOE_INDEX = 15, PH_MOE_CHUNK0 = 16, PH_MOE_COMBINE = 26, PH_POSTFFN1 = 27, N_PHASES = 28;
constexpr int KSPLIT = 7, KS_BYTES = FFE / KSPLIT;
#ifndef KMASK
#define KMASK 0xFFFF
#endif
#define KON(b) (((KMASK) >> (b)) & 1)
#define NREP(b) (((REPK) == (b)) ? nrep2 : 1)
#if MK_ONE_LAUNCH
#define IN(k) true
#else
#define IN(k) (lo <= (k) && (k) < hi)
#endif
#define SEAM(k) do { if (IN(k) && IN((k) + 1)) { xcd_barrier(bar, F.wave0 * 64 + lane_id()); if (REPK == 20) xcd_barrier(bar, F.wave0 * 64 + lane_id()); \
    if (TSA >= 0) { if (blockIdx.x == 0 && F.wave0 == 0 && lane_id() == 0) __hip_atomic_store((unsigned long long*)(F.ctl + CW_TS) + (k) + 1, (unsigned long long)__builtin_amdgcn_s_memrealtime(), __ATOMIC_RELAXED, __HIP_MEMORY_SCOPE_AGENT); } } } while (0)

template <int LAYER>
__device__ __forceinline__ void run_layer(Frame& F, const XcdBarrier& bar, const int* posp, const int lo, const int hi, const int nrep2) {
        constexpr int layer = LAYER; constexpr int pb = LAYER == 0 ? PH_L0 : PH_L1;
        if (KON(2) && IN(pb)) for (int rp = NREP(2); rp > 0; --rp) {
            REFRESH(F);
            pg8::SchedPlain S; S.init(M / 256, NIN / 256, NWG, (int)blockIdx.x); S.dup = (REPK == 25); S.Bt = (const char*)(F.ws + WS_WIN) + (size_t)layer * NIN * 1024 * 2; S.tstep = (size_t)256 * 1024 * 2;
            EpiInProj E{(bf16*)(F.ws + WS_P), posp, (float*)(F.ctl + CW_KM) + (size_t)layer * 32768};
            pg8::gemm_phase(F.lds, F.wave0, (const char*)(F.ws + WS_HB), 2 * 1024, S, E);
        }
        SEAM(pb);
        if (KON(3) && IN(pb + 1)) for (int rp = NREP(3); rp > 0; --rp) phase_mixers(F, layer);
        SEAM(pb + 1);
        if (KON(4) && IN(pb + 2)) for (int rp = NREP(4); rp > 0; --rp) phase_mixnorm(F, layer);
        SEAM(pb + 2);
        if (KON(5) && IN(pb + 3)) for (int rp = NREP(5); rp > 0; --rp) {
            REFRESH(F);
            pg8::SchedPlain S; S.init(M / 256, 4, NWG, (int)blockIdx.x); S.Bt = (const char*)(F.ws + WS_WOUT) + (size_t)layer * 1024 * 1024 * 2; S.tstep = (size_t)256 * 1024 * 2;
            EpiPlain E{(bf16*)(F.ws + WS_Y), 1024, 0};
            pg8::gemm_phase(F.lds, F.wave0, (const char*)(F.ws + WS_HB), 2 * 1024, S, E);
        }
        SEAM(pb + 3);
        if (KON(6) && IN(pb + 4)) for (int rp = (layer == 0 ? NREP(6) : 1); rp > 0; --rp) phase_postmix(F, layer, layer == 1);
        SEAM(pb + 4);
        if constexpr (LAYER == 0) {
            if (KON(7) && IN(pb + 5)) for (int rp = NREP(7); rp > 0; --rp) {
                REFRESH(F);
                pg8::SchedPlain S; S.init(M / 256, 2 * FFD / 256, NWG, (int)blockIdx.x); S.dup = (REPK == 24); S.Bt = (const char*)(F.ws + WS_WFGU); S.tstep = (size_t)256 * 1024;
                EpiSwiGLU E{(bf16*)(F.ws + WS_FH), FFD};
                pg8::gemm_phase<EpiSwiGLU, pg8::SchedPlain, true>(F.lds, F.wave0, (const char*)(F.ws + WS_HB), 1024, S, E, E8_WGU, E8_ONE);
            }
            SEAM(pb + 5);
            if (KON(8) && IN(pb + 6)) for (int rp = NREP(8); rp > 0; --rp) {
                REFRESH(F);
                pg8::SchedPlain S; S.init(M / 256, 4, NWG, (int)blockIdx.x); S.Bt = (const char*)(F.ws + WS_WFD); S.tstep = (size_t)256 * FFD * 2;
                EpiPlain E{(bf16*)(F.ws + WS_HB), 1024, 0};
                pg8::gemm_phase(F.lds, F.wave0, (const char*)(F.ws + WS_FH), 2 * FFD, S, E);
            }
            SEAM(pb + 6);
            if (KON(9) && IN(pb + 7)) phase_postffn(F, 0, false);
            SEAM(pb + 7);
        } else {
            if (KON(10) && IN(PH_MOE_INDEX)) for (int rp = NREP(10); rp > 0; --rp) phase_moe_index(F);
            SEAM(PH_MOE_INDEX);
            for (int rp14 = NREP(14); rp14 > 0; --rp14)
            for (int c = 0; c < NCHUNK; ++c) {
                const int pg = PH_MOE_CHUNK0 + 2 * c;
                if (IN(pg) || IN(pg + 1)) {
                    REFRESH(F);
                    int ts[9], cnt[8]; moe_tiles(F, ts, cnt);
                    const int tile0 = CHUNK_TILES * c; int nt = ts[8] - tile0; nt = nt > CHUNK_TILES ? CHUNK_TILES : nt;
                    if (KON(11) && IN(pg) && nt > 0) for (int rp = NREP(11); rp > 0; --rp) {
                        pg8::SchedMoe<true> S; S.init(nt, 2 * FFE / 256, NWG, (int)blockIdx.x); S.Bt = (const char*)(F.ws + WS_WMGU); S.tstep = (size_t)256 * 1024; S.estride = (size_t)2 * FFE * 1024;
                        S.tile0 = tile0; S.s2t = (const int*)(F.ws + WS_S2T); S.dup = (REPK == 22); S.ksb = 0;
#pragma unroll
                        for (int k = 0; k < 7; ++k) S.ts[k] = ts[k + 1];
                        { LAS int* tab = (LAS int*)(F.lds + LDSX_OFF + 1024); S.tab = tab;
                          pg8::StaticOrder so; so.init(nt, 2 * FFE / 256, NWG, (int)blockIdx.x); const int* s2t = (const int*)(F.ws + WS_S2T);
                          int tv[8];
#pragma unroll
                          for (int i = 0; i < 8; ++i) { pg8::Unit u; const bool ok = so.next(i, u); tv[i] = (ok && F.tid < 256) ? s2t[(size_t)(tile0 + u.pm) * 256 + F.tid] : 0; }
#pragma unroll
                          for (int i = 0; i < 8; ++i) if (F.tid < 256) tab[i * 256 + F.tid] = tv[i];
                          __syncthreads(); }
                        EpiSwiGLU8 E{F.ws + WS_HID + (size_t)(c & 1) * HID_BYTES, FFE};
                        pg8::gemm_phase<EpiSwiGLU8, pg8::SchedMoe<true>, true>(F.lds, F.wave0, (const char*)(F.ws + WS_HB), 1024, S, E, E8_WGU, E8_ONE);
                    }
                    SEAM(pg);
                    if (KON(12) && IN(pg + 1) && nt > 0) for (int rp = NREP(12); rp > 0; --rp) {
                        const bool ksp = (c == NCHUNK - 1);
                        pg8::SchedMoe<false> S; S.init(nt, ksp ? 4 * KSPLIT : 4, NWG, (int)blockIdx.x); S.Bt = (const char*)(F.ws + WS_WMD); S.tstep = (size_t)256 * FFE; S.estride = (size_t)1024 * FFE;
                        S.tile0 = tile0; S.s2t = nullptr; S.tab = nullptr; S.dup = (REPK == 23); S.ksb = ksp ? KS_BYTES : 0;
#pragma unroll
                        for (int k = 0; k < 7; ++k) S.ts[k] = ts[k + 1];
                        EpiPlain E{ksp ? (bf16*)(F.ws + WS_HID + (size_t)((c & 1) ^ 1) * HID_BYTES) : (bf16*)(F.ws + WS_YS), 1024, ksp ? 0 : tile0 * 256, ksp ? (size_t)8 * 256 * 1024 : 0};
                        pg8::gemm_phase<EpiPlain, pg8::SchedMoe<false>, true>(F.lds, F.wave0, (const char*)(F.ws + WS_HID + (size_t)(c & 1) * HID_BYTES), FFE, S, E, E8_WD, E8_HID, ksp ? KS_BYTES / 128 : 0);
                    }
                    if (c == NCHUNK - 1 || !(MK_ONE_LAUNCH)) SEAM(pg + 1);
                }
            }
            if (IN(PH_MOE_COMBINE)) {
                REFRESH(F);
                int ts[9], cnt[8]; moe_tiles(F, ts, cnt);
                const int tile0 = CHUNK_TILES * (NCHUNK - 1), nrow = (ts[8] - tile0) * 256;
                const bf16* YP = (const bf16*)(F.ws + WS_HID + (size_t)(((NCHUNK - 1) & 1) ^ 1) * HID_BYTES); bf16* YS = (bf16*)(F.ws + WS_YS);
                for (int row = F.vcu * 8 + F.wave; row < nrow; row += NWG * 8) {
                    float a[16];
#pragma unroll
                    for (int i = 0; i < 16; ++i) a[i] = 0.f;
#pragma unroll
                    for (int p = 0; p < KSPLIT; ++p) { float v[16]; ld_bf16_row(v, YP + ((size_t)p * 8 * 256 + row) * 1024, F.lane);
#pragma unroll
                        for (int i = 0; i < 16; ++i) a[i] += v[i]; }
                    st_bf16_row(a, YS + ((size_t)tile0 * 256 + row) * 1024, F.lane);
                }
            }
            SEAM(PH_MOE_COMBINE);
            if (KON(13) && IN(PH_POSTFFN1)) phase_postffn(F, 1, true);
        }
}
__global__ void __launch_bounds__(512, 2) fwd_kernel(Args args) {
    extern __shared__ __attribute__((aligned(16))) unsigned char lds_raw[];
    Frame F;
    F.lds = (LAS unsigned char*)lds_raw;
    F.ws0 = args.ws; F.ws = args.ws; F.ctl = (unsigned*)(args.ws + WS_CTL); F.out = args.out;
    F.wave0 = __builtin_amdgcn_readfirstlane((int)threadIdx.x >> 6); REFRESH(F);
    { const int bx = blockIdx.x; F.vcu = (bx % 8) * (NWG / 8) + bx / 8; }
    volatile LAS unsigned* MISC = (volatile LAS unsigned*)(F.lds + LDSX_OFF);
    if (F.tid < 16) MISC[F.tid] = 0u;
    __syncthreads();
    const int lo = args.ph_lo, hi = args.ph_hi;
    int nrep2 = 2; asm volatile("" : "+s"(nrep2));
    const bool multi = MK_ONE_LAUNCH ? true : (hi - lo) > 1; (void)lo; (void)hi;
    XcdBarrier bar; bar.bar = F.ctl + CW_BAR; bar.x = 0; bar.st = nullptr;
    if (multi) bar = xcd_barrier_post(F.ctl + CW_BAR, MISC + 8, F.tid);
    if (KON(0) && IN(PH_PROLOGUE)) for (int rp = NREP(0); rp > 0; --rp) phase_prologue(F);
    SEAM(PH_PROLOGUE);
    if (KON(1) && IN(PH_PRENORM)) for (int rp = NREP(1); rp > 0; --rp) phase_prenorm0(F);
    SEAM(PH_PRENORM);
    if (TSA >= 0) { if (blockIdx.x == 0 && F.tid == 0) __hip_atomic_store((unsigned long long*)(F.ctl + CW_TS), (unsigned long long)__builtin_amdgcn_s_memrealtime(), __ATOMIC_RELAXED, __HIP_MEMORY_SCOPE_AGENT); }
    run_layer<0>(F, bar, (const int*)args.in[I_POS], lo, hi, nrep2);
    run_layer<1>(F, bar, (const int*)args.in[I_POS], lo, hi, nrep2);
    if (TSA >= 0) {
        REFRESH(F);
        if (blockIdx.x == 0 && F.tid == 0) __hip_atomic_store((unsigned long long*)(F.ctl + CW_TS) + N_PHASES, (unsigned long long)__builtin_amdgcn_s_memrealtime(), __ATOMIC_RELAXED, __HIP_MEMORY_SCOPE_AGENT);
        xcd_barrier(bar, F.tid);
        const unsigned long long ta = __hip_atomic_load((unsigned long long*)(F.ctl + CW_TS) + TSA, __ATOMIC_RELAXED, __HIP_MEMORY_SCOPE_AGENT), tb = __hip_atomic_load((unsigned long long*)(F.ctl + CW_TS) + TSB, __ATOMIC_RELAXED, __HIP_MEMORY_SCOPE_AGENT);
        const float e = sqrtf((float)(((long long)(tb - ta) + 400) / 800 * 8) * 1e-4f);
        const int rpw = M / (NWG * 8);
        for (int k = 0; k < rpw; ++k) { const int m = (F.vcu * 8 + F.wave) * rpw + k; float x[16]; ld_f32_row(x, F.out + (size_t)m * D, F.lane);
#pragma unroll
            for (int i = 0; i < 16; ++i) x[i] *= (1.0f + e);
            st_f32_row(x, F.out + (size_t)m * D, F.lane); }
    }
#undef IN
#undef SEAM
}

extern "C" void kernel_launch(void* const* d_in, const int* in_sizes, int n_in, void* d_out, int out_size, void* d_ws, size_t ws_size, hipStream_t stream) {
    static int grid = 0;
    if (grid == 0) {
        if (n_in != 26 || out_size != M * D || ws_size < WS_END) { fprintf(stderr, "kernel_launch: unexpected problem: n_in %d out %d ws %zu (need %zu)\n", n_in, out_size, ws_size, (size_t)WS_END); grid = -1; return; }
        int dev = 0, cus = 0, per_cu = 0;
        if (hipGetDevice(&dev) != hipSuccess || hipDeviceGetAttribute(&cus, hipDeviceAttributeMultiprocessorCount, dev) != hipSuccess) { grid = -1; return; }
        if (hipFuncSetAttribute((const void*)fwd_kernel, hipFuncAttributeMaxDynamicSharedMemorySize, LDS_BYTES) != hipSuccess) { fprintf(stderr, "kernel_launch: hipFuncSetAttribute failed\n"); grid = -1; return; }
        if (hipOccupancyMaxActiveBlocksPerMultiprocessor(&per_cu, (const void*)fwd_kernel, 512, LDS_BYTES) != hipSuccess || per_cu < 1) fprintf(stderr, "kernel_launch: occupancy query says %d\n", per_cu);
        (void)hipGetLastError();
        if (cus != NWG) { fprintf(stderr, "kernel_launch: built for a %d-CU device, found %d\n", NWG, cus); grid = -1; return; }
        grid = NWG;
        fprintf(stderr, "kernel_launch: grid %d, ws %zu\n", grid, ws_size);
    }
    if (grid < 0) return;
    (void)hipMemsetAsync((char*)d_ws + WS_CTL, 0, CTL_ZERO_BYTES, stream);
    Args a{};
    for (int i = 0; i < 26; ++i) a.in[i] = d_in[i];
    a.out = (float*)d_out; a.ws = (unsigned char*)d_ws;
#if MK_ONE_LAUNCH
    a.ph_lo = 0; a.ph_hi = N_PHASES;
    hipLaunchKernelGGL(fwd_kernel, dim3(grid), dim3(512), LDS_BYTES, stream, a);
#else
    for (int p = 0; p < N_PHASES; ++p) { a.ph_lo = p; a.ph_hi = p + 1; hipLaunchKernelGGL(fwd_kernel, dim3(grid), dim3(512), LDS_BYTES, stream, a); }
#endif
}
```
